# Optimizing an MI355X kernel written in HIP

```python
import jax, jax.numpy as jnp
from jax import lax
import numpy as np

D_MODEL = 1024
BATCH = 2
SEQ = 16384
DEPTH = 4

N_META = 16
DEEPNORM_ALPHA = (2 * DEPTH) ** 0.25
DEEPNORM_BETA = (8 * DEPTH) ** -0.25
LN_EPS = 1e-5
RG_WIDTH = 1344
RG_BLOCKS = 8
RG_BLOCK_W = RG_WIDTH // RG_BLOCKS
RG_CONV_W = 4
RG_C = 8.0
GLA_HEADS = 4
GLA_DK = D_MODEL // 2 // GLA_HEADS
GLA_DV = D_MODEL // GLA_HEADS
GLA_QK = GLA_HEADS * GLA_DK
GLA_VD = GLA_HEADS * GLA_DV
GLA_RANK = 16
GLA_TAU = 16.0
GLA_CHUNK = 64
GLA_PAD = (-N_META) % GLA_CHUNK
D_FF = 3584
N_EXPERTS = 8
TOP_K = 2
N_REC = (DEPTH + 1) // 2
N_GLA = DEPTH // 2

kernel_name = "hybrid_rglru_gla_moe_deepnorm"


def _normalize(x):
    xf = x.astype(jnp.float32)
    mu = jnp.mean(xf, axis=-1, keepdims=True)
    xc = xf - mu
    var = jnp.mean(xc * xc, axis=-1, keepdims=True)
    return xc * lax.rsqrt(var + LN_EPS)


def layer_norm(x, g, b):
    return (_normalize(x) * g + b).astype(x.dtype)


def swiglu(h, w_in, w_out):
    gate, up = jnp.split(h @ w_in, 2, axis=-1)
    return (jax.nn.silu(gate) * up) @ w_out


def _linear_scan_combine(c1, c2):
    a1, b1 = c1
    a2, b2 = c2
    return a1 * a2, a2 * b1 + b2


def rglru_block(h, w_in, conv_w, conv_b, w_gates, b_gates, lam, w_out):
    Bsz, T, _ = h.shape
    proj = h @ w_in
    gate_branch, xr = jnp.split(proj, 2, axis=-1)
    xp = jnp.pad(xr, ((0, 0), (RG_CONV_W - 1, 0), (0, 0)))
    xc = conv_b
    for tap in range(RG_CONV_W):
        xc = xc + xp[:, tap:tap + T] * conv_w[tap]
    gates = jnp.einsum('btnc,gncd->gbtnd', xc.reshape(Bsz, T, RG_BLOCKS, RG_BLOCK_W), w_gates)
    gates = gates.reshape(2, Bsz, T, RG_WIDTH) + b_gates[:, None, None, :]
    gates = jax.nn.sigmoid(gates.astype(jnp.float32))
    r_t, i_t = gates[0], gates[1]
    log_a = -RG_C * r_t * jax.nn.softplus(-lam.astype(jnp.float32))
    a_t = jnp.exp(log_a)
    u_t = jnp.sqrt(-jnp.expm1(2.0 * log_a)) * (i_t * xc)
    _, hs = lax.associative_scan(_linear_scan_combine, (a_t, u_t), axis=1)
    y = hs * jax.nn.gelu(gate_branch.astype(jnp.float32))
    return (y @ w_out).astype(h.dtype)


def gla_block(h, w_in, w_gate_up, b_gate, norm_g, w_out):
    Bsz, T, _ = h.shape
    proj = h @ w_in
    q, k, v, r, z = jnp.split(
        proj, [GLA_QK, 2 * GLA_QK, 2 * GLA_QK + GLA_VD, 2 * GLA_QK + 2 * GLA_VD], axis=-1)
    log_g = jax.nn.log_sigmoid((z @ w_gate_up + b_gate).astype(jnp.float32)) / GLA_TAU
    L = T + GLA_PAD
    nc = L // GLA_CHUNK

    def to_chunks(t, d):
        t = jnp.pad(t, ((0, 0), (GLA_PAD, 0), (0, 0)))
        return t.reshape(Bsz, nc, GLA_CHUNK, GLA_HEADS, d).transpose(0, 3, 1, 2, 4)

    qc = to_chunks(q, GLA_DK) * (GLA_DK ** -0.5)
    kc = to_chunks(k, GLA_DK)
    vc = to_chunks(v, GLA_DV)
    gc = to_chunks(log_g, GLA_DK)
    b = jnp.cumsum(gc, axis=3)
    b_mid = b[:, :, :, GLA_CHUNK // 2 - 1:GLA_CHUNK // 2]
    b_last = b[:, :, :, -1:]
    scores = jnp.einsum('bhncd,bhnsd->bhncs', qc * jnp.exp(b - b_mid), kc * jnp.exp(b_mid - b))
    causal = jnp.tril(jnp.ones((GLA_CHUNK, GLA_CHUNK), dtype=bool))
    scores = jnp.where(causal, scores, 0.0)
    o_intra = jnp.einsum('bhncs,bhnse->bhnce', scores, vc)
    q_in = qc * jnp.exp(b)
    k_out = kc * jnp.exp(b_last - b)
    decay = jnp.exp(b_last[:, :, :, 0])

    def step(S, xs):
        qn, kn, vn, dn = xs
        o = jnp.einsum('bhcd,bhde->bhce', qn, S)
        S = dn[..., None] * S + jnp.einsum('bhcd,bhce->bhde', kn, vn)
        return S, o

    S0 = jnp.zeros((Bsz, GLA_HEADS, GLA_DK, GLA_DV), jnp.float32)
    xs = (jnp.moveaxis(q_in, 2, 0), jnp.moveaxis(k_out, 2, 0),
          jnp.moveaxis(vc, 2, 0), jnp.moveaxis(decay, 2, 0))
    _, o_inter = lax.scan(step, S0, xs)
    o = o_intra + jnp.moveaxis(o_inter, 0, 2)
    o = o.transpose(0, 2, 3, 1, 4).reshape(Bsz, L, GLA_HEADS, GLA_DV)[:, GLA_PAD:]
    o = _normalize(o) * norm_g
    o = o.reshape(Bsz, T, GLA_VD) * jax.nn.silu(r.astype(jnp.float32))
    return (o @ w_out).astype(h.dtype)


def moe_swiglu(h, router, w_in, w_out):
    Bsz, T, D = h.shape
    hf = h.reshape(Bsz * T, D)
    logits = (hf @ router).astype(jnp.float32)
    top_logit, top_idx = lax.top_k(logits, TOP_K)
    top_w = jax.nn.softmax(top_logit, axis=-1)
    gates = jnp.einsum('nk,nke->ne', top_w, jax.nn.one_hot(top_idx, N_EXPERTS, dtype=jnp.float32))
    y = jnp.zeros((Bsz * T, D), jnp.float32)
    for e in range(N_EXPERTS):
        y = y + gates[:, e:e + 1] * swiglu(hf, w_in[e], w_out[e])
    return y.reshape(Bsz, T, D).astype(h.dtype)


def setup_inputs(seed: int = 0) -> dict:
    key = jax.random.key(seed)
    ks = jax.random.split(key, 24)
    f32 = jnp.float32

    def nrm(k, shape, fan_in, scale=1.0):
        return jax.random.normal(k, shape, f32) * (scale * fan_in ** -0.5)

    x = jax.random.normal(ks[0], (BATCH, SEQ, D_MODEL), f32)
    meta_tokens = jax.random.normal(ks[1], (N_META, D_MODEL), f32)
    ln_gain = 1.0 + 0.02 * jax.random.normal(ks[2], (DEPTH, 2, D_MODEL), f32)
    ln_bias = 0.02 * jax.random.normal(ks[3], (DEPTH, 2, D_MODEL), f32)
    rg_w_in = nrm(ks[4], (N_REC, D_MODEL, 2 * RG_WIDTH), D_MODEL)
    rg_conv_w = nrm(ks[5], (N_REC, RG_CONV_W, RG_WIDTH), RG_CONV_W)
    rg_conv_b = 0.02 * jax.random.normal(ks[6], (N_REC, RG_WIDTH), f32)
    rg_w_gates = nrm(ks[7], (N_REC, 2, RG_BLOCKS, RG_BLOCK_W, RG_BLOCK_W), RG_BLOCK_W)
    rg_b_gates = 0.02 * jax.random.normal(ks[8], (N_REC, 2, RG_WIDTH), f32)
    a_pow_c = jax.random.uniform(ks[9], (N_REC, RG_WIDTH), f32, minval=0.9, maxval=0.999)
    a_base = a_pow_c ** (1.0 / RG_C)
    rg_lambda = jnp.log(a_base) - jnp.log1p(-a_base)
    rg_w_out = nrm(ks[10], (N_REC, RG_WIDTH, D_MODEL), RG_WIDTH, DEEPNORM_BETA)
    gla_w_in = nrm(ks[11], (N_GLA, D_MODEL, 2 * GLA_QK + 2 * GLA_VD + GLA_RANK), D_MODEL)
    gla_w_gate_up = nrm(ks[12], (N_GLA, GLA_RANK, GLA_QK), GLA_RANK)
    gla_b_gate = 2.0 + 0.1 * jax.random.normal(ks[13], (N_GLA, GLA_QK), f32)
    gla_norm_g = 1.0 + 0.02 * jax.random.normal(ks[14], (N_GLA, GLA_HEADS, GLA_DV), f32)
    gla_w_out = nrm(ks[15], (N_GLA, GLA_VD, D_MODEL), GLA_VD, DEEPNORM_BETA)
    ffn_w_in = nrm(ks[16], (N_REC, D_MODEL, 2 * D_FF), D_MODEL)
    ffn_w_out = nrm(ks[17], (N_REC, D_FF, D_MODEL), D_FF, DEEPNORM_BETA)
    moe_router = nrm(ks[18], (N_GLA, D_MODEL, N_EXPERTS), D_MODEL)
    moe_w_in = nrm(ks[19], (N_GLA, N_EXPERTS, D_MODEL, 2 * D_FF), D_MODEL)
    moe_w_out = nrm(ks[20], (N_GLA, N_EXPERTS, D_FF, D_MODEL), D_FF, DEEPNORM_BETA)
    return {
        "x": x, "meta_tokens": meta_tokens, "ln_gain": ln_gain, "ln_bias": ln_bias,
        "rg_w_in": rg_w_in, "rg_conv_w": rg_conv_w, "rg_conv_b": rg_conv_b,
        "rg_w_gates": rg_w_gates, "rg_b_gates": rg_b_gates, "rg_lambda": rg_lambda,
        "rg_w_out": rg_w_out,
        "gla_w_in": gla_w_in, "gla_w_gate_up": gla_w_gate_up, "gla_b_gate": gla_b_gate,
        "gla_norm_g": gla_norm_g, "gla_w_out": gla_w_out,
        "ffn_w_in": ffn_w_in, "ffn_w_out": ffn_w_out,
        "moe_router": moe_router, "moe_w_in": moe_w_in, "moe_w_out": moe_w_out,
    }


def reference(x, meta_tokens, ln_gain, ln_bias,
              rg_w_in, rg_conv_w, rg_conv_b, rg_w_gates, rg_b_gates, rg_lambda, rg_w_out,
              gla_w_in, gla_w_gate_up, gla_b_gate, gla_norm_g, gla_w_out,
              ffn_w_in, ffn_w_out, moe_router, moe_w_in, moe_w_out):
    Bsz = x.shape[0]
    meta = jnp.broadcast_to(meta_tokens.astype(x.dtype)[None], (Bsz, N_META, D_MODEL))
    h = jnp.concatenate([meta, x], axis=1)
    for i in range(DEPTH):
        j = i // 2
        if i % 2 == 0:
            mix = rglru_block(h, rg_w_in[j], rg_conv_w[j], rg_conv_b[j], rg_w_gates[j],
                              rg_b_gates[j], rg_lambda[j], rg_w_out[j])
        else:
            mix = gla_block(h, gla_w_in[j], gla_w_gate_up[j], gla_b_gate[j],
                            gla_norm_g[j], gla_w_out[j])
        h = layer_norm(DEEPNORM_ALPHA * h + mix, ln_gain[i, 0], ln_bias[i, 0])
        if i % 2 == 0:
            ff = swiglu(h, ffn_w_in[j], ffn_w_out[j]).astype(h.dtype)
        else:
            ff = moe_swiglu(h, moe_router[j], moe_w_in[j], moe_w_out[j])
        h = layer_norm(DEEPNORM_ALPHA * h + ff, ln_gain[i, 1], ln_bias[i, 1])
    return h[:, N_META:]
```

```cpp
#include <hip/hip_runtime.h>
#include <cstdio>
#include <cstdint>

#define GAS __attribute__((address_space(1)))
#define LAS __attribute__((address_space(3)))
typedef unsigned short bf16;
typedef unsigned v4u __attribute__((ext_vector_type(4)));
typedef unsigned v2u __attribute__((ext_vector_type(2)));
typedef float f32x4 __attribute__((ext_vector_type(4)));
typedef float f32x2 __attribute__((ext_vector_type(2)));
typedef short bf16x8 __attribute__((ext_vector_type(8)));
typedef short bf16x4 __attribute__((ext_vector_type(4)));
typedef GAS unsigned gu32;
#define RLX_AGENT __ATOMIC_RELAXED, __HIP_MEMORY_SCOPE_AGENT
#define LDS_WAIT() asm volatile("s_waitcnt lgkmcnt(0)" ::: "memory")
#define VM_WAIT() asm volatile("s_waitcnt vmcnt(0)" ::: "memory")

__device__ __forceinline__ unsigned f2bf(float f) { unsigned u = __builtin_bit_cast(unsigned, f); return (u + 0x7fffu + ((u >> 16) & 1u)) >> 16; }
__device__ __forceinline__ unsigned pk2(float lo, float hi) { return f2bf(lo) | (f2bf(hi) << 16); }
__device__ __forceinline__ float bflo(unsigned w) { return __builtin_bit_cast(float, w << 16); }
__device__ __forceinline__ float bfhi(unsigned w) { return __builtin_bit_cast(float, w & 0xffff0000u); }
__device__ __forceinline__ float bf2f(bf16 b) { return __builtin_bit_cast(float, (unsigned)b << 16); }
__device__ __forceinline__ unsigned cvt_pk_bf16(float lo, float hi) { unsigned r; asm volatile("v_cvt_pk_bf16_f32 %0, %1, %2" : "=v"(r) : "v"(lo), "v"(hi)); return r; }
__device__ __forceinline__ float fast_exp(float x) { return __builtin_amdgcn_exp2f(x * 1.44269504089f); }
__device__ __forceinline__ float sigmoid_f(float x) { return __builtin_amdgcn_rcpf(1.0f + fast_exp(-x)); }
__device__ __forceinline__ float silu_f(float x) { return x * sigmoid_f(x); }
__device__ __forceinline__ float gelu_tanh_f(float x) { const float u = 0.7978845608028654f * (x + 0.044715f * x * x * x); return x * sigmoid_f(2.0f * u); }
__device__ __forceinline__ float wave_sum(float v) {
#pragma unroll
    for (int o = 1; o < 64; o <<= 1) v += __shfl_xor(v, o);
    return v;
}

namespace pg8 {
constexpr int BM = 256, BK = 64, HALF = 128, HTB = HALF * BK * 2  , STAGE_BYTES = 8 * HTB, NXCD = 8, WGM = 8;
__host__ __device__ __forceinline__ int lds_byte(int r, int c) { const int st = (r >> 4) * 2 + (c >> 5), rr = r & 15, cc = c & 31, ob = rr * 64 + cc * 2; return st * 1024 + (ob ^ (((ob >> 9) & 1) << 5)); }
__host__ __device__ __forceinline__ void stage_rc(int b, int& R, int& C) { const int st = b / 1024, sb = b % 1024, swz = sb ^ (((sb >> 9) & 1) << 5); R = (st >> 1) * 16 + swz / 64; C = (st & 1) * 32 + (swz % 64) / 2; }
__host__ __device__ __forceinline__ int perm32(int rho) { const int n = rho >> 4, i = rho & 15; return 8 * (i >> 2) + 4 * n + (i & 3); }

struct Unit { int pm, pn; };
struct Gemm { int K, lda; };

struct OrderBase {
    int nM, nN, nwg, G, c;
    __device__ __forceinline__ void init_order(int nM_, int nN_, int G_, int c_) { nM = nM_; nN = nN_; nwg = nM * nN; G = G_; c = c_; }
    __device__ __forceinline__ bool next(int i, Unit& u) const {
        const long L = (long)i * G + c; if (L >= nwg) return false;
        int wgid = (int)L; { const int q = nwg / NXCD, r = nwg % NXCD, xcd = wgid % NXCD, off = wgid / NXCD; wgid = (xcd < r ? xcd * (q + 1) : r * (q + 1) + (xcd - r) * q) + off; }
        const int nig = WGM * nN, gid = wgid / nig, fm = gid * WGM, gsz = (nM - fm) < WGM ? (nM - fm) : WGM;
        u.pm = fm + ((wgid % nig) % gsz); u.pn = (wgid % nig) / gsz; return true;
    }
};
struct DenseOrder : OrderBase {
    const char* A; const char* Bt; size_t a_tile, b_tile;
    __device__ __forceinline__ void init(const bf16* A_, int lda, const bf16* Bt_, int K, int nM_, int nN_, int G_, int c_) { A = (const char*)A_; Bt = (const char*)Bt_; a_tile = (size_t)BM * lda * 2; b_tile = (size_t)BM * K * 2; init_order(nM_, nN_, G_, c_); }
    __device__ __forceinline__ const char* a_base(const Unit& u) const { return A + (size_t)u.pm * a_tile; }
    __device__ __forceinline__ const char* b_base(const Unit& u) const { return Bt + (size_t)u.pn * b_tile; }
};
struct GatesOrder : DenseOrder {
    __device__ __forceinline__ const char* a_base(const Unit& u) const { return A + (size_t)u.pm * a_tile + (size_t)(u.pn >> 1) * 512; }
};
struct MoeOrder : DenseOrder {
    int pe[8]; size_t e_bytes;
    __device__ __forceinline__ const char* b_base(const Unit& u) const {
        int e = 0;
#pragma unroll
        for (int j = 0; j < 7; ++j) e += (u.pm >= pe[j]) ? 1 : 0;
        return Bt + (size_t)e * e_bytes + (size_t)u.pn * b_tile;
    }
};

template <class Epi, class Sched, bool ALIGN_EPI = true>
__device__ __forceinline__ void gemm_phase(LAS unsigned char* lds, const int tid, const Gemm g, const Sched& S, const Epi& E) {
    const int wid = __builtin_amdgcn_readfirstlane(tid >> 6), lane = tid & 63, wr = wid >> 2, wc = wid & 3, fr = lane & 15, fq = lane >> 4;
    const int K = g.K, nt = K / BK;
    unsigned voffA[2], voffB[2];
#pragma unroll
    for (int i = 0; i < 2; ++i) { int R, C; stage_rc(tid * 16 + i * 8192, R, C); const int Rb = Epi::PERM ? ((R & ~31) + perm32(R & 31)) : R;
        voffA[i] = (unsigned)(R * g.lda + C) * 2u; voffB[i] = (unsigned)(Rb * K + C) * 2u; }
    const size_t kstep = (size_t)(BK * 2);
    const size_t hstepA = (size_t)HALF * g.lda * 2, hstepB = (size_t)HALF * K * 2;
    const unsigned ldsw = (unsigned)wid * 1024u;
    const int aoff = lds_byte(wr * 64 + fr, fq * 8), boff = lds_byte(wc * 32 + fr, fq * 8);
#define PG8_SA(b, h) (((b) * 2 + (h)) * HTB)
#define PG8_SB(b, h) ((4 + (b) * 2 + (h)) * HTB)
#define PG8_STAGE(bufoff, gbase, voff) do { _Pragma("unroll") for (int _i = 0; _i < 2; ++_i) \
        __builtin_amdgcn_global_load_lds((const unsigned*)((const char*)(gbase) + (voff)[_i]), (LAS unsigned*)(lds + (bufoff) + ldsw + _i * 8192), 16, 0, 0); } while (0)
#define PG8_LDA(dst, b, h) do { _Pragma("unroll") for (int m = 0; m < 4; ++m) _Pragma("unroll") for (int k = 0; k < 2; ++k) dst[m][k] = *(const LAS bf16x8*)(lds + PG8_SA(b, h) + aoff + m * 2048 + k * 1024); } while (0)
#define PG8_LDB(dst, b, h) do { _Pragma("unroll") for (int n = 0; n < 2; ++n) _Pragma("unroll") for (int k = 0; k < 2; ++k) dst[n][k] = *(const LAS bf16x8*)(lds + PG8_SB(b, h) + boff + n * 2048 + k * 1024); } while (0)
#define PG8_MMA(ai, bj, At, Bt) do { __builtin_amdgcn_s_setprio(1); _Pragma("unroll") for (int m = 0; m < 4; ++m) _Pragma("unroll") for (int n = 0; n < 2; ++n) _Pragma("unroll") for (int k = 0; k < 2; ++k) \
        acc[ai][bj][m][n] = __builtin_amdgcn_mfma_f32_16x16x32_bf16(Bt[n][k], At[m][k], acc[ai][bj][m][n], 0, 0, 0); __builtin_amdgcn_s_setprio(0); } while (0)
#define PG8_WAIT_V(n) asm volatile("s_waitcnt vmcnt(" #n ")" ::: "memory")
#define PG8_WAIT_L(n) asm volatile("s_waitcnt lgkmcnt(" #n ")" ::: "memory")
#define PG8_BAR __builtin_amdgcn_s_barrier()
#define PG8_SCHED __builtin_amdgcn_sched_barrier(0)
    Unit cur, nxt; int ui = 0;
    if (!S.next(0, cur)) return;
    f32x4 acc[2][2][4][2];
#pragma unroll
    for (int a = 0; a < 2; ++a)
#pragma unroll
        for (int b = 0; b < 2; ++b)
#pragma unroll
            for (int m = 0; m < 4; ++m)
#pragma unroll
                for (int n = 0; n < 2; ++n) acc[a][b][m][n] = (f32x4){0.f, 0.f, 0.f, 0.f};
    bf16x8 At[4][2], B0[2][2], B1[2][2];
    const char* cA = S.a_base(cur); const char* cB = S.b_base(cur);
    PG8_STAGE(PG8_SB(0, 0), cB, voffB); PG8_STAGE(PG8_SB(0, 1), cB + hstepB, voffB); PG8_STAGE(PG8_SA(0, 0), cA, voffA); PG8_STAGE(PG8_SA(0, 1), cA + hstepA, voffA);
    if (wr == 1) PG8_BAR;
    PG8_WAIT_V(2); PG8_BAR;
    PG8_STAGE(PG8_SB(1, 0), cB + kstep, voffB); PG8_STAGE(PG8_SA(1, 0), cA + kstep, voffA); PG8_STAGE(PG8_SB(1, 1), cB + hstepB + kstep, voffB);
    PG8_WAIT_V(6); PG8_BAR;
    for (;;) {
        const bool has_next = S.next(ui + 1, nxt);
        const char* nA = has_next ? S.a_base(nxt) : cA; const char* nB = has_next ? S.b_base(nxt) : cB;
#pragma nounroll
        for (int t = 0; t < nt; t += 2) {
            const bool last = (t == nt - 2);
            const char* a1 = cA + (size_t)(t + 1) * kstep;
            const char* a2 = last ? nA : cA + (size_t)(t + 2) * kstep; const char* b2 = last ? nB : cB + (size_t)(t + 2) * kstep;
            const char* a3 = a2 + kstep; const char* b3 = b2 + kstep;
            PG8_LDB(B0, 0, 0); PG8_LDB(B1, 0, 1); PG8_SCHED; PG8_LDA(At, 0, 0); PG8_STAGE(PG8_SA(1, 1), a1 + hstepA, voffA);
            PG8_WAIT_V(8); PG8_WAIT_L(0); PG8_BAR; PG8_MMA(0, 0, At, B0); PG8_MMA(0, 1, At, B1); PG8_BAR; PG8_SCHED;
            PG8_LDA(At, 0, 1); PG8_STAGE(PG8_SB(0, 0), b2, voffB); PG8_STAGE(PG8_SB(0, 1), b2 + hstepB, voffB); PG8_STAGE(PG8_SA(0, 0), a2, voffA);
            PG8_WAIT_V(8); PG8_WAIT_L(0); PG8_BAR; PG8_MMA(1, 0, At, B0); PG8_MMA(1, 1, At, B1); PG8_BAR; PG8_SCHED;
            PG8_LDB(B0, 1, 0); PG8_LDB(B1, 1, 1); PG8_SCHED; PG8_LDA(At, 1, 0); PG8_STAGE(PG8_SA(0, 1), a2 + hstepA, voffA);
            PG8_WAIT_V(8); PG8_WAIT_L(0); PG8_BAR; PG8_MMA(0, 0, At, B0); PG8_MMA(0, 1, At, B1); PG8_BAR; PG8_SCHED;
            PG8_LDA(At, 1, 1); PG8_STAGE(PG8_SB(1, 0), b3, voffB); PG8_STAGE(PG8_SB(1, 1), b3 + hstepB, voffB); PG8_STAGE(PG8_SA(1, 0), a3, voffA);
            PG8_WAIT_V(8); PG8_WAIT_L(0); PG8_BAR; PG8_MMA(1, 0, At, B0); PG8_MMA(1, 1, At, B1); PG8_BAR; PG8_SCHED;
        }
        if constexpr (ALIGN_EPI) { if (wr == 0) PG8_BAR; }
        E(acc, cur, wr, wc, fr, fq);
        if (!has_next) break;
#pragma unroll
        for (int a = 0; a < 2; ++a)
#pragma unroll
            for (int b = 0; b < 2; ++b)
#pragma unroll
                for (int m = 0; m < 4; ++m)
#pragma unroll
                    for (int n = 0; n < 2; ++n) acc[a][b][m][n] = (f32x4){0.f, 0.f, 0.f, 0.f};
        cur = nxt; cA = nA; cB = nB; ++ui;
        if constexpr (ALIGN_EPI) { if (wr == 1) PG8_BAR; }
    }
    PG8_WAIT_V(0);
    if constexpr (!ALIGN_EPI) { if (wr == 0) PG8_BAR; }
    PG8_BAR;
#undef PG8_SA
#undef PG8_SB
#undef PG8_STAGE
#undef PG8_LDA
#undef PG8_LDB
#undef PG8_MMA
#undef PG8_WAIT_V
#undef PG8_WAIT_L
#undef PG8_BAR
#undef PG8_SCHED
}
}
#define XB_TMO      128
#define XB_XCNT(j)  (256  + 64 * (j))
#define XB_XSUB(j)  (1280 + 64 * (j))
#define XB_XGEN(j)  (2304 + 64 * (j))
#define XB_TOP      3328
#define XB_TOPGEN   3392
#define XCD_BAR_WORDS 3456
#define XB_SPIN_CAP (1u << 18)

__device__ __forceinline__ unsigned xb_ld(unsigned* p)              { return __hip_atomic_load(p, __ATOMIC_RELAXED, __HIP_MEMORY_SCOPE_AGENT); }
__device__ __forceinline__ unsigned xb_add(unsigned* p, unsigned v) { return __hip_atomic_fetch_add(p, v, __ATOMIC_RELAXED, __HIP_MEMORY_SCOPE_AGENT); }
__device__ __forceinline__ unsigned xb_xcc_id() { return (unsigned)__builtin_amdgcn_s_getreg((3 << 11) | 20) & 0xFu; }
#define XB_SPIN(cond, bar) do { unsigned _sp = 0; while (cond) { __builtin_amdgcn_s_sleep(1); \
    if ((++_sp & 255u) == 0u) { if (xb_ld(&(bar)[XB_TMO])) break; if (_sp > XB_SPIN_CAP) { atomicAdd(&(bar)[XB_TMO], 1u); break; } } } } while (0)

struct XcdBarrier {
    unsigned* bar; unsigned x;
    volatile LAS unsigned* st;
};

__device__ __forceinline__ XcdBarrier xcd_barrier_post(unsigned* bar, volatile LAS unsigned* st) {
    XcdBarrier b; b.bar = bar; b.x = xb_xcc_id(); b.st = st;
    if (threadIdx.x == 0) (void)xb_add(&bar[XB_XCNT(b.x)], 1u);
    return b;
}
__device__ __forceinline__ void xcd_barrier_complete(unsigned* bar, unsigned x, unsigned& nloc, unsigned& nx) {
    const unsigned G = gridDim.x * gridDim.y * gridDim.z;
    unsigned sum, cnt, mine, sp = 0u;
    for (;;) {
        sum = 0u; cnt = 0u; mine = 0u;
#pragma unroll
        for (unsigned j = 0; j < 16; ++j) { const unsigned c = xb_ld(&bar[XB_XCNT(j)]); sum += c; cnt += (c > 0u) ? 1u : 0u; mine = (j == x) ? c : mine; }
        if (sum == G) break;
        __builtin_amdgcn_s_sleep(1);
        if ((++sp & 255u) == 0u) { if (xb_ld(&bar[XB_TMO])) break; if (sp > XB_SPIN_CAP) { atomicAdd(&bar[XB_TMO], 1u); break; } }
    }
    nloc = mine > 0u ? mine : 1u; nx = cnt > 0u ? cnt : 1u;
}

__device__ __forceinline__ void xcd_barrier(const XcdBarrier& b) {
    asm volatile("s_waitcnt vmcnt(0)" ::: "memory");
    __syncthreads();
    if (threadIdx.x == 0) {
        unsigned* bar = b.bar;
        __builtin_amdgcn_s_waitcnt(0);
        unsigned nloc = b.st[0], nx = b.st[1];
        if (nloc == 0u) { xcd_barrier_complete(bar, b.x, nloc, nx); b.st[0] = nloc; b.st[1] = nx; }
        const unsigned old = xb_add(&bar[XB_XSUB(b.x)], 1u);
        const unsigned gen = old / nloc;
        if (old + 1u == (gen + 1u) * nloc) {
            __builtin_amdgcn_fence(__ATOMIC_RELEASE, "agent");
            asm volatile("s_waitcnt vmcnt(0)" ::: "memory");
            const unsigned og = xb_add(&bar[XB_TOP], 1u);
            const unsigned tg = og / nx;
            if (og + 1u == (tg + 1u) * nx) xb_add(&bar[XB_TOPGEN], 1u);
            else XB_SPIN(xb_ld(&bar[XB_TOPGEN]) == tg, bar);
            __builtin_amdgcn_fence(__ATOMIC_ACQUIRE, "agent");
            xb_add(&bar[XB_XGEN(b.x)], 1u);
            asm volatile("s_waitcnt vmcnt(0)" ::: "memory");
        } else {
            XB_SPIN(xb_ld(&bar[XB_XGEN(b.x)]) == gen, bar);
            __builtin_amdgcn_fence(__ATOMIC_ACQUIRE, "agent");
            asm volatile("s_waitcnt vmcnt(0)" ::: "memory");
        }
    }
    __syncthreads();
}

constexpr int NWAVES = 8, NTHR = 512;
constexpr int D = 1024, BATCH = 2, SEQ = 16384, NMETA = 16;
constexpr int MMAIN = BATCH * SEQ;
constexpr int MROWS = MMAIN + NMETA;
constexpr int MPAD = MMAIN + 256;
constexpr int RGW = 1344, RGBW = 168, NRG = 2816  , KRGO = 1408  , NGT = 4096, KGT = 256, XCW = 2048;
constexpr int FF = 3584, NE = 8, NFF2 = 2 * FF;
constexpr int GH = 4, GDK = 128, GDV = 256, GQK = 512, GVD = 1024, NGLA = 3072, GLAW = 3088, GRANK = 16;
constexpr int MSORT = 265 * 256;
constexpr float LN_EPS = 1e-5f, ALPHA = 1.6817928305074290f;
constexpr int SEG = 128, NSEG_B = SEQ / SEG, NSEG = 1 + BATCH * NSEG_B;
constexpr int CPS = 4, NSC_BH = SEQ / (64 * CPS), NGU = BATCH * GH * NSC_BH + GH;

constexpr size_t MiB = 1u << 20;
constexpr size_t WS_CTL = 0, CTL_ZERO_BYTES = 1 * MiB;
constexpr size_t WL_RGIN = 0, WL_GATES = WL_RGIN + (size_t)NRG * D * 2, WL_RGOUT = WL_GATES + (size_t)NGT * KGT * 2, WL_GLAIN = WL_RGOUT + (size_t)D * KRGO * 2,
                 WL_GLAOUT = WL_GLAIN + (size_t)NGLA * D * 2, WL_FFNIN = WL_GLAOUT + (size_t)D * D * 2, WL_FFNOUT = WL_FFNIN + (size_t)NFF2 * D * 2,
                 WL_MOEIN = WL_FFNOUT + (size_t)D * FF * 2, WL_MOEOUT = WL_MOEIN + (size_t)NE * NFF2 * D * 2, WL_STRIDE = WL_MOEOUT + (size_t)NE * D * FF * 2;
constexpr size_t WS_W = 1 * MiB;
constexpr size_t WS_H = WS_W + 2 * WL_STRIDE;
constexpr size_t WS_HB = WS_H + (size_t)MPAD * D * 4;
constexpr size_t WS_MIX = WS_HB + (size_t)MPAD * D * 2;
constexpr size_t WS_Z = WS_MIX + (size_t)MPAD * D * 4;
constexpr size_t WS_RT = WS_Z + 3 * MiB;
constexpr size_t WS_AGG = WS_RT + 1 * MiB;
constexpr size_t WS_S0 = WS_AGG + 3 * MiB;
constexpr size_t S_PROJ = 0, S_XC = S_PROJ + (size_t)MPAD * NRG * 2, S_LOGA = S_XC + (size_t)MPAD * XCW * 2, S_U = S_LOGA + (size_t)MPAD * RGW * 4, S_Y = S_U + (size_t)MPAD * RGW * 4, S_RG_END = S_Y + (size_t)MPAD * KRGO * 2;
constexpr size_t S_HID = 0;
constexpr size_t S_QKVR = 0, S_KVS = S_QKVR + (size_t)MPAD * NGLA * 2, S_SST = S_KVS + (size_t)NGU * GDK * GDV * 4, S_O = S_SST + (size_t)NGU * GDK * GDV * 4, S_DEC = S_O + (size_t)MPAD * D * 2, S_GLA_END = S_DEC + 1 * MiB;
constexpr size_t S_AS = 0, S_HS = S_AS + (size_t)MSORT * D * 2, S_YS = S_HS + (size_t)MSORT * FF * 2, S_MOE_END = S_YS + (size_t)MSORT * D * 4;
constexpr size_t S_MAX = S_RG_END > S_MOE_END ? (S_RG_END > S_GLA_END ? S_RG_END : S_GLA_END) : (S_MOE_END > S_GLA_END ? S_MOE_END : S_GLA_END);
constexpr size_t WS_END = WS_S0 + S_MAX;
constexpr int CW_TMO = 0, CW_BAR = 4096, CW_MOE = 8192;

constexpr int LDS_BYTES = 163840, MISC_OFF = LDS_BYTES - 64;

struct Frame {
    LAS unsigned char* lds; gu32* ctl; unsigned char* ws;
    int tid, lane, wave, G, bx;
    __device__ __forceinline__ void fresh() { asm volatile("" : "+v"(tid)); asm volatile("" : "+s"(bx)); asm volatile("" : "+s"(ws)); lane = tid & 63; wave = __builtin_amdgcn_readfirstlane(tid >> 6); ctl = (gu32*)(ws + WS_CTL); }
};
struct Args { const float* in[21]; float* out; unsigned char* ws; int ph_lo, ph_hi; unsigned submask; int pad; };

struct EpiBf16Gelu {
    static constexpr bool PERM = true, PAIR = false;
    bf16* O; int ldc, gelu_cols;
    __device__ __forceinline__ void operator()(const f32x4 (&acc)[2][2][4][2], const pg8::Unit& u, int wr, int wc, int fr, int fq) const {
        const int row0 = u.pm * 256 + wr * 64 + fr, col0 = u.pn * 256 + wc * 32 + 8 * fq;
#pragma unroll
        for (int ai = 0; ai < 2; ++ai)
#pragma unroll
            for (int m = 0; m < 4; ++m) { bf16* rowp = O + (size_t)(row0 + ai * 128 + m * 16) * ldc + col0;
#pragma unroll
                for (int bj = 0; bj < 2; ++bj) { f32x4 v0 = acc[ai][bj][m][0], v1 = acc[ai][bj][m][1];
                    if (col0 + bj * 128 < gelu_cols) {
#pragma unroll
                        for (int j = 0; j < 4; ++j) { v0[j] = gelu_tanh_f(v0[j]); v1[j] = gelu_tanh_f(v1[j]); } }
                    v4u w; w.x = cvt_pk_bf16(v0[0], v0[1]); w.y = cvt_pk_bf16(v0[2], v0[3]); w.z = cvt_pk_bf16(v1[0], v1[1]); w.w = cvt_pk_bf16(v1[2], v1[3]);
                    *(v4u*)(rowp + bj * 128) = w; } }
    }
    __device__ __forceinline__ void meta_task(int task, int& r0, int& aoff) const { r0 = task * 16; aoff = 0; }
    __device__ __forceinline__ void meta(int task, f32x4 a0, f32x4, int fr, int fq) const {
        const int col = task * 16 + 4 * fq;
        if (col < gelu_cols) {
#pragma unroll
            for (int j = 0; j < 4; ++j) a0[j] = gelu_tanh_f(a0[j]); }
        v2u w; w.x = cvt_pk_bf16(a0[0], a0[1]); w.y = cvt_pk_bf16(a0[2], a0[3]);
        *(v2u*)(O + (size_t)(MMAIN + fr) * ldc + col) = w;
    }
};
struct EpiSwiglu {
    static constexpr bool PERM = true, PAIR = true;
    bf16* O; int ldc;
    __device__ __forceinline__ void operator()(const f32x4 (&acc)[2][2][4][2], const pg8::Unit& u, int wr, int wc, int fr, int fq) const {
        const int row0 = u.pm * 256 + wr * 64 + fr, col0 = u.pn * 128 + wc * 32 + 8 * fq;
#pragma unroll
        for (int ai = 0; ai < 2; ++ai)
#pragma unroll
            for (int m = 0; m < 4; ++m) { bf16* rowp = O + (size_t)(row0 + ai * 128 + m * 16) * ldc + col0;
                f32x4 g0 = acc[ai][0][m][0], g1 = acc[ai][0][m][1]; const f32x4 u0 = acc[ai][1][m][0], u1 = acc[ai][1][m][1];
#pragma unroll
                for (int j = 0; j < 4; ++j) { g0[j] = silu_f(g0[j]) * u0[j]; g1[j] = silu_f(g1[j]) * u1[j]; }
                v4u w; w.x = cvt_pk_bf16(g0[0], g0[1]); w.y = cvt_pk_bf16(g0[2], g0[3]); w.z = cvt_pk_bf16(g1[0], g1[1]); w.w = cvt_pk_bf16(g1[2], g1[3]);
                *(v4u*)rowp = w; }
    }
    __device__ __forceinline__ void meta_task(int task, int& r0, int& aoff) const { r0 = (task >> 3) * 256 + (task & 7) * 16; aoff = 0; }
    __device__ __forceinline__ void meta(int task, f32x4 a0, f32x4 a1, int fr, int fq) const {
        const int col = (task >> 3) * 128 + (task & 7) * 16 + 4 * fq;
#pragma unroll
        for (int j = 0; j < 4; ++j) a0[j] = silu_f(a0[j]) * a1[j];
        v2u w; w.x = cvt_pk_bf16(a0[0], a0[1]); w.y = cvt_pk_bf16(a0[2], a0[3]);
        *(v2u*)(O + (size_t)(MMAIN + fr) * ldc + col) = w;
    }
};
struct EpiF32 {
    static constexpr bool PERM = false, PAIR = false;
    float* C; int ldc;
    __device__ __forceinline__ void operator()(const f32x4 (&acc)[2][2][4][2], const pg8::Unit& u, int wr, int wc, int fr, int fq) const {
        const int row0 = u.pm * 256 + wr * 64 + fr, col0 = u.pn * 256 + wc * 32 + 4 * fq;
#pragma unroll
        for (int ai = 0; ai < 2; ++ai)
#pragma unroll
            for (int m = 0; m < 4; ++m) { float* rowp = C + (size_t)(row0 + ai * 128 + m * 16) * ldc + col0;
#pragma unroll
                for (int bj = 0; bj < 2; ++bj)
#pragma unroll
                    for (int n = 0; n < 2; ++n) *(f32x4*)(rowp + bj * 128 + n * 16) = acc[ai][bj][m][n]; }
    }
    __device__ __forceinline__ void meta_task(int task, int& r0, int& aoff) const { r0 = task * 16; aoff = 0; }
    __device__ __forceinline__ void meta(int task, f32x4 a0, f32x4, int fr, int fq) const { *(f32x4*)(C + (size_t)(MMAIN + fr) * ldc + task * 16 + 4 * fq) = a0; }
};

template <class Epi>
__device__ __forceinline__ void meta_gemm(Frame& F, const bf16* A16, int lda, int K, const bf16* Bt, int ntasks, const Epi& E) {
    const int fr = F.lane & 15, fq = F.lane >> 4;
    LAS f32x4* red = (LAS f32x4*)F.lds;
    for (int task = F.bx; task < ntasks; task += F.G) {
        int r0, aoff; E.meta_task(task, r0, aoff);
        f32x4 acc0 = (f32x4){0.f, 0.f, 0.f, 0.f}, acc1 = acc0;
        const bf16* ap = A16 + (size_t)fr * lda + aoff + fq * 8; const bf16* bp0 = Bt + (size_t)(r0 + fr) * K + fq * 8; const bf16* bp1 = bp0 + (size_t)128 * K;
        for (int ks = F.wave; ks < K / 32; ks += NWAVES) {
            const bf16x8 a = *(const bf16x8*)(ap + ks * 32); const bf16x8 b0 = *(const bf16x8*)(bp0 + ks * 32);
            acc0 = __builtin_amdgcn_mfma_f32_16x16x32_bf16(b0, a, acc0, 0, 0, 0);
            if (Epi::PAIR) { const bf16x8 b1 = *(const bf16x8*)(bp1 + ks * 32); acc1 = __builtin_amdgcn_mfma_f32_16x16x32_bf16(b1, a, acc1, 0, 0, 0); }
        }
        red[(F.wave * 2 + 0) * 64 + F.lane] = acc0; if (Epi::PAIR) red[(F.wave * 2 + 1) * 64 + F.lane] = acc1;
        __syncthreads();
        if (F.wave == 0) {
            f32x4 s0 = red[F.lane], s1 = Epi::PAIR ? red[64 + F.lane] : acc1;
#pragma unroll
            for (int w = 1; w < NWAVES; ++w) { s0 += red[(w * 2) * 64 + F.lane]; if (Epi::PAIR) s1 += red[(w * 2 + 1) * 64 + F.lane]; }
            E.meta(task, s0, s1, fr, fq);
        }
        __syncthreads();
    }
}

__device__ __forceinline__ void transpose_item(const float* W, int ldw, int Ksrc, int c0, int nvalid, bf16* WT, int Kdst, int n0, int k0, LAS float* scr, int lane) {
#pragma unroll 8
    for (int i = 0; i < 32; ++i) { const int kk = 2 * i + (lane >> 5), c = lane & 31;
        const bool ok = (k0 + kk < Ksrc) && (c < nvalid); const float v = W[ok ? (size_t)(k0 + kk) * ldw + c0 + c : (size_t)0];
        scr[kk * 33 + c] = ok ? v : 0.f; }
    LDS_WAIT(); asm volatile("" ::: "memory");
    const int c = lane & 7;
#pragma unroll
    for (int j = 0; j < 4; ++j) { const int n = (lane >> 3) + 8 * j; const LAS float* s = scr + (8 * c) * 33 + n;
        v4u o; o.x = pk2(s[0 * 33], s[1 * 33]); o.y = pk2(s[2 * 33], s[3 * 33]); o.z = pk2(s[4 * 33], s[5 * 33]); o.w = pk2(s[6 * 33], s[7 * 33]);
        *(v4u*)(WT + (size_t)(n0 + n) * Kdst + k0 + 8 * c) = o; }
    LDS_WAIT(); asm volatile("" ::: "memory");
}
__device__ __forceinline__ void map_id(int n0, int nsrc, int& c0, int& nv) { c0 = n0; nv = nsrc - n0; nv = nv < 0 ? 0 : (nv > 32 ? 32 : nv); if (nv == 0) c0 = 0; }
__device__ __forceinline__ void map_swiglu(int n0, int& c0, int& nv) { const int tile = n0 >> 8, rr = n0 & 255; c0 = rr < 128 ? tile * 128 + rr : FF + tile * 128 + rr - 128; nv = 32; }

__device__ __forceinline__ void p0_prologue(Frame& F, const Args& a) {
    LAS float* scr = (LAS float*)(F.lds + F.wave * 16384);
    const int gw = F.bx * NWAVES + F.wave, NGW = F.G * NWAVES;
    constexpr int I_RGIN = (D / 64) * (NRG / 32), I_GATES = (KGT / 64) * (NGT / 32), I_RGOUT = (KRGO / 64) * (D / 32), I_GLAIN = (D / 64) * (NGLA / 32), I_GLAOUT = (D / 64) * (D / 32),
                  I_FFNIN = (D / 64) * (NFF2 / 32), I_FFNOUT = (FF / 64) * (D / 32), I_MOEIN = NE * I_FFNIN, I_MOEOUT = NE * I_FFNOUT;
    constexpr int I_PER_J = I_RGIN + I_GATES + I_RGOUT + I_GLAIN + I_GLAOUT + I_FFNIN + I_FFNOUT + I_MOEIN + I_MOEOUT;
    for (int it = gw; it < 2 * I_PER_J; it += NGW) {
        const int j = it / I_PER_J; int r = it - j * I_PER_J;
        unsigned char* wl = F.ws + WS_W + (size_t)j * WL_STRIDE;
        int c0, nv;
        if (r < I_RGIN) { const int nb = r % (NRG / 32), kb = r / (NRG / 32); map_id(nb * 32, 2 * RGW, c0, nv);
            transpose_item(a.in[4] + (size_t)j * D * 2 * RGW, 2 * RGW, D, c0, nv, (bf16*)(wl + WL_RGIN), D, nb * 32, kb * 64, scr, F.lane); continue; } r -= I_RGIN;
        if (r < I_GATES) { const int nb = r % (NGT / 32), kb = r / (NGT / 32); const int n0 = nb * 32, pn = n0 >> 8, rr = n0 & 255, g = rr >> 7, cc = rr & 127, d0 = (pn & 1) * 128 + cc, blk = pn >> 1;
            nv = RGBW - d0; nv = nv < 0 ? 0 : (nv > 32 ? 32 : nv); c0 = nv ? d0 : 0;
            transpose_item(a.in[7] + ((size_t)(j * 2 + g) * 8 + blk) * RGBW * RGBW, RGBW, RGBW, c0, nv, (bf16*)(wl + WL_GATES), KGT, n0, kb * 64, scr, F.lane); continue; } r -= I_GATES;
        if (r < I_RGOUT) { const int nb = r % (D / 32), kb = r / (D / 32);
            transpose_item(a.in[10] + (size_t)j * RGW * D, D, RGW, nb * 32, 32, (bf16*)(wl + WL_RGOUT), KRGO, nb * 32, kb * 64, scr, F.lane); continue; } r -= I_RGOUT;
        if (r < I_GLAIN) { const int nb = r % (NGLA / 32), kb = r / (NGLA / 32);
            transpose_item(a.in[11] + (size_t)j * D * GLAW, GLAW, D, nb * 32, 32, (bf16*)(wl + WL_GLAIN), D, nb * 32, kb * 64, scr, F.lane); continue; } r -= I_GLAIN;
        if (r < I_GLAOUT) { const int nb = r % (D / 32), kb = r / (D / 32);
            transpose_item(a.in[15] + (size_t)j * D * D, D, D, nb * 32, 32, (bf16*)(wl + WL_GLAOUT), D, nb * 32, kb * 64, scr, F.lane); continue; } r -= I_GLAOUT;
        if (r < I_FFNIN) { const int nb = r % (NFF2 / 32), kb = r / (NFF2 / 32); map_swiglu(nb * 32, c0, nv);
            transpose_item(a.in[16] + (size_t)j * D * NFF2, NFF2, D, c0, nv, (bf16*)(wl + WL_FFNIN), D, nb * 32, kb * 64, scr, F.lane); continue; } r -= I_FFNIN;
        if (r < I_FFNOUT) { const int nb = r % (D / 32), kb = r / (D / 32);
            transpose_item(a.in[17] + (size_t)j * FF * D, D, FF, nb * 32, 32, (bf16*)(wl + WL_FFNOUT), FF, nb * 32, kb * 64, scr, F.lane); continue; } r -= I_FFNOUT;
        if (r < I_MOEIN) { const int e = r / I_FFNIN, r2 = r % I_FFNIN; const int nb = r2 % (NFF2 / 32), kb = r2 / (NFF2 / 32); map_swiglu(nb * 32, c0, nv);
            transpose_item(a.in[19] + ((size_t)j * NE + e) * D * NFF2, NFF2, D, c0, nv, (bf16*)(wl + WL_MOEIN) + (size_t)e * NFF2 * D, D, nb * 32, kb * 64, scr, F.lane); continue; } r -= I_MOEIN;
        { const int e = r / I_FFNOUT, r2 = r % I_FFNOUT; const int nb = r2 % (D / 32), kb = r2 / (D / 32);
            transpose_item(a.in[20] + ((size_t)j * NE + e) * FF * D, D, FF, nb * 32, 32, (bf16*)(wl + WL_MOEOUT) + (size_t)e * D * FF, FF, nb * 32, kb * 64, scr, F.lane); }
    }
    float* H = (float*)(F.ws + WS_H); bf16* HB = (bf16*)(F.ws + WS_HB);
    for (int m = gw; m < MROWS; m += NGW) {
        const float* src = m < MMAIN ? a.in[0] + (size_t)m * D : a.in[1] + (size_t)(m - MMAIN) * D;
#pragma unroll
        for (int q = 0; q < 4; ++q) { const f32x4 v = *(const f32x4*)(src + 4 * F.lane + 256 * q);
            *(f32x4*)(H + (size_t)m * D + 4 * F.lane + 256 * q) = v;
            v2u w; w.x = pk2(v[0], v[1]); w.y = pk2(v[2], v[3]); *(v2u*)(HB + (size_t)m * D + 4 * F.lane + 256 * q) = w; }
    }
}

__device__ __forceinline__ void ln_phase(Frame& F, int mixkind, const float* gam, const float* bet, int extra, const float* Wx, int ldx, float* outp, gu32* moe_cnt) {
    float* H = (float*)(F.ws + WS_H); bf16* HB = (bf16*)(F.ws + WS_HB); const float* MIX = (const float*)(F.ws + WS_MIX);
    const float* YS = (const float*)(F.ws + WS_S0 + S_YS);
    int* E1 = (int*)(F.ws + WS_RT); int* E2 = E1 + MROWS; float* W1 = (float*)(E2 + MROWS); float* W2 = W1 + MROWS; int* POS1 = (int*)(W2 + MROWS); int* POS2 = POS1 + MROWS;
    float* Z = (float*)(F.ws + WS_Z);
    LAS float* WL = (LAS float*)F.lds;
    LAS unsigned* lcnt = (LAS unsigned*)(F.lds + 65536);
    const int NC = extra == 1 ? 16 : (extra == 2 ? 8 : 0);
    if (extra) { for (int i = F.tid; i < NC * D; i += NTHR) { const int e = i / D, c = i % D; WL[e * D + c] = Wx[(size_t)c * ldx + e]; }
        if (F.tid < 8) lcnt[F.tid] = 0u;
        __syncthreads(); }
    const int gw = F.bx * NWAVES + F.wave, NGW = F.G * NWAVES;
    f32x4 gv[4], bv[4];
#pragma unroll
    for (int q = 0; q < 4; ++q) { gv[q] = *(const f32x4*)(gam + 4 * F.lane + 256 * q); bv[q] = *(const f32x4*)(bet + 4 * F.lane + 256 * q); }
    unsigned mycnt = 0u;
    for (int m = gw; m < MROWS; m += NGW) {
        f32x4 v[4]; float s = 0.f;
        const float* hp = H + (size_t)m * D + 4 * F.lane;
#pragma unroll
        for (int q = 0; q < 4; ++q) v[q] = *(const f32x4*)(hp + 256 * q) * ALPHA;
        if (mixkind == 1) { const float* mp = MIX + (size_t)m * D + 4 * F.lane;
#pragma unroll
            for (int q = 0; q < 4; ++q) v[q] += *(const f32x4*)(mp + 256 * q); }
        if (mixkind == 2) { const float w1 = W1[m], w2 = W2[m]; const float* y1 = YS + (size_t)POS1[m] * D + 4 * F.lane; const float* y2 = YS + (size_t)POS2[m] * D + 4 * F.lane;
#pragma unroll
            for (int q = 0; q < 4; ++q) v[q] += *(const f32x4*)(y1 + 256 * q) * w1 + *(const f32x4*)(y2 + 256 * q) * w2; }
#pragma unroll
        for (int q = 0; q < 4; ++q) s += (v[q][0] + v[q][1]) + (v[q][2] + v[q][3]);
        const float mean = wave_sum(s) * (1.f / D); float s2 = 0.f;
#pragma unroll
        for (int q = 0; q < 4; ++q) { v[q] = v[q] - mean; s2 += (v[q][0] * v[q][0] + v[q][1] * v[q][1]) + (v[q][2] * v[q][2] + v[q][3] * v[q][3]); }
        const float rstd = 1.f / sqrtf(wave_sum(s2) * (1.f / D) + LN_EPS);
#pragma unroll
        for (int q = 0; q < 4; ++q) { v[q] = v[q] * rstd * gv[q] + bv[q];
            *(f32x4*)(H + (size_t)m * D + 4 * F.lane + 256 * q) = v[q];
            v2u w; w.x = pk2(v[q][0], v[q][1]); w.y = pk2(v[q][2], v[q][3]); *(v2u*)(HB + (size_t)m * D + 4 * F.lane + 256 * q) = w; }
        if (outp && m < MMAIN) {
#pragma unroll
            for (int q = 0; q < 4; ++q) *(f32x4*)(outp + (size_t)m * D + 4 * F.lane + 256 * q) = v[q]; }
        if (extra) {
            float lg[16];
#pragma unroll
            for (int e = 0; e < 16; ++e) { lg[e] = 0.f; if (e < NC) { float p = 0.f;
#pragma unroll
                    for (int q = 0; q < 4; ++q) { const f32x4 w = *(const LAS f32x4*)(WL + e * D + 4 * F.lane + 256 * q); p += (v[q][0] * w[0] + v[q][1] * w[1]) + (v[q][2] * w[2] + v[q][3] * w[3]); }
                    lg[e] = wave_sum(p); } }
            if (extra == 1) { float zv = 0.f;
#pragma unroll
                for (int e = 0; e < 16; ++e) zv = (F.lane == e) ? lg[e] : zv;
                if (F.lane < 16) Z[(size_t)m * 16 + F.lane] = zv; }
            else { int e1 = 0; float l1 = lg[0];
#pragma unroll
                for (int e = 1; e < 8; ++e) if (lg[e] > l1) { l1 = lg[e]; e1 = e; }
                int e2 = -1; float l2 = -3.0e38f;
#pragma unroll
                for (int e = 0; e < 8; ++e) if (e != e1 && lg[e] > l2) { l2 = lg[e]; e2 = e; }
                const float w2 = 1.f / (1.f + __expf(l1 - l2)), w1 = 1.f - w2;
                if (F.lane == 0) { E1[m] = e1; E2[m] = e2; W1[m] = w1; W2[m] = w2; }
                mycnt += (F.lane == e1 || F.lane == e2) ? 1u : 0u; }
        }
    }
    if (extra == 2) { if (F.lane < 8 && mycnt) __hip_atomic_fetch_add(&lcnt[F.lane], mycnt, __ATOMIC_RELAXED, __HIP_MEMORY_SCOPE_WORKGROUP);
        __syncthreads();
        if (F.tid < 8 && lcnt[F.tid]) __hip_atomic_fetch_add(moe_cnt + F.tid, lcnt[F.tid], RLX_AGENT); }
}

struct EpiGates {
    static constexpr bool PERM = true, PAIR = true;
    float* LOGA; float* U; const bf16* XC; const float* bg; const float* lam;
    __device__ __forceinline__ void chan4(int ch, f32x4& br, f32x4& bi, f32x4& c8) const {
        br = *(const f32x4*)(bg + ch); bi = *(const f32x4*)(bg + RGW + ch); const f32x4 lm = *(const f32x4*)(lam + ch);
#pragma unroll
        for (int t = 0; t < 4; ++t) c8[t] = -8.0f * log1pf(__expf(-lm[t]));
    }
    __device__ __forceinline__ void elem4(int row, int blk, int d, f32x4 ra, f32x4 ia, const f32x4& br, const f32x4& bi, const f32x4& c8) const {
        const int ch = blk * RGBW + d;
        const v2u xw = *(const v2u*)(XC + (size_t)row * XCW + blk * 256 + d);
        const float xc[4] = {bflo(xw.x), bfhi(xw.x), bflo(xw.y), bfhi(xw.y)};
        f32x4 la, uu;
#pragma unroll
        for (int t = 0; t < 4; ++t) {
            const float r = sigmoid_f(ra[t] + br[t]), ig = sigmoid_f(ia[t] + bi[t]);
            const float l = c8[t] * r;
            const float a2 = fast_exp(2.0f * l);
            la[t] = l; uu[t] = sqrtf(fmaxf(1.0f - a2, 0.f)) * (ig * xc[t]);
        }
        *(f32x4*)(LOGA + (size_t)row * RGW + ch) = la; *(f32x4*)(U + (size_t)row * RGW + ch) = uu;
    }
    __device__ __forceinline__ void operator()(const f32x4 (&acc)[2][2][4][2], const pg8::Unit& u, int wr, int wc, int fr, int fq) const {
        const int row0 = u.pm * 256 + wr * 64 + fr, blk = u.pn >> 1, d0 = (u.pn & 1) * 128 + wc * 32 + 8 * fq;
#pragma unroll
        for (int n = 0; n < 2; ++n) { const int d = d0 + 4 * n; if (d < RGBW) {
            f32x4 br, bi, c8; chan4(blk * RGBW + d, br, bi, c8);
#pragma unroll
            for (int ai = 0; ai < 2; ++ai)
#pragma unroll
                for (int m = 0; m < 4; ++m) elem4(row0 + ai * 128 + m * 16, blk, d, acc[ai][0][m][n], acc[ai][1][m][n], br, bi, c8); } }
    }
    __device__ __forceinline__ void meta_task(int task, int& r0, int& aoff) const { const int pn = task >> 3; r0 = pn * 256 + (task & 7) * 16; aoff = (pn >> 1) * 256; }
    __device__ __forceinline__ void meta(int task, f32x4 a0, f32x4 a1, int fr, int fq) const {
        const int pn = task >> 3, d = (pn & 1) * 128 + (task & 7) * 16 + 4 * fq;
        if (d < RGBW) { f32x4 br, bi, c8; chan4((pn >> 1) * RGBW + d, br, bi, c8); elem4(MMAIN + fr, pn >> 1, d, a0, a1, br, bi, c8); }
    }
};

__device__ __forceinline__ int conv_src_row(int row, int delta) {
    if (row < MMAIN) { const int t = row & (SEQ - 1); return (t - delta >= 0) ? row - delta : MMAIN + NMETA + (t - delta); }
    const int jm = row - MMAIN; return (jm - delta >= 0) ? row - delta : -1;
}
__device__ __forceinline__ void rg_conv_phase(Frame& F, const float* cw, const float* cb) {
    const bf16* PROJ = (const bf16*)(F.ws + WS_S0 + S_PROJ); bf16* XC = (bf16*)(F.ws + WS_S0 + S_XC);
    for (int idx = F.bx * NTHR + F.tid; idx < MROWS * 256; idx += F.G * NTHR) {
        const int row = idx >> 8, g = idx & 255, blk = g >> 5, kk = (g & 31) * 8;
        v4u o = (v4u){0u, 0u, 0u, 0u};
        if (kk < RGBW) {
            const int ch = blk * RGBW + kk;
            float a[8];
            { const f32x4 b0 = *(const f32x4*)(cb + ch), b1 = *(const f32x4*)(cb + ch + 4);
#pragma unroll
              for (int t = 0; t < 4; ++t) { a[t] = b0[t]; a[4 + t] = b1[t]; } }
#pragma unroll
            for (int tap = 0; tap < 4; ++tap) {
                const int rr = conv_src_row(row, 3 - tap);
                if (rr >= 0) {
                    const v4u x = *(const v4u*)(PROJ + (size_t)rr * NRG + RGW + ch);
                    const f32x4 w0 = *(const f32x4*)(cw + tap * RGW + ch), w1 = *(const f32x4*)(cw + tap * RGW + ch + 4);
                    a[0] += bflo(x.x) * w0[0]; a[1] += bfhi(x.x) * w0[1]; a[2] += bflo(x.y) * w0[2]; a[3] += bfhi(x.y) * w0[3];
                    a[4] += bflo(x.z) * w1[0]; a[5] += bfhi(x.z) * w1[1]; a[6] += bflo(x.w) * w1[2]; a[7] += bfhi(x.w) * w1[3];
                }
            }
            o.x = pk2(a[0], a[1]); o.y = pk2(a[2], a[3]); o.z = pk2(a[4], a[5]); o.w = pk2(a[6], a[7]);
        }
        *(v4u*)(XC + (size_t)row * XCW + blk * 256 + kk) = o;
    }
}
template <bool FIX>
__device__ __forceinline__ void rg_scan_phase(Frame& F) {
    const float* LOGA = (const float*)(F.ws + WS_S0 + S_LOGA); const float* U = (const float*)(F.ws + WS_S0 + S_U);
    const bf16* PROJ = (const bf16*)(F.ws + WS_S0 + S_PROJ); bf16* Y = (bf16*)(F.ws + WS_S0 + S_Y);
    float* AGGA = (float*)(F.ws + WS_AGG); float* AGGH = AGGA + (size_t)NSEG * RGW;
    const int gw = F.bx * NWAVES + F.wave, NGW = F.G * NWAVES;
    for (int task = gw; task < NSEG * 21; task += NGW) {
        const int seg = task / 21, cg = task - seg * 21, ch = cg * 64 + F.lane;
        const int row0 = seg == 0 ? MMAIN : (seg - 1) * SEG, nrows = seg == 0 ? NMETA : SEG;
        float h = 0.f, cl = 0.f;
        if (FIX && seg > 0) {
            h = AGGH[ch];
            const int sb = 1 + ((seg - 1) / NSEG_B) * NSEG_B, ns = (seg - 1) % NSEG_B;
            for (int q = 0; q < ns; ++q) h = __expf(AGGA[(size_t)(sb + q) * RGW + ch]) * h + AGGH[(size_t)(sb + q) * RGW + ch];
        }
        for (int r = 0; r < nrows; r += 8) {
            float la[8], uu[8], gt[8];
#pragma unroll
            for (int t = 0; t < 8; ++t) { const size_t o = (size_t)(row0 + r + t) * RGW + ch; la[t] = LOGA[o]; uu[t] = U[o]; if (FIX) gt[t] = bf2f(PROJ[(size_t)(row0 + r + t) * NRG + ch]); }
#pragma unroll
            for (int t = 0; t < 8; ++t) { h = __expf(la[t]) * h + uu[t]; cl += la[t];
                if (FIX) { Y[(size_t)(row0 + r + t) * KRGO + ch] = (bf16)f2bf(h * gt[t]); if (cg == 20) Y[(size_t)(row0 + r + t) * KRGO + RGW + F.lane] = (bf16)0; } }
        }
        if (!FIX) { AGGA[(size_t)seg * RGW + ch] = cl; AGGH[(size_t)seg * RGW + ch] = h; }
    }
}

#define RG_PHASES \
        if (IN(pb + 0)) { if (on_rg) { \
            bf16* PROJ = (bf16*)(F.ws + WS_S0 + S_PROJ); EpiBf16Gelu E{PROJ, NRG, RGW}; \
            meta_gemm(F, HB + (size_t)MMAIN * D, D, D, (const bf16*)(wl + WL_RGIN), NRG / 16, E); \
            pg8::Gemm g{D, D}; pg8::DenseOrder S; S.init(HB, D, (const bf16*)(wl + WL_RGIN), D, MMAIN / 256, NRG / 256, F.G, F.bx); \
            pg8::gemm_phase<EpiBf16Gelu, pg8::DenseOrder>(F.lds, F.tid, g, S, E); } \
            SEAM(pb + 0); } \
        if (IN(pb + 1)) { if (on_rg) rg_conv_phase(F, args.in[5] + (size_t)j * 4 * RGW, args.in[6] + (size_t)j * RGW); SEAM(pb + 1); } \
        if (IN(pb + 2)) { if (on_rg) { \
            const bf16* XC = (const bf16*)(F.ws + WS_S0 + S_XC); \
            EpiGates E{(float*)(F.ws + WS_S0 + S_LOGA), (float*)(F.ws + WS_S0 + S_U), XC, args.in[8] + (size_t)j * 2 * RGW, args.in[9] + (size_t)j * RGW}; \
            meta_gemm(F, XC + (size_t)MMAIN * XCW, XCW, KGT, (const bf16*)(wl + WL_GATES), (NGT / 256) * 8, E); \
            pg8::Gemm g{KGT, XCW}; pg8::GatesOrder S; S.init(XC, XCW, (const bf16*)(wl + WL_GATES), KGT, MMAIN / 256, NGT / 256, F.G, F.bx); \
            pg8::gemm_phase<EpiGates, pg8::GatesOrder>(F.lds, F.tid, g, S, E); } \
            SEAM(pb + 2); } \
        if (IN(pb + 3)) { if (on_rg) rg_scan_phase<false>(F); SEAM(pb + 3); } \
        if (IN(pb + 4)) { if (on_rg) rg_scan_phase<true>(F); SEAM(pb + 4); } \
        if (IN(pb + 5)) { if (on_rg) { \
            const bf16* Y = (const bf16*)(F.ws + WS_S0 + S_Y); EpiF32 E{MIX, D}; \
            meta_gemm(F, Y + (size_t)MMAIN * KRGO, KRGO, KRGO, (const bf16*)(wl + WL_RGOUT), D / 16, E); \
            pg8::Gemm g{KRGO, KRGO}; pg8::DenseOrder S; S.init(Y, KRGO, (const bf16*)(wl + WL_RGOUT), KRGO, MMAIN / 256, D / 256, F.G, F.bx); \
            pg8::gemm_phase<EpiF32, pg8::DenseOrder>(F.lds, F.tid, g, S, E); } \
            SEAM(pb + 5); }

constexpr int GL_QT = 0, GL_KT = 17408  , GL_KTT = 34816, GL_VT = 53248, GL_ST = 90112  , GL_SM = 155648;
constexpr int QTS = 136, KTTS = 72, VTS = 72, PS = 72, BS = 132;
static_assert(GL_SM + 2560 <= MISC_OFF, "GLA LDS map");

template <int MODE>
__device__ __forceinline__ void gla_phase(Frame& F, const float* wgu, const float* bgate, const float* normg) {
    const bf16* QKVR = (const bf16*)(F.ws + WS_S0 + S_QKVR); const float* Z = (const float*)(F.ws + WS_Z);
    float* KVS = (float*)(F.ws + WS_S0 + S_KVS); const float* SST = (const float*)(F.ws + WS_S0 + S_SST); float* DEC = (float*)(F.ws + WS_S0 + S_DEC);
    bf16* O = (bf16*)(F.ws + WS_S0 + S_O);
    LAS bf16* QT = (LAS bf16*)(F.lds + GL_QT); LAS bf16* KT = (LAS bf16*)(F.lds + GL_KT); LAS bf16* PP = (LAS bf16*)(F.lds + GL_KT);
    LAS bf16* KTT = (LAS bf16*)(F.lds + GL_KTT); LAS bf16* VT = (LAS bf16*)(F.lds + GL_VT); LAS unsigned char* ST = F.lds + GL_ST;
    LAS float* Bc = (LAS float*)(F.lds + GL_ST); LAS float* ZC = (LAS float*)(F.lds + GL_ST + 36864);
    LAS float* em = (LAS float*)(F.lds + GL_SM); LAS float* ef = em + 128; LAS float* stats = ef + 128;
    const int tid0 = F.tid;
    for (int u = F.bx; u < NGU; u += F.G) {
        const bool meta = u >= BATCH * GH * NSC_BH;
        const int h = meta ? u - BATCH * GH * NSC_BH : (u / NSC_BH) % GH, b = meta ? 0 : u / (GH * NSC_BH), sc = meta ? 0 : u % NSC_BH;
        const int nch = meta ? 1 : CPS;
        f32x4 sacc[8][2];
        int lofs = (4 * ((tid0 & 63) >> 4)) * GDV + 32 * (tid0 >> 6) + (tid0 & 15); asm volatile("" : "+v"(lofs));
#pragma unroll
        for (int dt = 0; dt < 8; ++dt)
#pragma unroll
            for (int i = 0; i < 2; ++i) {
                sacc[dt][i] = (f32x4){0.f, 0.f, 0.f, 0.f};
                if (MODE == 1 && !meta) {
#pragma unroll
                    for (int jj = 0; jj < 4; ++jj) sacc[dt][i][jj] = SST[(size_t)u * (GDK * GDV) + (size_t)((16 * dt + jj) * GDV + 16 * i) + lofs]; }
            }
        float dsum = 0.f;
        for (int ci = 0; ci < nch; ++ci) {
            int tid = tid0; asm volatile("" : "+v"(tid));
            const int lane = tid & 63, w = __builtin_amdgcn_readfirstlane(tid >> 6), fr = lane & 15, fq = lane >> 4;
            const int rbase = meta ? 0 : b * SEQ + (sc * CPS + ci) * 64;
            if (tid < 256) { const int c = tid >> 2, part = tid & 3; const bool valid = !meta || c >= 48; const int row = meta ? MMAIN + c - 48 : rbase + c;
                f32x4 zv = (f32x4){0.f, 0.f, 0.f, 0.f}; if (valid) zv = *(const f32x4*)(Z + (size_t)row * 16 + 4 * part);
                *(LAS f32x4*)(ZC + c * 16 + 4 * part) = zv; }
            const int dA = tid & 127, cgp = tid >> 7;
            float wg[16];
#pragma unroll
            for (int i = 0; i < 16; ++i) wg[i] = wgu[(size_t)i * GQK + h * GDK + dA];
            const float bgv = bgate[h * GDK + dA];
            __syncthreads(); __builtin_amdgcn_sched_barrier(0);
#pragma unroll 4
            for (int cc = 0; cc < 16; ++cc) { const int c = cgp * 16 + cc; float lg = bgv;
#pragma unroll
                for (int i = 0; i < 16; ++i) lg += ZC[c * 16 + i] * wg[i];
                float g = (fminf(lg, 0.f) - log1pf(__expf(-fabsf(lg)))) * (1.0f / 16.0f);
                if (meta && c < 48) g = 0.f;
                Bc[c * BS + dA] = g; }
            __syncthreads(); __builtin_amdgcn_sched_barrier(0);
            if (tid < 128) { float run = 0.f, bm = 0.f;
#pragma unroll 8
                for (int c = 0; c < 64; ++c) { run += Bc[c * BS + tid]; Bc[c * BS + tid] = run; if (c == 31) bm = run; }
                em[tid] = __expf(bm); ef[tid] = __expf(run - bm); dsum += run; }
            __syncthreads(); __builtin_amdgcn_sched_barrier(0);
            { const int c = tid >> 3, d0 = (tid & 7) * 16, e0 = (tid & 7) * 32; const bool valid = !meta || c >= 48; const int row = meta ? MMAIN + c - 48 : rbase + c;
                const bf16* rp = QKVR + (size_t)row * NGLA;
                v4u q0 = (v4u){0u, 0u, 0u, 0u}, q1 = q0, k0 = q0, k1 = q0, vv[4] = {q0, q0, q0, q0};
                if (valid) { if (MODE == 1) { q0 = *(const v4u*)(rp + h * GDK + d0); q1 = *(const v4u*)(rp + h * GDK + d0 + 8); }
                    k0 = *(const v4u*)(rp + GQK + h * GDK + d0); k1 = *(const v4u*)(rp + GQK + h * GDK + d0 + 8);
#pragma unroll
                    for (int t = 0; t < 4; ++t) vv[t] = *(const v4u*)(rp + 2 * GQK + h * GDV + e0 + 8 * t); }
                const unsigned qw[8] = {q0.x, q0.y, q0.z, q0.w, q1.x, q1.y, q1.z, q1.w}, kw[8] = {k0.x, k0.y, k0.z, k0.w, k1.x, k1.y, k1.z, k1.w};
                unsigned qo[8], ko[8];
#pragma unroll
                for (int t = 0; t < 8; ++t) {
                    const int d = d0 + 2 * t;
                    const float x0 = Bc[c * BS + d] - Bc[31 * BS + d], x1 = Bc[c * BS + d + 1] - Bc[31 * BS + d + 1];
                    const float e0f = __expf(x0), e1f = __expf(x1), r0 = __expf(-x0), r1 = __expf(-x1);
                    const float ka = bflo(kw[t]) * r0, kb = bfhi(kw[t]) * r1;
                    ko[t] = pk2(ka, kb);
                    if (MODE == 1) qo[t] = pk2(bflo(qw[t]) * (0.08838834764831845f * e0f), bfhi(qw[t]) * (0.08838834764831845f * e1f));
                    KTT[(d) * KTTS + c] = (bf16)(ko[t] & 0xffffu); KTT[(d + 1) * KTTS + c] = (bf16)(ko[t] >> 16);
                }
                *(LAS v4u*)(KT + c * QTS + d0) = (v4u){ko[0], ko[1], ko[2], ko[3]}; *(LAS v4u*)(KT + c * QTS + d0 + 8) = (v4u){ko[4], ko[5], ko[6], ko[7]};
                if (MODE == 1) { *(LAS v4u*)(QT + c * QTS + d0) = (v4u){qo[0], qo[1], qo[2], qo[3]}; *(LAS v4u*)(QT + c * QTS + d0 + 8) = (v4u){qo[4], qo[5], qo[6], qo[7]}; }
#pragma unroll
                for (int t = 0; t < 4; ++t) { const unsigned vw[4] = {vv[t].x, vv[t].y, vv[t].z, vv[t].w};
#pragma unroll
                    for (int s = 0; s < 4; ++s) { const int e = e0 + 8 * t + 2 * s; VT[e * VTS + c] = (bf16)(vw[s] & 0xffffu); VT[(e + 1) * VTS + c] = (bf16)(vw[s] >> 16); } }
            }
            __syncthreads(); __builtin_amdgcn_sched_barrier(0);
            f32x4 pacc[2];
#pragma unroll
            for (int dt = 0; dt < 8; ++dt) { const f32x4 emv = *(const LAS f32x4*)(em + 16 * dt + 4 * fq);
#pragma unroll
                for (int i = 0; i < 2; ++i) { sacc[dt][i] = sacc[dt][i] * emv;
                    if (MODE == 1) { const int e = 32 * w + 16 * i + fr; const int ck = (2 * dt + (fq >> 1)) ^ (e & 15);
                        v2u sw; sw.x = pk2(sacc[dt][i][0], sacc[dt][i][1]); sw.y = pk2(sacc[dt][i][2], sacc[dt][i][3]);
                        *(LAS v2u*)(ST + e * 256 + ck * 16 + (fq & 1) * 8) = sw; } } }
            if (MODE == 1) {
                const int mt = w & 3, ntp = w >> 2;
#pragma unroll
                for (int ii = 0; ii < 2; ++ii) { const int nt = 2 * ntp + ii; pacc[ii] = (f32x4){0.f, 0.f, 0.f, 0.f};
                    if (nt <= mt) {
#pragma unroll
                        for (int ks = 0; ks < 4; ++ks) { const bf16x8 kf = *(const LAS bf16x8*)(KT + (16 * nt + fr) * QTS + 32 * ks + 8 * fq); const bf16x8 qf = *(const LAS bf16x8*)(QT + (16 * mt + fr) * QTS + 32 * ks + 8 * fq);
                            pacc[ii] = __builtin_amdgcn_mfma_f32_16x16x32_bf16(kf, qf, pacc[ii], 0, 0, 0); }
                        if (nt == mt) {
#pragma unroll
                            for (int jj = 0; jj < 4; ++jj) if (4 * fq + jj > fr) pacc[ii][jj] = 0.f; }
                    } }
            }
            __syncthreads(); __builtin_amdgcn_sched_barrier(0);
            if (MODE == 1) { const int mt = w & 3, ntp = w >> 2;
#pragma unroll
                for (int ii = 0; ii < 2; ++ii) { const int nt = 2 * ntp + ii; v2u pw; pw.x = pk2(pacc[ii][0], pacc[ii][1]); pw.y = pk2(pacc[ii][2], pacc[ii][3]);
                    *(LAS v2u*)(PP + (16 * mt + fr) * PS + 16 * nt + 4 * fq) = pw; }
                __syncthreads(); __builtin_amdgcn_sched_barrier(0);
            }
            f32x4 oacc[8];
            if (MODE == 1) { const int mt = w & 3, eh = w >> 2;
                bf16x8 pf[2], qf[4];
#pragma unroll
                for (int ks = 0; ks < 2; ++ks) pf[ks] = *(const LAS bf16x8*)(PP + (16 * mt + fr) * PS + 32 * ks + 8 * fq);
#pragma unroll
                for (int ks = 0; ks < 4; ++ks) qf[ks] = *(const LAS bf16x8*)(QT + (16 * mt + fr) * QTS + 32 * ks + 8 * fq);
#pragma unroll
                for (int t = 0; t < 8; ++t) { const int e = 128 * eh + 16 * t + fr; f32x4 a = (f32x4){0.f, 0.f, 0.f, 0.f};
#pragma unroll
                    for (int ks = 0; ks < 2; ++ks) { const bf16x8 vf = *(const LAS bf16x8*)(VT + e * VTS + 32 * ks + 8 * fq); a = __builtin_amdgcn_mfma_f32_16x16x32_bf16(vf, pf[ks], a, 0, 0, 0); }
#pragma unroll
                    for (int ks = 0; ks < 4; ++ks) { const int ck = (4 * ks + fq) ^ (e & 15); const bf16x8 sf = *(const LAS bf16x8*)(ST + e * 256 + ck * 16); a = __builtin_amdgcn_mfma_f32_16x16x32_bf16(sf, qf[ks], a, 0, 0, 0); }
                    oacc[t] = a; }
            }
            { bf16x8 vf[2][2];
#pragma unroll
              for (int i = 0; i < 2; ++i)
#pragma unroll
                  for (int ks = 0; ks < 2; ++ks) vf[i][ks] = *(const LAS bf16x8*)(VT + (32 * w + 16 * i + fr) * VTS + 32 * ks + 8 * fq);
#pragma unroll
              for (int dt = 0; dt < 8; ++dt) { const f32x4 efv = *(const LAS f32x4*)(ef + 16 * dt + 4 * fq);
#pragma unroll
                  for (int ks = 0; ks < 2; ++ks) { const bf16x8 kf = *(const LAS bf16x8*)(KTT + (16 * dt + fr) * KTTS + 32 * ks + 8 * fq);
#pragma unroll
                      for (int i = 0; i < 2; ++i) sacc[dt][i] = __builtin_amdgcn_mfma_f32_16x16x32_bf16(kf, vf[i][ks], sacc[dt][i], 0, 0, 0); }
#pragma unroll
                  for (int i = 0; i < 2; ++i) sacc[dt][i] = sacc[dt][i] * efv; }
            }
            if (MODE == 1) { const int mt = w & 3, eh = w >> 2, c = 16 * mt + fr;
                float s1 = 0.f, s2 = 0.f;
#pragma unroll
                for (int t = 0; t < 8; ++t)
#pragma unroll
                    for (int jj = 0; jj < 4; ++jj) { s1 += oacc[t][jj]; s2 += oacc[t][jj] * oacc[t][jj]; }
                s1 += __shfl_xor(s1, 16); s1 += __shfl_xor(s1, 32); s2 += __shfl_xor(s2, 16); s2 += __shfl_xor(s2, 32);
                if (fq == 0) { stats[(c * 2 + eh) * 2 + 0] = s1; stats[(c * 2 + eh) * 2 + 1] = s2; }
                __syncthreads(); __builtin_amdgcn_sched_barrier(0);
                const float t1 = stats[(c * 2 + 0) * 2 + 0] + stats[(c * 2 + 1) * 2 + 0], t2 = stats[(c * 2 + 0) * 2 + 1] + stats[(c * 2 + 1) * 2 + 1];
                const float mean = t1 * (1.0f / GDV), var = fmaxf(t2 * (1.0f / GDV) - mean * mean, 0.f), rstd = 1.0f / sqrtf(var + LN_EPS);
                const bool valid = !meta || c >= 48; const int row = meta ? MMAIN + c - 48 : rbase + c;
                if (valid) {
#pragma unroll
                    for (int t = 0; t < 8; ++t) { const int e = 128 * eh + 16 * t + 4 * fq;
                        const v2u rw = *(const v2u*)(QKVR + (size_t)row * NGLA + 2 * GQK + GVD + h * GDV + e);
                        const f32x4 ng = *(const f32x4*)(normg + h * GDV + e);
                        const float r4[4] = {bflo(rw.x), bfhi(rw.x), bflo(rw.y), bfhi(rw.y)}; float o4[4];
#pragma unroll
                        for (int jj = 0; jj < 4; ++jj) o4[jj] = (oacc[t][jj] - mean) * rstd * ng[jj] * silu_f(r4[jj]);
                        v2u ow; ow.x = pk2(o4[0], o4[1]); ow.y = pk2(o4[2], o4[3]);
                        *(v2u*)(O + (size_t)row * D + h * GDV + e) = ow; } }
            }
            __syncthreads(); __builtin_amdgcn_sched_barrier(0);
        }
        if (MODE == 0) {
            int lofs2 = (4 * ((tid0 & 63) >> 4)) * GDV + 32 * (tid0 >> 6) + (tid0 & 15); asm volatile("" : "+v"(lofs2));
#pragma unroll
            for (int dt = 0; dt < 8; ++dt)
#pragma unroll
                for (int i = 0; i < 2; ++i)
#pragma unroll
                    for (int jj = 0; jj < 4; ++jj) KVS[(size_t)u * (GDK * GDV) + (size_t)((16 * dt + jj) * GDV + 16 * i) + lofs2] = sacc[dt][i][jj];
            if (tid0 < 128) DEC[(size_t)u * GDK + tid0] = dsum;
        }
    }
}
__device__ __forceinline__ void gla_scan_phase(Frame& F) {
    const float* KVS = (const float*)(F.ws + WS_S0 + S_KVS); float* SST = (float*)(F.ws + WS_S0 + S_SST); const float* DEC = (const float*)(F.ws + WS_S0 + S_DEC);
    constexpr int NEL = GDK * GDV;
    for (int idx = F.bx * NTHR + F.tid; idx < BATCH * GH * NEL; idx += F.G * NTHR) {
        const int bh = idx / NEL, el = idx - bh * NEL, d = el / GDV, h = bh % GH;
        float s = KVS[(size_t)(BATCH * GH * NSC_BH + h) * NEL + el];
        const size_t ub = (size_t)bh * NSC_BH;
        SST[ub * NEL + el] = s;
        for (int sc = 0; sc + 1 < NSC_BH; ++sc) { s = __expf(DEC[(ub + sc) * GDK + d]) * s + KVS[(ub + sc) * NEL + el]; SST[(ub + sc + 1) * NEL + el] = s; }
    }
}

#define GLA_PHASES \
        if (IN(pb + 10)) { if (on_gla) { \
            bf16* QKVR = (bf16*)(F.ws + WS_S0 + S_QKVR); EpiBf16Gelu E{QKVR, NGLA, 0}; \
            meta_gemm(F, HB + (size_t)MMAIN * D, D, D, (const bf16*)(wl + WL_GLAIN), NGLA / 16, E); \
            pg8::Gemm g{D, D}; pg8::DenseOrder S; S.init(HB, D, (const bf16*)(wl + WL_GLAIN), D, MMAIN / 256, NGLA / 256, F.G, F.bx); \
            pg8::gemm_phase<EpiBf16Gelu, pg8::DenseOrder>(F.lds, F.tid, g, S, E); } \
            SEAM(pb + 10); } \
        if (IN(pb + 11)) { if (on_gla) gla_phase<0>(F, args.in[12] + (size_t)j * GRANK * GQK, args.in[13] + (size_t)j * GQK, args.in[14] + (size_t)j * GVD); SEAM(pb + 11); } \
        if (IN(pb + 12)) { if (on_gla) gla_scan_phase(F); SEAM(pb + 12); } \
        if (IN(pb + 13)) { if (on_gla) gla_phase<1>(F, args.in[12] + (size_t)j * GRANK * GQK, args.in[13] + (size_t)j * GQK, args.in[14] + (size_t)j * GVD); SEAM(pb + 13); } \
        if (IN(pb + 14)) { if (on_gla) { \
            const bf16* O = (const bf16*)(F.ws + WS_S0 + S_O); EpiF32 E{MIX, D}; \
            meta_gemm(F, O + (size_t)MMAIN * D, D, D, (const bf16*)(wl + WL_GLAOUT), D / 16, E); \
            pg8::Gemm g{D, D}; pg8::DenseOrder S; S.init(O, D, (const bf16*)(wl + WL_GLAOUT), D, MMAIN / 256, D / 256, F.G, F.bx); \
            pg8::gemm_phase<EpiF32, pg8::DenseOrder>(F.lds, F.tid, g, S, E); } \
            SEAM(pb + 14); }

__device__ __forceinline__ void moe_panel_ends(const gu32* cnt, int (&pe)[8]) {
    int acc = 0;
#pragma unroll
    for (int e = 0; e < 8; ++e) { const int c = (int)__hip_atomic_load(cnt + e, RLX_AGENT); acc += (c + 255) >> 8; pe[e] = acc; }
}
__device__ __forceinline__ void moe_gather_phase(Frame& F, gu32* moe) {
    const bf16* HB = (const bf16*)(F.ws + WS_HB); bf16* AS = (bf16*)(F.ws + WS_S0 + S_AS);
    const int* E1 = (const int*)(F.ws + WS_RT); const int* E2 = E1 + MROWS; int* POS1 = (int*)(F.ws + WS_RT) + 4 * MROWS; int* POS2 = POS1 + MROWS;
    LAS unsigned* lcnt = (LAS unsigned*)F.lds; LAS unsigned* lbase = lcnt + 8; LAS int* lpos = (LAS int*)(F.lds + 256);
    const int per = (MROWS + F.G - 1) / F.G, t0 = F.bx * per, nt = (t0 + per <= MROWS) ? per : (MROWS - t0 > 0 ? MROWS - t0 : 0);
    if (F.tid < 8) lcnt[F.tid] = 0u;
    __syncthreads();
    int e1 = 0, e2 = 0; unsigned r1 = 0, r2 = 0;
    if (F.tid < nt) { e1 = E1[t0 + F.tid]; e2 = E2[t0 + F.tid];
        r1 = __hip_atomic_fetch_add(&lcnt[e1], 1u, __ATOMIC_RELAXED, __HIP_MEMORY_SCOPE_WORKGROUP); r2 = __hip_atomic_fetch_add(&lcnt[e2], 1u, __ATOMIC_RELAXED, __HIP_MEMORY_SCOPE_WORKGROUP); }
    __syncthreads();
    if (F.tid < 8) { int ps = 0, accp = 0;
#pragma unroll
        for (int e = 0; e < 8; ++e) { ps = (e == F.tid) ? accp : ps; accp += ((int)__hip_atomic_load(moe + e, RLX_AGENT) + 255) >> 8; }
        const unsigned c = lcnt[F.tid]; const unsigned off = c ? __hip_atomic_fetch_add(moe + 64 + F.tid, c, RLX_AGENT) : 0u;
        lbase[F.tid] = (unsigned)ps * 256u + off; }
    __syncthreads();
    if (F.tid < nt) { const int p1 = (int)(lbase[e1] + r1), p2 = (int)(lbase[e2] + r2); POS1[t0 + F.tid] = p1; POS2[t0 + F.tid] = p2; lpos[2 * F.tid] = p1; lpos[2 * F.tid + 1] = p2; }
    __syncthreads();
    for (int t = F.wave; t < nt; t += NWAVES) {
        const v4u* src = (const v4u*)(HB + (size_t)(t0 + t) * D); const v4u a = src[F.lane], b = src[64 + F.lane];
        v4u* d1 = (v4u*)(AS + (size_t)lpos[2 * t] * D); v4u* d2 = (v4u*)(AS + (size_t)lpos[2 * t + 1] * D);
        d1[F.lane] = a; d1[64 + F.lane] = b; d2[F.lane] = a; d2[64 + F.lane] = b;
    }
}

#define MOE_PHASES \
        if (IN(pb + 16)) { if (on_moe) moe_gather_phase(F, F.ctl + CW_MOE + 256 * j); SEAM(pb + 16); } \
        if (IN(pb + 17)) { if (on_moe) { \
            const bf16* AS = (const bf16*)(F.ws + WS_S0 + S_AS); bf16* HS = (bf16*)(F.ws + WS_S0 + S_HS); EpiSwiglu E{HS, FF}; \
            pg8::Gemm g{D, D}; pg8::MoeOrder S; moe_panel_ends(F.ctl + CW_MOE + 256 * j, S.pe); S.e_bytes = (size_t)NFF2 * D * 2; \
            S.init(AS, D, (const bf16*)(wl + WL_MOEIN), D, S.pe[7], NFF2 / 256, F.G, F.bx); \
            pg8::gemm_phase<EpiSwiglu, pg8::MoeOrder>(F.lds, F.tid, g, S, E); } \
            SEAM(pb + 17); } \
        if (IN(pb + 18)) { if (on_moe) { \
            const bf16* HS = (const bf16*)(F.ws + WS_S0 + S_HS); EpiF32 E{(float*)(F.ws + WS_S0 + S_YS), D}; \
            pg8::Gemm g{FF, FF}; pg8::MoeOrder S; moe_panel_ends(F.ctl + CW_MOE + 256 * j, S.pe); S.e_bytes = (size_t)D * FF * 2; \
            S.init(HS, FF, (const bf16*)(wl + WL_MOEOUT), FF, S.pe[7], D / 256, F.G, F.bx); \
            pg8::gemm_phase<EpiF32, pg8::MoeOrder>(F.lds, F.tid, g, S, E); } \
            SEAM(pb + 18); }

constexpr int NPHASE = 41;
#ifndef MK_PER_PHASE
#define MK_PER_PHASE 1
#endif
#ifndef MK_DBG
#define MK_DBG 0
#endif
#ifndef MK_SUBMASK
#define MK_SUBMASK 0xFFu
#endif

__global__ void __launch_bounds__(NTHR, 2) fwd(Args args) {
    extern __shared__ __attribute__((aligned(16))) unsigned char lds[];
    Frame F;
    F.lds = (LAS unsigned char*)lds; F.ws = args.ws; F.ctl = (gu32*)(args.ws + WS_CTL);
    F.tid = threadIdx.x; F.lane = F.tid & 63; F.wave = __builtin_amdgcn_readfirstlane(F.tid >> 6); F.G = gridDim.x; F.bx = blockIdx.x;
    volatile LAS unsigned* MISC = (volatile LAS unsigned*)(F.lds + MISC_OFF);
    if (F.tid < 16) MISC[F.tid] = 0u;
    __syncthreads();
    const int lo = args.ph_lo, hi = args.ph_hi;
    XcdBarrier bar; bar.bar = (unsigned*)(F.ctl + CW_BAR); bar.x = 0; bar.st = nullptr;
    if (hi - lo > 1) bar = xcd_barrier_post((unsigned*)(F.ctl + CW_BAR), MISC);
#define IN(k) (lo <= (k) && (k) < hi && (F.fresh(), true))
#define SEAM(k) do { if ((k) + 1 < hi) xcd_barrier(bar); } while (0)
    const unsigned submask = args.submask;
    const float* ln_gain = args.in[2]; const float* ln_bias = args.in[3];
    bf16* HB = (bf16*)(F.ws + WS_HB); float* MIX = (float*)(F.ws + WS_MIX);

    if (IN(0)) { p0_prologue(F, args); SEAM(0); }

    for (int j = 0; j < 2; ++j) {
        const int pb = 1 + 20 * j;
        unsigned char* wl = F.ws + WS_W + (size_t)j * WL_STRIDE;
        const bool on_rg = (submask >> (4 * j + 0)) & 1u, on_ffn = (submask >> (4 * j + 1)) & 1u, on_gla = (submask >> (4 * j + 2)) & 1u, on_moe = (submask >> (4 * j + 3)) & 1u;
        RG_PHASES
        if (IN(pb + 6)) { ln_phase(F, on_rg ? 1 : 0, ln_gain + (size_t)(2 * j) * 2 * D, ln_bias + (size_t)(2 * j) * 2 * D, 0, nullptr, 0, nullptr, nullptr); SEAM(pb + 6); }
        if (IN(pb + 7)) { if (on_ffn) {
            bf16* HID = (bf16*)(F.ws + WS_S0 + S_HID);
            EpiSwiglu E{HID, FF};
            if (!(MK_DBG & 1)) meta_gemm(F, HB + (size_t)MMAIN * D, D, D, (const bf16*)(wl + WL_FFNIN), (NFF2 / 256) * 8, E);
            pg8::Gemm g{D, D}; pg8::DenseOrder S; S.init(HB, D, (const bf16*)(wl + WL_FFNIN), D, MMAIN / 256, NFF2 / 256, F.G, F.bx);
            if (!(MK_DBG & 2)) pg8::gemm_phase<EpiSwiglu, pg8::DenseOrder>(F.lds, F.tid, g, S, E); }
            SEAM(pb + 7); }
        if (IN(pb + 8)) { if (on_ffn) {
            const bf16* HID = (const bf16*)(F.ws + WS_S0 + S_HID);
            EpiF32 E{MIX, D};
            if (!(MK_DBG & 4)) meta_gemm(F, HID + (size_t)MMAIN * FF, FF, FF, (const bf16*)(wl + WL_FFNOUT), D / 16, E);
            pg8::Gemm g{FF, FF}; pg8::DenseOrder S; S.init(HID, FF, (const bf16*)(wl + WL_FFNOUT), FF, MMAIN / 256, D / 256, F.G, F.bx);
            if (!(MK_DBG & 8)) pg8::gemm_phase<EpiF32, pg8::DenseOrder>(F.lds, F.tid, g, S, E); }
            SEAM(pb + 8); }
        if (IN(pb + 9)) { ln_phase(F, on_ffn ? 1 : 0, ln_gain + (size_t)(2 * j) * 2 * D + D, ln_bias + (size_t)(2 * j) * 2 * D + D, 1, args.in[11] + (size_t)j * D * GLAW + NGLA, GLAW, nullptr, nullptr); SEAM(pb + 9); }
        GLA_PHASES
        if (IN(pb + 15)) { ln_phase(F, on_gla ? 1 : 0, ln_gain + (size_t)(2 * j + 1) * 2 * D, ln_bias + (size_t)(2 * j + 1) * 2 * D, on_moe ? 2 : 0, args.in[18] + (size_t)j * D * NE, NE, nullptr, F.ctl + CW_MOE + 256 * j); SEAM(pb + 15); }
        MOE_PHASES
        if (IN(pb + 19)) { ln_phase(F, on_moe ? 2 : 0, ln_gain + (size_t)(2 * j + 1) * 2 * D + D, ln_bias + (size_t)(2 * j + 1) * 2 * D + D, 0, nullptr, 0, j == 1 ? args.out : nullptr, nullptr); SEAM(pb + 19); }
    }
#undef IN
#undef SEAM
}

static bool phase_enabled(int k, unsigned mask) {
    if (k == 0) return true;
    const int j = (k - 1) / 20, r = (k - 1) % 20;
    int sub;
    if (r <= 5) sub = 0; else if (r == 6) return true; else if (r <= 8) sub = 1; else if (r == 9) return true;
    else if (r <= 14) sub = 2; else if (r == 15) return true; else if (r <= 18) sub = 3; else return true;
    return (mask >> (4 * j + sub)) & 1u;
}
extern "C" void kernel_launch(void* const* d_in, const int* in_sizes, int n_in, void* d_out, int out_size, void* d_ws, size_t ws_size, hipStream_t stream) {
    static int grid = 0;
    if (grid == 0) {
        if (n_in != 21 || out_size != MMAIN * D || ws_size < WS_END) { fprintf(stderr, "kernel_launch: unexpected shapes: n_in %d out %d ws %zu (need %zu); nothing launched\n", n_in, out_size, ws_size, (size_t)WS_END); grid = -1; return; }
        int dev = 0, cus = 0, per_cu = 0;
        if (hipGetDevice(&dev) != hipSuccess || hipDeviceGetAttribute(&cus, hipDeviceAttributeMultiprocessorCount, dev) != hipSuccess) { grid = -1; return; }
        if (hipFuncSetAttribute((const void*)fwd, hipFuncAttributeMaxDynamicSharedMemorySize, LDS_BYTES) != hipSuccess) { fprintf(stderr, "kernel_launch: hipFuncSetAttribute failed\n"); grid = -1; return; }
        if (hipOccupancyMaxActiveBlocksPerMultiprocessor(&per_cu, (const void*)fwd, NTHR, LDS_BYTES) != hipSuccess || per_cu < 1) fprintf(stderr, "kernel_launch: note: occupancy query reports %d\n", per_cu);
        (void)hipGetLastError();
        grid = cus;
    }
    if (grid < 0) return;
    (void)hipMemsetAsync((char*)d_ws + WS_CTL, 0, CTL_ZERO_BYTES, stream);
    Args a{};
    for (int i = 0; i < 21; ++i) a.in[i] = (const float*)d_in[i];
    a.out = (float*)d_out; a.ws = (unsigned char*)d_ws; a.submask = MK_SUBMASK; a.pad = 0;
#if MK_PER_PHASE
    for (int k = 0; k < NPHASE; ++k) { if (!phase_enabled(k, MK_SUBMASK)) continue; a.ph_lo = k; a.ph_hi = k + 1; hipLaunchKernelGGL(fwd, dim3(grid), dim3(NTHR), LDS_BYTES, stream, a); }
#else
    a.ph_lo = 0; a.ph_hi = NPHASE; hipLaunchKernelGGL(fwd, dim3(grid), dim3(NTHR), LDS_BYTES, stream, a);
#endif
}
```

```cpp
#define MK_SUBMASK 0xFFu
#define MK_PER_PHASE 0
#include <hip/hip_runtime.h>
#include <cstdio>
#include <cstdint>

#define GAS __attribute__((address_space(1)))
#define LAS __attribute__((address_space(3)))
typedef unsigned short bf16;
typedef unsigned v4u __attribute__((ext_vector_type(4)));
typedef unsigned v2u __attribute__((ext_vector_type(2)));
typedef float f32x4 __attribute__((ext_vector_type(4)));
typedef float f32x2 __attribute__((ext_vector_type(2)));
typedef short bf16x8 __attribute__((ext_vector_type(8)));
typedef short bf16x4 __attribute__((ext_vector_type(4)));
typedef GAS unsigned gu32;
#define RLX_AGENT __ATOMIC_RELAXED, __HIP_MEMORY_SCOPE_AGENT
#define LDS_WAIT() asm volatile("s_waitcnt lgkmcnt(0)" ::: "memory")
#define VM_WAIT() asm volatile("s_waitcnt vmcnt(0)" ::: "memory")

__device__ __forceinline__ unsigned f2bf(float f) { unsigned u = __builtin_bit_cast(unsigned, f); return (u + 0x7fffu + ((u >> 16) & 1u)) >> 16; }
__device__ __forceinline__ unsigned pk2(float lo, float hi) { return f2bf(lo) | (f2bf(hi) << 16); }
__device__ __forceinline__ float bflo(unsigned w) { return __builtin_bit_cast(float, w << 16); }
__device__ __forceinline__ float bfhi(unsigned w) { return __builtin_bit_cast(float, w & 0xffff0000u); }
__device__ __forceinline__ float bf2f(bf16 b) { return __builtin_bit_cast(float, (unsigned)b << 16); }
__device__ __forceinline__ unsigned cvt_pk_bf16(float lo, float hi) { unsigned r; asm volatile("v_cvt_pk_bf16_f32 %0, %1, %2" : "=v"(r) : "v"(lo), "v"(hi)); return r; }
__device__ __forceinline__ float fast_exp(float x) { return __builtin_amdgcn_exp2f(x * 1.44269504089f); }
__device__ __forceinline__ float sigmoid_f(float x) { return __builtin_amdgcn_rcpf(1.0f + fast_exp(-x)); }
__device__ __forceinline__ float silu_f(float x) { return x * sigmoid_f(x); }
__device__ __forceinline__ float gelu_tanh_f(float x) { const float u = 0.7978845608028654f * (x + 0.044715f * x * x * x); return x * sigmoid_f(2.0f * u); }
__device__ __forceinline__ float wave_sum(float v) {
#pragma unroll
    for (int o = 1; o < 64; o <<= 1) v += __shfl_xor(v, o);
    return v;
}

namespace pg8 {
constexpr int BM = 256, BK = 64, HALF = 128, HTB = HALF * BK * 2  , STAGE_BYTES = 8 * HTB, NXCD = 8, WGM = 8;
__host__ __device__ __forceinline__ int lds_byte(int r, int c) { const int st = (r >> 4) * 2 + (c >> 5), rr = r & 15, cc = c & 31, ob = rr * 64 + cc * 2; return st * 1024 + (ob ^ (((ob >> 9) & 1) << 5)); }
__host__ __device__ __forceinline__ void stage_rc(int b, int& R, int& C) { const int st = b / 1024, sb = b % 1024, swz = sb ^ (((sb >> 9) & 1) << 5); R = (st >> 1) * 16 + swz / 64; C = (st & 1) * 32 + (swz % 64) / 2; }
__host__ __device__ __forceinline__ int perm32(int rho) { const int n = rho >> 4, i = rho & 15; return 8 * (i >> 2) + 4 * n + (i & 3); }

struct Unit { int pm, pn; };
struct Gemm { int K, lda; };

struct OrderBase {
    int nM, nN, nwg, G, c;
    __device__ __forceinline__ void init_order(int nM_, int nN_, int G_, int c_) { nM = nM_; nN = nN_; nwg = nM * nN; G = G_; c = c_; }
    __device__ __forceinline__ bool next(int i, Unit& u) const {
        const long L = (long)i * G + c; if (L >= nwg) return false;
        int wgid = (int)L; { const int q = nwg / NXCD, r = nwg % NXCD, xcd = wgid % NXCD, off = wgid / NXCD; wgid = (xcd < r ? xcd * (q + 1) : r * (q + 1) + (xcd - r) * q) + off; }
        const int nig = WGM * nN, gid = wgid / nig, fm = gid * WGM, gsz = (nM - fm) < WGM ? (nM - fm) : WGM;
        u.pm = fm + ((wgid % nig) % gsz); u.pn = (wgid % nig) / gsz; return true;
    }
};
struct DenseOrder : OrderBase {
    const char* A; const char* Bt; size_t a_tile, b_tile;
    __device__ __forceinline__ void init(const bf16* A_, int lda, const bf16* Bt_, int K, int nM_, int nN_, int G_, int c_) { A = (const char*)A_; Bt = (const char*)Bt_; a_tile = (size_t)BM * lda * 2; b_tile = (size_t)BM * K * 2; init_order(nM_, nN_, G_, c_); }
    __device__ __forceinline__ const char* a_base(const Unit& u) const { return A + (size_t)u.pm * a_tile; }
    __device__ __forceinline__ const char* b_base(const Unit& u) const { return Bt + (size_t)u.pn * b_tile; }
};
struct GatesOrder : DenseOrder {
    __device__ __forceinline__ const char* a_base(const Unit& u) const { return A + (size_t)u.pm * a_tile + (size_t)(u.pn >> 1) * 512; }
};
struct MoeOrder : DenseOrder {
    int pe[8]; size_t e_bytes;
    __device__ __forceinline__ const char* b_base(const Unit& u) const {
        int e = 0;
#pragma unroll
        for (int j = 0; j < 7; ++j) e += (u.pm >= pe[j]) ? 1 : 0;
        return Bt + (size_t)e * e_bytes + (size_t)u.pn * b_tile;
    }
};

template <class Epi, class Sched, bool ALIGN_EPI = true>
__device__ __forceinline__ void gemm_phase(LAS unsigned char* lds, const int tid, const Gemm g, const Sched& S, const Epi& E) {
    const int wid = __builtin_amdgcn_readfirstlane(tid >> 6), lane = tid & 63, wr = wid >> 2, wc = wid & 3, fr = lane & 15, fq = lane >> 4;
    const int K = g.K, nt = K / BK;
    unsigned voffA[2], voffB[2];
#pragma unroll
    for (int i = 0; i < 2; ++i) { int R, C; stage_rc(tid * 16 + i * 8192, R, C); const int Rb = Epi::PERM ? ((R & ~31) + perm32(R & 31)) : R;
        voffA[i] = (unsigned)(R * g.lda + C) * 2u; voffB[i] = (unsigned)(Rb * K + C) * 2u; }
    const size_t kstep = (size_t)(BK * 2);
    const size_t hstepA = (size_t)HALF * g.lda * 2, hstepB = (size_t)HALF * K * 2;
    const unsigned ldsw = (unsigned)wid * 1024u;
    const int aoff = lds_byte(wr * 64 + fr, fq * 8), boff = lds_byte(wc * 32 + fr, fq * 8);
#define PG8_SA(b, h) (((b) * 2 + (h)) * HTB)
#define PG8_SB(b, h) ((4 + (b) * 2 + (h)) * HTB)
#define PG8_STAGE(bufoff, gbase, voff) do { _Pragma("unroll") for (int _i = 0; _i < 2; ++_i) \
        __builtin_amdgcn_global_load_lds((const unsigned*)((const char*)(gbase) + (voff)[_i]), (LAS unsigned*)(lds + (bufoff) + ldsw + _i * 8192), 16, 0, 0); } while (0)
#define PG8_LDA(dst, b, h) do { _Pragma("unroll") for (int m = 0; m < 4; ++m) _Pragma("unroll") for (int k = 0; k < 2; ++k) dst[m][k] = *(const LAS bf16x8*)(lds + PG8_SA(b, h) + aoff + m * 2048 + k * 1024); } while (0)
#define PG8_LDB(dst, b, h) do { _Pragma("unroll") for (int n = 0; n < 2; ++n) _Pragma("unroll") for (int k = 0; k < 2; ++k) dst[n][k] = *(const LAS bf16x8*)(lds + PG8_SB(b, h) + boff + n * 2048 + k * 1024); } while (0)
#define PG8_MMA(ai, bj, At, Bt) do { __builtin_amdgcn_s_setprio(1); _Pragma("unroll") for (int m = 0; m < 4; ++m) _Pragma("unroll") for (int n = 0; n < 2; ++n) _Pragma("unroll") for (int k = 0; k < 2; ++k) \
        acc[ai][bj][m][n] = __builtin_amdgcn_mfma_f32_16x16x32_bf16(Bt[n][k], At[m][k], acc[ai][bj][m][n], 0, 0, 0); __builtin_amdgcn_s_setprio(0); } while (0)
#define PG8_WAIT_V(n) asm volatile("s_waitcnt vmcnt(" #n ")" ::: "memory")
#define PG8_WAIT_L(n) asm volatile("s_waitcnt lgkmcnt(" #n ")" ::: "memory")
#define PG8_BAR __builtin_amdgcn_s_barrier()
#define PG8_SCHED __builtin_amdgcn_sched_barrier(0)
    Unit cur, nxt; int ui = 0;
    if (!S.next(0, cur)) return;
    f32x4 acc[2][2][4][2];
#pragma unroll
    for (int a = 0; a < 2; ++a)
#pragma unroll
        for (int b = 0; b < 2; ++b)
#pragma unroll
            for (int m = 0; m < 4; ++m)
#pragma unroll
                for (int n = 0; n < 2; ++n) acc[a][b][m][n] = (f32x4){0.f, 0.f, 0.f, 0.f};
    bf16x8 At[4][2], B0[2][2], B1[2][2];
    const char* cA = S.a_base(cur); const char* cB = S.b_base(cur);
    PG8_STAGE(PG8_SB(0, 0), cB, voffB); PG8_STAGE(PG8_SB(0, 1), cB + hstepB, voffB); PG8_STAGE(PG8_SA(0, 0), cA, voffA); PG8_STAGE(PG8_SA(0, 1), cA + hstepA, voffA);
    if (wr == 1) PG8_BAR;
    PG8_WAIT_V(2); PG8_BAR;
    PG8_STAGE(PG8_SB(1, 0), cB + kstep, voffB); PG8_STAGE(PG8_SA(1, 0), cA + kstep, voffA); PG8_STAGE(PG8_SB(1, 1), cB + hstepB + kstep, voffB);
    PG8_WAIT_V(6); PG8_BAR;
    for (;;) {
        const bool has_next = S.next(ui + 1, nxt);
        const char* nA = has_next ? S.a_base(nxt) : cA; const char* nB = has_next ? S.b_base(nxt) : cB;
#pragma nounroll
        for (int t = 0; t < nt; t += 2) {
            const bool last = (t == nt - 2);
            const char* a1 = cA + (size_t)(t + 1) * kstep;
            const char* a2 = last ? nA : cA + (size_t)(t + 2) * kstep; const char* b2 = last ? nB : cB + (size_t)(t + 2) * kstep;
            const char* a3 = a2 + kstep; const char* b3 = b2 + kstep;
            PG8_LDB(B0, 0, 0); PG8_LDB(B1, 0, 1); PG8_SCHED; PG8_LDA(At, 0, 0); PG8_STAGE(PG8_SA(1, 1), a1 + hstepA, voffA);
            PG8_WAIT_V(8); PG8_WAIT_L(0); PG8_BAR; PG8_MMA(0, 0, At, B0); PG8_MMA(0, 1, At, B1); PG8_BAR; PG8_SCHED;
            PG8_LDA(At, 0, 1); PG8_STAGE(PG8_SB(0, 0), b2, voffB); PG8_STAGE(PG8_SB(0, 1), b2 + hstepB, voffB); PG8_STAGE(PG8_SA(0, 0), a2, voffA);
            PG8_WAIT_V(8); PG8_WAIT_L(0); PG8_BAR; PG8_MMA(1, 0, At, B0); PG8_MMA(1, 1, At, B1); PG8_BAR; PG8_SCHED;
            PG8_LDB(B0, 1, 0); PG8_LDB(B1, 1, 1); PG8_SCHED; PG8_LDA(At, 1, 0); PG8_STAGE(PG8_SA(0, 1), a2 + hstepA, voffA);
            PG8_WAIT_V(8); PG8_WAIT_L(0); PG8_BAR; PG8_MMA(0, 0, At, B0); PG8_MMA(0, 1, At, B1); PG8_BAR; PG8_SCHED;
            PG8_LDA(At, 1, 1); PG8_STAGE(PG8_SB(1, 0), b3, voffB); PG8_STAGE(PG8_SB(1, 1), b3 + hstepB, voffB); PG8_STAGE(PG8_SA(1, 0), a3, voffA);
            PG8_WAIT_V(8); PG8_WAIT_L(0); PG8_BAR; PG8_MMA(1, 0, At, B0); PG8_MMA(1, 1, At, B1); PG8_BAR; PG8_SCHED;
        }
        if constexpr (ALIGN_EPI) { if (wr == 0) PG8_BAR; }
        E(acc, cur, wr, wc, fr, fq);
        if (!has_next) break;
#pragma unroll
        for (int a = 0; a < 2; ++a)
#pragma unroll
            for (int b = 0; b < 2; ++b)
#pragma unroll
                for (int m = 0; m < 4; ++m)
#pragma unroll
                    for (int n = 0; n < 2; ++n) acc[a][b][m][n] = (f32x4){0.f, 0.f, 0.f, 0.f};
        cur = nxt; cA = nA; cB = nB; ++ui;
        if constexpr (ALIGN_EPI) { if (wr == 1) PG8_BAR; }
    }
    PG8_WAIT_V(0);
    if constexpr (!ALIGN_EPI) { if (wr == 0) PG8_BAR; }
    PG8_BAR;
#undef PG8_SA
#undef PG8_SB
#undef PG8_STAGE
#undef PG8_LDA
#undef PG8_LDB
#undef PG8_MMA
#undef PG8_WAIT_V
#undef PG8_WAIT_L
#undef PG8_BAR
#undef PG8_SCHED
}
}
#define XB_TMO      128
#define XB_XCNT(j)  (256  + 64 * (j))
#define XB_XSUB(j)  (1280 + 64 * (j))
#define XB_XGEN(j)  (2304 + 64 * (j))
#define XB_TOP      3328
#define XB_TOPGEN   3392
#define XCD_BAR_WORDS 3456
#define XB_SPIN_CAP (1u << 18)

__device__ __forceinline__ unsigned xb_ld(unsigned* p)              { return __hip_atomic_load(p, __ATOMIC_RELAXED, __HIP_MEMORY_SCOPE_AGENT); }
__device__ __forceinline__ unsigned xb_add(unsigned* p, unsigned v) { return __hip_atomic_fetch_add(p, v, __ATOMIC_RELAXED, __HIP_MEMORY_SCOPE_AGENT); }
__device__ __forceinline__ unsigned xb_xcc_id() { return (unsigned)__builtin_amdgcn_s_getreg((3 << 11) | 20) & 0xFu; }
#define XB_SPIN(cond, bar) do { unsigned _sp = 0; while (cond) { __builtin_amdgcn_s_sleep(1); \
    if ((++_sp & 255u) == 0u) { if (xb_ld(&(bar)[XB_TMO])) break; if (_sp > XB_SPIN_CAP) { atomicAdd(&(bar)[XB_TMO], 1u); break; } } } } while (0)

struct XcdBarrier {
    unsigned* bar; unsigned x;
    volatile LAS unsigned* st;
};

__device__ __forceinline__ XcdBarrier xcd_barrier_post(unsigned* bar, volatile LAS unsigned* st) {
    XcdBarrier b; b.bar = bar; b.x = xb_xcc_id(); b.st = st;
    if (threadIdx.x == 0) (void)xb_add(&bar[XB_XCNT(b.x)], 1u);
    return b;
}
__device__ __forceinline__ void xcd_barrier_complete(unsigned* bar, unsigned x, unsigned& nloc, unsigned& nx) {
    const unsigned G = gridDim.x * gridDim.y * gridDim.z;
    unsigned sum, cnt, mine, sp = 0u;
    for (;;) {
        sum = 0u; cnt = 0u; mine = 0u;
#pragma unroll
        for (unsigned j = 0; j < 16; ++j) { const unsigned c = xb_ld(&bar[XB_XCNT(j)]); sum += c; cnt += (c > 0u) ? 1u : 0u; mine = (j == x) ? c : mine; }
        if (sum == G) break;
        __builtin_amdgcn_s_sleep(1);
        if ((++sp & 255u) == 0u) { if (xb_ld(&bar[XB_TMO])) break; if (sp > XB_SPIN_CAP) { atomicAdd(&bar[XB_TMO], 1u); break; } }
    }
    nloc = mine > 0u ? mine : 1u; nx = cnt > 0u ? cnt : 1u;
}

__device__ __forceinline__ void xcd_barrier(const XcdBarrier& b) {
    asm volatile("s_waitcnt vmcnt(0)" ::: "memory");
    __syncthreads();
    if (threadIdx.x == 0) {
        unsigned* bar = b.bar;
        __builtin_amdgcn_s_waitcnt(0);
        unsigned nloc = b.st[0], nx = b.st[1];
        if (nloc == 0u) { xcd_barrier_complete(bar, b.x, nloc, nx); b.st[0] = nloc; b.st[1] = nx; }
        const unsigned old = xb_add(&bar[XB_XSUB(b.x)], 1u);
        const unsigned gen = old / nloc;
        if (old + 1u == (gen + 1u) * nloc) {
            __builtin_amdgcn_fence(__ATOMIC_RELEASE, "agent");
            asm volatile("s_waitcnt vmcnt(0)" ::: "memory");
            const unsigned og = xb_add(&bar[XB_TOP], 1u);
            const unsigned tg = og / nx;
            if (og + 1u == (tg + 1u) * nx) xb_add(&bar[XB_TOPGEN], 1u);
            else XB_SPIN(xb_ld(&bar[XB_TOPGEN]) == tg, bar);
            __builtin_amdgcn_fence(__ATOMIC_ACQUIRE, "agent");
            xb_add(&bar[XB_XGEN(b.x)], 1u);
            asm volatile("s_waitcnt vmcnt(0)" ::: "memory");
        } else {
            XB_SPIN(xb_ld(&bar[XB_XGEN(b.x)]) == gen, bar);
            __builtin_amdgcn_fence(__ATOMIC_ACQUIRE, "agent");
            asm volatile("s_waitcnt vmcnt(0)" ::: "memory");
        }
    }
    __syncthreads();
}

constexpr int NWAVES = 8, NTHR = 512;
constexpr int D = 1024, BATCH = 2, SEQ = 16384, NMETA = 16;
constexpr int MMAIN = BATCH * SEQ;
constexpr int MROWS = MMAIN + NMETA;
constexpr int MPAD = MMAIN + 256;
constexpr int RGW = 1344, RGBW = 168, NRG = 2816  , KRGO = 1408  , NGT = 4096, KGT = 256, XCW = 2048;
constexpr int FF = 3584, NE = 8, NFF2 = 2 * FF;
constexpr int GH = 4, GDK = 128, GDV = 256, GQK = 512, GVD = 1024, NGLA = 3072, GLAW = 3088, GRANK = 16;
constexpr int MSORT = 265 * 256;
constexpr float LN_EPS = 1e-5f, ALPHA = 1.6817928305074290f;
constexpr int SEG = 128, NSEG_B = SEQ / SEG, NSEG = 1 + BATCH * NSEG_B;
constexpr int CPS = 4, NSC_BH = SEQ / (64 * CPS), NGU = BATCH * GH * NSC_BH + GH;

constexpr size_t MiB = 1u << 20;
constexpr size_t WS_CTL = 0, CTL_ZERO_BYTES = 1 * MiB;
constexpr size_t WL_RGIN = 0, WL_GATES = WL_RGIN + (size_t)NRG * D * 2, WL_RGOUT = WL_GATES + (size_t)NGT * KGT * 2, WL_GLAIN = WL_RGOUT + (size_t)D * KRGO * 2,
                 WL_GLAOUT = WL_GLAIN + (size_t)NGLA * D * 2, WL_FFNIN = WL_GLAOUT + (size_t)D * D * 2, WL_FFNOUT = WL_FFNIN + (size_t)NFF2 * D * 2,
                 WL_MOEIN = WL_FFNOUT + (size_t)D * FF * 2, WL_MOEOUT = WL_MOEIN + (size_t)NE * NFF2 * D * 2, WL_STRIDE = WL_MOEOUT + (size_t)NE * D * FF * 2;
constexpr size_t WS_W = 1 * MiB;
constexpr size_t WS_H = WS_W + 2 * WL_STRIDE;
constexpr size_t WS_HB = WS_H + (size_t)MPAD * D * 4;
constexpr size_t WS_MIX = WS_HB + (size_t)MPAD * D * 2;
constexpr size_t WS_Z = WS_MIX + (size_t)MPAD * D * 4;
constexpr size_t WS_RT = WS_Z + 3 * MiB;
constexpr size_t WS_AGG = WS_RT + 1 * MiB;
constexpr size_t WS_S0 = WS_AGG + 3 * MiB;
constexpr size_t S_PROJ = 0, S_XC = S_PROJ + (size_t)MPAD * NRG * 2, S_LOGA = S_XC + (size_t)MPAD * XCW * 2, S_U = S_LOGA + (size_t)MPAD * RGW * 4, S_Y = S_U + (size_t)MPAD * RGW * 4, S_RG_END = S_Y + (size_t)MPAD * KRGO * 2;
constexpr size_t S_HID = 0;
constexpr size_t S_QKVR = 0, S_KVS = S_QKVR + (size_t)MPAD * NGLA * 2, S_SST = S_KVS + (size_t)NGU * GDK * GDV * 4, S_O = S_SST + (size_t)NGU * GDK * GDV * 4, S_DEC = S_O + (size_t)MPAD * D * 2, S_GLA_END = S_DEC + 1 * MiB;
constexpr size_t S_AS = 0, S_HS = S_AS + (size_t)MSORT * D * 2, S_YS = S_HS + (size_t)MSORT * FF * 2, S_MOE_END = S_YS + (size_t)MSORT * D * 4;
constexpr size_t S_MAX = S_RG_END > S_MOE_END ? (S_RG_END > S_GLA_END ? S_RG_END : S_GLA_END) : (S_MOE_END > S_GLA_END ? S_MOE_END : S_GLA_END);
constexpr size_t WS_END = WS_S0 + S_MAX;
constexpr int CW_TMO = 0, CW_BAR = 4096, CW_MOE = 8192;

constexpr int LDS_BYTES = 163840, MISC_OFF = LDS_BYTES - 64;

struct Frame {
    LAS unsigned char* lds; gu32* ctl; unsigned char* ws;
    int tid, lane, wave, G, bx;
    __device__ __forceinline__ void fresh() { asm volatile("" : "+v"(tid)); asm volatile("" : "+s"(bx)); asm volatile("" : "+s"(ws)); lane = tid & 63; wave = __builtin_amdgcn_readfirstlane(tid >> 6); ctl = (gu32*)(ws + WS_CTL); }
};
struct Args { const float* in[21]; float* out; unsigned char* ws; int ph_lo, ph_hi; unsigned submask; int pad; };

struct EpiBf16Gelu {
    static constexpr bool PERM = true, PAIR = false;
    bf16* O; int ldc, gelu_cols;
    __device__ __forceinline__ void operator()(const f32x4 (&acc)[2][2][4][2], const pg8::Unit& u, int wr, int wc, int fr, int fq) const {
        const int row0 = u.pm * 256 + wr * 64 + fr, col0 = u.pn * 256 + wc * 32 + 8 * fq;
#pragma unroll
        for (int ai = 0; ai < 2; ++ai)
#pragma unroll
            for (int m = 0; m < 4; ++m) { bf16* rowp = O + (size_t)(row0 + ai * 128 + m * 16) * ldc + col0;
#pragma unroll
                for (int bj = 0; bj < 2; ++bj) { f32x4 v0 = acc[ai][bj][m][0], v1 = acc[ai][bj][m][1];
                    if (col0 + bj * 128 < gelu_cols) {
#pragma unroll
                        for (int j = 0; j < 4; ++j) { v0[j] = gelu_tanh_f(v0[j]); v1[j] = gelu_tanh_f(v1[j]); } }
                    v4u w; w.x = cvt_pk_bf16(v0[0], v0[1]); w.y = cvt_pk_bf16(v0[2], v0[3]); w.z = cvt_pk_bf16(v1[0], v1[1]); w.w = cvt_pk_bf16(v1[2], v1[3]);
                    *(v4u*)(rowp + bj * 128) = w; } }
    }
    __device__ __forceinline__ void meta_task(int task, int& r0, int& aoff) const { r0 = task * 16; aoff = 0; }
    __device__ __forceinline__ void meta(int task, f32x4 a0, f32x4, int fr, int fq) const {
        const int col = task * 16 + 4 * fq;
        if (col < gelu_cols) {
#pragma unroll
            for (int j = 0; j < 4; ++j) a0[j] = gelu_tanh_f(a0[j]); }
        v2u w; w.x = cvt_pk_bf16(a0[0], a0[1]); w.y = cvt_pk_bf16(a0[2], a0[3]);
        *(v2u*)(O + (size_t)(MMAIN + fr) * ldc + col) = w;
    }
};
struct EpiSwiglu {
    static constexpr bool PERM = true, PAIR = true;
    bf16* O; int ldc;
    __device__ __forceinline__ void operator()(const f32x4 (&acc)[2][2][4][2], const pg8::Unit& u, int wr, int wc, int fr, int fq) const {
        const int row0 = u.pm * 256 + wr * 64 + fr, col0 = u.pn * 128 + wc * 32 + 8 * fq;
#pragma unroll
        for (int ai = 0; ai < 2; ++ai)
#pragma unroll
            for (int m = 0; m < 4; ++m) { bf16* rowp = O + (size_t)(row0 + ai * 128 + m * 16) * ldc + col0;
                f32x4 g0 = acc[ai][0][m][0], g1 = acc[ai][0][m][1]; const f32x4 u0 = acc[ai][1][m][0], u1 = acc[ai][1][m][1];
#pragma unroll
                for (int j = 0; j < 4; ++j) { g0[j] = silu_f(g0[j]) * u0[j]; g1[j] = silu_f(g1[j]) * u1[j]; }
                v4u w; w.x = cvt_pk_bf16(g0[0], g0[1]); w.y = cvt_pk_bf16(g0[2], g0[3]); w.z = cvt_pk_bf16(g1[0], g1[1]); w.w = cvt_pk_bf16(g1[2], g1[3]);
                *(v4u*)rowp = w; }
    }
    __device__ __forceinline__ void meta_task(int task, int& r0, int& aoff) const { r0 = (task >> 3) * 256 + (task & 7) * 16; aoff = 0; }
    __device__ __forceinline__ void meta(int task, f32x4 a0, f32x4 a1, int fr, int fq) const {
        const int col = (task >> 3) * 128 + (task & 7) * 16 + 4 * fq;
#pragma unroll
        for (int j = 0; j < 4; ++j) a0[j] = silu_f(a0[j]) * a1[j];
        v2u w; w.x = cvt_pk_bf16(a0[0], a0[1]); w.y = cvt_pk_bf16(a0[2], a0[3]);
        *(v2u*)(O + (size_t)(MMAIN + fr) * ldc + col) = w;
    }
};
struct EpiF32 {
    static constexpr bool PERM = false, PAIR = false;
    float* C; int ldc;
    __device__ __forceinline__ void operator()(const f32x4 (&acc)[2][2][4][2], const pg8::Unit& u, int wr, int wc, int fr, int fq) const {
        const int row0 = u.pm * 256 + wr * 64 + fr, col0 = u.pn * 256 + wc * 32 + 4 * fq;
#pragma unroll
        for (int ai = 0; ai < 2; ++ai)
#pragma unroll
            for (int m = 0; m < 4; ++m) { float* rowp = C + (size_t)(row0 + ai * 128 + m * 16) * ldc + col0;
#pragma unroll
                for (int bj = 0; bj < 2; ++bj)
#pragma unroll
                    for (int n = 0; n < 2; ++n) *(f32x4*)(rowp + bj * 128 + n * 16) = acc[ai][bj][m][n]; }
    }
    __device__ __forceinline__ void meta_task(int task, int& r0, int& aoff) const { r0 = task * 16; aoff = 0; }
    __device__ __forceinline__ void meta(int task, f32x4 a0, f32x4, int fr, int fq) const { *(f32x4*)(C + (size_t)(MMAIN + fr) * ldc + task * 16 + 4 * fq) = a0; }
};

template <class Epi>
__device__ __forceinline__ void meta_gemm(Frame& F, const bf16* A16, int lda, int K, const bf16* Bt, int ntasks, const Epi& E) {
    const int fr = F.lane & 15, fq = F.lane >> 4;
    LAS f32x4* red = (LAS f32x4*)F.lds;
    for (int task = F.bx; task < ntasks; task += F.G) {
        int r0, aoff; E.meta_task(task, r0, aoff);
        f32x4 acc0 = (f32x4){0.f, 0.f, 0.f, 0.f}, acc1 = acc0;
        const bf16* ap = A16 + (size_t)fr * lda + aoff + fq * 8; const bf16* bp0 = Bt + (size_t)(r0 + fr) * K + fq * 8; const bf16* bp1 = bp0 + (size_t)128 * K;
        for (int ks = F.wave; ks < K / 32; ks += NWAVES) {
            const bf16x8 a = *(const bf16x8*)(ap + ks * 32); const bf16x8 b0 = *(const bf16x8*)(bp0 + ks * 32);
            acc0 = __builtin_amdgcn_mfma_f32_16x16x32_bf16(b0, a, acc0, 0, 0, 0);
            if (Epi::PAIR) { const bf16x8 b1 = *(const bf16x8*)(bp1 + ks * 32); acc1 = __builtin_amdgcn_mfma_f32_16x16x32_bf16(b1, a, acc1, 0, 0, 0); }
        }
        red[(F.wave * 2 + 0) * 64 + F.lane] = acc0; if (Epi::PAIR) red[(F.wave * 2 + 1) * 64 + F.lane] = acc1;
        __syncthreads();
        if (F.wave == 0) {
            f32x4 s0 = red[F.lane], s1 = Epi::PAIR ? red[64 + F.lane] : acc1;
#pragma unroll
            for (int w = 1; w < NWAVES; ++w) { s0 += red[(w * 2) * 64 + F.lane]; if (Epi::PAIR) s1 += red[(w * 2 + 1) * 64 + F.lane]; }
            E.meta(task, s0, s1, fr, fq);
        }
        __syncthreads();
    }
}

__device__ __forceinline__ void transpose_item(const float* W, int ldw, int Ksrc, int c0, int nvalid, bf16* WT, int Kdst, int n0, int k0, LAS float* scr, int lane) {
#pragma unroll 8
    for (int i = 0; i < 32; ++i) { const int kk = 2 * i + (lane >> 5), c = lane & 31;
        const bool ok = (k0 + kk < Ksrc) && (c < nvalid); const float v = W[ok ? (size_t)(k0 + kk) * ldw + c0 + c : (size_t)0];
        scr[kk * 33 + c] = ok ? v : 0.f; }
    LDS_WAIT(); asm volatile("" ::: "memory");
    const int c = lane & 7;
#pragma unroll
    for (int j = 0; j < 4; ++j) { const int n = (lane >> 3) + 8 * j; const LAS float* s = scr + (8 * c) * 33 + n;
        v4u o; o.x = pk2(s[0 * 33], s[1 * 33]); o.y = pk2(s[2 * 33], s[3 * 33]); o.z = pk2(s[4 * 33], s[5 * 33]); o.w = pk2(s[6 * 33], s[7 * 33]);
        *(v4u*)(WT + (size_t)(n0 + n) * Kdst + k0 + 8 * c) = o; }
    LDS_WAIT(); asm volatile("" ::: "memory");
}
__device__ __forceinline__ void map_id(int n0, int nsrc, int& c0, int& nv) { c0 = n0; nv = nsrc - n0; nv = nv < 0 ? 0 : (nv > 32 ? 32 : nv); if (nv == 0) c0 = 0; }
__device__ __forceinline__ void map_swiglu(int n0, int& c0, int& nv) { const int tile = n0 >> 8, rr = n0 & 255; c0 = rr < 128 ? tile * 128 + rr : FF + tile * 128 + rr - 128; nv = 32; }

__device__ __forceinline__ void p0_prologue(Frame& F, const Args& a) {
    LAS float* scr = (LAS float*)(F.lds + F.wave * 16384);
    const int gw = F.bx * NWAVES + F.wave, NGW = F.G * NWAVES;
    constexpr int I_RGIN = (D / 64) * (NRG / 32), I_GATES = (KGT / 64) * (NGT / 32), I_RGOUT = (KRGO / 64) * (D / 32), I_GLAIN = (D / 64) * (NGLA / 32), I_GLAOUT = (D / 64) * (D / 32),
                  I_FFNIN = (D / 64) * (NFF2 / 32), I_FFNOUT = (FF / 64) * (D / 32), I_MOEIN = NE * I_FFNIN, I_MOEOUT = NE * I_FFNOUT;
    constexpr int I_PER_J = I_RGIN + I_GATES + I_RGOUT + I_GLAIN + I_GLAOUT + I_FFNIN + I_FFNOUT + I_MOEIN + I_MOEOUT;
    for (int it = gw; it < 2 * I_PER_J; it += NGW) {
        const int j = it / I_PER_J; int r = it - j * I_PER_J;
        unsigned char* wl = F.ws + WS_W + (size_t)j * WL_STRIDE;
        int c0, nv;
        if (r < I_RGIN) { const int nb = r % (NRG / 32), kb = r / (NRG / 32); map_id(nb * 32, 2 * RGW, c0, nv);
            transpose_item(a.in[4] + (size_t)j * D * 2 * RGW, 2 * RGW, D, c0, nv, (bf16*)(wl + WL_RGIN), D, nb * 32, kb * 64, scr, F.lane); continue; } r -= I_RGIN;
        if (r < I_GATES) { const int nb = r % (NGT / 32), kb = r / (NGT / 32); const int n0 = nb * 32, pn = n0 >> 8, rr = n0 & 255, g = rr >> 7, cc = rr & 127, d0 = (pn & 1) * 128 + cc, blk = pn >> 1;
            nv = RGBW - d0; nv = nv < 0 ? 0 : (nv > 32 ? 32 : nv); c0 = nv ? d0 : 0;
            transpose_item(a.in[7] + ((size_t)(j * 2 + g) * 8 + blk) * RGBW * RGBW, RGBW, RGBW, c0, nv, (bf16*)(wl + WL_GATES), KGT, n0, kb * 64, scr, F.lane); continue; } r -= I_GATES;
        if (r < I_RGOUT) { const int nb = r % (D / 32), kb = r / (D / 32);
            transpose_item(a.in[10] + (size_t)j * RGW * D, D, RGW, nb * 32, 32, (bf16*)(wl + WL_RGOUT), KRGO, nb * 32, kb * 64, scr, F.lane); continue; } r -= I_RGOUT;
        if (r < I_GLAIN) { const int nb = r % (NGLA / 32), kb = r / (NGLA / 32);
            transpose_item(a.in[11] + (size_t)j * D * GLAW, GLAW, D, nb * 32, 32, (bf16*)(wl + WL_GLAIN), D, nb * 32, kb * 64, scr, F.lane); continue; } r -= I_GLAIN;
        if (r < I_GLAOUT) { const int nb = r % (D / 32), kb = r / (D / 32);
            transpose_item(a.in[15] + (size_t)j * D * D, D, D, nb * 32, 32, (bf16*)(wl + WL_GLAOUT), D, nb * 32, kb * 64, scr, F.lane); continue; } r -= I_GLAOUT;
        if (r < I_FFNIN) { const int nb = r % (NFF2 / 32), kb = r / (NFF2 / 32); map_swiglu(nb * 32, c0, nv);
            transpose_item(a.in[16] + (size_t)j * D * NFF2, NFF2, D, c0, nv, (bf16*)(wl + WL_FFNIN), D, nb * 32, kb * 64, scr, F.lane); continue; } r -= I_FFNIN;
        if (r < I_FFNOUT) { const int nb = r % (D / 32), kb = r / (D / 32);
            transpose_item(a.in[17] + (size_t)j * FF * D, D, FF, nb * 32, 32, (bf16*)(wl + WL_FFNOUT), FF, nb * 32, kb * 64, scr, F.lane); continue; } r -= I_FFNOUT;
        if (r < I_MOEIN) { const int e = r / I_FFNIN, r2 = r % I_FFNIN; const int nb = r2 % (NFF2 / 32), kb = r2 / (NFF2 / 32); map_swiglu(nb * 32, c0, nv);
            transpose_item(a.in[19] + ((size_t)j * NE + e) * D * NFF2, NFF2, D, c0, nv, (bf16*)(wl + WL_MOEIN) + (size_t)e * NFF2 * D, D, nb * 32, kb * 64, scr, F.lane); continue; } r -= I_MOEIN;
        { const int e = r / I_FFNOUT, r2 = r % I_FFNOUT; const int nb = r2 % (D / 32), kb = r2 / (D / 32);
            transpose_item(a.in[20] + ((size_t)j * NE + e) * FF * D, D, FF, nb * 32, 32, (bf16*)(wl + WL_MOEOUT) + (size_t)e * D * FF, FF, nb * 32, kb * 64, scr, F.lane); }
    }
    float* H = (float*)(F.ws + WS_H); bf16* HB = (bf16*)(F.ws + WS_HB);
    for (int m = gw; m < MROWS; m += NGW) {
        const float* src = m < MMAIN ? a.in[0] + (size_t)m * D : a.in[1] + (size_t)(m - MMAIN) * D;
#pragma unroll
        for (int q = 0; q < 4; ++q) { const f32x4 v = *(const f32x4*)(src + 4 * F.lane + 256 * q);
            *(f32x4*)(H + (size_t)m * D + 4 * F.lane + 256 * q) = v;
            v2u w; w.x = pk2(v[0], v[1]); w.y = pk2(v[2], v[3]); *(v2u*)(HB + (size_t)m * D + 4 * F.lane + 256 * q) = w; }
    }
}

__device__ __forceinline__ void ln_phase(Frame& F, int mixkind, const float* gam, const float* bet, int extra, const float* Wx, int ldx, float* outp, gu32* moe_cnt) {
    float* H = (float*)(F.ws + WS_H); bf16* HB = (bf16*)(F.ws + WS_HB); const float* MIX = (const float*)(F.ws + WS_MIX);
    const float* YS = (const float*)(F.ws + WS_S0 + S_YS);
    int* E1 = (int*)(F.ws + WS_RT); int* E2 = E1 + MROWS; float* W1 = (float*)(E2 + MROWS); float* W2 = W1 + MROWS; int* POS1 = (int*)(W2 + MROWS); int* POS2 = POS1 + MROWS;
    float* Z = (float*)(F.ws + WS_Z);
    LAS float* WL = (LAS float*)F.lds;
    LAS unsigned* lcnt = (LAS unsigned*)(F.lds + 65536);
    const int NC = extra == 1 ? 16 : (extra == 2 ? 8 : 0);
    if (extra) { for (int i = F.tid; i < NC * D; i += NTHR) { const int e = i / D, c = i % D; WL[e * D + c] = Wx[(size_t)c * ldx + e]; }
        if (F.tid < 8) lcnt[F.tid] = 0u;
        __syncthreads(); }
    const int gw = F.bx * NWAVES + F.wave, NGW = F.G * NWAVES;
    f32x4 gv[4], bv[4];
#pragma unroll
    for (int q = 0; q < 4; ++q) { gv[q] = *(const f32x4*)(gam + 4 * F.lane + 256 * q); bv[q] = *(const f32x4*)(bet + 4 * F.lane + 256 * q); }
    unsigned mycnt = 0u;
    for (int m = gw; m < MROWS; m += NGW) {
        f32x4 v[4]; float s = 0.f;
        const float* hp = H + (size_t)m * D + 4 * F.lane;
#pragma unroll
        for (int q = 0; q < 4; ++q) v[q] = *(const f32x4*)(hp + 256 * q) * ALPHA;
        if (mixkind == 1) { const float* mp = MIX + (size_t)m * D + 4 * F.lane;
#pragma unroll
            for (int q = 0; q < 4; ++q) v[q] += *(const f32x4*)(mp + 256 * q); }
        if (mixkind == 2) { const float w1 = W1[m], w2 = W2[m]; const float* y1 = YS + (size_t)POS1[m] * D + 4 * F.lane; const float* y2 = YS + (size_t)POS2[m] * D + 4 * F.lane;
#pragma unroll
            for (int q = 0; q < 4; ++q) v[q] += *(const f32x4*)(y1 + 256 * q) * w1 + *(const f32x4*)(y2 + 256 * q) * w2; }
#pragma unroll
        for (int q = 0; q < 4; ++q) s += (v[q][0] + v[q][1]) + (v[q][2] + v[q][3]);
        const float mean = wave_sum(s) * (1.f / D); float s2 = 0.f;
#pragma unroll
        for (int q = 0; q < 4; ++q) { v[q] = v[q] - mean; s2 += (v[q][0] * v[q][0] + v[q][1] * v[q][1]) + (v[q][2] * v[q][2] + v[q][3] * v[q][3]); }
        const float rstd = 1.f / sqrtf(wave_sum(s2) * (1.f / D) + LN_EPS);
#pragma unroll
        for (int q = 0; q < 4; ++q) { v[q] = v[q] * rstd * gv[q] + bv[q];
            *(f32x4*)(H + (size_t)m * D + 4 * F.lane + 256 * q) = v[q];
            v2u w; w.x = pk2(v[q][0], v[q][1]); w.y = pk2(v[q][2], v[q][3]); *(v2u*)(HB + (size_t)m * D + 4 * F.lane + 256 * q) = w; }
        if (outp && m < MMAIN) {
#pragma unroll
            for (int q = 0; q < 4; ++q) *(f32x4*)(outp + (size_t)m * D + 4 * F.lane + 256 * q) = v[q]; }
        if (extra) {
            float lg[16];
#pragma unroll
            for (int e = 0; e < 16; ++e) { lg[e] = 0.f; if (e < NC) { float p = 0.f;
#pragma unroll
                    for (int q = 0; q < 4; ++q) { const f32x4 w = *(const LAS f32x4*)(WL + e * D + 4 * F.lane + 256 * q); p += (v[q][0] * w[0] + v[q][1] * w[1]) + (v[q][2] * w[2] + v[q][3] * w[3]); }
                    lg[e] = wave_sum(p); } }
            if (extra == 1) { float zv = 0.f;
#pragma unroll
                for (int e = 0; e < 16; ++e) zv = (F.lane == e) ? lg[e] : zv;
                if (F.lane < 16) Z[(size_t)m * 16 + F.lane] = zv; }
            else { int e1 = 0; float l1 = lg[0];
#pragma unroll
                for (int e = 1; e < 8; ++e) if (lg[e] > l1) { l1 = lg[e]; e1 = e; }
                int e2 = -1; float l2 = -3.0e38f;
#pragma unroll
                for (int e = 0; e < 8; ++e) if (e != e1 && lg[e] > l2) { l2 = lg[e]; e2 = e; }
                const float w2 = 1.f / (1.f + __expf(l1 - l2)), w1 = 1.f - w2;
                if (F.lane == 0) { E1[m] = e1; E2[m] = e2; W1[m] = w1; W2[m] = w2; }
                mycnt += (F.lane == e1 || F.lane == e2) ? 1u : 0u; }
        }
    }
    if (extra == 2) { if (F.lane < 8 && mycnt) __hip_atomic_fetch_add(&lcnt[F.lane], mycnt, __ATOMIC_RELAXED, __HIP_MEMORY_SCOPE_WORKGROUP);
        __syncthreads();
        if (F.tid < 8 && lcnt[F.tid]) __hip_atomic_fetch_add(moe_cnt + F.tid, lcnt[F.tid], RLX_AGENT); }
}

struct EpiGates {
    static constexpr bool PERM = true, PAIR = true;
    float* LOGA; float* U; const bf16* XC; const float* bg; const float* lam;
    __device__ __forceinline__ void chan4(int ch, f32x4& br, f32x4& bi, f32x4& c8) const {
        br = *(const f32x4*)(bg + ch); bi = *(const f32x4*)(bg + RGW + ch); const f32x4 lm = *(const f32x4*)(lam + ch);
#pragma unroll
        for (int t = 0; t < 4; ++t) c8[t] = -8.0f * log1pf(__expf(-lm[t]));
    }
    __device__ __forceinline__ void elem4(int row, int blk, int d, f32x4 ra, f32x4 ia, const f32x4& br, const f32x4& bi, const f32x4& c8) const {
        const int ch = blk * RGBW + d;
        const v2u xw = *(const v2u*)(XC + (size_t)row * XCW + blk * 256 + d);
        const float xc[4] = {bflo(xw.x), bfhi(xw.x), bflo(xw.y), bfhi(xw.y)};
        f32x4 la, uu;
#pragma unroll
        for (int t = 0; t < 4; ++t) {
            const float r = sigmoid_f(ra[t] + br[t]), ig = sigmoid_f(ia[t] + bi[t]);
            const float l = c8[t] * r;
            const float a2 = fast_exp(2.0f * l);
            la[t] = l; uu[t] = sqrtf(fmaxf(1.0f - a2, 0.f)) * (ig * xc[t]);
        }
        *(f32x4*)(LOGA + (size_t)row * RGW + ch) = la; *(f32x4*)(U + (size_t)row * RGW + ch) = uu;
    }
    __device__ __forceinline__ void operator()(const f32x4 (&acc)[2][2][4][2], const pg8::Unit& u, int wr, int wc, int fr, int fq) const {
        const int row0 = u.pm * 256 + wr * 64 + fr, blk = u.pn >> 1, d0 = (u.pn & 1) * 128 + wc * 32 + 8 * fq;
#pragma unroll
        for (int n = 0; n < 2; ++n) { const int d = d0 + 4 * n; if (d < RGBW) {
            f32x4 br, bi, c8; chan4(blk * RGBW + d, br, bi, c8);
#pragma unroll
            for (int ai = 0; ai < 2; ++ai)
#pragma unroll
                for (int m = 0; m < 4; ++m) elem4(row0 + ai * 128 + m * 16, blk, d, acc[ai][0][m][n], acc[ai][1][m][n], br, bi, c8); } }
    }
    __device__ __forceinline__ void meta_task(int task, int& r0, int& aoff) const { const int pn = task >> 3; r0 = pn * 256 + (task & 7) * 16; aoff = (pn >> 1) * 256; }
    __device__ __forceinline__ void meta(int task, f32x4 a0, f32x4 a1, int fr, int fq) const {
        const int pn = task >> 3, d = (pn & 1) * 128 + (task & 7) * 16 + 4 * fq;
        if (d < RGBW) { f32x4 br, bi, c8; chan4((pn >> 1) * RGBW + d, br, bi, c8); elem4(MMAIN + fr, pn >> 1, d, a0, a1, br, bi, c8); }
    }
};

__device__ __forceinline__ int conv_src_row(int row, int delta) {
    if (row < MMAIN) { const int t = row & (SEQ - 1); return (t - delta >= 0) ? row - delta : MMAIN + NMETA + (t - delta); }
    const int jm = row - MMAIN; return (jm - delta >= 0) ? row - delta : -1;
}
__device__ __forceinline__ void rg_conv_phase(Frame& F, const float* cw, const float* cb) {
    const bf16* PROJ = (const bf16*)(F.ws + WS_S0 + S_PROJ); bf16* XC = (bf16*)(F.ws + WS_S0 + S_XC);
    for (int idx = F.bx * NTHR + F.tid; idx < MROWS * 256; idx += F.G * NTHR) {
        const int row = idx >> 8, g = idx & 255, blk = g >> 5, kk = (g & 31) * 8;
        v4u o = (v4u){0u, 0u, 0u, 0u};
        if (kk < RGBW) {
            const int ch = blk * RGBW + kk;
            float a[8];
            { const f32x4 b0 = *(const f32x4*)(cb + ch), b1 = *(const f32x4*)(cb + ch + 4);
#pragma unroll
              for (int t = 0; t < 4; ++t) { a[t] = b0[t]; a[4 + t] = b1[t]; } }
#pragma unroll
            for (int tap = 0; tap < 4; ++tap) {
                const int rr = conv_src_row(row, 3 - tap);
                if (rr >= 0) {
                    const v4u x = *(const v4u*)(PROJ + (size_t)rr * NRG + RGW + ch);
                    const f32x4 w0 = *(const f32x4*)(cw + tap * RGW + ch), w1 = *(const f32x4*)(cw + tap * RGW + ch + 4);
                    a[0] += bflo(x.x) * w0[0]; a[1] += bfhi(x.x) * w0[1]; a[2] += bflo(x.y) * w0[2]; a[3] += bfhi(x.y) * w0[3];
                    a[4] += bflo(x.z) * w1[0]; a[5] += bfhi(x.z) * w1[1]; a[6] += bflo(x.w) * w1[2]; a[7] += bfhi(x.w) * w1[3];
                }
            }
            o.x = pk2(a[0], a[1]); o.y = pk2(a[2], a[3]); o.z = pk2(a[4], a[5]); o.w = pk2(a[6], a[7]);
        }
        *(v4u*)(XC + (size_t)row * XCW + blk * 256 + kk) = o;
    }
}
template <bool FIX>
__device__ __forceinline__ void rg_scan_phase(Frame& F) {
    const float* LOGA = (const float*)(F.ws + WS_S0 + S_LOGA); const float* U = (const float*)(F.ws + WS_S0 + S_U);
    const bf16* PROJ = (const bf16*)(F.ws + WS_S0 + S_PROJ); bf16* Y = (bf16*)(F.ws + WS_S0 + S_Y);
    float* AGGA = (float*)(F.ws + WS_AGG); float* AGGH = AGGA + (size_t)NSEG * RGW;
    const int gw = F.bx * NWAVES + F.wave, NGW = F.G * NWAVES;
    for (int task = gw; task < NSEG * 21; task += NGW) {
        const int seg = task / 21, cg = task - seg * 21, ch = cg * 64 + F.lane;
        const int row0 = seg == 0 ? MMAIN : (seg - 1) * SEG, nrows = seg == 0 ? NMETA : SEG;
        float h = 0.f, cl = 0.f;
        if (FIX && seg > 0) {
            h = AGGH[ch];
            const int sb = 1 + ((seg - 1) / NSEG_B) * NSEG_B, ns = (seg - 1) % NSEG_B;
            for (int q = 0; q < ns; ++q) h = __expf(AGGA[(size_t)(sb + q) * RGW + ch]) * h + AGGH[(size_t)(sb + q) * RGW + ch];
        }
        for (int r = 0; r < nrows; r += 8) {
            float la[8], uu[8], gt[8];
#pragma unroll
            for (int t = 0; t < 8; ++t) { const size_t o = (size_t)(row0 + r + t) * RGW + ch; la[t] = LOGA[o]; uu[t] = U[o]; if (FIX) gt[t] = bf2f(PROJ[(size_t)(row0 + r + t) * NRG + ch]); }
#pragma unroll
            for (int t = 0; t < 8; ++t) { h = __expf(la[t]) * h + uu[t]; cl += la[t];
                if (FIX) { Y[(size_t)(row0 + r + t) * KRGO + ch] = (bf16)f2bf(h * gt[t]); if (cg == 20) Y[(size_t)(row0 + r + t) * KRGO + RGW + F.lane] = (bf16)0; } }
        }
        if (!FIX) { AGGA[(size_t)seg * RGW + ch] = cl; AGGH[(size_t)seg * RGW + ch] = h; }
    }
}

#define RG_PHASES \
        if (IN(pb + 0)) { if (on_rg) { \
            bf16* PROJ = (bf16*)(F.ws + WS_S0 + S_PROJ); EpiBf16Gelu E{PROJ, NRG, RGW}; \
            meta_gemm(F, HB + (size_t)MMAIN * D, D, D, (const bf16*)(wl + WL_RGIN), NRG / 16, E); \
            pg8::Gemm g{D, D}; pg8::DenseOrder S; S.init(HB, D, (const bf16*)(wl + WL_RGIN), D, MMAIN / 256, NRG / 256, F.G, F.bx); \
            pg8::gemm_phase<EpiBf16Gelu, pg8::DenseOrder>(F.lds, F.tid, g, S, E); } \
            SEAM(pb + 0); } \
        if (IN(pb + 1)) { if (on_rg) rg_conv_phase(F, args.in[5] + (size_t)j * 4 * RGW, args.in[6] + (size_t)j * RGW); SEAM(pb + 1); } \
        if (IN(pb + 2)) { if (on_rg) { \
            const bf16* XC = (const bf16*)(F.ws + WS_S0 + S_XC); \
            EpiGates E{(float*)(F.ws + WS_S0 + S_LOGA), (float*)(F.ws + WS_S0 + S_U), XC, args.in[8] + (size_t)j * 2 * RGW, args.in[9] + (size_t)j * RGW}; \
            meta_gemm(F, XC + (size_t)MMAIN * XCW, XCW, KGT, (const bf16*)(wl + WL_GATES), (NGT / 256) * 8, E); \
            pg8::Gemm g{KGT, XCW}; pg8::GatesOrder S; S.init(XC, XCW, (const bf16*)(wl + WL_GATES), KGT, MMAIN / 256, NGT / 256, F.G, F.bx); \
            pg8::gemm_phase<EpiGates, pg8::GatesOrder>(F.lds, F.tid, g, S, E); } \
            SEAM(pb + 2); } \
        if (IN(pb + 3)) { if (on_rg) rg_scan_phase<false>(F); SEAM(pb + 3); } \
        if (IN(pb + 4)) { if (on_rg) rg_scan_phase<true>(F); SEAM(pb + 4); } \
        if (IN(pb + 5)) { if (on_rg) { \
            const bf16* Y = (const bf16*)(F.ws + WS_S0 + S_Y); EpiF32 E{MIX, D}; \
            meta_gemm(F, Y + (size_t)MMAIN * KRGO, KRGO, KRGO, (const bf16*)(wl + WL_RGOUT), D / 16, E); \
            pg8::Gemm g{KRGO, KRGO}; pg8::DenseOrder S; S.init(Y, KRGO, (const bf16*)(wl + WL_RGOUT), KRGO, MMAIN / 256, D / 256, F.G, F.bx); \
            pg8::gemm_phase<EpiF32, pg8::DenseOrder>(F.lds, F.tid, g, S, E); } \
            SEAM(pb + 5); }

constexpr int GL_QT = 0, GL_KT = 17408  , GL_KTT = 34816, GL_VT = 53248, GL_ST = 90112  , GL_SM = 155648;
constexpr int QTS = 136, KTTS = 72, VTS = 72, PS = 72, BS = 132;
static_assert(GL_SM + 2560 <= MISC_OFF, "GLA LDS map");

template <int MODE>
__device__ __forceinline__ void gla_phase(Frame& F, const float* wgu, const float* bgate, const float* normg) {
    const bf16* QKVR = (const bf16*)(F.ws + WS_S0 + S_QKVR); const float* Z = (const float*)(F.ws + WS_Z);
    float* KVS = (float*)(F.ws + WS_S0 + S_KVS); const float* SST = (const float*)(F.ws + WS_S0 + S_SST); float* DEC = (float*)(F.ws + WS_S0 + S_DEC);
    bf16* O = (bf16*)(F.ws + WS_S0 + S_O);
    LAS bf16* QT = (LAS bf16*)(F.lds + GL_QT); LAS bf16* KT = (LAS bf16*)(F.lds + GL_KT); LAS bf16* PP = (LAS bf16*)(F.lds + GL_KT);
    LAS bf16* KTT = (LAS bf16*)(F.lds + GL_KTT); LAS bf16* VT = (LAS bf16*)(F.lds + GL_VT); LAS unsigned char* ST = F.lds + GL_ST;
    LAS float* Bc = (LAS float*)(F.lds + GL_ST); LAS float* ZC = (LAS float*)(F.lds + GL_ST + 36864);
    LAS float* em = (LAS float*)(F.lds + GL_SM); LAS float* ef = em + 128; LAS float* stats = ef + 128;
    const int tid0 = F.tid;
    for (int u = F.bx; u < NGU; u += F.G) {
        const bool meta = u >= BATCH * GH * NSC_BH;
        const int h = meta ? u - BATCH * GH * NSC_BH : (u / NSC_BH) % GH, b = meta ? 0 : u / (GH * NSC_BH), sc = meta ? 0 : u % NSC_BH;
        const int nch = meta ? 1 : CPS;
        f32x4 sacc[8][2];
        int lofs = (4 * ((tid0 & 63) >> 4)) * GDV + 32 * (tid0 >> 6) + (tid0 & 15); asm volatile("" : "+v"(lofs));
#pragma unroll
        for (int dt = 0; dt < 8; ++dt)
#pragma unroll
            for (int i = 0; i < 2; ++i) {
                sacc[dt][i] = (f32x4){0.f, 0.f, 0.f, 0.f};
                if (MODE == 1 && !meta) {
#pragma unroll
                    for (int jj = 0; jj < 4; ++jj) sacc[dt][i][jj] = SST[(size_t)u * (GDK * GDV) + (size_t)((16 * dt + jj) * GDV + 16 * i) + lofs]; }
            }
        float dsum = 0.f;
        for (int ci = 0; ci < nch; ++ci) {
            int tid = tid0; asm volatile("" : "+v"(tid));
            const int lane = tid & 63, w = __builtin_amdgcn_readfirstlane(tid >> 6), fr = lane & 15, fq = lane >> 4;
            const int rbase = meta ? 0 : b * SEQ + (sc * CPS + ci) * 64;
            if (tid < 256) { const int c = tid >> 2, part = tid & 3; const bool valid = !meta || c >= 48; const int row = meta ? MMAIN + c - 48 : rbase + c;
                f32x4 zv = (f32x4){0.f, 0.f, 0.f, 0.f}; if (valid) zv = *(const f32x4*)(Z + (size_t)row * 16 + 4 * part);
                *(LAS f32x4*)(ZC + c * 16 + 4 * part) = zv; }
            const int dA = tid & 127, cgp = tid >> 7;
            float wg[16];
#pragma unroll
            for (int i = 0; i < 16; ++i) wg[i] = wgu[(size_t)i * GQK + h * GDK + dA];
            const float bgv = bgate[h * GDK + dA];
            __syncthreads(); __builtin_amdgcn_sched_barrier(0);
#pragma unroll 4
            for (int cc = 0; cc < 16; ++cc) { const int c = cgp * 16 + cc; float lg = bgv;
#pragma unroll
                for (int i = 0; i < 16; ++i) lg += ZC[c * 16 + i] * wg[i];
                float g = (fminf(lg, 0.f) - log1pf(__expf(-fabsf(lg)))) * (1.0f / 16.0f);
                if (meta && c < 48) g = 0.f;
                Bc[c * BS + dA] = g; }
            __syncthreads(); __builtin_amdgcn_sched_barrier(0);
            if (tid < 128) { float run = 0.f, bm = 0.f;
#pragma unroll 8
                for (int c = 0; c < 64; ++c) { run += Bc[c * BS + tid]; Bc[c * BS + tid] = run; if (c == 31) bm = run; }
                em[tid] = __expf(bm); ef[tid] = __expf(run - bm); dsum += run; }
            __syncthreads(); __builtin_amdgcn_sched_barrier(0);
            { const int c = tid >> 3, d0 = (tid & 7) * 16, e0 = (tid & 7) * 32; const bool valid = !meta || c >= 48; const int row = meta ? MMAIN + c - 48 : rbase + c;
                const bf16* rp = QKVR + (size_t)row * NGLA;
                v4u q0 = (v4u){0u, 0u, 0u, 0u}, q1 = q0, k0 = q0, k1 = q0, vv[4] = {q0, q0, q0, q0};
                if (valid) { if (MODE == 1) { q0 = *(const v4u*)(rp + h * GDK + d0); q1 = *(const v4u*)(rp + h * GDK + d0 + 8); }
                    k0 = *(const v4u*)(rp + GQK + h * GDK + d0); k1 = *(const v4u*)(rp + GQK + h * GDK + d0 + 8);
#pragma unroll
                    for (int t = 0; t < 4; ++t) vv[t] = *(const v4u*)(rp + 2 * GQK + h * GDV + e0 + 8 * t); }
                const unsigned qw[8] = {q0.x, q0.y, q0.z, q0.w, q1.x, q1.y, q1.z, q1.w}, kw[8] = {k0.x, k0.y, k0.z, k0.w, k1.x, k1.y, k1.z, k1.w};
                unsigned qo[8], ko[8];
#pragma unroll
                for (int t = 0; t < 8; ++t) {
                    const int d = d0 + 2 * t;
                    const float x0 = Bc[c * BS + d] - Bc[31 * BS + d], x1 = Bc[c * BS + d + 1] - Bc[31 * BS + d + 1];
                    const float e0f = __expf(x0), e1f = __expf(x1), r0 = __expf(-x0), r1 = __expf(-x1);
                    const float ka = bflo(kw[t]) * r0, kb = bfhi(kw[t]) * r1;
                    ko[t] = pk2(ka, kb);
                    if (MODE == 1) qo[t] = pk2(bflo(qw[t]) * (0.08838834764831845f * e0f), bfhi(qw[t]) * (0.08838834764831845f * e1f));
                    KTT[(d) * KTTS + c] = (bf16)(ko[t] & 0xffffu); KTT[(d + 1) * KTTS + c] = (bf16)(ko[t] >> 16);
                }
                *(LAS v4u*)(KT + c * QTS + d0) = (v4u){ko[0], ko[1], ko[2], ko[3]}; *(LAS v4u*)(KT + c * QTS + d0 + 8) = (v4u){ko[4], ko[5], ko[6], ko[7]};
                if (MODE == 1) { *(LAS v4u*)(QT + c * QTS + d0) = (v4u){qo[0], qo[1], qo[2], qo[3]}; *(LAS v4u*)(QT + c * QTS + d0 + 8) = (v4u){qo[4], qo[5], qo[6], qo[7]}; }
#pragma unroll
                for (int t = 0; t < 4; ++t) { const unsigned vw[4] = {vv[t].x, vv[t].y, vv[t].z, vv[t].w};
#pragma unroll
                    for (int s = 0; s < 4; ++s) { const int e = e0 + 8 * t + 2 * s; VT[e * VTS + c] = (bf16)(vw[s] & 0xffffu); VT[(e + 1) * VTS + c] = (bf16)(vw[s] >> 16); } }
            }
            __syncthreads(); __builtin_amdgcn_sched_barrier(0);
            f32x4 pacc[2];
#pragma unroll
            for (int dt = 0; dt < 8; ++dt) { const f32x4 emv = *(const LAS f32x4*)(em + 16 * dt + 4 * fq);
#pragma unroll
                for (int i = 0; i < 2; ++i) { sacc[dt][i] = sacc[dt][i] * emv;
                    if (MODE == 1) { const int e = 32 * w + 16 * i + fr; const int ck = (2 * dt + (fq >> 1)) ^ (e & 15);
                        v2u sw; sw.x = pk2(sacc[dt][i][0], sacc[dt][i][1]); sw.y = pk2(sacc[dt][i][2], sacc[dt][i][3]);
                        *(LAS v2u*)(ST + e * 256 + ck * 16 + (fq & 1) * 8) = sw; } } }
            if (MODE == 1) {
                const int mt = w & 3, ntp = w >> 2;
#pragma unroll
                for (int ii = 0; ii < 2; ++ii) { const int nt = 2 * ntp + ii; pacc[ii] = (f32x4){0.f, 0.f, 0.f, 0.f};
                    if (nt <= mt) {
#pragma unroll
                        for (int ks = 0; ks < 4; ++ks) { const bf16x8 kf = *(const LAS bf16x8*)(KT + (16 * nt + fr) * QTS + 32 * ks + 8 * fq); const bf16x8 qf = *(const LAS bf16x8*)(QT + (16 * mt + fr) * QTS + 32 * ks + 8 * fq);
                            pacc[ii] = __builtin_amdgcn_mfma_f32_16x16x32_bf16(kf, qf, pacc[ii], 0, 0, 0); }
                        if (nt == mt) {
#pragma unroll
                            for (int jj = 0; jj < 4; ++jj) if (4 * fq + jj > fr) pacc[ii][jj] = 0.f; }
                    } }
            }
            __syncthreads(); __builtin_amdgcn_sched_barrier(0);
            if (MODE == 1) { const int mt = w & 3, ntp = w >> 2;
#pragma unroll
                for (int ii = 0; ii < 2; ++ii) { const int nt = 2 * ntp + ii; v2u pw; pw.x = pk2(pacc[ii][0], pacc[ii][1]); pw.y = pk2(pacc[ii][2], pacc[ii][3]);
                    *(LAS v2u*)(PP + (16 * mt + fr) * PS + 16 * nt + 4 * fq) = pw; }
                __syncthreads(); __builtin_amdgcn_sched_barrier(0);
            }
            f32x4 oacc[8];
            if (MODE == 1) { const int mt = w & 3, eh = w >> 2;
                bf16x8 pf[2], qf[4];
#pragma unroll
                for (int ks = 0; ks < 2; ++ks) pf[ks] = *(const LAS bf16x8*)(PP + (16 * mt + fr) * PS + 32 * ks + 8 * fq);
#pragma unroll
                for (int ks = 0; ks < 4; ++ks) qf[ks] = *(const LAS bf16x8*)(QT + (16 * mt + fr) * QTS + 32 * ks + 8 * fq);
#pragma unroll
                for (int t = 0; t < 8; ++t) { const int e = 128 * eh + 16 * t + fr; f32x4 a = (f32x4){0.f, 0.f, 0.f, 0.f};
#pragma unroll
                    for (int ks = 0; ks < 2; ++ks) { const bf16x8 vf = *(const LAS bf16x8*)(VT + e * VTS + 32 * ks + 8 * fq); a = __builtin_amdgcn_mfma_f32_16x16x32_bf16(vf, pf[ks], a, 0, 0, 0); }
#pragma unroll
                    for (int ks = 0; ks < 4; ++ks) { const int ck = (4 * ks + fq) ^ (e & 15); const bf16x8 sf = *(const LAS bf16x8*)(ST + e * 256 + ck * 16); a = __builtin_amdgcn_mfma_f32_16x16x32_bf16(sf, qf[ks], a, 0, 0, 0); }
                    oacc[t] = a; }
            }
            { bf16x8 vf[2][2];
#pragma unroll
              for (int i = 0; i < 2; ++i)
#pragma unroll
                  for (int ks = 0; ks < 2; ++ks) vf[i][ks] = *(const LAS bf16x8*)(VT + (32 * w + 16 * i + fr) * VTS + 32 * ks + 8 * fq);
#pragma unroll
              for (int dt = 0; dt < 8; ++dt) { const f32x4 efv = *(const LAS f32x4*)(ef + 16 * dt + 4 * fq);
#pragma unroll
                  for (int ks = 0; ks < 2; ++ks) { const bf16x8 kf = *(const LAS bf16x8*)(KTT + (16 * dt + fr) * KTTS + 32 * ks + 8 * fq);
#pragma unroll
                      for (int i = 0; i < 2; ++i) sacc[dt][i] = __builtin_amdgcn_mfma_f32_16x16x32_bf16(kf, vf[i][ks], sacc[dt][i], 0, 0, 0); }
#pragma unroll
                  for (int i = 0; i < 2; ++i) sacc[dt][i] = sacc[dt][i] * efv; }
            }
            if (MODE == 1) { const int mt = w & 3, eh = w >> 2, c = 16 * mt + fr;
                float s1 = 0.f, s2 = 0.f;
#pragma unroll
                for (int t = 0; t < 8; ++t)
#pragma unroll
                    for (int jj = 0; jj < 4; ++jj) { s1 += oacc[t][jj]; s2 += oacc[t][jj] * oacc[t][jj]; }
                s1 += __shfl_xor(s1, 16); s1 += __shfl_xor(s1, 32); s2 += __shfl_xor(s2, 16); s2 += __shfl_xor(s2, 32);
                if (fq == 0) { stats[(c * 2 + eh) * 2 + 0] = s1; stats[(c * 2 + eh) * 2 + 1] = s2; }
                __syncthreads(); __builtin_amdgcn_sched_barrier(0);
                const float t1 = stats[(c * 2 + 0) * 2 + 0] + stats[(c * 2 + 1) * 2 + 0], t2 = stats[(c * 2 + 0) * 2 + 1] + stats[(c * 2 + 1) * 2 + 1];
                const float mean = t1 * (1.0f / GDV), var = fmaxf(t2 * (1.0f / GDV) - mean * mean, 0.f), rstd = 1.0f / sqrtf(var + LN_EPS);
                const bool valid = !meta || c >= 48; const int row = meta ? MMAIN + c - 48 : rbase + c;
                if (valid) {
#pragma unroll
                    for (int t = 0; t < 8; ++t) { const int e = 128 * eh + 16 * t + 4 * fq;
                        const v2u rw = *(const v2u*)(QKVR + (size_t)row * NGLA + 2 * GQK + GVD + h * GDV + e);
                        const f32x4 ng = *(const f32x4*)(normg + h * GDV + e);
                        const float r4[4] = {bflo(rw.x), bfhi(rw.x), bflo(rw.y), bfhi(rw.y)}; float o4[4];
#pragma unroll
                        for (int jj = 0; jj < 4; ++jj) o4[jj] = (oacc[t][jj] - mean) * rstd * ng[jj] * silu_f(r4[jj]);
                        v2u ow; ow.x = pk2(o4[0], o4[1]); ow.y = pk2(o4[2], o4[3]);
                        *(v2u*)(O + (size_t)row * D + h * GDV + e) = ow; } }
            }
            __syncthreads(); __builtin_amdgcn_sched_barrier(0);
        }
        if (MODE == 0) {
            int lofs2 = (4 * ((tid0 & 63) >> 4)) * GDV + 32 * (tid0 >> 6) + (tid0 & 15); asm volatile("" : "+v"(lofs2));
#pragma unroll
            for (int dt = 0; dt < 8; ++dt)
#pragma unroll
                for (int i = 0; i < 2; ++i)
#pragma unroll
                    for (int jj = 0; jj < 4; ++jj) KVS[(size_t)u * (GDK * GDV) + (size_t)((16 * dt + jj) * GDV + 16 * i) + lofs2] = sacc[dt][i][jj];
            if (tid0 < 128) DEC[(size_t)u * GDK + tid0] = dsum;
        }
    }
}
__device__ __forceinline__ void gla_scan_phase(Frame& F) {
    const float* KVS = (const float*)(F.ws + WS_S0 + S_KVS); float* SST = (float*)(F.ws + WS_S0 + S_SST); const float* DEC = (const float*)(F.ws + WS_S0 + S_DEC);
    constexpr int NEL = GDK * GDV;
    for (int idx = F.bx * NTHR + F.tid; idx < BATCH * GH * NEL; idx += F.G * NTHR) {
        const int bh = idx / NEL, el = idx - bh * NEL, d = el / GDV, h = bh % GH;
        float s = KVS[(size_t)(BATCH * GH * NSC_BH + h) * NEL + el];
        const size_t ub = (size_t)bh * NSC_BH;
        SST[ub * NEL + el] = s;
        for (int sc = 0; sc + 1 < NSC_BH; ++sc) { s = __expf(DEC[(ub + sc) * GDK + d]) * s + KVS[(ub + sc) * NEL + el]; SST[(ub + sc + 1) * NEL + el] = s; }
    }
}

#define GLA_PHASES \
        if (IN(pb + 10)) { if (on_gla) { \
            bf16* QKVR = (bf16*)(F.ws + WS_S0 + S_QKVR); EpiBf16Gelu E{QKVR, NGLA, 0}; \
            meta_gemm(F, HB + (size_t)MMAIN * D, D, D, (const bf16*)(wl + WL_GLAIN), NGLA / 16, E); \
            pg8::Gemm g{D, D}; pg8::DenseOrder S; S.init(HB, D, (const bf16*)(wl + WL_GLAIN), D, MMAIN / 256, NGLA / 256, F.G, F.bx); \
            pg8::gemm_phase<EpiBf16Gelu, pg8::DenseOrder>(F.lds, F.tid, g, S, E); } \
            SEAM(pb + 10); } \
        if (IN(pb + 11)) { if (on_gla) gla_phase<0>(F, args.in[12] + (size_t)j * GRANK * GQK, args.in[13] + (size_t)j * GQK, args.in[14] + (size_t)j * GVD); SEAM(pb + 11); } \
        if (IN(pb + 12)) { if (on_gla) gla_scan_phase(F); SEAM(pb + 12); } \
        if (IN(pb + 13)) { if (on_gla) gla_phase<1>(F, args.in[12] + (size_t)j * GRANK * GQK, args.in[13] + (size_t)j * GQK, args.in[14] + (size_t)j * GVD); SEAM(pb + 13); } \
        if (IN(pb + 14)) { if (on_gla) { \
            const bf16* O = (const bf16*)(F.ws + WS_S0 + S_O); EpiF32 E{MIX, D}; \
            meta_gemm(F, O + (size_t)MMAIN * D, D, D, (const bf16*)(wl + WL_GLAOUT), D / 16, E); \
            pg8::Gemm g{D, D}; pg8::DenseOrder S; S.init(O, D, (const bf16*)(wl + WL_GLAOUT), D, MMAIN / 256, D / 256, F.G, F.bx); \
            pg8::gemm_phase<EpiF32, pg8::DenseOrder>(F.lds, F.tid, g, S, E); } \
            SEAM(pb + 14); }

__device__ __forceinline__ void moe_panel_ends(const gu32* cnt, int (&pe)[8]) {
    int acc = 0;
#pragma unroll
    for (int e = 0; e < 8; ++e) { const int c = (int)__hip_atomic_load(cnt + e, RLX_AGENT); acc += (c + 255) >> 8; pe[e] = acc; }
}
__device__ __forceinline__ void moe_gather_phase(Frame& F, gu32* moe) {
    const bf16* HB = (const bf16*)(F.ws + WS_HB); bf16* AS = (bf16*)(F.ws + WS_S0 + S_AS);
    const int* E1 = (const int*)(F.ws + WS_RT); const int* E2 = E1 + MROWS; int* POS1 = (int*)(F.ws + WS_RT) + 4 * MROWS; int* POS2 = POS1 + MROWS;
    LAS unsigned* lcnt = (LAS unsigned*)F.lds; LAS unsigned* lbase = lcnt + 8; LAS int* lpos = (LAS int*)(F.lds + 256);
    const int per = (MROWS + F.G - 1) / F.G, t0 = F.bx * per, nt = (t0 + per <= MROWS) ? per : (MROWS - t0 > 0 ? MROWS - t0 : 0);
    if (F.tid < 8) lcnt[F.tid] = 0u;
    __syncthreads();
    int e1 = 0, e2 = 0; unsigned r1 = 0, r2 = 0;
    if (F.tid < nt) { e1 = E1[t0 + F.tid]; e2 = E2[t0 + F.tid];
        r1 = __hip_atomic_fetch_add(&lcnt[e1], 1u, __ATOMIC_RELAXED, __HIP_MEMORY_SCOPE_WORKGROUP); r2 = __hip_atomic_fetch_add(&lcnt[e2], 1u, __ATOMIC_RELAXED, __HIP_MEMORY_SCOPE_WORKGROUP); }
    __syncthreads();
    if (F.tid < 8) { int ps = 0, accp = 0;
#pragma unroll
        for (int e = 0; e < 8; ++e) { ps = (e == F.tid) ? accp : ps; accp += ((int)__hip_atomic_load(moe + e, RLX_AGENT) + 255) >> 8; }
        const unsigned c = lcnt[F.tid]; const unsigned off = c ? __hip_atomic_fetch_add(moe + 64 + F.tid, c, RLX_AGENT) : 0u;
        lbase[F.tid] = (unsigned)ps * 256u + off; }
    __syncthreads();
    if (F.tid < nt) { const int p1 = (int)(lbase[e1] + r1), p2 = (int)(lbase[e2] + r2); POS1[t0 + F.tid] = p1; POS2[t0 + F.tid] = p2; lpos[2 * F.tid] = p1; lpos[2 * F.tid + 1] = p2; }
    __syncthreads();
    for (int t = F.wave; t < nt; t += NWAVES) {
        const v4u* src = (const v4u*)(HB + (size_t)(t0 + t) * D); const v4u a = src[F.lane], b = src[64 + F.lane];
        v4u* d1 = (v4u*)(AS + (size_t)lpos[2 * t] * D); v4u* d2 = (v4u*)(AS + (size_t)lpos[2 * t + 1] * D);
        d1[F.lane] = a; d1[64 + F.lane] = b; d2[F.lane] = a; d2[64 + F.lane] = b;
    }
}

#define MOE_PHASES \
        if (IN(pb + 16)) { if (on_moe) moe_gather_phase(F, F.ctl + CW_MOE + 256 * j); SEAM(pb + 16); } \
        if (IN(pb + 17)) { if (on_moe) { \
            const bf16* AS = (const bf16*)(F.ws + WS_S0 + S_AS); bf16* HS = (bf16*)(F.ws + WS_S0 + S_HS); EpiSwiglu E{HS, FF}; \
            pg8::Gemm g{D, D}; pg8::MoeOrder S; moe_panel_ends(F.ctl + CW_MOE + 256 * j, S.pe); S.e_bytes = (size_t)NFF2 * D * 2; \
            S.init(AS, D, (const bf16*)(wl + WL_MOEIN), D, S.pe[7], NFF2 / 256, F.G, F.bx); \
            pg8::gemm_phase<EpiSwiglu, pg8::MoeOrder>(F.lds, F.tid, g, S, E); } \
            SEAM(pb + 17); } \
        if (IN(pb + 18)) { if (on_moe) { \
            const bf16* HS = (const bf16*)(F.ws + WS_S0 + S_HS); EpiF32 E{(float*)(F.ws + WS_S0 + S_YS), D}; \
            pg8::Gemm g{FF, FF}; pg8::MoeOrder S; moe_panel_ends(F.ctl + CW_MOE + 256 * j, S.pe); S.e_bytes = (size_t)D * FF * 2; \
            S.init(HS, FF, (const bf16*)(wl + WL_MOEOUT), FF, S.pe[7], D / 256, F.G, F.bx); \
            pg8::gemm_phase<EpiF32, pg8::MoeOrder>(F.lds, F.tid, g, S, E); } \
            SEAM(pb + 18); }

constexpr int NPHASE = 41;
#ifndef MK_PER_PHASE
#define MK_PER_PHASE 1
#endif
#ifndef MK_DBG
#define MK_DBG 0
#endif
#ifndef MK_SUBMASK
#define MK_SUBMASK 0xFFu
#endif

__global__ void __launch_bounds__(NTHR, 2) fwd(Args args) {
    extern __shared__ __attribute__((aligned(16))) unsigned char lds[];
    Frame F;
    F.lds = (LAS unsigned char*)lds; F.ws = args.ws; F.ctl = (gu32*)(args.ws + WS_CTL);
    F.tid = threadIdx.x; F.lane = F.tid & 63; F.wave = __builtin_amdgcn_readfirstlane(F.tid >> 6); F.G = gridDim.x; F.bx = blockIdx.x;
    volatile LAS unsigned* MISC = (volatile LAS unsigned*)(F.lds + MISC_OFF);
    if (F.tid < 16) MISC[F.tid] = 0u;
    __syncthreads();
    const int lo = args.ph_lo, hi = args.ph_hi;
    XcdBarrier bar; bar.bar = (unsigned*)(F.ctl + CW_BAR); bar.x = 0; bar.st = nullptr;
    if (hi - lo > 1) bar = xcd_barrier_post((unsigned*)(F.ctl + CW_BAR), MISC);
#define IN(k) (lo <= (k) && (k) < hi && (F.fresh(), true))
#define SEAM(k) do { if ((k) + 1 < hi) xcd_barrier(bar); } while (0)
    const unsigned submask = args.submask;
    const float* ln_gain = args.in[2]; const float* ln_bias = args.in[3];
    bf16* HB = (bf16*)(F.ws + WS_HB); float* MIX = (float*)(F.ws + WS_MIX);

    if (IN(0)) { p0_prologue(F, args); SEAM(0); }

    for (int j = 0; j < 2; ++j) {
        const int pb = 1 + 20 * j;
        unsigned char* wl = F.ws + WS_W + (size_t)j * WL_STRIDE;
        const bool on_rg = (submask >> (4 * j + 0)) & 1u, on_ffn = (submask >> (4 * j + 1)) & 1u, on_gla = (submask >> (4 * j + 2)) & 1u, on_moe = (submask >> (4 * j + 3)) & 1u;
        RG_PHASES
        if (IN(pb + 6)) { ln_phase(F, on_rg ? 1 : 0, ln_gain + (size_t)(2 * j) * 2 * D, ln_bias + (size_t)(2 * j) * 2 * D, 0, nullptr, 0, nullptr, nullptr); SEAM(pb + 6); }
        if (IN(pb + 7)) { if (on_ffn) {
            bf16* HID = (bf16*)(F.ws + WS_S0 + S_HID);
            EpiSwiglu E{HID, FF};
            if (!(MK_DBG & 1)) meta_gemm(F, HB + (size_t)MMAIN * D, D, D, (const bf16*)(wl + WL_FFNIN), (NFF2 / 256) * 8, E);
            pg8::Gemm g{D, D}; pg8::DenseOrder S; S.init(HB, D, (const bf16*)(wl + WL_FFNIN), D, MMAIN / 256, NFF2 / 256, F.G, F.bx);
            if (!(MK_DBG & 2)) pg8::gemm_phase<EpiSwiglu, pg8::DenseOrder>(F.lds, F.tid, g, S, E); }
            SEAM(pb + 7); }
        if (IN(pb + 8)) { if (on_ffn) {
            const bf16* HID = (const bf16*)(F.ws + WS_S0 + S_HID);
            EpiF32 E{MIX, D};
            if (!(MK_DBG & 4)) meta_gemm(F, HID + (size_t)MMAIN * FF, FF, FF, (const bf16*)(wl + WL_FFNOUT), D / 16, E);
            pg8::Gemm g{FF, FF}; pg8::DenseOrder S; S.init(HID, FF, (const bf16*)(wl + WL_FFNOUT), FF, MMAIN / 256, D / 256, F.G, F.bx);
            if (!(MK_DBG & 8)) pg8::gemm_phase<EpiF32, pg8::DenseOrder>(F.lds, F.tid, g, S, E); }
            SEAM(pb + 8); }
        if (IN(pb + 9)) { ln_phase(F, on_ffn ? 1 : 0, ln_gain + (size_t)(2 * j) * 2 * D + D, ln_bias + (size_t)(2 * j) * 2 * D + D, 1, args.in[11] + (size_t)j * D * GLAW + NGLA, GLAW, nullptr, nullptr); SEAM(pb + 9); }
        GLA_PHASES
        if (IN(pb + 15)) { ln_phase(F, on_gla ? 1 : 0, ln_gain + (size_t)(2 * j + 1) * 2 * D, ln_bias + (size_t)(2 * j + 1) * 2 * D, on_moe ? 2 : 0, args.in[18] + (size_t)j * D * NE, NE, nullptr, F.ctl + CW_MOE + 256 * j); SEAM(pb + 15); }
        MOE_PHASES
        if (IN(pb + 19)) { ln_phase(F, on_moe ? 2 : 0, ln_gain + (size_t)(2 * j + 1) * 2 * D + D, ln_bias + (size_t)(2 * j + 1) * 2 * D + D, 0, nullptr, 0, j == 1 ? args.out : nullptr, nullptr); SEAM(pb + 19); }
    }
#undef IN
#undef SEAM
}

static bool phase_enabled(int k, unsigned mask) {
    if (k == 0) return true;
    const int j = (k - 1) / 20, r = (k - 1) % 20;
    int sub;
    if (r <= 5) sub = 0; else if (r == 6) return true; else if (r <= 8) sub = 1; else if (r == 9) return true;
    else if (r <= 14) sub = 2; else if (r == 15) return true; else if (r <= 18) sub = 3; else return true;
    return (mask >> (4 * j + sub)) & 1u;
}
extern "C" void kernel_launch(void* const* d_in, const int* in_sizes, int n_in, void* d_out, int out_size, void* d_ws, size_t ws_size, hipStream_t stream) {
    static int grid = 0;
    if (grid == 0) {
        if (n_in != 21 || out_size != MMAIN * D || ws_size < WS_END) { fprintf(stderr, "kernel_launch: unexpected shapes: n_in %d out %d ws %zu (need %zu); nothing launched\n", n_in, out_size, ws_size, (size_t)WS_END); grid = -1; return; }
        int dev = 0, cus = 0, per_cu = 0;
        if (hipGetDevice(&dev) != hipSuccess || hipDeviceGetAttribute(&cus, hipDeviceAttributeMultiprocessorCount, dev) != hipSuccess) { grid = -1; return; }
        if (hipFuncSetAttribute((const void*)fwd, hipFuncAttributeMaxDynamicSharedMemorySize, LDS_BYTES) != hipSuccess) { fprintf(stderr, "kernel_launch: hipFuncSetAttribute failed\n"); grid = -1; return; }
        if (hipOccupancyMaxActiveBlocksPerMultiprocessor(&per_cu, (const void*)fwd, NTHR, LDS_BYTES) != hipSuccess || per_cu < 1) fprintf(stderr, "kernel_launch: note: occupancy query reports %d\n", per_cu);
        (void)hipGetLastError();
        grid = cus;
    }
    if (grid < 0) return;
    (void)hipMemsetAsync((char*)d_ws + WS_CTL, 0, CTL_ZERO_BYTES, stream);
    Args a{};
    for (int i = 0; i < 21; ++i) a.in[i] = (const float*)d_in[i];
    a.out = (float*)d_out; a.ws = (unsigned char*)d_ws; a.submask = MK_SUBMASK; a.pad = 0;
#if MK_PER_PHASE
    for (int k = 0; k < NPHASE; ++k) { if (!phase_enabled(k, MK_SUBMASK)) continue; a.ph_lo = k; a.ph_hi = k + 1; hipLaunchKernelGGL(fwd, dim3(grid), dim3(NTHR), LDS_BYTES, stream, a); }
#else
    a.ph_lo = 0; a.ph_hi = NPHASE; hipLaunchKernelGGL(fwd, dim3(grid), dim3(NTHR), LDS_BYTES, stream, a);
#endif
}
```

```cpp
#include <hip/hip_runtime.h>
#include <cstdio>
#include <cstdint>

#define GAS __attribute__((address_space(1)))
#define LAS __attribute__((address_space(3)))
typedef unsigned short bf16;
typedef unsigned v4u __attribute__((ext_vector_type(4)));
typedef unsigned v2u __attribute__((ext_vector_type(2)));
typedef float f32x4 __attribute__((ext_vector_type(4)));
typedef float f32x2 __attribute__((ext_vector_type(2)));
typedef short bf16x8 __attribute__((ext_vector_type(8)));
typedef short bf16x4 __attribute__((ext_vector_type(4)));
typedef GAS unsigned gu32;
#define RLX_AGENT __ATOMIC_RELAXED, __HIP_MEMORY_SCOPE_AGENT
#define LDS_WAIT() asm volatile("s_waitcnt lgkmcnt(0)" ::: "memory")
#define VM_WAIT() asm volatile("s_waitcnt vmcnt(0)" ::: "memory")

__device__ __forceinline__ unsigned f2bf(float f) { unsigned u = __builtin_bit_cast(unsigned, f); return (u + 0x7fffu + ((u >> 16) & 1u)) >> 16; }
__device__ __forceinline__ unsigned pk2(float lo, float hi) { return f2bf(lo) | (f2bf(hi) << 16); }
__device__ __forceinline__ float bflo(unsigned w) { return __builtin_bit_cast(float, w << 16); }
__device__ __forceinline__ float bfhi(unsigned w) { return __builtin_bit_cast(float, w & 0xffff0000u); }
__device__ __forceinline__ float bf2f(bf16 b) { return __builtin_bit_cast(float, (unsigned)b << 16); }
__device__ __forceinline__ unsigned cvt_pk_bf16(float lo, float hi) { unsigned r; asm volatile("v_cvt_pk_bf16_f32 %0, %1, %2" : "=v"(r) : "v"(lo), "v"(hi)); return r; }
__device__ __forceinline__ float fast_exp(float x) { return __builtin_amdgcn_exp2f(x * 1.44269504089f); }
__device__ __forceinline__ float sigmoid_f(float x) { return __builtin_amdgcn_rcpf(1.0f + fast_exp(-x)); }
__device__ __forceinline__ float silu_f(float x) { return x * sigmoid_f(x); }
__device__ __forceinline__ float gelu_tanh_f(float x) { const float u = 0.7978845608028654f * (x + 0.044715f * x * x * x); return x * sigmoid_f(2.0f * u); }
__device__ __forceinline__ float wave_sum(float v) {
#pragma unroll
    for (int o = 1; o < 64; o <<= 1) v += __shfl_xor(v, o);
    return v;
}

namespace pg8 {
constexpr int BM = 256, BK = 64, HALF = 128, HTB = HALF * BK * 2  , STAGE_BYTES = 8 * HTB, NXCD = 8, WGM = 8;
__host__ __device__ __forceinline__ int lds_byte(int r, int c) { const int st = (r >> 4) * 2 + (c >> 5), rr = r & 15, cc = c & 31, ob = rr * 64 + cc * 2; return st * 1024 + (ob ^ (((ob >> 9) & 1) << 5)); }
__host__ __device__ __forceinline__ void stage_rc(int b, int& R, int& C) { const int st = b / 1024, sb = b % 1024, swz = sb ^ (((sb >> 9) & 1) << 5); R = (st >> 1) * 16 + swz / 64; C = (st & 1) * 32 + (swz % 64) / 2; }
__host__ __device__ __forceinline__ int perm32(int rho) { const int n = rho >> 4, i = rho & 15; return 8 * (i >> 2) + 4 * n + (i & 3); }

struct Unit { int pm, pn; };
struct Gemm { int K, lda; };

struct OrderBase {
    int nM, nN, nwg, G, c;
    __device__ __forceinline__ void init_order(int nM_, int nN_, int G_, int c_) { nM = nM_; nN = nN_; nwg = nM * nN; G = G_; c = c_; }
    __device__ __forceinline__ bool next(int i, Unit& u) const {
        const long L = (long)i * G + c; if (L >= nwg) return false;
        int wgid = (int)L; { const int q = nwg / NXCD, r = nwg % NXCD, xcd = wgid % NXCD, off = wgid / NXCD; wgid = (xcd < r ? xcd * (q + 1) : r * (q + 1) + (xcd - r) * q) + off; }
        const int nig = WGM * nN, gid = wgid / nig, fm = gid * WGM, gsz = (nM - fm) < WGM ? (nM - fm) : WGM;
        u.pm = fm + ((wgid % nig) % gsz); u.pn = (wgid % nig) / gsz; return true;
    }
};
struct DenseOrder : OrderBase {
    const char* A; const char* Bt; size_t a_tile, b_tile;
    __device__ __forceinline__ void init(const bf16* A_, int lda, const bf16* Bt_, int K, int nM_, int nN_, int G_, int c_) { A = (const char*)A_; Bt = (const char*)Bt_; a_tile = (size_t)BM * lda * 2; b_tile = (size_t)BM * K * 2; init_order(nM_, nN_, G_, c_); }
    __device__ __forceinline__ const char* a_base(const Unit& u) const { return A + (size_t)u.pm * a_tile; }
    __device__ __forceinline__ const char* b_base(const Unit& u) const { return Bt + (size_t)u.pn * b_tile; }
};
struct GatesOrder : DenseOrder {
    __device__ __forceinline__ const char* a_base(const Unit& u) const { return A + (size_t)u.pm * a_tile + (size_t)(u.pn >> 1) * 512; }
};
struct MoeOrder : DenseOrder {
    int pe[8]; size_t e_bytes;
    __device__ __forceinline__ const char* b_base(const Unit& u) const {
        int e = 0;
#pragma unroll
        for (int j = 0; j < 7; ++j) e += (u.pm >= pe[j]) ? 1 : 0;
        return Bt + (size_t)e * e_bytes + (size_t)u.pn * b_tile;
    }
};

template <class Epi, class Sched, bool ALIGN_EPI = true>
__device__ __forceinline__ void gemm_phase(LAS unsigned char* lds, const int tid, const Gemm g, const Sched& S, const Epi& E) {
    const int wid = __builtin_amdgcn_readfirstlane(tid >> 6), lane = tid & 63, wr = wid >> 2, wc = wid & 3, fr = lane & 15, fq = lane >> 4;
    const int K = g.K, nt = K / BK;
    unsigned voffA[2], voffB[2];
#pragma unroll
    for (int i = 0; i < 2; ++i) { int R, C; stage_rc(tid * 16 + i * 8192, R, C); const int Rb = Epi::PERM ? ((R & ~31) + perm32(R & 31)) : R;
        voffA[i] = (unsigned)(R * g.lda + C) * 2u; voffB[i] = (unsigned)(Rb * K + C) * 2u; }
    const size_t kstep = (size_t)(BK * 2);
    const size_t hstepA = (size_t)HALF * g.lda * 2, hstepB = (size_t)HALF * K * 2;
    const unsigned ldsw = (unsigned)wid * 1024u;
    const int aoff = lds_byte(wr * 64 + fr, fq * 8), boff = lds_byte(wc * 32 + fr, fq * 8);
#define PG8_SA(b, h) (((b) * 2 + (h)) * HTB)
#define PG8_SB(b, h) ((4 + (b) * 2 + (h)) * HTB)
#define PG8_STAGE(bufoff, gbase, voff) do { _Pragma("unroll") for (int _i = 0; _i < 2; ++_i) \
        __builtin_amdgcn_global_load_lds((const unsigned*)((const char*)(gbase) + (voff)[_i]), (LAS unsigned*)(lds + (bufoff) + ldsw + _i * 8192), 16, 0, 0); } while (0)
#define PG8_LDA(dst, b, h) do { _Pragma("unroll") for (int m = 0; m < 4; ++m) _Pragma("unroll") for (int k = 0; k < 2; ++k) dst[m][k] = *(const LAS bf16x8*)(lds + PG8_SA(b, h) + aoff + m * 2048 + k * 1024); } while (0)
#define PG8_LDB(dst, b, h) do { _Pragma("unroll") for (int n = 0; n < 2; ++n) _Pragma("unroll") for (int k = 0; k < 2; ++k) dst[n][k] = *(const LAS bf16x8*)(lds + PG8_SB(b, h) + boff + n * 2048 + k * 1024); } while (0)
#define PG8_MMA(ai, bj, At, Bt) do { __builtin_amdgcn_s_setprio(1); _Pragma("unroll") for (int m = 0; m < 4; ++m) _Pragma("unroll") for (int n = 0; n < 2; ++n) _Pragma("unroll") for (int k = 0; k < 2; ++k) \
        acc[ai][bj][m][n] = __builtin_amdgcn_mfma_f32_16x16x32_bf16(Bt[n][k], At[m][k], acc[ai][bj][m][n], 0, 0, 0); __builtin_amdgcn_s_setprio(0); } while (0)
#define PG8_WAIT_V(n) asm volatile("s_waitcnt vmcnt(" #n ")" ::: "memory")
#define PG8_WAIT_L(n) asm volatile("s_waitcnt lgkmcnt(" #n ")" ::: "memory")
#define PG8_BAR __builtin_amdgcn_s_barrier()
#define PG8_SCHED __builtin_amdgcn_sched_barrier(0)
    Unit cur, nxt; int ui = 0;
    if (!S.next(0, cur)) return;
    f32x4 acc[2][2][4][2];
#pragma unroll
    for (int a = 0; a < 2; ++a)
#pragma unroll
        for (int b = 0; b < 2; ++b)
#pragma unroll
            for (int m = 0; m < 4; ++m)
#pragma unroll
                for (int n = 0; n < 2; ++n) acc[a][b][m][n] = (f32x4){0.f, 0.f, 0.f, 0.f};
    bf16x8 At[4][2], B0[2][2], B1[2][2];
    const char* cA = S.a_base(cur); const char* cB = S.b_base(cur);
    PG8_STAGE(PG8_SB(0, 0), cB, voffB); PG8_STAGE(PG8_SB(0, 1), cB + hstepB, voffB); PG8_STAGE(PG8_SA(0, 0), cA, voffA); PG8_STAGE(PG8_SA(0, 1), cA + hstepA, voffA);
    if (wr == 1) PG8_BAR;
    PG8_WAIT_V(2); PG8_BAR;
    PG8_STAGE(PG8_SB(1, 0), cB + kstep, voffB); PG8_STAGE(PG8_SA(1, 0), cA + kstep, voffA); PG8_STAGE(PG8_SB(1, 1), cB + hstepB + kstep, voffB);
    PG8_WAIT_V(6); PG8_BAR;
    for (;;) {
        const bool has_next = S.next(ui + 1, nxt);
        const char* nA = has_next ? S.a_base(nxt) : cA; const char* nB = has_next ? S.b_base(nxt) : cB;
#pragma nounroll
        for (int t = 0; t < nt; t += 2) {
            const bool last = (t == nt - 2);
            const char* a1 = cA + (size_t)(t + 1) * kstep;
            const char* a2 = last ? nA : cA + (size_t)(t + 2) * kstep; const char* b2 = last ? nB : cB + (size_t)(t + 2) * kstep;
            const char* a3 = a2 + kstep; const char* b3 = b2 + kstep;
            PG8_LDB(B0, 0, 0); PG8_LDB(B1, 0, 1); PG8_SCHED; PG8_LDA(At, 0, 0); PG8_STAGE(PG8_SA(1, 1), a1 + hstepA, voffA);
            PG8_WAIT_V(8); PG8_WAIT_L(0); PG8_BAR; PG8_MMA(0, 0, At, B0); PG8_MMA(0, 1, At, B1); PG8_BAR; PG8_SCHED;
            PG8_LDA(At, 0, 1); PG8_STAGE(PG8_SB(0, 0), b2, voffB); PG8_STAGE(PG8_SB(0, 1), b2 + hstepB, voffB); PG8_STAGE(PG8_SA(0, 0), a2, voffA);
            PG8_WAIT_V(8); PG8_WAIT_L(0); PG8_BAR; PG8_MMA(1, 0, At, B0); PG8_MMA(1, 1, At, B1); PG8_BAR; PG8_SCHED;
            PG8_LDB(B0, 1, 0); PG8_LDB(B1, 1, 1); PG8_SCHED; PG8_LDA(At, 1, 0); PG8_STAGE(PG8_SA(0, 1), a2 + hstepA, voffA);
            PG8_WAIT_V(8); PG8_WAIT_L(0); PG8_BAR; PG8_MMA(0, 0, At, B0); PG8_MMA(0, 1, At, B1); PG8_BAR; PG8_SCHED;
            PG8_LDA(At, 1, 1); PG8_STAGE(PG8_SB(1, 0), b3, voffB); PG8_STAGE(PG8_SB(1, 1), b3 + hstepB, voffB); PG8_STAGE(PG8_SA(1, 0), a3, voffA);
            PG8_WAIT_V(8); PG8_WAIT_L(0); PG8_BAR; PG8_MMA(1, 0, At, B0); PG8_MMA(1, 1, At, B1); PG8_BAR; PG8_SCHED;
        }
        if constexpr (ALIGN_EPI) { if (wr == 0) PG8_BAR; }
        E(acc, cur, wr, wc, fr, fq);
        if (!has_next) break;
#pragma unroll
        for (int a = 0; a < 2; ++a)
#pragma unroll
            for (int b = 0; b < 2; ++b)
#pragma unroll
                for (int m = 0; m < 4; ++m)
#pragma unroll
                    for (int n = 0; n < 2; ++n) acc[a][b][m][n] = (f32x4){0.f, 0.f, 0.f, 0.f};
        cur = nxt; cA = nA; cB = nB; ++ui;
        if constexpr (ALIGN_EPI) { if (wr == 1) PG8_BAR; }
    }
    PG8_WAIT_V(0);
    if constexpr (!ALIGN_EPI) { if (wr == 0) PG8_BAR; }
    PG8_BAR;
#undef PG8_SA
#undef PG8_SB
#undef PG8_STAGE
#undef PG8_LDA
#undef PG8_LDB
#undef PG8_MMA
#undef PG8_WAIT_V
#undef PG8_WAIT_L
#undef PG8_BAR
#undef PG8_SCHED
}
}
#define XB_TMO      128
#define XB_XCNT(j)  (256  + 64 * (j))
#define XB_XSUB(j)  (1280 + 64 * (j))
#define XB_XGEN(j)  (2304 + 64 * (j))
#define XB_TOP      3328
#define XB_TOPGEN   3392
#define XCD_BAR_WORDS 3456
#define XB_SPIN_CAP (1u << 18)

__device__ __forceinline__ unsigned xb_ld(unsigned* p)              { return __hip_atomic_load(p, __ATOMIC_RELAXED, __HIP_MEMORY_SCOPE_AGENT); }
__device__ __forceinline__ unsigned xb_add(unsigned* p, unsigned v) { return __hip_atomic_fetch_add(p, v, __ATOMIC_RELAXED, __HIP_MEMORY_SCOPE_AGENT); }
__device__ __forceinline__ unsigned xb_xcc_id() { return (unsigned)__builtin_amdgcn_s_getreg((3 << 11) | 20) & 0xFu; }
#define XB_SPIN(cond, bar) do { unsigned _sp = 0; while (cond) { __builtin_amdgcn_s_sleep(1); \
    if ((++_sp & 255u) == 0u) { if (xb_ld(&(bar)[XB_TMO])) break; if (_sp > XB_SPIN_CAP) { atomicAdd(&(bar)[XB_TMO], 1u); break; } } } } while (0)

struct XcdBarrier {
    unsigned* bar; unsigned x;
    volatile LAS unsigned* st;
};

__device__ __forceinline__ XcdBarrier xcd_barrier_post(unsigned* bar, volatile LAS unsigned* st) {
    XcdBarrier b; b.bar = bar; b.x = xb_xcc_id(); b.st = st;
    if (threadIdx.x == 0) (void)xb_add(&bar[XB_XCNT(b.x)], 1u);
    return b;
}
__device__ __forceinline__ void xcd_barrier_complete(unsigned* bar, unsigned x, unsigned& nloc, unsigned& nx) {
    const unsigned G = gridDim.x * gridDim.y * gridDim.z;
    unsigned sum, cnt, mine, sp = 0u;
    for (;;) {
        sum = 0u; cnt = 0u; mine = 0u;
#pragma unroll
        for (unsigned j = 0; j < 16; ++j) { const unsigned c = xb_ld(&bar[XB_XCNT(j)]); sum += c; cnt += (c > 0u) ? 1u : 0u; mine = (j == x) ? c : mine; }
        if (sum == G) break;
        __builtin_amdgcn_s_sleep(1);
        if ((++sp & 255u) == 0u) { if (xb_ld(&bar[XB_TMO])) break; if (sp > XB_SPIN_CAP) { atomicAdd(&bar[XB_TMO], 1u); break; } }
    }
    nloc = mine > 0u ? mine : 1u; nx = cnt > 0u ? cnt : 1u;
}

__device__ __forceinline__ void xcd_barrier(const XcdBarrier& b) {
    asm volatile("s_waitcnt vmcnt(0)" ::: "memory");
    __syncthreads();
    if (threadIdx.x == 0) {
        unsigned* bar = b.bar;
        __builtin_amdgcn_s_waitcnt(0);
        unsigned nloc = b.st[0], nx = b.st[1];
        if (nloc == 0u) { xcd_barrier_complete(bar, b.x, nloc, nx); b.st[0] = nloc; b.st[1] = nx; }
        const unsigned old = xb_add(&bar[XB_XSUB(b.x)], 1u);
        const unsigned gen = old / nloc;
        if (old + 1u == (gen + 1u) * nloc) {
            __builtin_amdgcn_fence(__ATOMIC_RELEASE, "agent");
            asm volatile("s_waitcnt vmcnt(0)" ::: "memory");
            const unsigned og = xb_add(&bar[XB_TOP], 1u);
            const unsigned tg = og / nx;
            if (og + 1u == (tg + 1u) * nx) xb_add(&bar[XB_TOPGEN], 1u);
            else XB_SPIN(xb_ld(&bar[XB_TOPGEN]) == tg, bar);
            __builtin_amdgcn_fence(__ATOMIC_ACQUIRE, "agent");
            xb_add(&bar[XB_XGEN(b.x)], 1u);
            asm volatile("s_waitcnt vmcnt(0)" ::: "memory");
        } else {
            XB_SPIN(xb_ld(&bar[XB_XGEN(b.x)]) == gen, bar);
            __builtin_amdgcn_fence(__ATOMIC_ACQUIRE, "agent");
            asm volatile("s_waitcnt vmcnt(0)" ::: "memory");
        }
    }
    __syncthreads();
}

constexpr int NWAVES = 8, NTHR = 512;
constexpr int D = 1024, BATCH = 2, SEQ = 16384, NMETA = 16;
constexpr int MMAIN = BATCH * SEQ;
constexpr int MROWS = MMAIN + NMETA;
constexpr int MPAD = MMAIN + 256;
constexpr int RGW = 1344, RGBW = 168, NRG = 2816  , KRGO = 1408  , NGT = 4096, KGT = 256, XCW = 2048;
constexpr int FF = 3584, NE = 8, NFF2 = 2 * FF;
constexpr int GH = 4, GDK = 128, GDV = 256, GQK = 512, GVD = 1024, NGLA = 3072, GLAW = 3088, GRANK = 16;
constexpr int MSORT = 265 * 256;
constexpr float LN_EPS = 1e-5f, ALPHA = 1.6817928305074290f;
constexpr int SEG = 128, NSEG_B = SEQ / SEG, NSEG = 1 + BATCH * NSEG_B;
constexpr int CPS = 4, NSC_BH = SEQ / (64 * CPS), NGU = BATCH * GH * NSC_BH + GH;

constexpr size_t MiB = 1u << 20;
constexpr size_t WS_CTL = 0, CTL_ZERO_BYTES = 1 * MiB;
constexpr size_t WL_RGIN = 0, WL_GATES = WL_RGIN + (size_t)NRG * D * 2, WL_RGOUT = WL_GATES + (size_t)NGT * KGT * 2, WL_GLAIN = WL_RGOUT + (size_t)D * KRGO * 2,
                 WL_GLAOUT = WL_GLAIN + (size_t)NGLA * D * 2, WL_FFNIN = WL_GLAOUT + (size_t)D * D * 2, WL_FFNOUT = WL_FFNIN + (size_t)NFF2 * D * 2,
                 WL_MOEIN = WL_FFNOUT + (size_t)D * FF * 2, WL_MOEOUT = WL_MOEIN + (size_t)NE * NFF2 * D * 2, WL_STRIDE = WL_MOEOUT + (size_t)NE * D * FF * 2;
constexpr size_t WS_W = 1 * MiB;
constexpr size_t WS_H = WS_W + 2 * WL_STRIDE;
constexpr size_t WS_HB = WS_H + (size_t)MPAD * D * 4;
constexpr size_t WS_MIX = WS_HB + (size_t)MPAD * D * 2;
constexpr size_t WS_Z = WS_MIX + (size_t)MPAD * D * 4;
constexpr size_t WS_RT = WS_Z + 3 * MiB;
constexpr size_t WS_AGG = WS_RT + 1 * MiB;
constexpr size_t WS_S0 = WS_AGG + 3 * MiB;
constexpr size_t S_PROJ = 0, S_XC = S_PROJ + (size_t)MPAD * NRG * 2, S_LOGA = S_XC + (size_t)MPAD * XCW * 2, S_U = S_LOGA + (size_t)MPAD * RGW * 4, S_Y = S_U + (size_t)MPAD * RGW * 4, S_RG_END = S_Y + (size_t)MPAD * KRGO * 2;
constexpr size_t S_HID = 0;
constexpr size_t S_QKVR = 0, S_KVS = S_QKVR + (size_t)MPAD * NGLA * 2, S_SST = S_KVS + (size_t)NGU * GDK * GDV * 4, S_O = S_SST + (size_t)NGU * GDK * GDV * 4, S_DEC = S_O + (size_t)MPAD * D * 2, S_GLA_END = S_DEC + 1 * MiB;
constexpr size_t S_AS = 0, S_HS = S_AS + (size_t)MSORT * D * 2, S_YS = S_HS + (size_t)MSORT * FF * 2, S_MOE_END = S_YS + (size_t)MSORT * D * 4;
constexpr size_t S_MAX = S_RG_END > S_MOE_END ? (S_RG_END > S_GLA_END ? S_RG_END : S_GLA_END) : (S_MOE_END > S_GLA_END ? S_MOE_END : S_GLA_END);
constexpr size_t WS_END = WS_S0 + S_MAX;
constexpr int CW_TMO = 0, CW_BAR = 4096, CW_MOE = 8192;

constexpr int LDS_BYTES = 163840, MISC_OFF = LDS_BYTES - 64;

struct Frame {
    LAS unsigned char* lds; gu32* ctl; unsigned char* ws;
    int tid, lane, wave, G, bx;
    __device__ __forceinline__ void fresh() { asm volatile("" : "+v"(tid)); asm volatile("" : "+s"(bx)); asm volatile("" : "+s"(ws)); lane = tid & 63; wave = __builtin_amdgcn_readfirstlane(tid >> 6); ctl = (gu32*)(ws + WS_CTL); }
};
struct Args { const float* in[21]; float* out; unsigned char* ws; int ph_lo, ph_hi; unsigned submask; int pad; };

struct EpiBf16Gelu {
    static constexpr bool PERM = true, PAIR = false;
    bf16* O; int ldc, gelu_cols;
    __device__ __forceinline__ void operator()(const f32x4 (&acc)[2][2][4][2], const pg8::Unit& u, int wr, int wc, int fr, int fq) const {
        const int row0 = u.pm * 256 + wr * 64 + fr, col0 = u.pn * 256 + wc * 32 + 8 * fq;
#pragma unroll
        for (int ai = 0; ai < 2; ++ai)
#pragma unroll
            for (int m = 0; m < 4; ++m) { bf16* rowp = O + (size_t)(row0 + ai * 128 + m * 16) * ldc + col0;
#pragma unroll
                for (int bj = 0; bj < 2; ++bj) { f32x4 v0 = acc[ai][bj][m][0], v1 = acc[ai][bj][m][1];
                    if (col0 + bj * 128 < gelu_cols) {
#pragma unroll
                        for (int j = 0; j < 4; ++j) { v0[j] = gelu_tanh_f(v0[j]); v1[j] = gelu_tanh_f(v1[j]); } }
                    v4u w; w.x = cvt_pk_bf16(v0[0], v0[1]); w.y = cvt_pk_bf16(v0[2], v0[3]); w.z = cvt_pk_bf16(v1[0], v1[1]); w.w = cvt_pk_bf16(v1[2], v1[3]);
                    *(v4u*)(rowp + bj * 128) = w; } }
    }
    __device__ __forceinline__ void meta_task(int task, int& r0, int& aoff) const { r0 = task * 16; aoff = 0; }
    __device__ __forceinline__ void meta(int task, f32x4 a0, f32x4, int fr, int fq) const {
        const int col = task * 16 + 4 * fq;
        if (col < gelu_cols) {
#pragma unroll
            for (int j = 0; j < 4; ++j) a0[j] = gelu_tanh_f(a0[j]); }
        v2u w; w.x = cvt_pk_bf16(a0[0], a0[1]); w.y = cvt_pk_bf16(a0[2], a0[3]);
        *(v2u*)(O + (size_t)(MMAIN + fr) * ldc + col) = w;
    }
};
struct EpiSwiglu {
    static constexpr bool PERM = true, PAIR = true;
    bf16* O; int ldc;
    __device__ __forceinline__ void operator()(const f32x4 (&acc)[2][2][4][2], const pg8::Unit& u, int wr, int wc, int fr, int fq) const {
        const int row0 = u.pm * 256 + wr * 64 + fr, col0 = u.pn * 128 + wc * 32 + 8 * fq;
#pragma unroll
        for (int ai = 0; ai < 2; ++ai)
#pragma unroll
            for (int m = 0; m < 4; ++m) { bf16* rowp = O + (size_t)(row0 + ai * 128 + m * 16) * ldc + col0;
                f32x4 g0 = acc[ai][0][m][0], g1 = acc[ai][0][m][1]; const f32x4 u0 = acc[ai][1][m][0], u1 = acc[ai][1][m][1];
#pragma unroll
                for (int j = 0; j < 4; ++j) { g0[j] = silu_f(g0[j]) * u0[j]; g1[j] = silu_f(g1[j]) * u1[j]; }
                v4u w; w.x = cvt_pk_bf16(g0[0], g0[1]); w.y = cvt_pk_bf16(g0[2], g0[3]); w.z = cvt_pk_bf16(g1[0], g1[1]); w.w = cvt_pk_bf16(g1[2], g1[3]);
                *(v4u*)rowp = w; }
    }
    __device__ __forceinline__ void meta_task(int task, int& r0, int& aoff) const { r0 = (task >> 3) * 256 + (task & 7) * 16; aoff = 0; }
    __device__ __forceinline__ void meta(int task, f32x4 a0, f32x4 a1, int fr, int fq) const {
        const int col = (task >> 3) * 128 + (task & 7) * 16 + 4 * fq;
#pragma unroll
        for (int j = 0; j < 4; ++j) a0[j] = silu_f(a0[j]) * a1[j];
        v2u w; w.x = cvt_pk_bf16(a0[0], a0[1]); w.y = cvt_pk_bf16(a0[2], a0[3]);
        *(v2u*)(O + (size_t)(MMAIN + fr) * ldc + col) = w;
    }
};
struct EpiF32 {
    static constexpr bool PERM = false, PAIR = false;
    float* C; int ldc;
    __device__ __forceinline__ void operator()(const f32x4 (&acc)[2][2][4][2], const pg8::Unit& u, int wr, int wc, int fr, int fq) const {
        const int row0 = u.pm * 256 + wr * 64 + fr, col0 = u.pn * 256 + wc * 32 + 4 * fq;
#pragma unroll
        for (int ai = 0; ai < 2; ++ai)
#pragma unroll
            for (int m = 0; m < 4; ++m) { float* rowp = C + (size_t)(row0 + ai * 128 + m * 16) * ldc + col0;
#pragma unroll
                for (int bj = 0; bj < 2; ++bj)
#pragma unroll
                    for (int n = 0; n < 2; ++n) *(f32x4*)(rowp + bj * 128 + n * 16) = acc[ai][bj][m][n]; }
    }
    __device__ __forceinline__ void meta_task(int task, int& r0, int& aoff) const { r0 = task * 16; aoff = 0; }
    __device__ __forceinline__ void meta(int task, f32x4 a0, f32x4, int fr, int fq) const { *(f32x4*)(C + (size_t)(MMAIN + fr) * ldc + task * 16 + 4 * fq) = a0; }
};

template <class Epi>
__device__ __forceinline__ void meta_gemm(Frame& F, const bf16* A16, int lda, int K, const bf16* Bt, int ntasks, const Epi& E) {
    const int fr = F.lane & 15, fq = F.lane >> 4;
    LAS f32x4* red = (LAS f32x4*)F.lds;
    for (int task = F.bx; task < ntasks; task += F.G) {
        int r0, aoff; E.meta_task(task, r0, aoff);
        f32x4 acc0 = (f32x4){0.f, 0.f, 0.f, 0.f}, acc1 = acc0;
        const bf16* ap = A16 + (size_t)fr * lda + aoff + fq * 8; const bf16* bp0 = Bt + (size_t)(r0 + fr) * K + fq * 8; const bf16* bp1 = bp0 + (size_t)128 * K;
        for (int ks = F.wave; ks < K / 32; ks += NWAVES) {
            const bf16x8 a = *(const bf16x8*)(ap + ks * 32); const bf16x8 b0 = *(const bf16x8*)(bp0 + ks * 32);
            acc0 = __builtin_amdgcn_mfma_f32_16x16x32_bf16(b0, a, acc0, 0, 0, 0);
            if (Epi::PAIR) { const bf16x8 b1 = *(const bf16x8*)(bp1 + ks * 32); acc1 = __builtin_amdgcn_mfma_f32_16x16x32_bf16(b1, a, acc1, 0, 0, 0); }
        }
        red[(F.wave * 2 + 0) * 64 + F.lane] = acc0; if (Epi::PAIR) red[(F.wave * 2 + 1) * 64 + F.lane] = acc1;
        __syncthreads();
        if (F.wave == 0) {
            f32x4 s0 = red[F.lane], s1 = Epi::PAIR ? red[64 + F.lane] : acc1;
#pragma unroll
            for (int w = 1; w < NWAVES; ++w) { s0 += red[(w * 2) * 64 + F.lane]; if (Epi::PAIR) s1 += red[(w * 2 + 1) * 64 + F.lane]; }
            E.meta(task, s0, s1, fr, fq);
        }
        __syncthreads();
    }
}

__device__ __forceinline__ void transpose_item(const float* W, int ldw, int Ksrc, int c0, int nvalid, bf16* WT, int Kdst, int n0, int k0, LAS float* scr, int lane) {
#pragma unroll 8
    for (int i = 0; i < 32; ++i) { const int kk = 2 * i + (lane >> 5), c = lane & 31;
        const bool ok = (k0 + kk < Ksrc) && (c < nvalid); const float v = W[ok ? (size_t)(k0 + kk) * ldw + c0 + c : (size_t)0];
        scr[kk * 33 + c] = ok ? v : 0.f; }
    LDS_WAIT(); asm volatile("" ::: "memory");
    const int c = lane & 7;
#pragma unroll
    for (int j = 0; j < 4; ++j) { const int n = (lane >> 3) + 8 * j; const LAS float* s = scr + (8 * c) * 33 + n;
        v4u o; o.x = pk2(s[0 * 33], s[1 * 33]); o.y = pk2(s[2 * 33], s[3 * 33]); o.z = pk2(s[4 * 33], s[5 * 33]); o.w = pk2(s[6 * 33], s[7 * 33]);
        *(v4u*)(WT + (size_t)(n0 + n) * Kdst + k0 + 8 * c) = o; }
    LDS_WAIT(); asm volatile("" ::: "memory");
}
__device__ __forceinline__ void map_id(int n0, int nsrc, int& c0, int& nv) { c0 = n0; nv = nsrc - n0; nv = nv < 0 ? 0 : (nv > 32 ? 32 : nv); if (nv == 0) c0 = 0; }
__device__ __forceinline__ void map_swiglu(int n0, int& c0, int& nv) { const int tile = n0 >> 8, rr = n0 & 255; c0 = rr < 128 ? tile * 128 + rr : FF + tile * 128 + rr - 128; nv = 32; }

__device__ __forceinline__ void p0_prologue(Frame& F, const Args& a) {
    LAS float* scr = (LAS float*)(F.lds + F.wave * 16384);
    const int gw = F.bx * NWAVES + F.wave, NGW = F.G * NWAVES;
    constexpr int I_RGIN = (D / 64) * (NRG / 32), I_GATES = (KGT / 64) * (NGT / 32), I_RGOUT = (KRGO / 64) * (D / 32), I_GLAIN = (D / 64) * (NGLA / 32), I_GLAOUT = (D / 64) * (D / 32),
                  I_FFNIN = (D / 64) * (NFF2 / 32), I_FFNOUT = (FF / 64) * (D / 32), I_MOEIN = NE * I_FFNIN, I_MOEOUT = NE * I_FFNOUT;
    constexpr int I_PER_J = I_RGIN + I_GATES + I_RGOUT + I_GLAIN + I_GLAOUT + I_FFNIN + I_FFNOUT + I_MOEIN + I_MOEOUT;
    for (int it = gw; it < 2 * I_PER_J; it += NGW) {
        const int j = it / I_PER_J; int r = it - j * I_PER_J;
        unsigned char* wl = F.ws + WS_W + (size_t)j * WL_STRIDE;
        int c0, nv;
        if (r < I_RGIN) { const int nb = r % (NRG / 32), kb = r / (NRG / 32); map_id(nb * 32, 2 * RGW, c0, nv);
            transpose_item(a.in[4] + (size_t)j * D * 2 * RGW, 2 * RGW, D, c0, nv, (bf16*)(wl + WL_RGIN), D, nb * 32, kb * 64, scr, F.lane); continue; } r -= I_RGIN;
        if (r < I_GATES) { const int nb = r % (NGT / 32), kb = r / (NGT / 32); const int n0 = nb * 32, pn = n0 >> 8, rr = n0 & 255, g = rr >> 7, cc = rr & 127, d0 = (pn & 1) * 128 + cc, blk = pn >> 1;
            nv = RGBW - d0; nv = nv < 0 ? 0 : (nv > 32 ? 32 : nv); c0 = nv ? d0 : 0;
            transpose_item(a.in[7] + ((size_t)(j * 2 + g) * 8 + blk) * RGBW * RGBW, RGBW, RGBW, c0, nv, (bf16*)(wl + WL_GATES), KGT, n0, kb * 64, scr, F.lane); continue; } r -= I_GATES;
        if (r < I_RGOUT) { const int nb = r % (D / 32), kb = r / (D / 32);
            transpose_item(a.in[10] + (size_t)j * RGW * D, D, RGW, nb * 32, 32, (bf16*)(wl + WL_RGOUT), KRGO, nb * 32, kb * 64, scr, F.lane); continue; } r -= I_RGOUT;
        if (r < I_GLAIN) { const int nb = r % (NGLA / 32), kb = r / (NGLA / 32);
            transpose_item(a.in[11] + (size_t)j * D * GLAW, GLAW, D, nb * 32, 32, (bf16*)(wl + WL_GLAIN), D, nb * 32, kb * 64, scr, F.lane); continue; } r -= I_GLAIN;
        if (r < I_GLAOUT) { const int nb = r % (D / 32), kb = r / (D / 32);
            transpose_item(a.in[15] + (size_t)j * D * D, D, D, nb * 32, 32, (bf16*)(wl + WL_GLAOUT), D, nb * 32, kb * 64, scr, F.lane); continue; } r -= I_GLAOUT;
        if (r < I_FFNIN) { const int nb = r % (NFF2 / 32), kb = r / (NFF2 / 32); map_swiglu(nb * 32, c0, nv);
            transpose_item(a.in[16] + (size_t)j * D * NFF2, NFF2, D, c0, nv, (bf16*)(wl + WL_FFNIN), D, nb * 32, kb * 64, scr, F.lane); continue; } r -= I_FFNIN;
        if (r < I_FFNOUT) { const int nb = r % (D / 32), kb = r / (D / 32);
            transpose_item(a.in[17] + (size_t)j * FF * D, D, FF, nb * 32, 32, (bf16*)(wl + WL_FFNOUT), FF, nb * 32, kb * 64, scr, F.lane); continue; } r -= I_FFNOUT;
        if (r < I_MOEIN) { const int e = r / I_FFNIN, r2 = r % I_FFNIN; const int nb = r2 % (NFF2 / 32), kb = r2 / (NFF2 / 32); map_swiglu(nb * 32, c0, nv);
            transpose_item(a.in[19] + ((size_t)j * NE + e) * D * NFF2, NFF2, D, c0, nv, (bf16*)(wl + WL_MOEIN) + (size_t)e * NFF2 * D, D, nb * 32, kb * 64, scr, F.lane); continue; } r -= I_MOEIN;
        { const int e = r / I_FFNOUT, r2 = r % I_FFNOUT; const int nb = r2 % (D / 32), kb = r2 / (D / 32);
            transpose_item(a.in[20] + ((size_t)j * NE + e) * FF * D, D, FF, nb * 32, 32, (bf16*)(wl + WL_MOEOUT) + (size_t)e * D * FF, FF, nb * 32, kb * 64, scr, F.lane); }
    }
    bf16* HB = (bf16*)(F.ws + WS_HB);
    for (int m = gw; m < MROWS; m += NGW) {
        const float* src = m < MMAIN ? a.in[0] + (size_t)m * D : a.in[1] + (size_t)(m - MMAIN) * D;
#pragma unroll
        for (int q = 0; q < 4; ++q) { const f32x4 v = *(const f32x4*)(src + 4 * F.lane + 256 * q);
            v2u w; w.x = pk2(v[0], v[1]); w.y = pk2(v[2], v[3]); *(v2u*)(HB + (size_t)m * D + 4 * F.lane + 256 * q) = w; }
    }
}

struct LnRow { v4u h[2], a[2], b[2]; float w1, w2; };
__device__ __forceinline__ void unpack8(const v4u& w, float* o) { o[0] = bflo(w.x); o[1] = bfhi(w.x); o[2] = bflo(w.y); o[3] = bfhi(w.y); o[4] = bflo(w.z); o[5] = bfhi(w.z); o[6] = bflo(w.w); o[7] = bfhi(w.w); }
__device__ __forceinline__ void ln_phase(Frame& F, int mixkind, const float* gam, const float* bet, int extra, const float* Wx, int ldx, float* outp, gu32* moe_cnt) {
    bf16* HB = (bf16*)(F.ws + WS_HB); const bf16* MIX = (const bf16*)(F.ws + WS_MIX);
    const bf16* YS = (const bf16*)(F.ws + WS_S0 + S_YS);
    int* E1 = (int*)(F.ws + WS_RT); int* E2 = E1 + MROWS; float* W1 = (float*)(E2 + MROWS); float* W2 = W1 + MROWS; int* POS1 = (int*)(W2 + MROWS); int* POS2 = POS1 + MROWS;
    float* Z = (float*)(F.ws + WS_Z);
    LAS float* WL = (LAS float*)F.lds;
    LAS unsigned* lcnt = (LAS unsigned*)(F.lds + 65536);
    const int NC = extra == 1 ? 16 : (extra == 2 ? 8 : 0);
    if (extra) { for (int i = F.tid; i < NC * D; i += NTHR) { const int e = i / D, c = i % D; WL[e * D + c] = Wx[(size_t)c * ldx + e]; }
        if (F.tid < 8) lcnt[F.tid] = 0u;
        __syncthreads(); }
    const int gw = F.bx * NWAVES + F.wave, NGW = F.G * NWAVES, lane = F.lane;
    float gv[16], bv[16];
#pragma unroll
    for (int q = 0; q < 2; ++q)
#pragma unroll
        for (int t = 0; t < 2; ++t) { const f32x4 g4 = *(const f32x4*)(gam + 512 * q + 8 * lane + 4 * t), b4 = *(const f32x4*)(bet + 512 * q + 8 * lane + 4 * t);
#pragma unroll
            for (int k = 0; k < 4; ++k) { gv[8 * q + 4 * t + k] = g4[k]; bv[8 * q + 4 * t + k] = b4[k]; } }
    unsigned mycnt = 0u;
    for (int m0 = gw; m0 < MROWS; m0 += 2 * NGW) {
        LnRow R[2];
#pragma unroll
        for (int r = 0; r < 2; ++r) { const int m = m0 + r * NGW; if (m < MROWS) {
            const bf16* hp = HB + (size_t)m * D + 8 * lane; R[r].h[0] = *(const v4u*)hp; R[r].h[1] = *(const v4u*)(hp + 512);
            if (mixkind == 1) { const bf16* mp = MIX + (size_t)m * D + 8 * lane; R[r].a[0] = *(const v4u*)mp; R[r].a[1] = *(const v4u*)(mp + 512); }
            if (mixkind == 2) { R[r].w1 = W1[m]; R[r].w2 = W2[m]; const bf16* y1 = YS + (size_t)POS1[m] * D + 8 * lane; const bf16* y2 = YS + (size_t)POS2[m] * D + 8 * lane;
                R[r].a[0] = *(const v4u*)y1; R[r].a[1] = *(const v4u*)(y1 + 512); R[r].b[0] = *(const v4u*)y2; R[r].b[1] = *(const v4u*)(y2 + 512); } } }
#pragma unroll
        for (int r = 0; r < 2; ++r) { const int m = m0 + r * NGW; if (m < MROWS) {
            float v[16]; unpack8(R[r].h[0], v); unpack8(R[r].h[1], v + 8);
#pragma unroll
            for (int k = 0; k < 16; ++k) v[k] *= ALPHA;
            if (mixkind == 1) { float t[16]; unpack8(R[r].a[0], t); unpack8(R[r].a[1], t + 8);
#pragma unroll
                for (int k = 0; k < 16; ++k) v[k] += t[k]; }
            if (mixkind == 2) { float t[16], u[16]; unpack8(R[r].a[0], t); unpack8(R[r].a[1], t + 8); unpack8(R[r].b[0], u); unpack8(R[r].b[1], u + 8);
#pragma unroll
                for (int k = 0; k < 16; ++k) v[k] += t[k] * R[r].w1 + u[k] * R[r].w2; }
            float s = 0.f;
#pragma unroll
            for (int k = 0; k < 16; ++k) s += v[k];
            const float mean = wave_sum(s) * (1.f / D); float s2 = 0.f;
#pragma unroll
            for (int k = 0; k < 16; ++k) { v[k] -= mean; s2 += v[k] * v[k]; }
            const float rstd = 1.f / sqrtf(wave_sum(s2) * (1.f / D) + LN_EPS);
#pragma unroll
            for (int k = 0; k < 16; ++k) v[k] = v[k] * rstd * gv[k] + bv[k];
            bf16* op = HB + (size_t)m * D + 8 * lane;
            *(v4u*)op = (v4u){pk2(v[0], v[1]), pk2(v[2], v[3]), pk2(v[4], v[5]), pk2(v[6], v[7])}; *(v4u*)(op + 512) = (v4u){pk2(v[8], v[9]), pk2(v[10], v[11]), pk2(v[12], v[13]), pk2(v[14], v[15])};
            if (outp && m < MMAIN) { float* o = outp + (size_t)m * D + 8 * lane;
                *(f32x4*)o = (f32x4){v[0], v[1], v[2], v[3]}; *(f32x4*)(o + 4) = (f32x4){v[4], v[5], v[6], v[7]}; *(f32x4*)(o + 512) = (f32x4){v[8], v[9], v[10], v[11]}; *(f32x4*)(o + 516) = (f32x4){v[12], v[13], v[14], v[15]}; }
            if (extra) {
                float lg[16];
#pragma unroll
                for (int e = 0; e < 16; ++e) { lg[e] = 0.f; if (e < NC) { float p = 0.f;
#pragma unroll
                        for (int q = 0; q < 2; ++q) { const f32x4 w0 = *(const LAS f32x4*)(WL + e * D + 512 * q + 8 * lane), w1 = *(const LAS f32x4*)(WL + e * D + 512 * q + 8 * lane + 4);
                            p += (v[8 * q + 0] * w0[0] + v[8 * q + 1] * w0[1]) + (v[8 * q + 2] * w0[2] + v[8 * q + 3] * w0[3]) + (v[8 * q + 4] * w1[0] + v[8 * q + 5] * w1[1]) + (v[8 * q + 6] * w1[2] + v[8 * q + 7] * w1[3]); }
                        lg[e] = wave_sum(p); } }
                if (extra == 1) { float zv = 0.f;
#pragma unroll
                    for (int e = 0; e < 16; ++e) zv = (lane == e) ? lg[e] : zv;
                    if (lane < 16) Z[(size_t)m * 16 + lane] = zv; }
                else { int e1 = 0; float l1 = lg[0];
#pragma unroll
                    for (int e = 1; e < 8; ++e) if (lg[e] > l1) { l1 = lg[e]; e1 = e; }
                    int e2 = -1; float l2 = -3.0e38f;
#pragma unroll
                    for (int e = 0; e < 8; ++e) if (e != e1 && lg[e] > l2) { l2 = lg[e]; e2 = e; }
                    const float w2 = 1.f / (1.f + __expf(l1 - l2)), w1 = 1.f - w2;
                    if (lane == 0) { E1[m] = e1; E2[m] = e2; W1[m] = w1; W2[m] = w2; }
                    mycnt += (lane == e1 || lane == e2) ? 1u : 0u; }
            } } }
    }
    if (extra == 2) { if (lane < 8 && mycnt) __hip_atomic_fetch_add(&lcnt[lane], mycnt, __ATOMIC_RELAXED, __HIP_MEMORY_SCOPE_WORKGROUP);
        __syncthreads();
        if (F.tid < 8 && lcnt[F.tid]) __hip_atomic_fetch_add(moe_cnt + F.tid, lcnt[F.tid], RLX_AGENT); }
}

struct EpiGates {
    static constexpr bool PERM = true, PAIR = true;
    bf16* LOGA; bf16* U; const bf16* XC; const float* bg; const float* lam;
    __device__ __forceinline__ void chan4(int ch, f32x4& br, f32x4& bi, f32x4& c8) const {
        br = *(const f32x4*)(bg + ch); bi = *(const f32x4*)(bg + RGW + ch); const f32x4 lm = *(const f32x4*)(lam + ch);
#pragma unroll
        for (int t = 0; t < 4; ++t) c8[t] = -8.0f * log1pf(__expf(-lm[t]));
    }
    __device__ __forceinline__ void elem4(int row, int blk, int d, f32x4 ra, f32x4 ia, const f32x4& br, const f32x4& bi, const f32x4& c8) const {
        const int ch = blk * RGBW + d;
        const v2u xw = *(const v2u*)(XC + (size_t)row * XCW + blk * 256 + d);
        const float xc[4] = {bflo(xw.x), bfhi(xw.x), bflo(xw.y), bfhi(xw.y)};
        f32x4 la, uu;
#pragma unroll
        for (int t = 0; t < 4; ++t) {
            const float r = sigmoid_f(ra[t] + br[t]), ig = sigmoid_f(ia[t] + bi[t]);
            const float l = c8[t] * r;
            const float a2 = fast_exp(2.0f * l);
            la[t] = l; uu[t] = sqrtf(fmaxf(1.0f - a2, 0.f)) * (ig * xc[t]);
        }
        *(v2u*)(LOGA + (size_t)row * RGW + ch) = (v2u){pk2(la[0], la[1]), pk2(la[2], la[3])}; *(v2u*)(U + (size_t)row * RGW + ch) = (v2u){pk2(uu[0], uu[1]), pk2(uu[2], uu[3])};
    }
    __device__ __forceinline__ void operator()(const f32x4 (&acc)[2][2][4][2], const pg8::Unit& u, int wr, int wc, int fr, int fq) const {
        const int row0 = u.pm * 256 + wr * 64 + fr, blk = u.pn >> 1, d0 = (u.pn & 1) * 128 + wc * 32 + 8 * fq;
#pragma unroll
        for (int n = 0; n < 2; ++n) { const int d = d0 + 4 * n; if (d < RGBW) {
            f32x4 br, bi, c8; chan4(blk * RGBW + d, br, bi, c8);
#pragma unroll
            for (int ai = 0; ai < 2; ++ai)
#pragma unroll
                for (int m = 0; m < 4; ++m) elem4(row0 + ai * 128 + m * 16, blk, d, acc[ai][0][m][n], acc[ai][1][m][n], br, bi, c8); } }
    }
    __device__ __forceinline__ void meta_task(int task, int& r0, int& aoff) const { const int pn = task >> 3; r0 = pn * 256 + (task & 7) * 16; aoff = (pn >> 1) * 256; }
    __device__ __forceinline__ void meta(int task, f32x4 a0, f32x4 a1, int fr, int fq) const {
        const int pn = task >> 3, d = (pn & 1) * 128 + (task & 7) * 16 + 4 * fq;
        if (d < RGBW) { f32x4 br, bi, c8; chan4((pn >> 1) * RGBW + d, br, bi, c8); elem4(MMAIN + fr, pn >> 1, d, a0, a1, br, bi, c8); }
    }
};

__device__ __forceinline__ int conv_src_row(int row, int delta) {
    if (row < MMAIN) { const int t = row & (SEQ - 1); return (t - delta >= 0) ? row - delta : MMAIN + NMETA + (t - delta); }
    const int jm = row - MMAIN; return (jm - delta >= 0) ? row - delta : -1;
}
__device__ __forceinline__ void rg_conv_phase(Frame& F, const float* cw, const float* cb) {
    const bf16* PROJ = (const bf16*)(F.ws + WS_S0 + S_PROJ); bf16* XC = (bf16*)(F.ws + WS_S0 + S_XC);
    for (int idx = F.bx * NTHR + F.tid; idx < (MROWS / 4) * 256; idx += F.G * NTHR) {
        const int r0 = (idx >> 8) * 4, g = idx & 255, blk = g >> 5, kk = (g & 31) * 8;
        bf16* xo = XC + (size_t)r0 * XCW + blk * 256 + kk;
        if (kk < RGBW) {
            const int ch = blk * RGBW + kk;
            v4u x[7];
#pragma unroll
            for (int t = 0; t < 3; ++t) { const int rr = conv_src_row(r0, 3 - t); x[t] = (v4u){0u, 0u, 0u, 0u}; if (rr >= 0) x[t] = *(const v4u*)(PROJ + (size_t)rr * NRG + RGW + ch); }
#pragma unroll
            for (int t = 0; t < 4; ++t) x[3 + t] = *(const v4u*)(PROJ + (size_t)(r0 + t) * NRG + RGW + ch);
            float w[4][8], bb[8];
            { const f32x4 b0 = *(const f32x4*)(cb + ch), b1 = *(const f32x4*)(cb + ch + 4);
#pragma unroll
              for (int k = 0; k < 4; ++k) { bb[k] = b0[k]; bb[4 + k] = b1[k]; } }
#pragma unroll
            for (int tap = 0; tap < 4; ++tap) { const f32x4 w0 = *(const f32x4*)(cw + tap * RGW + ch), w1 = *(const f32x4*)(cw + tap * RGW + ch + 4);
#pragma unroll
                for (int k = 0; k < 4; ++k) { w[tap][k] = w0[k]; w[tap][4 + k] = w1[k]; } }
            float xf[7][8];
#pragma unroll
            for (int t = 0; t < 7; ++t) unpack8(x[t], xf[t]);
#pragma unroll
            for (int i = 0; i < 4; ++i) { float a[8];
#pragma unroll
                for (int k = 0; k < 8; ++k) a[k] = bb[k] + xf[i][k] * w[0][k] + xf[i + 1][k] * w[1][k] + xf[i + 2][k] * w[2][k] + xf[i + 3][k] * w[3][k];
                *(v4u*)(xo + (size_t)i * XCW) = (v4u){pk2(a[0], a[1]), pk2(a[2], a[3]), pk2(a[4], a[5]), pk2(a[6], a[7])}; }
        } else {
#pragma unroll
            for (int i = 0; i < 4; ++i) *(v4u*)(xo + (size_t)i * XCW) = (v4u){0u, 0u, 0u, 0u};
        }
    }
}
template <bool FIX>
__device__ __forceinline__ void rg_scan_phase(Frame& F) {
    const bf16* LOGA = (const bf16*)(F.ws + WS_S0 + S_LOGA); const bf16* U = (const bf16*)(F.ws + WS_S0 + S_U);
    const bf16* PROJ = (const bf16*)(F.ws + WS_S0 + S_PROJ); bf16* Y = (bf16*)(F.ws + WS_S0 + S_Y);
    float* AGGA = (float*)(F.ws + WS_AGG); float* AGGH = AGGA + (size_t)NSEG * RGW;
    const int gw = F.bx * NWAVES + F.wave, NGW = F.G * NWAVES;
    constexpr int NCG = 11, RB = 16;
    for (int task = gw; task < NSEG * NCG; task += NGW) {
        const int seg = task / NCG, cg = task - seg * NCG, ch = cg * 128 + 2 * F.lane;
        const int row0 = seg == 0 ? MMAIN : (seg - 1) * SEG, nrows = seg == 0 ? NMETA : SEG;
        if (ch >= RGW) {
            if (FIX) for (int r = 0; r < nrows; ++r) *(unsigned*)(Y + (size_t)(row0 + r) * KRGO + ch) = 0u;
            continue;
        }
        float h0 = 0.f, h1 = 0.f, c0 = 0.f, c1 = 0.f;
        if (FIX && seg > 0) {
            { const f32x2 hm = *(const f32x2*)(AGGH + ch); h0 = hm[0]; h1 = hm[1]; }
            const int sb = 1 + ((seg - 1) / NSEG_B) * NSEG_B, ns = (seg - 1) % NSEG_B;
            for (int q = 0; q < ns; q += 8) { f32x2 aa[8], hh[8];
#pragma unroll
                for (int t = 0; t < 8; ++t) { const int qq = (q + t < ns) ? q + t : ns - 1; aa[t] = *(const f32x2*)(AGGA + (size_t)(sb + qq) * RGW + ch); hh[t] = *(const f32x2*)(AGGH + (size_t)(sb + qq) * RGW + ch); }
#pragma unroll
                for (int t = 0; t < 8; ++t) if (q + t < ns) { h0 = __expf(aa[t][0]) * h0 + hh[t][0]; h1 = __expf(aa[t][1]) * h1 + hh[t][1]; } }
        }
        for (int r = 0; r < nrows; r += RB) {
            unsigned la[RB], uu[RB], gt[RB];
#pragma unroll
            for (int t = 0; t < RB; ++t) { const size_t o = (size_t)(row0 + r + t) * RGW + ch; la[t] = *(const unsigned*)(LOGA + o); uu[t] = *(const unsigned*)(U + o); if (FIX) gt[t] = *(const unsigned*)(PROJ + (size_t)(row0 + r + t) * NRG + ch); }
#pragma unroll
            for (int t = 0; t < RB; ++t) { const float l0 = bflo(la[t]), l1 = bfhi(la[t]);
                h0 = __expf(l0) * h0 + bflo(uu[t]); h1 = __expf(l1) * h1 + bfhi(uu[t]); c0 += l0; c1 += l1;
                if (FIX) *(unsigned*)(Y + (size_t)(row0 + r + t) * KRGO + ch) = pk2(h0 * bflo(gt[t]), h1 * bfhi(gt[t])); }
        }
        if (!FIX) { *(f32x2*)(AGGA + (size_t)seg * RGW + ch) = (f32x2){c0, c1}; *(f32x2*)(AGGH + (size_t)seg * RGW + ch) = (f32x2){h0, h1}; }
    }
}

#define RG_PHASES \
        if (IN(pb + 0)) { if (on_rg) { \
            bf16* PROJ = (bf16*)(F.ws + WS_S0 + S_PROJ); EpiBf16Gelu E{PROJ, NRG, RGW}; \
            meta_gemm(F, HB + (size_t)MMAIN * D, D, D, (const bf16*)(wl + WL_RGIN), NRG / 16, E); \
            pg8::Gemm g{D, D}; pg8::DenseOrder S; S.init(HB, D, (const bf16*)(wl + WL_RGIN), D, MMAIN / 256, NRG / 256, F.G, F.bx); \
            pg8::gemm_phase<EpiBf16Gelu, pg8::DenseOrder>(F.lds, F.tid, g, S, E); } \
            SEAM(pb + 0); } \
        if (IN(pb + 1)) { if (on_rg) rg_conv_phase(F, args.in[5] + (size_t)j * 4 * RGW, args.in[6] + (size_t)j * RGW); SEAM(pb + 1); } \
        if (IN(pb + 2)) { if (on_rg) { \
            const bf16* XC = (const bf16*)(F.ws + WS_S0 + S_XC); \
            EpiGates E{(bf16*)(F.ws + WS_S0 + S_LOGA), (bf16*)(F.ws + WS_S0 + S_U), XC, args.in[8] + (size_t)j * 2 * RGW, args.in[9] + (size_t)j * RGW}; \
            meta_gemm(F, XC + (size_t)MMAIN * XCW, XCW, KGT, (const bf16*)(wl + WL_GATES), (NGT / 256) * 8, E); \
            pg8::Gemm g{KGT, XCW}; pg8::GatesOrder S; S.init(XC, XCW, (const bf16*)(wl + WL_GATES), KGT, MMAIN / 256, NGT / 256, F.G, F.bx); \
            pg8::gemm_phase<EpiGates, pg8::GatesOrder>(F.lds, F.tid, g, S, E); } \
            SEAM(pb + 2); } \
        if (IN(pb + 3)) { if (on_rg) rg_scan_phase<false>(F); SEAM(pb + 3); } \
        if (IN(pb + 4)) { if (on_rg) rg_scan_phase<true>(F); SEAM(pb + 4); } \
        if (IN(pb + 5)) { if (on_rg) { \
            const bf16* Y = (const bf16*)(F.ws + WS_S0 + S_Y); EpiBf16Gelu E{MIX, D, 0}; \
            meta_gemm(F, Y + (size_t)MMAIN * KRGO, KRGO, KRGO, (const bf16*)(wl + WL_RGOUT), D / 16, E); \
            pg8::Gemm g{KRGO, KRGO}; pg8::DenseOrder S; S.init(Y, KRGO, (const bf16*)(wl + WL_RGOUT), KRGO, MMAIN / 256, D / 256, F.G, F.bx); \
            pg8::gemm_phase<EpiBf16Gelu, pg8::DenseOrder>(F.lds, F.tid, g, S, E); } \
            SEAM(pb + 5); }

constexpr int GL_QT = 0, GL_KT = 17408  , GL_KTT = 34816, GL_VT = 53248, GL_ST = 90112  , GL_SM = 155648;
constexpr int QTS = 136, KTTS = 72, VTS = 72, PS = 72, BS = 132;
static_assert(GL_SM + 2560 <= MISC_OFF, "GLA LDS map");

template <int MODE>
__device__ __forceinline__ void gla_phase(Frame& F, const float* wgu, const float* bgate, const float* normg) {
    const bf16* QKVR = (const bf16*)(F.ws + WS_S0 + S_QKVR); const float* Z = (const float*)(F.ws + WS_Z);
    float* KVS = (float*)(F.ws + WS_S0 + S_KVS); const float* SST = (const float*)(F.ws + WS_S0 + S_SST); float* DEC = (float*)(F.ws + WS_S0 + S_DEC);
    bf16* O = (bf16*)(F.ws + WS_S0 + S_O);
    LAS bf16* QT = (LAS bf16*)(F.lds + GL_QT); LAS bf16* KT = (LAS bf16*)(F.lds + GL_KT); LAS bf16* PP = (LAS bf16*)(F.lds + GL_KT);
    LAS bf16* KTT = (LAS bf16*)(F.lds + GL_KTT); LAS bf16* VT = (LAS bf16*)(F.lds + GL_VT); LAS unsigned char* ST = F.lds + GL_ST;
    LAS float* Bc = (LAS float*)(F.lds + GL_ST); LAS float* ZC = (LAS float*)(F.lds + GL_ST + 36864);
    LAS float* em = (LAS float*)(F.lds + GL_SM); LAS float* ef = em + 128; LAS float* stats = ef + 128;
    const int tid0 = F.tid;
    for (int u = F.bx; u < NGU; u += F.G) {
        const bool meta = u >= BATCH * GH * NSC_BH;
        const int h = meta ? u - BATCH * GH * NSC_BH : (u / NSC_BH) % GH, b = meta ? 0 : u / (GH * NSC_BH), sc = meta ? 0 : u % NSC_BH;
        const int nch = meta ? 1 : CPS;
        f32x4 sacc[8][2];
        int lofs = (4 * ((tid0 & 63) >> 4)) * GDV + 32 * (tid0 >> 6) + (tid0 & 15); asm volatile("" : "+v"(lofs));
#pragma unroll
        for (int dt = 0; dt < 8; ++dt)
#pragma unroll
            for (int i = 0; i < 2; ++i) {
                sacc[dt][i] = (f32x4){0.f, 0.f, 0.f, 0.f};
                if (MODE == 1 && !meta) {
#pragma unroll
                    for (int jj = 0; jj < 4; ++jj) sacc[dt][i][jj] = SST[(size_t)u * (GDK * GDV) + (size_t)((16 * dt + jj) * GDV + 16 * i) + lofs]; }
            }
        float dsum = 0.f;
        for (int ci = 0; ci < nch; ++ci) {
            int tid = tid0; asm volatile("" : "+v"(tid));
            const int lane = tid & 63, w = __builtin_amdgcn_readfirstlane(tid >> 6), fr = lane & 15, fq = lane >> 4;
            const int rbase = meta ? 0 : b * SEQ + (sc * CPS + ci) * 64;
            if (tid < 256) { const int c = tid >> 2, part = tid & 3; const bool valid = !meta || c >= 48; const int row = meta ? MMAIN + c - 48 : rbase + c;
                f32x4 zv = (f32x4){0.f, 0.f, 0.f, 0.f}; if (valid) zv = *(const f32x4*)(Z + (size_t)row * 16 + 4 * part);
                *(LAS f32x4*)(ZC + c * 16 + 4 * part) = zv; }
            const int dA = tid & 127, cgp = tid >> 7;
            float wg[16];
#pragma unroll
            for (int i = 0; i < 16; ++i) wg[i] = wgu[(size_t)i * GQK + h * GDK + dA];
            const float bgv = bgate[h * GDK + dA];
            __syncthreads(); __builtin_amdgcn_sched_barrier(0);
#pragma unroll 4
            for (int cc = 0; cc < 16; ++cc) { const int c = cgp * 16 + cc; float lg = bgv;
#pragma unroll
                for (int i = 0; i < 16; ++i) lg += ZC[c * 16 + i] * wg[i];
                float g = (fminf(lg, 0.f) - log1pf(__expf(-fabsf(lg)))) * (1.0f / 16.0f);
                if (meta && c < 48) g = 0.f;
                Bc[c * BS + dA] = g; }
            __syncthreads(); __builtin_amdgcn_sched_barrier(0);
            if (tid < 128) { float run = 0.f, bm = 0.f;
#pragma unroll 8
                for (int c = 0; c < 64; ++c) { run += Bc[c * BS + tid]; Bc[c * BS + tid] = run; if (c == 31) bm = run; }
                em[tid] = __expf(bm); ef[tid] = __expf(run - bm); dsum += run; }
            __syncthreads(); __builtin_amdgcn_sched_barrier(0);
            { const int c = tid >> 3, d0 = (tid & 7) * 16, e0 = (tid & 7) * 32; const bool valid = !meta || c >= 48; const int row = meta ? MMAIN + c - 48 : rbase + c;
                const bf16* rp = QKVR + (size_t)row * NGLA;
                v4u q0 = (v4u){0u, 0u, 0u, 0u}, q1 = q0, k0 = q0, k1 = q0, vv[4] = {q0, q0, q0, q0};
                if (valid) { if (MODE == 1) { q0 = *(const v4u*)(rp + h * GDK + d0); q1 = *(const v4u*)(rp + h * GDK + d0 + 8); }
                    k0 = *(const v4u*)(rp + GQK + h * GDK + d0); k1 = *(const v4u*)(rp + GQK + h * GDK + d0 + 8);
#pragma unroll
                    for (int t = 0; t < 4; ++t) vv[t] = *(const v4u*)(rp + 2 * GQK + h * GDV + e0 + 8 * t); }
                const unsigned qw[8] = {q0.x, q0.y, q0.z, q0.w, q1.x, q1.y, q1.z, q1.w}, kw[8] = {k0.x, k0.y, k0.z, k0.w, k1.x, k1.y, k1.z, k1.w};
                unsigned qo[8], ko[8];
#pragma unroll
                for (int t = 0; t < 8; ++t) {
                    const int d = d0 + 2 * t;
                    const float x0 = Bc[c * BS + d] - Bc[31 * BS + d], x1 = Bc[c * BS + d + 1] - Bc[31 * BS + d + 1];
                    const float e0f = __expf(x0), e1f = __expf(x1), r0 = __expf(-x0), r1 = __expf(-x1);
                    const float ka = bflo(kw[t]) * r0, kb = bfhi(kw[t]) * r1;
                    ko[t] = pk2(ka, kb);
                    if (MODE == 1) qo[t] = pk2(bflo(qw[t]) * (0.08838834764831845f * e0f), bfhi(qw[t]) * (0.08838834764831845f * e1f));
                    KTT[(d) * KTTS + c] = (bf16)(ko[t] & 0xffffu); KTT[(d + 1) * KTTS + c] = (bf16)(ko[t] >> 16);
                }
                *(LAS v4u*)(KT + c * QTS + d0) = (v4u){ko[0], ko[1], ko[2], ko[3]}; *(LAS v4u*)(KT + c * QTS + d0 + 8) = (v4u){ko[4], ko[5], ko[6], ko[7]};
                if (MODE == 1) { *(LAS v4u*)(QT + c * QTS + d0) = (v4u){qo[0], qo[1], qo[2], qo[3]}; *(LAS v4u*)(QT + c * QTS + d0 + 8) = (v4u){qo[4], qo[5], qo[6], qo[7]}; }
#pragma unroll
                for (int t = 0; t < 4; ++t) { const unsigned vw[4] = {vv[t].x, vv[t].y, vv[t].z, vv[t].w};
#pragma unroll
                    for (int s = 0; s < 4; ++s) { const int e = e0 + 8 * t + 2 * s; VT[e * VTS + c] = (bf16)(vw[s] & 0xffffu); VT[(e + 1) * VTS + c] = (bf16)(vw[s] >> 16); } }
            }
            __syncthreads(); __builtin_amdgcn_sched_barrier(0);
            f32x4 pacc[2];
#pragma unroll
            for (int dt = 0; dt < 8; ++dt) { const f32x4 emv = *(const LAS f32x4*)(em + 16 * dt + 4 * fq);
#pragma unroll
                for (int i = 0; i < 2; ++i) { sacc[dt][i] = sacc[dt][i] * emv;
                    if (MODE == 1) { const int e = 32 * w + 16 * i + fr; const int ck = (2 * dt + (fq >> 1)) ^ (e & 15);
                        v2u sw; sw.x = pk2(sacc[dt][i][0], sacc[dt][i][1]); sw.y = pk2(sacc[dt][i][2], sacc[dt][i][3]);
                        *(LAS v2u*)(ST + e * 256 + ck * 16 + (fq & 1) * 8) = sw; } } }
            if (MODE == 1) {
                const int mt = w & 3, ntp = w >> 2;
#pragma unroll
                for (int ii = 0; ii < 2; ++ii) { const int nt = 2 * ntp + ii; pacc[ii] = (f32x4){0.f, 0.f, 0.f, 0.f};
                    if (nt <= mt) {
#pragma unroll
                        for (int ks = 0; ks < 4; ++ks) { const bf16x8 kf = *(const LAS bf16x8*)(KT + (16 * nt + fr) * QTS + 32 * ks + 8 * fq); const bf16x8 qf = *(const LAS bf16x8*)(QT + (16 * mt + fr) * QTS + 32 * ks + 8 * fq);
                            pacc[ii] = __builtin_amdgcn_mfma_f32_16x16x32_bf16(kf, qf, pacc[ii], 0, 0, 0); }
                        if (nt == mt) {
#pragma unroll
                            for (int jj = 0; jj < 4; ++jj) if (4 * fq + jj > fr) pacc[ii][jj] = 0.f; }
                    } }
            }
            __syncthreads(); __builtin_amdgcn_sched_barrier(0);
            if (MODE == 1) { const int mt = w & 3, ntp = w >> 2;
#pragma unroll
                for (int ii = 0; ii < 2; ++ii) { const int nt = 2 * ntp + ii; v2u pw; pw.x = pk2(pacc[ii][0], pacc[ii][1]); pw.y = pk2(pacc[ii][2], pacc[ii][3]);
                    *(LAS v2u*)(PP + (16 * mt + fr) * PS + 16 * nt + 4 * fq) = pw; }
                __syncthreads(); __builtin_amdgcn_sched_barrier(0);
            }
            f32x4 oacc[8];
            if (MODE == 1) { const int mt = w & 3, eh = w >> 2;
                bf16x8 pf[2], qf[4];
#pragma unroll
                for (int ks = 0; ks < 2; ++ks) pf[ks] = *(const LAS bf16x8*)(PP + (16 * mt + fr) * PS + 32 * ks + 8 * fq);
#pragma unroll
                for (int ks = 0; ks < 4; ++ks) qf[ks] = *(const LAS bf16x8*)(QT + (16 * mt + fr) * QTS + 32 * ks + 8 * fq);
#pragma unroll
                for (int t = 0; t < 8; ++t) { const int e = 128 * eh + 16 * t + fr; f32x4 a = (f32x4){0.f, 0.f, 0.f, 0.f};
#pragma unroll
                    for (int ks = 0; ks < 2; ++ks) { const bf16x8 vf = *(const LAS bf16x8*)(VT + e * VTS + 32 * ks + 8 * fq); a = __builtin_amdgcn_mfma_f32_16x16x32_bf16(vf, pf[ks], a, 0, 0, 0); }
#pragma unroll
                    for (int ks = 0; ks < 4; ++ks) { const int ck = (4 * ks + fq) ^ (e & 15); const bf16x8 sf = *(const LAS bf16x8*)(ST + e * 256 + ck * 16); a = __builtin_amdgcn_mfma_f32_16x16x32_bf16(sf, qf[ks], a, 0, 0, 0); }
                    oacc[t] = a; }
            }
            { bf16x8 vf[2][2];
#pragma unroll
              for (int i = 0; i < 2; ++i)
#pragma unroll
                  for (int ks = 0; ks < 2; ++ks) vf[i][ks] = *(const LAS bf16x8*)(VT + (32 * w + 16 * i + fr) * VTS + 32 * ks + 8 * fq);
#pragma unroll
              for (int dt = 0; dt < 8; ++dt) { const f32x4 efv = *(const LAS f32x4*)(ef + 16 * dt + 4 * fq);
#pragma unroll
                  for (int ks = 0; ks < 2; ++ks) { const bf16x8 kf = *(const LAS bf16x8*)(KTT + (16 * dt + fr) * KTTS + 32 * ks + 8 * fq);
#pragma unroll
                      for (int i = 0; i < 2; ++i) sacc[dt][i] = __builtin_amdgcn_mfma_f32_16x16x32_bf16(kf, vf[i][ks], sacc[dt][i], 0, 0, 0); }
#pragma unroll
                  for (int i = 0; i < 2; ++i) sacc[dt][i] = sacc[dt][i] * efv; }
            }
            if (MODE == 1) { const int mt = w & 3, eh = w >> 2, c = 16 * mt + fr;
                float s1 = 0.f, s2 = 0.f;
#pragma unroll
                for (int t = 0; t < 8; ++t)
#pragma unroll
                    for (int jj = 0; jj < 4; ++jj) { s1 += oacc[t][jj]; s2 += oacc[t][jj] * oacc[t][jj]; }
                s1 += __shfl_xor(s1, 16); s1 += __shfl_xor(s1, 32); s2 += __shfl_xor(s2, 16); s2 += __shfl_xor(s2, 32);
                if (fq == 0) { stats[(c * 2 + eh) * 2 + 0] = s1; stats[(c * 2 + eh) * 2 + 1] = s2; }
                __syncthreads(); __builtin_amdgcn_sched_barrier(0);
                const float t1 = stats[(c * 2 + 0) * 2 + 0] + stats[(c * 2 + 1) * 2 + 0], t2 = stats[(c * 2 + 0) * 2 + 1] + stats[(c * 2 + 1) * 2 + 1];
                const float mean = t1 * (1.0f / GDV), var = fmaxf(t2 * (1.0f / GDV) - mean * mean, 0.f), rstd = 1.0f / sqrtf(var + LN_EPS);
                const bool valid = !meta || c >= 48; const int row = meta ? MMAIN + c - 48 : rbase + c;
                if (valid) {
#pragma unroll
                    for (int t = 0; t < 8; ++t) { const int e = 128 * eh + 16 * t + 4 * fq;
                        const v2u rw = *(const v2u*)(QKVR + (size_t)row * NGLA + 2 * GQK + GVD + h * GDV + e);
                        const f32x4 ng = *(const f32x4*)(normg + h * GDV + e);
                        const float r4[4] = {bflo(rw.x), bfhi(rw.x), bflo(rw.y), bfhi(rw.y)}; float o4[4];
#pragma unroll
                        for (int jj = 0; jj < 4; ++jj) o4[jj] = (oacc[t][jj] - mean) * rstd * ng[jj] * silu_f(r4[jj]);
                        v2u ow; ow.x = pk2(o4[0], o4[1]); ow.y = pk2(o4[2], o4[3]);
                        *(v2u*)(O + (size_t)row * D + h * GDV + e) = ow; } }
            }
            __syncthreads(); __builtin_amdgcn_sched_barrier(0);
        }
        if (MODE == 0) {
            int lofs2 = (4 * ((tid0 & 63) >> 4)) * GDV + 32 * (tid0 >> 6) + (tid0 & 15); asm volatile("" : "+v"(lofs2));
#pragma unroll
            for (int dt = 0; dt < 8; ++dt)
#pragma unroll
                for (int i = 0; i < 2; ++i)
#pragma unroll
                    for (int jj = 0; jj < 4; ++jj) KVS[(size_t)u * (GDK * GDV) + (size_t)((16 * dt + jj) * GDV + 16 * i) + lofs2] = sacc[dt][i][jj];
            if (tid0 < 128) DEC[(size_t)u * GDK + tid0] = dsum;
        }
    }
}
__device__ __forceinline__ void gla_scan_phase(Frame& F) {
    const float* KVS = (const float*)(F.ws + WS_S0 + S_KVS); float* SST = (float*)(F.ws + WS_S0 + S_SST); const float* DEC = (const float*)(F.ws + WS_S0 + S_DEC);
    constexpr int NEL = GDK * GDV;
    for (int idx = F.bx * NTHR + F.tid; idx < BATCH * GH * NEL; idx += F.G * NTHR) {
        const int bh = idx / NEL, el = idx - bh * NEL, d = el / GDV, h = bh % GH;
        float s = KVS[(size_t)(BATCH * GH * NSC_BH + h) * NEL + el];
        const size_t ub = (size_t)bh * NSC_BH;
        SST[ub * NEL + el] = s;
        for (int sc = 0; sc + 1 < NSC_BH; ++sc) { s = __expf(DEC[(ub + sc) * GDK + d]) * s + KVS[(ub + sc) * NEL + el]; SST[(ub + sc + 1) * NEL + el] = s; }
    }
}

#define GLA_PHASES \
        if (IN(pb + 10)) { if (on_gla) { \
            bf16* QKVR = (bf16*)(F.ws + WS_S0 + S_QKVR); EpiBf16Gelu E{QKVR, NGLA, 0}; \
            meta_gemm(F, HB + (size_t)MMAIN * D, D, D, (const bf16*)(wl + WL_GLAIN), NGLA / 16, E); \
            pg8::Gemm g{D, D}; pg8::DenseOrder S; S.init(HB, D, (const bf16*)(wl + WL_GLAIN), D, MMAIN / 256, NGLA / 256, F.G, F.bx); \
            pg8::gemm_phase<EpiBf16Gelu, pg8::DenseOrder>(F.lds, F.tid, g, S, E); } \
            SEAM(pb + 10); } \
        if (IN(pb + 11)) { if (on_gla) gla_phase<0>(F, args.in[12] + (size_t)j * GRANK * GQK, args.in[13] + (size_t)j * GQK, args.in[14] + (size_t)j * GVD); SEAM(pb + 11); } \
        if (IN(pb + 12)) { if (on_gla) gla_scan_phase(F); SEAM(pb + 12); } \
        if (IN(pb + 13)) { if (on_gla) gla_phase<1>(F, args.in[12] + (size_t)j * GRANK * GQK, args.in[13] + (size_t)j * GQK, args.in[14] + (size_t)j * GVD); SEAM(pb + 13); } \
        if (IN(pb + 14)) { if (on_gla) { \
            const bf16* O = (const bf16*)(F.ws + WS_S0 + S_O); EpiBf16Gelu E{MIX, D, 0}; \
            meta_gemm(F, O + (size_t)MMAIN * D, D, D, (const bf16*)(wl + WL_GLAOUT), D / 16, E); \
            pg8::Gemm g{D, D}; pg8::DenseOrder S; S.init(O, D, (const bf16*)(wl + WL_GLAOUT), D, MMAIN / 256, D / 256, F.G, F.bx); \
            pg8::gemm_phase<EpiBf16Gelu, pg8::DenseOrder>(F.lds, F.tid, g, S, E); } \
            SEAM(pb + 14); }

__device__ __forceinline__ void moe_panel_ends(const gu32* cnt, int (&pe)[8]) {
    int acc = 0;
#pragma unroll
    for (int e = 0; e < 8; ++e) { const int c = (int)__hip_atomic_load(cnt + e, RLX_AGENT); acc += (c + 255) >> 8; pe[e] = acc; }
}
__device__ __forceinline__ void moe_gather_phase(Frame& F, gu32* moe) {
    const bf16* HB = (const bf16*)(F.ws + WS_HB); bf16* AS = (bf16*)(F.ws + WS_S0 + S_AS);
    const int* E1 = (const int*)(F.ws + WS_RT); const int* E2 = E1 + MROWS; int* POS1 = (int*)(F.ws + WS_RT) + 4 * MROWS; int* POS2 = POS1 + MROWS;
    LAS unsigned* lcnt = (LAS unsigned*)F.lds; LAS unsigned* lbase = lcnt + 8; LAS int* lpos = (LAS int*)(F.lds + 256);
    const int per = (MROWS + F.G - 1) / F.G, t0 = F.bx * per, nt = (t0 + per <= MROWS) ? per : (MROWS - t0 > 0 ? MROWS - t0 : 0);
    if (F.tid < 8) lcnt[F.tid] = 0u;
    __syncthreads();
    int e1 = 0, e2 = 0; unsigned r1 = 0, r2 = 0;
    if (F.tid < nt) { e1 = E1[t0 + F.tid]; e2 = E2[t0 + F.tid];
        r1 = __hip_atomic_fetch_add(&lcnt[e1], 1u, __ATOMIC_RELAXED, __HIP_MEMORY_SCOPE_WORKGROUP); r2 = __hip_atomic_fetch_add(&lcnt[e2], 1u, __ATOMIC_RELAXED, __HIP_MEMORY_SCOPE_WORKGROUP); }
    __syncthreads();
    if (F.tid < 8) { int ps = 0, accp = 0;
#pragma unroll
        for (int e = 0; e < 8; ++e) { ps = (e == F.tid) ? accp : ps; accp += ((int)__hip_atomic_load(moe + e, RLX_AGENT) + 255) >> 8; }
        const unsigned c = lcnt[F.tid]; const unsigned off = c ? __hip_atomic_fetch_add(moe + 64 + F.tid, c, RLX_AGENT) : 0u;
        lbase[F.tid] = (unsigned)ps * 256u + off; }
    __syncthreads();
    if (F.tid < nt) { const int p1 = (int)(lbase[e1] + r1), p2 = (int)(lbase[e2] + r2); POS1[t0 + F.tid] = p1; POS2[t0 + F.tid] = p2; lpos[2 * F.tid] = p1; lpos[2 * F.tid + 1] = p2; }
    __syncthreads();
    for (int t = F.wave; t < nt; t += NWAVES) {
        const v4u* src = (const v4u*)(HB + (size_t)(t0 + t) * D); const v4u a = src[F.lane], b = src[64 + F.lane];
        v4u* d1 = (v4u*)(AS + (size_t)lpos[2 * t] * D); v4u* d2 = (v4u*)(AS + (size_t)lpos[2 * t + 1] * D);
        d1[F.lane] = a; d1[64 + F.lane] = b; d2[F.lane] = a; d2[64 + F.lane] = b;
    }
}

#define MOE_PHASES \
        if (IN(pb + 16)) { if (on_moe) moe_gather_phase(F, F.ctl + CW_MOE + 256 * j); SEAM(pb + 16); } \
        if (IN(pb + 17)) { if (on_moe) { \
            const bf16* AS = (const bf16*)(F.ws + WS_S0 + S_AS); bf16* HS = (bf16*)(F.ws + WS_S0 + S_HS); EpiSwiglu E{HS, FF}; \
            pg8::Gemm g{D, D}; pg8::MoeOrder S; moe_panel_ends(F.ctl + CW_MOE + 256 * j, S.pe); S.e_bytes = (size_t)NFF2 * D * 2; \
            S.init(AS, D, (const bf16*)(wl + WL_MOEIN), D, S.pe[7], NFF2 / 256, F.G, F.bx); \
            pg8::gemm_phase<EpiSwiglu, pg8::MoeOrder>(F.lds, F.tid, g, S, E); } \
            SEAM(pb + 17); } \
        if (IN(pb + 18)) { if (on_moe) { \
            const bf16* HS = (const bf16*)(F.ws + WS_S0 + S_HS); EpiBf16Gelu E{(bf16*)(F.ws + WS_S0 + S_YS), D, 0}; \
            pg8::Gemm g{FF, FF}; pg8::MoeOrder S; moe_panel_ends(F.ctl + CW_MOE + 256 * j, S.pe); S.e_bytes = (size_t)D * FF * 2; \
            S.init(HS, FF, (const bf16*)(wl + WL_MOEOUT), FF, S.pe[7], D / 256, F.G, F.bx); \
            pg8::gemm_phase<EpiBf16Gelu, pg8::MoeOrder>(F.lds, F.tid, g, S, E); } \
            SEAM(pb + 18); }

constexpr int NPHASE = 41;
#ifndef MK_PER_PHASE
#define MK_PER_PHASE 0
#endif
#ifndef MK_DBG
#define MK_DBG 0
#endif
#ifndef MK_SUBMASK
#define MK_SUBMASK 0xFFu
#endif

__global__ void __launch_bounds__(NTHR, 2) fwd(Args args) {
    extern __shared__ __attribute__((aligned(16))) unsigned char lds[];
    Frame F;
    F.lds = (LAS unsigned char*)lds; F.ws = args.ws; F.ctl = (gu32*)(args.ws + WS_CTL);
    F.tid = threadIdx.x; F.lane = F.tid & 63; F.wave = __builtin_amdgcn_readfirstlane(F.tid >> 6); F.G = gridDim.x; F.bx = blockIdx.x;
    volatile LAS unsigned* MISC = (volatile LAS unsigned*)(F.lds + MISC_OFF);
    if (F.tid < 16) MISC[F.tid] = 0u;
    __syncthreads();
    const int lo = args.ph_lo, hi = args.ph_hi;
    XcdBarrier bar; bar.bar = (unsigned*)(F.ctl + CW_BAR); bar.x = 0; bar.st = nullptr;
    if (hi - lo > 1) bar = xcd_barrier_post((unsigned*)(F.ctl + CW_BAR), MISC);
#define IN(k) (lo <= (k) && (k) < hi && (F.fresh(), true))
#define SEAM(k) do { if ((k) + 1 < hi) xcd_barrier(bar); } while (0)
    const unsigned submask = args.submask;
    const float* ln_gain = args.in[2]; const float* ln_bias = args.in[3];
    bf16* HB = (bf16*)(F.ws + WS_HB); bf16* MIX = (bf16*)(F.ws + WS_MIX);

    if (IN(0)) { p0_prologue(F, args); SEAM(0); }

    for (int j = 0; j < 2; ++j) {
        const int pb = 1 + 20 * j;
        unsigned char* wl = F.ws + WS_W + (size_t)j * WL_STRIDE;
        const bool on_rg = (submask >> (4 * j + 0)) & 1u, on_ffn = (submask >> (4 * j + 1)) & 1u, on_gla = (submask >> (4 * j + 2)) & 1u, on_moe = (submask >> (4 * j + 3)) & 1u;
        RG_PHASES
        if (IN(pb + 6)) { ln_phase(F, on_rg ? 1 : 0, ln_gain + (size_t)(2 * j) * 2 * D, ln_bias + (size_t)(2 * j) * 2 * D, 0, nullptr, 0, nullptr, nullptr); SEAM(pb + 6); }
        if (IN(pb + 7)) { if (on_ffn) {
            bf16* HID = (bf16*)(F.ws + WS_S0 + S_HID);
            EpiSwiglu E{HID, FF};
            if (!(MK_DBG & 1)) meta_gemm(F, HB + (size_t)MMAIN * D, D, D, (const bf16*)(wl + WL_FFNIN), (NFF2 / 256) * 8, E);
            pg8::Gemm g{D, D}; pg8::DenseOrder S; S.init(HB, D, (const bf16*)(wl + WL_FFNIN), D, MMAIN / 256, NFF2 / 256, F.G, F.bx);
            if (!(MK_DBG & 2)) pg8::gemm_phase<EpiSwiglu, pg8::DenseOrder>(F.lds, F.tid, g, S, E); }
            SEAM(pb + 7); }
        if (IN(pb + 8)) { if (on_ffn) {
            const bf16* HID = (const bf16*)(F.ws + WS_S0 + S_HID);
            EpiBf16Gelu E{MIX, D, 0};
            if (!(MK_DBG & 4)) meta_gemm(F, HID + (size_t)MMAIN * FF, FF, FF, (const bf16*)(wl + WL_FFNOUT), D / 16, E);
            pg8::Gemm g{FF, FF}; pg8::DenseOrder S; S.init(HID, FF, (const bf16*)(wl + WL_FFNOUT), FF, MMAIN / 256, D / 256, F.G, F.bx);
            if (!(MK_DBG & 8)) pg8::gemm_phase<EpiBf16Gelu, pg8::DenseOrder>(F.lds, F.tid, g, S, E); }
            SEAM(pb + 8); }
        if (IN(pb + 9)) { ln_phase(F, on_ffn ? 1 : 0, ln_gain + (size_t)(2 * j) * 2 * D + D, ln_bias + (size_t)(2 * j) * 2 * D + D, 1, args.in[11] + (size_t)j * D * GLAW + NGLA, GLAW, nullptr, nullptr); SEAM(pb + 9); }
        GLA_PHASES
        if (IN(pb + 15)) { ln_phase(F, on_gla ? 1 : 0, ln_gain + (size_t)(2 * j + 1) * 2 * D, ln_bias + (size_t)(2 * j + 1) * 2 * D, on_moe ? 2 : 0, args.in[18] + (size_t)j * D * NE, NE, nullptr, F.ctl + CW_MOE + 256 * j); SEAM(pb + 15); }
        MOE_PHASES
        if (IN(pb + 19)) { ln_phase(F, on_moe ? 2 : 0, ln_gain + (size_t)(2 * j + 1) * 2 * D + D, ln_bias + (size_t)(2 * j + 1) * 2 * D + D, 0, nullptr, 0, j == 1 ? args.out : nullptr, nullptr); SEAM(pb + 19); }
    }
#undef IN
#undef SEAM
}

static bool phase_enabled(int k, unsigned mask) {
    if (k == 0) return true;
    const int j = (k - 1) / 20, r = (k - 1) % 20;
    int sub;
    if (r <= 5) sub = 0; else if (r == 6) return true; else if (r <= 8) sub = 1; else if (r == 9) return true;
    else if (r <= 14) sub = 2; else if (r == 15) return true; else if (r <= 18) sub = 3; else return true;
    return (mask >> (4 * j + sub)) & 1u;
}
extern "C" void kernel_launch(void* const* d_in, const int* in_sizes, int n_in, void* d_out, int out_size, void* d_ws, size_t ws_size, hipStream_t stream) {
    static int grid = 0;
    if (grid == 0) {
        if (n_in != 21 || out_size != MMAIN * D || ws_size < WS_END) { fprintf(stderr, "kernel_launch: unexpected shapes: n_in %d out %d ws %zu (need %zu); nothing launched\n", n_in, out_size, ws_size, (size_t)WS_END); grid = -1; return; }
        int dev = 0, cus = 0, per_cu = 0;
        if (hipGetDevice(&dev) != hipSuccess || hipDeviceGetAttribute(&cus, hipDeviceAttributeMultiprocessorCount, dev) != hipSuccess) { grid = -1; return; }
        if (hipFuncSetAttribute((const void*)fwd, hipFuncAttributeMaxDynamicSharedMemorySize, LDS_BYTES) != hipSuccess) { fprintf(stderr, "kernel_launch: hipFuncSetAttribute failed\n"); grid = -1; return; }
        if (hipOccupancyMaxActiveBlocksPerMultiprocessor(&per_cu, (const void*)fwd, NTHR, LDS_BYTES) != hipSuccess || per_cu < 1) fprintf(stderr, "kernel_launch: note: occupancy query reports %d\n", per_cu);
        (void)hipGetLastError();
        grid = cus;
    }
    if (grid < 0) return;
    (void)hipMemsetAsync((char*)d_ws + WS_CTL, 0, CTL_ZERO_BYTES, stream);
    Args a{};
    for (int i = 0; i < 21; ++i) a.in[i] = (const float*)d_in[i];
    a.out = (float*)d_out; a.ws = (unsigned char*)d_ws; a.submask = MK_SUBMASK; a.pad = 0;
#if MK_PER_PHASE
    for (int k = 0; k < NPHASE; ++k) { if (!phase_enabled(k, MK_SUBMASK)) continue; a.ph_lo = k; a.ph_hi = k + 1; hipLaunchKernelGGL(fwd, dim3(grid), dim3(NTHR), LDS_BYTES, stream, a); }
#else
    a.ph_lo = 0; a.ph_hi = NPHASE; hipLaunchKernelGGL(fwd, dim3(grid), dim3(NTHR), LDS_BYTES, stream, a);
#ifdef MK_PROBE_LIST
    { const int pl[] = {MK_PROBE_LIST}; for (int k : pl) { a.ph_lo = k; a.ph_hi = k + 1; hipLaunchKernelGGL(fwd, dim3(grid), dim3(NTHR), LDS_BYTES, stream, a); } }
#endif
#endif
}
```

```cpp
#include <hip/hip_runtime.h>
#include <cstdio>
#include <cstdint>

#define GAS __attribute__((address_space(1)))
#define LAS __attribute__((address_space(3)))
typedef unsigned short bf16;
typedef unsigned v4u __attribute__((ext_vector_type(4)));
typedef unsigned v2u __attribute__((ext_vector_type(2)));
typedef float f32x4 __attribute__((ext_vector_type(4)));
typedef float f32x2 __attribute__((ext_vector_type(2)));
typedef short bf16x8 __attribute__((ext_vector_type(8)));
typedef short bf16x4 __attribute__((ext_vector_type(4)));
typedef GAS unsigned gu32;
#define RLX_AGENT __ATOMIC_RELAXED, __HIP_MEMORY_SCOPE_AGENT
#define LDS_WAIT() asm volatile("s_waitcnt lgkmcnt(0)" ::: "memory")
#define VM_WAIT() asm volatile("s_waitcnt vmcnt(0)" ::: "memory")

__device__ __forceinline__ unsigned f2bf(float f) { unsigned u = __builtin_bit_cast(unsigned, f); return (u + 0x7fffu + ((u >> 16) & 1u)) >> 16; }
__device__ __forceinline__ unsigned pk2(float lo, float hi) { return f2bf(lo) | (f2bf(hi) << 16); }
__device__ __forceinline__ float bflo(unsigned w) { return __builtin_bit_cast(float, w << 16); }
__device__ __forceinline__ float bfhi(unsigned w) { return __builtin_bit_cast(float, w & 0xffff0000u); }
__device__ __forceinline__ float bf2f(bf16 b) { return __builtin_bit_cast(float, (unsigned)b << 16); }
__device__ __forceinline__ unsigned cvt_pk_bf16(float lo, float hi) { unsigned r; asm volatile("v_cvt_pk_bf16_f32 %0, %1, %2" : "=v"(r) : "v"(lo), "v"(hi)); return r; }
__device__ __forceinline__ float fast_exp(float x) { return __builtin_amdgcn_exp2f(x * 1.44269504089f); }
__device__ __forceinline__ float sigmoid_f(float x) { return __builtin_amdgcn_rcpf(1.0f + fast_exp(-x)); }
__device__ __forceinline__ float silu_f(float x) { return x * sigmoid_f(x); }
__device__ __forceinline__ float gelu_tanh_f(float x) { const float u = 0.7978845608028654f * (x + 0.044715f * x * x * x); return x * sigmoid_f(2.0f * u); }
__device__ __forceinline__ float wave_sum(float v) {
#pragma unroll
    for (int o = 1; o < 64; o <<= 1) v += __shfl_xor(v, o);
    return v;
}

namespace pg8 {
constexpr int BM = 256, BK = 64, HALF = 128, HTB = HALF * BK * 2  , STAGE_BYTES = 8 * HTB, NXCD = 8, WGM = 8;
__host__ __device__ __forceinline__ int lds_byte(int r, int c) { const int st = (r >> 4) * 2 + (c >> 5), rr = r & 15, cc = c & 31, ob = rr * 64 + cc * 2; return st * 1024 + (ob ^ (((ob >> 9) & 1) << 5)); }
__host__ __device__ __forceinline__ void stage_rc(int b, int& R, int& C) { const int st = b / 1024, sb = b % 1024, swz = sb ^ (((sb >> 9) & 1) << 5); R = (st >> 1) * 16 + swz / 64; C = (st & 1) * 32 + (swz % 64) / 2; }
__host__ __device__ __forceinline__ int perm32(int rho) { const int n = rho >> 4, i = rho & 15; return 8 * (i >> 2) + 4 * n + (i & 3); }

struct Unit { int pm, pn; };
struct Gemm { int K, lda; };

struct OrderBase {
    int nM, nN, nwg, G, c;
    __device__ __forceinline__ void init_order(int nM_, int nN_, int G_, int c_) { nM = nM_; nN = nN_; nwg = nM * nN; G = G_; c = c_; }
    __device__ __forceinline__ bool next(int i, Unit& u) const {
        const long L = (long)i * G + c; if (L >= nwg) return false;
        int wgid = (int)L; { const int q = nwg / NXCD, r = nwg % NXCD, xcd = wgid % NXCD, off = wgid / NXCD; wgid = (xcd < r ? xcd * (q + 1) : r * (q + 1) + (xcd - r) * q) + off; }
        const int nig = WGM * nN, gid = wgid / nig, fm = gid * WGM, gsz = (nM - fm) < WGM ? (nM - fm) : WGM;
        u.pm = fm + ((wgid % nig) % gsz); u.pn = (wgid % nig) / gsz; return true;
    }
};
struct DenseOrder : OrderBase {
    const char* A; const char* Bt; size_t a_tile, b_tile;
    __device__ __forceinline__ void init(const bf16* A_, int lda, const bf16* Bt_, int K, int nM_, int nN_, int G_, int c_) { A = (const char*)A_; Bt = (const char*)Bt_; a_tile = (size_t)BM * lda * 2; b_tile = (size_t)BM * K * 2; init_order(nM_, nN_, G_, c_); }
    __device__ __forceinline__ const char* a_base(const Unit& u) const { return A + (size_t)u.pm * a_tile; }
    __device__ __forceinline__ const char* b_base(const Unit& u) const { return Bt + (size_t)u.pn * b_tile; }
};
struct GatesOrder : DenseOrder {
    __device__ __forceinline__ const char* a_base(const Unit& u) const { return A + (size_t)u.pm * a_tile + (size_t)(u.pn >> 1) * 512; }
};
struct MoeOrder : DenseOrder {
    int pe[8]; size_t e_bytes;
    __device__ __forceinline__ const char* b_base(const Unit& u) const {
        int e = 0;
#pragma unroll
        for (int j = 0; j < 7; ++j) e += (u.pm >= pe[j]) ? 1 : 0;
        return Bt + (size_t)e * e_bytes + (size_t)u.pn * b_tile;
    }
};

template <class Epi, class Sched, bool ALIGN_EPI = true>
__device__ __forceinline__ void gemm_phase(LAS unsigned char* lds, const int tid, const Gemm g, const Sched& S, const Epi& E) {
    const int wid = __builtin_amdgcn_readfirstlane(tid >> 6), lane = tid & 63, wr = wid >> 2, wc = wid & 3, fr = lane & 15, fq = lane >> 4;
    const int K = g.K, nt = K / BK;
    unsigned voffA[2], voffB[2];
#pragma unroll
    for (int i = 0; i < 2; ++i) { int R, C; stage_rc(tid * 16 + i * 8192, R, C); const int Rb = Epi::PERM ? ((R & ~31) + perm32(R & 31)) : R;
        voffA[i] = (unsigned)(R * g.lda + C) * 2u; voffB[i] = (unsigned)(Rb * K + C) * 2u; }
    const size_t kstep = (size_t)(BK * 2);
    const size_t hstepA = (size_t)HALF * g.lda * 2, hstepB = (size_t)HALF * K * 2;
    const unsigned ldsw = (unsigned)wid * 1024u;
    const int aoff = lds_byte(wr * 64 + fr, fq * 8), boff = lds_byte(wc * 32 + fr, fq * 8);
#define PG8_SA(b, h) (((b) * 2 + (h)) * HTB)
#define PG8_SB(b, h) ((4 + (b) * 2 + (h)) * HTB)
#define PG8_STAGE(bufoff, gbase, voff) do { _Pragma("unroll") for (int _i = 0; _i < 2; ++_i) \
        __builtin_amdgcn_global_load_lds((const unsigned*)((const char*)(gbase) + (voff)[_i]), (LAS unsigned*)(lds + (bufoff) + ldsw + _i * 8192), 16, 0, 0); } while (0)
#define PG8_LDA(dst, b, h) do { _Pragma("unroll") for (int m = 0; m < 4; ++m) _Pragma("unroll") for (int k = 0; k < 2; ++k) dst[m][k] = *(const LAS bf16x8*)(lds + PG8_SA(b, h) + aoff + m * 2048 + k * 1024); } while (0)
#define PG8_LDB(dst, b, h) do { _Pragma("unroll") for (int n = 0; n < 2; ++n) _Pragma("unroll") for (int k = 0; k < 2; ++k) dst[n][k] = *(const LAS bf16x8*)(lds + PG8_SB(b, h) + boff + n * 2048 + k * 1024); } while (0)
#define PG8_MMA(ai, bj, At, Bt) do { __builtin_amdgcn_s_setprio(1); _Pragma("unroll") for (int m = 0; m < 4; ++m) _Pragma("unroll") for (int n = 0; n < 2; ++n) _Pragma("unroll") for (int k = 0; k < 2; ++k) \
        acc[ai][bj][m][n] = __builtin_amdgcn_mfma_f32_16x16x32_bf16(Bt[n][k], At[m][k], acc[ai][bj][m][n], 0, 0, 0); __builtin_amdgcn_s_setprio(0); } while (0)
#define PG8_WAIT_V(n) asm volatile("s_waitcnt vmcnt(" #n ")" ::: "memory")
#define PG8_WAIT_L(n) asm volatile("s_waitcnt lgkmcnt(" #n ")" ::: "memory")
#define PG8_BAR __builtin_amdgcn_s_barrier()
#define PG8_SCHED __builtin_amdgcn_sched_barrier(0)
    Unit cur, nxt; int ui = 0;
    if (!S.next(0, cur)) return;
    f32x4 acc[2][2][4][2];
#pragma unroll
    for (int a = 0; a < 2; ++a)
#pragma unroll
        for (int b = 0; b < 2; ++b)
#pragma unroll
            for (int m = 0; m < 4; ++m)
#pragma unroll
                for (int n = 0; n < 2; ++n) acc[a][b][m][n] = (f32x4){0.f, 0.f, 0.f, 0.f};
    bf16x8 At[4][2], B0[2][2], B1[2][2];
    const char* cA = S.a_base(cur); const char* cB = S.b_base(cur);
    PG8_STAGE(PG8_SB(0, 0), cB, voffB); PG8_STAGE(PG8_SB(0, 1), cB + hstepB, voffB); PG8_STAGE(PG8_SA(0, 0), cA, voffA); PG8_STAGE(PG8_SA(0, 1), cA + hstepA, voffA);
    if (wr == 1) PG8_BAR;
    PG8_WAIT_V(2); PG8_BAR;
    PG8_STAGE(PG8_SB(1, 0), cB + kstep, voffB); PG8_STAGE(PG8_SA(1, 0), cA + kstep, voffA); PG8_STAGE(PG8_SB(1, 1), cB + hstepB + kstep, voffB);
    PG8_WAIT_V(6); PG8_BAR;
    for (;;) {
        const bool has_next = S.next(ui + 1, nxt);
        const char* nA = has_next ? S.a_base(nxt) : cA; const char* nB = has_next ? S.b_base(nxt) : cB;
#pragma nounroll
        for (int t = 0; t < nt; t += 2) {
            const bool last = (t == nt - 2);
            const char* a1 = cA + (size_t)(t + 1) * kstep;
            const char* a2 = last ? nA : cA + (size_t)(t + 2) * kstep; const char* b2 = last ? nB : cB + (size_t)(t + 2) * kstep;
            const char* a3 = a2 + kstep; const char* b3 = b2 + kstep;
            PG8_LDB(B0, 0, 0); PG8_LDB(B1, 0, 1); PG8_SCHED; PG8_LDA(At, 0, 0); PG8_STAGE(PG8_SA(1, 1), a1 + hstepA, voffA);
            PG8_WAIT_V(8); PG8_WAIT_L(0); PG8_BAR; PG8_MMA(0, 0, At, B0); PG8_MMA(0, 1, At, B1); PG8_BAR; PG8_SCHED;
            PG8_LDA(At, 0, 1); PG8_STAGE(PG8_SB(0, 0), b2, voffB); PG8_STAGE(PG8_SB(0, 1), b2 + hstepB, voffB); PG8_STAGE(PG8_SA(0, 0), a2, voffA);
            PG8_WAIT_V(8); PG8_WAIT_L(0); PG8_BAR; PG8_MMA(1, 0, At, B0); PG8_MMA(1, 1, At, B1); PG8_BAR; PG8_SCHED;
            PG8_LDB(B0, 1, 0); PG8_LDB(B1, 1, 1); PG8_SCHED; PG8_LDA(At, 1, 0); PG8_STAGE(PG8_SA(0, 1), a2 + hstepA, voffA);
            PG8_WAIT_V(8); PG8_WAIT_L(0); PG8_BAR; PG8_MMA(0, 0, At, B0); PG8_MMA(0, 1, At, B1); PG8_BAR; PG8_SCHED;
            PG8_LDA(At, 1, 1); PG8_STAGE(PG8_SB(1, 0), b3, voffB); PG8_STAGE(PG8_SB(1, 1), b3 + hstepB, voffB); PG8_STAGE(PG8_SA(1, 0), a3, voffA);
            PG8_WAIT_V(8); PG8_WAIT_L(0); PG8_BAR; PG8_MMA(1, 0, At, B0); PG8_MMA(1, 1, At, B1); PG8_BAR; PG8_SCHED;
        }
        if constexpr (ALIGN_EPI) { if (wr == 0) PG8_BAR; }
        E(acc, cur, wr, wc, fr, fq);
        if (!has_next) break;
#pragma unroll
        for (int a = 0; a < 2; ++a)
#pragma unroll
            for (int b = 0; b < 2; ++b)
#pragma unroll
                for (int m = 0; m < 4; ++m)
#pragma unroll
                    for (int n = 0; n < 2; ++n) acc[a][b][m][n] = (f32x4){0.f, 0.f, 0.f, 0.f};
        cur = nxt; cA = nA; cB = nB; ++ui;
        if constexpr (ALIGN_EPI) { if (wr == 1) PG8_BAR; }
    }
    PG8_WAIT_V(0);
    if constexpr (!ALIGN_EPI) { if (wr == 0) PG8_BAR; }
    PG8_BAR;
#undef PG8_SA
#undef PG8_SB
#undef PG8_STAGE
#undef PG8_LDA
#undef PG8_LDB
#undef PG8_MMA
#undef PG8_WAIT_V
#undef PG8_WAIT_L
#undef PG8_BAR
#undef PG8_SCHED
}
}
#define XB_TMO      128
#define XB_XCNT(j)  (256  + 64 * (j))
#define XB_XSUB(j)  (1280 + 64 * (j))
#define XB_XGEN(j)  (2304 + 64 * (j))
#define XB_TOP      3328
#define XB_TOPGEN   3392
#define XCD_BAR_WORDS 3456
#define XB_SPIN_CAP (1u << 18)

__device__ __forceinline__ unsigned xb_ld(unsigned* p)              { return __hip_atomic_load(p, __ATOMIC_RELAXED, __HIP_MEMORY_SCOPE_AGENT); }
__device__ __forceinline__ unsigned xb_add(unsigned* p, unsigned v) { return __hip_atomic_fetch_add(p, v, __ATOMIC_RELAXED, __HIP_MEMORY_SCOPE_AGENT); }
__device__ __forceinline__ unsigned xb_xcc_id() { return (unsigned)__builtin_amdgcn_s_getreg((3 << 11) | 20) & 0xFu; }
#define XB_SPIN(cond, bar) do { unsigned _sp = 0; while (cond) { __builtin_amdgcn_s_sleep(1); \
    if ((++_sp & 255u) == 0u) { if (xb_ld(&(bar)[XB_TMO])) break; if (_sp > XB_SPIN_CAP) { atomicAdd(&(bar)[XB_TMO], 1u); break; } } } } while (0)

struct XcdBarrier {
    unsigned* bar; unsigned x;
    volatile LAS unsigned* st;
};

__device__ __forceinline__ XcdBarrier xcd_barrier_post(unsigned* bar, volatile LAS unsigned* st) {
    XcdBarrier b; b.bar = bar; b.x = xb_xcc_id(); b.st = st;
    if (threadIdx.x == 0) (void)xb_add(&bar[XB_XCNT(b.x)], 1u);
    return b;
}
__device__ __forceinline__ void xcd_barrier_complete(unsigned* bar, unsigned x, unsigned& nloc, unsigned& nx) {
    const unsigned G = gridDim.x * gridDim.y * gridDim.z;
    unsigned sum, cnt, mine, sp = 0u;
    for (;;) {
        sum = 0u; cnt = 0u; mine = 0u;
#pragma unroll
        for (unsigned j = 0; j < 16; ++j) { const unsigned c = xb_ld(&bar[XB_XCNT(j)]); sum += c; cnt += (c > 0u) ? 1u : 0u; mine = (j == x) ? c : mine; }
        if (sum == G) break;
        __builtin_amdgcn_s_sleep(1);
        if ((++sp & 255u) == 0u) { if (xb_ld(&bar[XB_TMO])) break; if (sp > XB_SPIN_CAP) { atomicAdd(&bar[XB_TMO], 1u); break; } }
    }
    nloc = mine > 0u ? mine : 1u; nx = cnt > 0u ? cnt : 1u;
}

__device__ __forceinline__ void xcd_barrier(const XcdBarrier& b) {
    asm volatile("s_waitcnt vmcnt(0)" ::: "memory");
    __syncthreads();
    if (threadIdx.x == 0) {
        unsigned* bar = b.bar;
        __builtin_amdgcn_s_waitcnt(0);
        unsigned nloc = b.st[0], nx = b.st[1];
        if (nloc == 0u) { xcd_barrier_complete(bar, b.x, nloc, nx); b.st[0] = nloc; b.st[1] = nx; }
        const unsigned old = xb_add(&bar[XB_XSUB(b.x)], 1u);
        const unsigned gen = old / nloc;
        if (old + 1u == (gen + 1u) * nloc) {
            __builtin_amdgcn_fence(__ATOMIC_RELEASE, "agent");
            asm volatile("s_waitcnt vmcnt(0)" ::: "memory");
            const unsigned og = xb_add(&bar[XB_TOP], 1u);
            const unsigned tg = og / nx;
            if (og + 1u == (tg + 1u) * nx) xb_add(&bar[XB_TOPGEN], 1u);
            else XB_SPIN(xb_ld(&bar[XB_TOPGEN]) == tg, bar);
            __builtin_amdgcn_fence(__ATOMIC_ACQUIRE, "agent");
            xb_add(&bar[XB_XGEN(b.x)], 1u);
            asm volatile("s_waitcnt vmcnt(0)" ::: "memory");
        } else {
            XB_SPIN(xb_ld(&bar[XB_XGEN(b.x)]) == gen, bar);
            __builtin_amdgcn_fence(__ATOMIC_ACQUIRE, "agent");
            asm volatile("s_waitcnt vmcnt(0)" ::: "memory");
        }
    }
    __syncthreads();
}

constexpr int NWAVES = 8, NTHR = 512;
constexpr int D = 1024, BATCH = 2, SEQ = 16384, NMETA = 16;
constexpr int MMAIN = BATCH * SEQ;
constexpr int MROWS = MMAIN + NMETA;
constexpr int MPAD = MMAIN + 256;
constexpr int RGW = 1344, RGBW = 168, NRG = 2816  , KRGO = 1408  , NGT = 4096, KGT = 256, XCW = 2048;
constexpr int FF = 3584, NE = 8, NFF2 = 2 * FF;
constexpr int GH = 4, GDK = 128, GDV = 256, GQK = 512, GVD = 1024, NGLA = 3072, GLAW = 3088, GRANK = 16;
constexpr int MSORT = 265 * 256;
constexpr float LN_EPS = 1e-5f, ALPHA = 1.6817928305074290f;
constexpr int SEG = 128, NSEG_B = SEQ / SEG, NSEG = 1 + BATCH * NSEG_B;
constexpr int CPS = 4, NSC_BH = SEQ / (64 * CPS), NGU = BATCH * GH * NSC_BH + GH;

constexpr size_t MiB = 1u << 20;
constexpr size_t WS_CTL = 0, CTL_ZERO_BYTES = 1 * MiB;
constexpr size_t WL_RGIN = 0, WL_GATES = WL_RGIN + (size_t)NRG * D * 2, WL_RGOUT = WL_GATES + (size_t)NGT * KGT * 2, WL_GLAIN = WL_RGOUT + (size_t)D * KRGO * 2,
                 WL_GLAOUT = WL_GLAIN + (size_t)NGLA * D * 2, WL_FFNIN = WL_GLAOUT + (size_t)D * D * 2, WL_FFNOUT = WL_FFNIN + (size_t)NFF2 * D * 2,
                 WL_MOEIN = WL_FFNOUT + (size_t)D * FF * 2, WL_MOEOUT = WL_MOEIN + (size_t)NE * NFF2 * D * 2, WL_STRIDE = WL_MOEOUT + (size_t)NE * D * FF * 2;
constexpr size_t WS_W = 1 * MiB;
constexpr size_t WS_H = WS_W + 2 * WL_STRIDE;
constexpr size_t WS_HB = WS_H + (size_t)MPAD * D * 4;
constexpr size_t WS_MIX = WS_HB + (size_t)MPAD * D * 2;
constexpr size_t WS_Z = WS_MIX + (size_t)MPAD * D * 4;
constexpr size_t WS_RT = WS_Z + 3 * MiB;
constexpr size_t WS_AGG = WS_RT + 1 * MiB;
constexpr size_t WS_S0 = WS_AGG + 3 * MiB;
constexpr size_t S_PROJ = 0, S_XC = S_PROJ + (size_t)MPAD * NRG * 2, S_LOGA = S_XC + (size_t)MPAD * XCW * 2, S_U = S_LOGA + (size_t)MPAD * RGW * 4, S_Y = S_U + (size_t)MPAD * RGW * 4, S_RG_END = S_Y + (size_t)MPAD * KRGO * 2;
constexpr size_t S_HID = 0;
constexpr size_t S_QKVR = 0, S_KVS = S_QKVR + (size_t)MPAD * NGLA * 2, S_SST = S_KVS + (size_t)NGU * GDK * GDV * 4, S_O = S_SST + (size_t)NGU * GDK * GDV * 4, S_DEC = S_O + (size_t)MPAD * D * 2, S_GLA_END = S_DEC + 1 * MiB;
constexpr size_t S_AS = 0, S_HS = S_AS + (size_t)MSORT * D * 2, S_YS = S_HS + (size_t)MSORT * FF * 2, S_MOE_END = S_YS + (size_t)MSORT * D * 4;
constexpr size_t S_MAX = S_RG_END > S_MOE_END ? (S_RG_END > S_GLA_END ? S_RG_END : S_GLA_END) : (S_MOE_END > S_GLA_END ? S_MOE_END : S_GLA_END);
constexpr size_t WS_END = WS_S0 + S_MAX;
constexpr int CW_TMO = 0, CW_BAR = 4096, CW_MOE = 8192;

constexpr int LDS_BYTES = 163840, MISC_OFF = LDS_BYTES - 64;

struct Frame {
    LAS unsigned char* lds; gu32* ctl; unsigned char* ws;
    int tid, lane, wave, G, bx;
    __device__ __forceinline__ void fresh() { asm volatile("" : "+v"(tid)); asm volatile("" : "+s"(bx)); asm volatile("" : "+s"(ws)); lane = tid & 63; wave = __builtin_amdgcn_readfirstlane(tid >> 6); ctl = (gu32*)(ws + WS_CTL); }
};
struct Args { const float* in[21]; float* out; unsigned char* ws; int ph_lo, ph_hi; unsigned submask; int pad; };

struct EpiBf16Gelu {
    static constexpr bool PERM = true, PAIR = false;
    bf16* O; int ldc, gelu_cols;
    __device__ __forceinline__ void operator()(const f32x4 (&acc)[2][2][4][2], const pg8::Unit& u, int wr, int wc, int fr, int fq) const {
        const int row0 = u.pm * 256 + wr * 64 + fr, col0 = u.pn * 256 + wc * 32 + 8 * fq;
#pragma unroll
        for (int ai = 0; ai < 2; ++ai)
#pragma unroll
            for (int m = 0; m < 4; ++m) { bf16* rowp = O + (size_t)(row0 + ai * 128 + m * 16) * ldc + col0;
#pragma unroll
                for (int bj = 0; bj < 2; ++bj) { f32x4 v0 = acc[ai][bj][m][0], v1 = acc[ai][bj][m][1];
                    if (col0 + bj * 128 < gelu_cols) {
#pragma unroll
                        for (int j = 0; j < 4; ++j) { v0[j] = gelu_tanh_f(v0[j]); v1[j] = gelu_tanh_f(v1[j]); } }
                    v4u w; w.x = cvt_pk_bf16(v0[0], v0[1]); w.y = cvt_pk_bf16(v0[2], v0[3]); w.z = cvt_pk_bf16(v1[0], v1[1]); w.w = cvt_pk_bf16(v1[2], v1[3]);
                    *(v4u*)(rowp + bj * 128) = w; } }
    }
    __device__ __forceinline__ void meta_task(int task, int& r0, int& aoff) const { r0 = task * 16; aoff = 0; }
    __device__ __forceinline__ void meta(int task, f32x4 a0, f32x4, int fr, int fq) const {
        const int col = task * 16 + 4 * fq;
        if (col < gelu_cols) {
#pragma unroll
            for (int j = 0; j < 4; ++j) a0[j] = gelu_tanh_f(a0[j]); }
        v2u w; w.x = cvt_pk_bf16(a0[0], a0[1]); w.y = cvt_pk_bf16(a0[2], a0[3]);
        *(v2u*)(O + (size_t)(MMAIN + fr) * ldc + col) = w;
    }
};
struct EpiSwiglu {
    static constexpr bool PERM = true, PAIR = true;
    bf16* O; int ldc;
    __device__ __forceinline__ void operator()(const f32x4 (&acc)[2][2][4][2], const pg8::Unit& u, int wr, int wc, int fr, int fq) const {
        const int row0 = u.pm * 256 + wr * 64 + fr, col0 = u.pn * 128 + wc * 32 + 8 * fq;
#pragma unroll
        for (int ai = 0; ai < 2; ++ai)
#pragma unroll
            for (int m = 0; m < 4; ++m) { bf16* rowp = O + (size_t)(row0 + ai * 128 + m * 16) * ldc + col0;
                f32x4 g0 = acc[ai][0][m][0], g1 = acc[ai][0][m][1]; const f32x4 u0 = acc[ai][1][m][0], u1 = acc[ai][1][m][1];
#pragma unroll
                for (int j = 0; j < 4; ++j) { g0[j] = silu_f(g0[j]) * u0[j]; g1[j] = silu_f(g1[j]) * u1[j]; }
                v4u w; w.x = cvt_pk_bf16(g0[0], g0[1]); w.y = cvt_pk_bf16(g0[2], g0[3]); w.z = cvt_pk_bf16(g1[0], g1[1]); w.w = cvt_pk_bf16(g1[2], g1[3]);
                *(v4u*)rowp = w; }
    }
    __device__ __forceinline__ void meta_task(int task, int& r0, int& aoff) const { r0 = (task >> 3) * 256 + (task & 7) * 16; aoff = 0; }
    __device__ __forceinline__ void meta(int task, f32x4 a0, f32x4 a1, int fr, int fq) const {
        const int col = (task >> 3) * 128 + (task & 7) * 16 + 4 * fq;
#pragma unroll
        for (int j = 0; j < 4; ++j) a0[j] = silu_f(a0[j]) * a1[j];
        v2u w; w.x = cvt_pk_bf16(a0[0], a0[1]); w.y = cvt_pk_bf16(a0[2], a0[3]);
        *(v2u*)(O + (size_t)(MMAIN + fr) * ldc + col) = w;
    }
};
struct EpiF32 {
    static constexpr bool PERM = false, PAIR = false;
    float* C; int ldc;
    __device__ __forceinline__ void operator()(const f32x4 (&acc)[2][2][4][2], const pg8::Unit& u, int wr, int wc, int fr, int fq) const {
        const int row0 = u.pm * 256 + wr * 64 + fr, col0 = u.pn * 256 + wc * 32 + 4 * fq;
#pragma unroll
        for (int ai = 0; ai < 2; ++ai)
#pragma unroll
            for (int m = 0; m < 4; ++m) { float* rowp = C + (size_t)(row0 + ai * 128 + m * 16) * ldc + col0;
#pragma unroll
                for (int bj = 0; bj < 2; ++bj)
#pragma unroll
                    for (int n = 0; n < 2; ++n) *(f32x4*)(rowp + bj * 128 + n * 16) = acc[ai][bj][m][n]; }
    }
    __device__ __forceinline__ void meta_task(int task, int& r0, int& aoff) const { r0 = task * 16; aoff = 0; }
    __device__ __forceinline__ void meta(int task, f32x4 a0, f32x4, int fr, int fq) const { *(f32x4*)(C + (size_t)(MMAIN + fr) * ldc + task * 16 + 4 * fq) = a0; }
};

template <class Epi>
__device__ __forceinline__ void meta_gemm(Frame& F, const bf16* A16, int lda, int K, const bf16* Bt, int ntasks, const Epi& E) {
    const int fr = F.lane & 15, fq = F.lane >> 4;
    LAS f32x4* red = (LAS f32x4*)F.lds;
    for (int task = F.bx; task < ntasks; task += F.G) {
        int r0, aoff; E.meta_task(task, r0, aoff);
        f32x4 acc0 = (f32x4){0.f, 0.f, 0.f, 0.f}, acc1 = acc0;
        const bf16* ap = A16 + (size_t)fr * lda + aoff + fq * 8; const bf16* bp0 = Bt + (size_t)(r0 + fr) * K + fq * 8; const bf16* bp1 = bp0 + (size_t)128 * K;
        for (int ks = F.wave; ks < K / 32; ks += NWAVES) {
            const bf16x8 a = *(const bf16x8*)(ap + ks * 32); const bf16x8 b0 = *(const bf16x8*)(bp0 + ks * 32);
            acc0 = __builtin_amdgcn_mfma_f32_16x16x32_bf16(b0, a, acc0, 0, 0, 0);
            if (Epi::PAIR) { const bf16x8 b1 = *(const bf16x8*)(bp1 + ks * 32); acc1 = __builtin_amdgcn_mfma_f32_16x16x32_bf16(b1, a, acc1, 0, 0, 0); }
        }
        red[(F.wave * 2 + 0) * 64 + F.lane] = acc0; if (Epi::PAIR) red[(F.wave * 2 + 1) * 64 + F.lane] = acc1;
        __syncthreads();
        if (F.wave == 0) {
            f32x4 s0 = red[F.lane], s1 = Epi::PAIR ? red[64 + F.lane] : acc1;
#pragma unroll
            for (int w = 1; w < NWAVES; ++w) { s0 += red[(w * 2) * 64 + F.lane]; if (Epi::PAIR) s1 += red[(w * 2 + 1) * 64 + F.lane]; }
            E.meta(task, s0, s1, fr, fq);
        }
        __syncthreads();
    }
}

__device__ __forceinline__ void transpose_item(const float* W, int ldw, int Ksrc, int c0, int nvalid, bf16* WT, int Kdst, int n0, int k0, LAS float* scr, int lane) {
#pragma unroll 8
    for (int i = 0; i < 32; ++i) { const int kk = 2 * i + (lane >> 5), c = lane & 31;
        const bool ok = (k0 + kk < Ksrc) && (c < nvalid); const float v = W[ok ? (size_t)(k0 + kk) * ldw + c0 + c : (size_t)0];
        scr[kk * 33 + c] = ok ? v : 0.f; }
    LDS_WAIT(); asm volatile("" ::: "memory");
    const int c = lane & 7;
#pragma unroll
    for (int j = 0; j < 4; ++j) { const int n = (lane >> 3) + 8 * j; const LAS float* s = scr + (8 * c) * 33 + n;
        v4u o; o.x = pk2(s[0 * 33], s[1 * 33]); o.y = pk2(s[2 * 33], s[3 * 33]); o.z = pk2(s[4 * 33], s[5 * 33]); o.w = pk2(s[6 * 33], s[7 * 33]);
        *(v4u*)(WT + (size_t)(n0 + n) * Kdst + k0 + 8 * c) = o; }
    LDS_WAIT(); asm volatile("" ::: "memory");
}
__device__ __forceinline__ void map_id(int n0, int nsrc, int& c0, int& nv) { c0 = n0; nv = nsrc - n0; nv = nv < 0 ? 0 : (nv > 32 ? 32 : nv); if (nv == 0) c0 = 0; }
__device__ __forceinline__ void map_swiglu(int n0, int& c0, int& nv) { const int tile = n0 >> 8, rr = n0 & 255; c0 = rr < 128 ? tile * 128 + rr : FF + tile * 128 + rr - 128; nv = 32; }

__device__ __forceinline__ void p0_prologue(Frame& F, const Args& a) {
    LAS float* scr = (LAS float*)(F.lds + F.wave * 16384);
    const int gw = F.bx * NWAVES + F.wave, NGW = F.G * NWAVES;
    constexpr int I_RGIN = (D / 64) * (NRG / 32), I_GATES = (KGT / 64) * (NGT / 32), I_RGOUT = (KRGO / 64) * (D / 32), I_GLAIN = (D / 64) * (NGLA / 32), I_GLAOUT = (D / 64) * (D / 32),
                  I_FFNIN = (D / 64) * (NFF2 / 32), I_FFNOUT = (FF / 64) * (D / 32), I_MOEIN = NE * I_FFNIN, I_MOEOUT = NE * I_FFNOUT;
    constexpr int I_PER_J = I_RGIN + I_GATES + I_RGOUT + I_GLAIN + I_GLAOUT + I_FFNIN + I_FFNOUT + I_MOEIN + I_MOEOUT;
    for (int it = gw; it < 2 * I_PER_J; it += NGW) {
        const int j = it / I_PER_J; int r = it - j * I_PER_J;
        unsigned char* wl = F.ws + WS_W + (size_t)j * WL_STRIDE;
        int c0, nv;
        if (r < I_RGIN) { const int nb = r % (NRG / 32), kb = r / (NRG / 32); map_id(nb * 32, 2 * RGW, c0, nv);
            transpose_item(a.in[4] + (size_t)j * D * 2 * RGW, 2 * RGW, D, c0, nv, (bf16*)(wl + WL_RGIN), D, nb * 32, kb * 64, scr, F.lane); continue; } r -= I_RGIN;
        if (r < I_GATES) { const int nb = r % (NGT / 32), kb = r / (NGT / 32); const int n0 = nb * 32, pn = n0 >> 8, rr = n0 & 255, g = rr >> 7, cc = rr & 127, d0 = (pn & 1) * 128 + cc, blk = pn >> 1;
            nv = RGBW - d0; nv = nv < 0 ? 0 : (nv > 32 ? 32 : nv); c0 = nv ? d0 : 0;
            transpose_item(a.in[7] + ((size_t)(j * 2 + g) * 8 + blk) * RGBW * RGBW, RGBW, RGBW, c0, nv, (bf16*)(wl + WL_GATES), KGT, n0, kb * 64, scr, F.lane); continue; } r -= I_GATES;
        if (r < I_RGOUT) { const int nb = r % (D / 32), kb = r / (D / 32);
            transpose_item(a.in[10] + (size_t)j * RGW * D, D, RGW, nb * 32, 32, (bf16*)(wl + WL_RGOUT), KRGO, nb * 32, kb * 64, scr, F.lane); continue; } r -= I_RGOUT;
        if (r < I_GLAIN) { const int nb = r % (NGLA / 32), kb = r / (NGLA / 32);
            transpose_item(a.in[11] + (size_t)j * D * GLAW, GLAW, D, nb * 32, 32, (bf16*)(wl + WL_GLAIN), D, nb * 32, kb * 64, scr, F.lane); continue; } r -= I_GLAIN;
        if (r < I_GLAOUT) { const int nb = r % (D / 32), kb = r / (D / 32);
            transpose_item(a.in[15] + (size_t)j * D * D, D, D, nb * 32, 32, (bf16*)(wl + WL_GLAOUT), D, nb * 32, kb * 64, scr, F.lane); continue; } r -= I_GLAOUT;
        if (r < I_FFNIN) { const int nb = r % (NFF2 / 32), kb = r / (NFF2 / 32); map_swiglu(nb * 32, c0, nv);
            transpose_item(a.in[16] + (size_t)j * D * NFF2, NFF2, D, c0, nv, (bf16*)(wl + WL_FFNIN), D, nb * 32, kb * 64, scr, F.lane); continue; } r -= I_FFNIN;
        if (r < I_FFNOUT) { const int nb = r % (D / 32), kb = r / (D / 32);
            transpose_item(a.in[17] + (size_t)j * FF * D, D, FF, nb * 32, 32, (bf16*)(wl + WL_FFNOUT), FF, nb * 32, kb * 64, scr, F.lane); continue; } r -= I_FFNOUT;
        if (r < I_MOEIN) { const int e = r / I_FFNIN, r2 = r % I_FFNIN; const int nb = r2 % (NFF2 / 32), kb = r2 / (NFF2 / 32); map_swiglu(nb * 32, c0, nv);
            transpose_item(a.in[19] + ((size_t)j * NE + e) * D * NFF2, NFF2, D, c0, nv, (bf16*)(wl + WL_MOEIN) + (size_t)e * NFF2 * D, D, nb * 32, kb * 64, scr, F.lane); continue; } r -= I_MOEIN;
        { const int e = r / I_FFNOUT, r2 = r % I_FFNOUT; const int nb = r2 % (D / 32), kb = r2 / (D / 32);
            transpose_item(a.in[20] + ((size_t)j * NE + e) * FF * D, D, FF, nb * 32, 32, (bf16*)(wl + WL_MOEOUT) + (size_t)e * D * FF, FF, nb * 32, kb * 64, scr, F.lane); }
    }
    bf16* HB = (bf16*)(F.ws + WS_HB);
    for (int m = gw; m < MROWS; m += NGW) {
        const float* src = m < MMAIN ? a.in[0] + (size_t)m * D : a.in[1] + (size_t)(m - MMAIN) * D;
#pragma unroll
        for (int q = 0; q < 4; ++q) { const f32x4 v = *(const f32x4*)(src + 4 * F.lane + 256 * q);
            v2u w; w.x = pk2(v[0], v[1]); w.y = pk2(v[2], v[3]); *(v2u*)(HB + (size_t)m * D + 4 * F.lane + 256 * q) = w; }
    }
}

struct LnRow { v4u h[2], a[2], b[2]; float w1, w2; };
__device__ __forceinline__ void unpack8(const v4u& w, float* o) { o[0] = bflo(w.x); o[1] = bfhi(w.x); o[2] = bflo(w.y); o[3] = bfhi(w.y); o[4] = bflo(w.z); o[5] = bfhi(w.z); o[6] = bflo(w.w); o[7] = bfhi(w.w); }
__device__ __forceinline__ void ln_phase(Frame& F, int mixkind, const float* gam, const float* bet, int extra, const float* Wx, int ldx, float* outp, gu32* moe_cnt) {
    bf16* HB = (bf16*)(F.ws + WS_HB); const bf16* MIX = (const bf16*)(F.ws + WS_MIX);
    const bf16* YS = (const bf16*)(F.ws + WS_S0 + S_YS);
    int* E1 = (int*)(F.ws + WS_RT); int* E2 = E1 + MROWS; float* W1 = (float*)(E2 + MROWS); float* W2 = W1 + MROWS; int* POS1 = (int*)(W2 + MROWS); int* POS2 = POS1 + MROWS;
    float* Z = (float*)(F.ws + WS_Z);
    LAS float* WL = (LAS float*)F.lds;
    LAS unsigned* lcnt = (LAS unsigned*)(F.lds + 65536);
    const int NC = extra == 1 ? 16 : (extra == 2 ? 8 : 0);
    if (extra) { for (int i = F.tid; i < NC * D; i += NTHR) { const int e = i / D, c = i % D; WL[e * D + c] = Wx[(size_t)c * ldx + e]; }
        if (F.tid < 8) lcnt[F.tid] = 0u;
        __syncthreads(); }
    const int gw = F.bx * NWAVES + F.wave, NGW = F.G * NWAVES, lane = F.lane;
    float gv[16], bv[16];
#pragma unroll
    for (int q = 0; q < 2; ++q)
#pragma unroll
        for (int t = 0; t < 2; ++t) { const f32x4 g4 = *(const f32x4*)(gam + 512 * q + 8 * lane + 4 * t), b4 = *(const f32x4*)(bet + 512 * q + 8 * lane + 4 * t);
#pragma unroll
            for (int k = 0; k < 4; ++k) { gv[8 * q + 4 * t + k] = g4[k]; bv[8 * q + 4 * t + k] = b4[k]; } }
    unsigned mycnt = 0u;
    for (int m0 = gw; m0 < MROWS; m0 += 2 * NGW) {
        LnRow R[2];
#pragma unroll
        for (int r = 0; r < 2; ++r) { const int m = m0 + r * NGW; if (m < MROWS) {
            const bf16* hp = HB + (size_t)m * D + 8 * lane; R[r].h[0] = *(const v4u*)hp; R[r].h[1] = *(const v4u*)(hp + 512);
            if (mixkind == 1) { const bf16* mp = MIX + (size_t)m * D + 8 * lane; R[r].a[0] = *(const v4u*)mp; R[r].a[1] = *(const v4u*)(mp + 512); }
            if (mixkind == 2) { R[r].w1 = W1[m]; R[r].w2 = W2[m]; const bf16* y1 = YS + (size_t)POS1[m] * D + 8 * lane; const bf16* y2 = YS + (size_t)POS2[m] * D + 8 * lane;
                R[r].a[0] = *(const v4u*)y1; R[r].a[1] = *(const v4u*)(y1 + 512); R[r].b[0] = *(const v4u*)y2; R[r].b[1] = *(const v4u*)(y2 + 512); } } }
#pragma unroll
        for (int r = 0; r < 2; ++r) { const int m = m0 + r * NGW; if (m < MROWS) {
            float v[16]; unpack8(R[r].h[0], v); unpack8(R[r].h[1], v + 8);
#pragma unroll
            for (int k = 0; k < 16; ++k) v[k] *= ALPHA;
            if (mixkind == 1) { float t[16]; unpack8(R[r].a[0], t); unpack8(R[r].a[1], t + 8);
#pragma unroll
                for (int k = 0; k < 16; ++k) v[k] += t[k]; }
            if (mixkind == 2) { float t[16], u[16]; unpack8(R[r].a[0], t); unpack8(R[r].a[1], t + 8); unpack8(R[r].b[0], u); unpack8(R[r].b[1], u + 8);
#pragma unroll
                for (int k = 0; k < 16; ++k) v[k] += t[k] * R[r].w1 + u[k] * R[r].w2; }
            float s = 0.f;
#pragma unroll
            for (int k = 0; k < 16; ++k) s += v[k];
            const float mean = wave_sum(s) * (1.f / D); float s2 = 0.f;
#pragma unroll
            for (int k = 0; k < 16; ++k) { v[k] -= mean; s2 += v[k] * v[k]; }
            const float rstd = 1.f / sqrtf(wave_sum(s2) * (1.f / D) + LN_EPS);
#pragma unroll
            for (int k = 0; k < 16; ++k) v[k] = v[k] * rstd * gv[k] + bv[k];
            bf16* op = HB + (size_t)m * D + 8 * lane;
            *(v4u*)op = (v4u){pk2(v[0], v[1]), pk2(v[2], v[3]), pk2(v[4], v[5]), pk2(v[6], v[7])}; *(v4u*)(op + 512) = (v4u){pk2(v[8], v[9]), pk2(v[10], v[11]), pk2(v[12], v[13]), pk2(v[14], v[15])};
            if (outp && m < MMAIN) { float* o = outp + (size_t)m * D + 8 * lane;
                *(f32x4*)o = (f32x4){v[0], v[1], v[2], v[3]}; *(f32x4*)(o + 4) = (f32x4){v[4], v[5], v[6], v[7]}; *(f32x4*)(o + 512) = (f32x4){v[8], v[9], v[10], v[11]}; *(f32x4*)(o + 516) = (f32x4){v[12], v[13], v[14], v[15]}; }
            if (extra) {
                float lg[16];
#pragma unroll
                for (int e = 0; e < 16; ++e) { lg[e] = 0.f; if (e < NC) { float p = 0.f;
#pragma unroll
                        for (int q = 0; q < 2; ++q) { const f32x4 w0 = *(const LAS f32x4*)(WL + e * D + 512 * q + 8 * lane), w1 = *(const LAS f32x4*)(WL + e * D + 512 * q + 8 * lane + 4);
                            p += (v[8 * q + 0] * w0[0] + v[8 * q + 1] * w0[1]) + (v[8 * q + 2] * w0[2] + v[8 * q + 3] * w0[3]) + (v[8 * q + 4] * w1[0] + v[8 * q + 5] * w1[1]) + (v[8 * q + 6] * w1[2] + v[8 * q + 7] * w1[3]); }
                        lg[e] = wave_sum(p); } }
                if (extra == 1) { float zv = 0.f;
#pragma unroll
                    for (int e = 0; e < 16; ++e) zv = (lane == e) ? lg[e] : zv;
                    if (lane < 16) Z[(size_t)m * 16 + lane] = zv; }
                else { int e1 = 0; float l1 = lg[0];
#pragma unroll
                    for (int e = 1; e < 8; ++e) if (lg[e] > l1) { l1 = lg[e]; e1 = e; }
                    int e2 = -1; float l2 = -3.0e38f;
#pragma unroll
                    for (int e = 0; e < 8; ++e) if (e != e1 && lg[e] > l2) { l2 = lg[e]; e2 = e; }
                    const float w2 = 1.f / (1.f + __expf(l1 - l2)), w1 = 1.f - w2;
                    if (lane == 0) { E1[m] = e1; E2[m] = e2; W1[m] = w1; W2[m] = w2; }
                    mycnt += (lane == e1 || lane == e2) ? 1u : 0u; }
            } } }
    }
    if (extra == 2) { if (lane < 8 && mycnt) __hip_atomic_fetch_add(&lcnt[lane], mycnt, __ATOMIC_RELAXED, __HIP_MEMORY_SCOPE_WORKGROUP);
        __syncthreads();
        if (F.tid < 8 && lcnt[F.tid]) __hip_atomic_fetch_add(moe_cnt + F.tid, lcnt[F.tid], RLX_AGENT); }
}

struct EpiGates {
    static constexpr bool PERM = true, PAIR = true;
    bf16* LOGA; bf16* U; const bf16* XC; const float* bg; const float* lam;
    __device__ __forceinline__ void chan4(int ch, f32x4& br, f32x4& bi, f32x4& c8) const {
        br = *(const f32x4*)(bg + ch); bi = *(const f32x4*)(bg + RGW + ch); const f32x4 lm = *(const f32x4*)(lam + ch);
#pragma unroll
        for (int t = 0; t < 4; ++t) c8[t] = -8.0f * log1pf(__expf(-lm[t]));
    }
    __device__ __forceinline__ void elem4(int row, int blk, int d, f32x4 ra, f32x4 ia, const f32x4& br, const f32x4& bi, const f32x4& c8) const {
        const int ch = blk * RGBW + d;
        const v2u xw = *(const v2u*)(XC + (size_t)row * XCW + blk * 256 + d);
        const float xc[4] = {bflo(xw.x), bfhi(xw.x), bflo(xw.y), bfhi(xw.y)};
        f32x4 la, uu;
#pragma unroll
        for (int t = 0; t < 4; ++t) {
            const float r = sigmoid_f(ra[t] + br[t]), ig = sigmoid_f(ia[t] + bi[t]);
            const float l = c8[t] * r;
            const float a2 = fast_exp(2.0f * l);
            la[t] = l; uu[t] = sqrtf(fmaxf(1.0f - a2, 0.f)) * (ig * xc[t]);
        }
        *(v2u*)(LOGA + (size_t)row * RGW + ch) = (v2u){pk2(la[0], la[1]), pk2(la[2], la[3])}; *(v2u*)(U + (size_t)row * RGW + ch) = (v2u){pk2(uu[0], uu[1]), pk2(uu[2], uu[3])};
    }
    __device__ __forceinline__ void operator()(const f32x4 (&acc)[2][2][4][2], const pg8::Unit& u, int wr, int wc, int fr, int fq) const {
        const int row0 = u.pm * 256 + wr * 64 + fr, blk = u.pn >> 1, d0 = (u.pn & 1) * 128 + wc * 32 + 8 * fq;
#pragma unroll
        for (int n = 0; n < 2; ++n) { const int d = d0 + 4 * n; if (d < RGBW) {
            f32x4 br, bi, c8; chan4(blk * RGBW + d, br, bi, c8);
#pragma unroll
            for (int ai = 0; ai < 2; ++ai)
#pragma unroll
                for (int m = 0; m < 4; ++m) elem4(row0 + ai * 128 + m * 16, blk, d, acc[ai][0][m][n], acc[ai][1][m][n], br, bi, c8); } }
    }
    __device__ __forceinline__ void meta_task(int task, int& r0, int& aoff) const { const int pn = task >> 3; r0 = pn * 256 + (task & 7) * 16; aoff = (pn >> 1) * 256; }
    __device__ __forceinline__ void meta(int task, f32x4 a0, f32x4 a1, int fr, int fq) const {
        const int pn = task >> 3, d = (pn & 1) * 128 + (task & 7) * 16 + 4 * fq;
        if (d < RGBW) { f32x4 br, bi, c8; chan4((pn >> 1) * RGBW + d, br, bi, c8); elem4(MMAIN + fr, pn >> 1, d, a0, a1, br, bi, c8); }
    }
};

__device__ __forceinline__ int conv_src_row(int row, int delta) {
    if (row < MMAIN) { const int t = row & (SEQ - 1); return (t - delta >= 0) ? row - delta : MMAIN + NMETA + (t - delta); }
    const int jm = row - MMAIN; return (jm - delta >= 0) ? row - delta : -1;
}
__device__ __forceinline__ void rg_conv_phase(Frame& F, const float* cw, const float* cb) {
    const bf16* PROJ = (const bf16*)(F.ws + WS_S0 + S_PROJ); bf16* XC = (bf16*)(F.ws + WS_S0 + S_XC);
    for (int idx = F.bx * NTHR + F.tid; idx < (MROWS / 4) * 256; idx += F.G * NTHR) {
        const int r0 = (idx >> 8) * 4, g = idx & 255, blk = g >> 5, kk = (g & 31) * 8;
        bf16* xo = XC + (size_t)r0 * XCW + blk * 256 + kk;
        if (kk < RGBW) {
            const int ch = blk * RGBW + kk;
            v4u x[7];
#pragma unroll
            for (int t = 0; t < 3; ++t) { const int rr = conv_src_row(r0, 3 - t); x[t] = (v4u){0u, 0u, 0u, 0u}; if (rr >= 0) x[t] = *(const v4u*)(PROJ + (size_t)rr * NRG + RGW + ch); }
#pragma unroll
            for (int t = 0; t < 4; ++t) x[3 + t] = *(const v4u*)(PROJ + (size_t)(r0 + t) * NRG + RGW + ch);
            float w[4][8], bb[8];
            { const f32x4 b0 = *(const f32x4*)(cb + ch), b1 = *(const f32x4*)(cb + ch + 4);
#pragma unroll
              for (int k = 0; k < 4; ++k) { bb[k] = b0[k]; bb[4 + k] = b1[k]; } }
#pragma unroll
            for (int tap = 0; tap < 4; ++tap) { const f32x4 w0 = *(const f32x4*)(cw + tap * RGW + ch), w1 = *(const f32x4*)(cw + tap * RGW + ch + 4);
#pragma unroll
                for (int k = 0; k < 4; ++k) { w[tap][k] = w0[k]; w[tap][4 + k] = w1[k]; } }
            float xf[7][8];
#pragma unroll
            for (int t = 0; t < 7; ++t) unpack8(x[t], xf[t]);
#pragma unroll
            for (int i = 0; i < 4; ++i) { float a[8];
#pragma unroll
                for (int k = 0; k < 8; ++k) a[k] = bb[k] + xf[i][k] * w[0][k] + xf[i + 1][k] * w[1][k] + xf[i + 2][k] * w[2][k] + xf[i + 3][k] * w[3][k];
                *(v4u*)(xo + (size_t)i * XCW) = (v4u){pk2(a[0], a[1]), pk2(a[2], a[3]), pk2(a[4], a[5]), pk2(a[6], a[7])}; }
        } else {
#pragma unroll
            for (int i = 0; i < 4; ++i) *(v4u*)(xo + (size_t)i * XCW) = (v4u){0u, 0u, 0u, 0u};
        }
    }
}
template <bool FIX>
__device__ __forceinline__ void rg_scan_phase(Frame& F) {
    const bf16* LOGA = (const bf16*)(F.ws + WS_S0 + S_LOGA); const bf16* U = (const bf16*)(F.ws + WS_S0 + S_U);
    const bf16* PROJ = (const bf16*)(F.ws + WS_S0 + S_PROJ); bf16* Y = (bf16*)(F.ws + WS_S0 + S_Y);
    float* AGGA = (float*)(F.ws + WS_AGG); float* AGGH = AGGA + (size_t)NSEG * RGW;
    const int gw = F.bx * NWAVES + F.wave, NGW = F.G * NWAVES;
    constexpr int NCG = 11, RB = 16;
    for (int task = gw; task < NSEG * NCG; task += NGW) {
        const int seg = task / NCG, cg = task - seg * NCG, ch = cg * 128 + 2 * F.lane;
        const int row0 = seg == 0 ? MMAIN : (seg - 1) * SEG, nrows = seg == 0 ? NMETA : SEG;
        if (ch >= RGW) {
            if (FIX) for (int r = 0; r < nrows; ++r) *(unsigned*)(Y + (size_t)(row0 + r) * KRGO + ch) = 0u;
            continue;
        }
        float h0 = 0.f, h1 = 0.f, c0 = 0.f, c1 = 0.f;
        if (FIX && seg > 0) {
            { const f32x2 hm = *(const f32x2*)(AGGH + ch); h0 = hm[0]; h1 = hm[1]; }
            const int sb = 1 + ((seg - 1) / NSEG_B) * NSEG_B, ns = (seg - 1) % NSEG_B;
            for (int q = 0; q < ns; q += 8) { f32x2 aa[8], hh[8];
#pragma unroll
                for (int t = 0; t < 8; ++t) { const int qq = (q + t < ns) ? q + t : ns - 1; aa[t] = *(const f32x2*)(AGGA + (size_t)(sb + qq) * RGW + ch); hh[t] = *(const f32x2*)(AGGH + (size_t)(sb + qq) * RGW + ch); }
#pragma unroll
                for (int t = 0; t < 8; ++t) if (q + t < ns) { h0 = __expf(aa[t][0]) * h0 + hh[t][0]; h1 = __expf(aa[t][1]) * h1 + hh[t][1]; } }
        }
        for (int r = 0; r < nrows; r += RB) {
            unsigned la[RB], uu[RB], gt[RB];
#pragma unroll
            for (int t = 0; t < RB; ++t) { const size_t o = (size_t)(row0 + r + t) * RGW + ch; la[t] = *(const unsigned*)(LOGA + o); uu[t] = *(const unsigned*)(U + o); if (FIX) gt[t] = *(const unsigned*)(PROJ + (size_t)(row0 + r + t) * NRG + ch); }
#pragma unroll
            for (int t = 0; t < RB; ++t) { const float l0 = bflo(la[t]), l1 = bfhi(la[t]);
                h0 = __expf(l0) * h0 + bflo(uu[t]); h1 = __expf(l1) * h1 + bfhi(uu[t]); c0 += l0; c1 += l1;
                if (FIX) *(unsigned*)(Y + (size_t)(row0 + r + t) * KRGO + ch) = pk2(h0 * bflo(gt[t]), h1 * bfhi(gt[t])); }
        }
        if (!FIX) { *(f32x2*)(AGGA + (size_t)seg * RGW + ch) = (f32x2){c0, c1}; *(f32x2*)(AGGH + (size_t)seg * RGW + ch) = (f32x2){h0, h1}; }
    }
}

#define RG_PHASES \
        if (IN(pb + 0)) { if (on_rg) { \
            bf16* PROJ = (bf16*)(F.ws + WS_S0 + S_PROJ); EpiBf16Gelu E{PROJ, NRG, RGW}; \
            meta_gemm(F, HB + (size_t)MMAIN * D, D, D, (const bf16*)(wl + WL_RGIN), NRG / 16, E); \
            pg8::Gemm g{D, D}; pg8::DenseOrder S; S.init(HB, D, (const bf16*)(wl + WL_RGIN), D, MMAIN / 256, NRG / 256, F.G, F.bx); \
            pg8::gemm_phase<EpiBf16Gelu, pg8::DenseOrder>(F.lds, F.tid, g, S, E); } \
            SEAM(pb + 0); } \
        if (IN(pb + 1)) { if (on_rg) rg_conv_phase(F, args.in[5] + (size_t)j * 4 * RGW, args.in[6] + (size_t)j * RGW); SEAM(pb + 1); } \
        if (IN(pb + 2)) { if (on_rg) { \
            const bf16* XC = (const bf16*)(F.ws + WS_S0 + S_XC); \
            EpiGates E{(bf16*)(F.ws + WS_S0 + S_LOGA), (bf16*)(F.ws + WS_S0 + S_U), XC, args.in[8] + (size_t)j * 2 * RGW, args.in[9] + (size_t)j * RGW}; \
            meta_gemm(F, XC + (size_t)MMAIN * XCW, XCW, KGT, (const bf16*)(wl + WL_GATES), (NGT / 256) * 8, E); \
            pg8::Gemm g{KGT, XCW}; pg8::GatesOrder S; S.init(XC, XCW, (const bf16*)(wl + WL_GATES), KGT, MMAIN / 256, NGT / 256, F.G, F.bx); \
            pg8::gemm_phase<EpiGates, pg8::GatesOrder>(F.lds, F.tid, g, S, E); } \
            SEAM(pb + 2); } \
        if (IN(pb + 3)) { if (on_rg) rg_scan_phase<false>(F); SEAM(pb + 3); } \
        if (IN(pb + 4)) { if (on_rg) rg_scan_phase<true>(F); SEAM(pb + 4); } \
        if (IN(pb + 5)) { if (on_rg) { \
            const bf16* Y = (const bf16*)(F.ws + WS_S0 + S_Y); EpiBf16Gelu E{MIX, D, 0}; \
            meta_gemm(F, Y + (size_t)MMAIN * KRGO, KRGO, KRGO, (const bf16*)(wl + WL_RGOUT), D / 16, E); \
            pg8::Gemm g{KRGO, KRGO}; pg8::DenseOrder S; S.init(Y, KRGO, (const bf16*)(wl + WL_RGOUT), KRGO, MMAIN / 256, D / 256, F.G, F.bx); \
            pg8::gemm_phase<EpiBf16Gelu, pg8::DenseOrder>(F.lds, F.tid, g, S, E); } \
            SEAM(pb + 5); }

constexpr int GL_QT = 0, GL_KT = 17408  , GL_KTT = 34816, GL_VT = 53248, GL_ST = 90112  , GL_SM = 155648;
constexpr int QTS = 136, KTTS = 72, VTS = 72, PS = 72, BS = 129;
static_assert(GL_SM + 2560 <= MISC_OFF, "GLA LDS map");

template <int MODE>
__device__ __forceinline__ void gla_phase(Frame& F, const float* wgu, const float* bgate, const float* normg) {
    const bf16* QKVR = (const bf16*)(F.ws + WS_S0 + S_QKVR); const float* Z = (const float*)(F.ws + WS_Z);
    float* KVS = (float*)(F.ws + WS_S0 + S_KVS); const float* SST = (const float*)(F.ws + WS_S0 + S_SST); float* DEC = (float*)(F.ws + WS_S0 + S_DEC);
    bf16* O = (bf16*)(F.ws + WS_S0 + S_O);
    LAS bf16* QT = (LAS bf16*)(F.lds + GL_QT); LAS bf16* KT = (LAS bf16*)(F.lds + GL_KT); LAS bf16* PP = (LAS bf16*)(F.lds + GL_KT);
    LAS bf16* KTT = (LAS bf16*)(F.lds + GL_KTT); LAS bf16* VT = (LAS bf16*)(F.lds + GL_VT); LAS unsigned char* ST = F.lds + GL_ST;
    LAS float* Bc = (LAS float*)(F.lds + GL_ST); LAS float* ZC = (LAS float*)(F.lds + GL_ST + 36864); LAS float* TOT = (LAS float*)(F.lds + GL_ST + 40960); LAS float* OFFM = (LAS float*)(F.lds + GL_ST + 43520);
    LAS float* em = (LAS float*)(F.lds + GL_SM); LAS float* ef = em + 128; LAS float* stats = ef + 128;
    const int tid0 = F.tid;
    for (int u = F.bx; u < NGU; u += F.G) {
        const bool meta = u >= BATCH * GH * NSC_BH;
        const int h = meta ? u - BATCH * GH * NSC_BH : (u / NSC_BH) % GH, b = meta ? 0 : u / (GH * NSC_BH), sc = meta ? 0 : u % NSC_BH;
        const int nch = meta ? 1 : CPS;
        f32x4 sacc[8][2];
        int lofs = (4 * ((tid0 & 63) >> 4)) * GDV + 32 * (tid0 >> 6) + (tid0 & 15); asm volatile("" : "+v"(lofs));
#pragma unroll
        for (int dt = 0; dt < 8; ++dt)
#pragma unroll
            for (int i = 0; i < 2; ++i) {
                sacc[dt][i] = (f32x4){0.f, 0.f, 0.f, 0.f};
                if (MODE == 1 && !meta) {
#pragma unroll
                    for (int jj = 0; jj < 4; ++jj) sacc[dt][i][jj] = SST[(size_t)u * (GDK * GDV) + (size_t)((16 * dt + jj) * GDV + 16 * i) + lofs]; }
            }
        float dsum = 0.f;
        for (int ci = 0; ci < nch; ++ci) {
            int tid = tid0; asm volatile("" : "+v"(tid));
            const int lane = tid & 63, w = __builtin_amdgcn_readfirstlane(tid >> 6), fr = lane & 15, fq = lane >> 4;
            const int rbase = meta ? 0 : b * SEQ + (sc * CPS + ci) * 64;
            if (tid < 256) { const int c = tid >> 2, part = tid & 3; const bool valid = !meta || c >= 48; const int row = meta ? MMAIN + c - 48 : rbase + c;
                f32x4 zv = (f32x4){0.f, 0.f, 0.f, 0.f}; if (valid) zv = *(const f32x4*)(Z + (size_t)row * 16 + 4 * part);
                *(LAS f32x4*)(ZC + c * 16 + 4 * part) = zv; }
            const int dA = tid & 127, cgp = tid >> 7;
            float wg[16];
#pragma unroll
            for (int i = 0; i < 16; ++i) wg[i] = wgu[(size_t)i * GQK + h * GDK + dA];
            const float bgv = bgate[h * GDK + dA];
            __syncthreads(); __builtin_amdgcn_sched_barrier(0);
            { float run = 0.f;
#pragma unroll 4
              for (int cc = 0; cc < 16; ++cc) { const int c = cgp * 16 + cc; float lg = bgv;
#pragma unroll
                for (int i = 0; i < 16; ++i) lg += ZC[c * 16 + i] * wg[i];
                float g = (fminf(lg, 0.f) - __logf(1.0f + __expf(-fabsf(lg)))) * (1.0f / 16.0f);
                if (meta && c < 48) g = 0.f;
                run += g; Bc[c * BS + dA] = run; }
              TOT[cgp * 129 + dA] = run; }
            __syncthreads(); __builtin_amdgcn_sched_barrier(0);
            if (tid < 128) { const float t0 = TOT[tid], t1 = TOT[129 + tid], t2 = TOT[258 + tid], t3 = TOT[387 + tid];
                const float bm = t0 + Bc[31 * BS + tid], bl = (t0 + t1) + (t2 + t3);
                em[tid] = __expf(bm); ef[tid] = __expf(bl - bm); dsum += bl;
                OFFM[tid] = -bm; OFFM[129 + tid] = t0 - bm; OFFM[258 + tid] = t0 + t1 - bm; OFFM[387 + tid] = t0 + t1 + t2 - bm; }
            __syncthreads(); __builtin_amdgcn_sched_barrier(0);
            { const int c = tid & 63, grp = tid >> 6, d0 = grp * 16, e0 = grp * 32; const bool valid = !meta || c >= 48; const int row = meta ? MMAIN + c - 48 : rbase + c;
                const bf16* rp = QKVR + (size_t)row * NGLA;
                v4u q0 = (v4u){0u, 0u, 0u, 0u}, q1 = q0, k0 = q0, k1 = q0, vv[4] = {q0, q0, q0, q0};
                if (valid) { if (MODE == 1) { q0 = *(const v4u*)(rp + h * GDK + d0); q1 = *(const v4u*)(rp + h * GDK + d0 + 8); }
                    k0 = *(const v4u*)(rp + GQK + h * GDK + d0); k1 = *(const v4u*)(rp + GQK + h * GDK + d0 + 8);
#pragma unroll
                    for (int t = 0; t < 4; ++t) vv[t] = *(const v4u*)(rp + 2 * GQK + h * GDV + e0 + 8 * t); }
                const unsigned qw[8] = {q0.x, q0.y, q0.z, q0.w, q1.x, q1.y, q1.z, q1.w}, kw[8] = {k0.x, k0.y, k0.z, k0.w, k1.x, k1.y, k1.z, k1.w};
                unsigned qo[8], ko[8];
                const LAS float* bcr = Bc + c * BS + d0; const LAS float* ofr = OFFM + (c >> 4) * 129 + d0;
#pragma unroll
                for (int t = 0; t < 8; ++t) {
                    const int d = d0 + 2 * t;
                    const float x0 = bcr[2 * t] + ofr[2 * t], x1 = bcr[2 * t + 1] + ofr[2 * t + 1];
                    const float e0f = __expf(x0), e1f = __expf(x1), r0 = __expf(-x0), r1 = __expf(-x1);
                    const float ka = bflo(kw[t]) * r0, kb = bfhi(kw[t]) * r1;
                    ko[t] = pk2(ka, kb);
                    if (MODE == 1) qo[t] = pk2(bflo(qw[t]) * (0.08838834764831845f * e0f), bfhi(qw[t]) * (0.08838834764831845f * e1f));
                    KTT[(d) * KTTS + c] = (bf16)(ko[t] & 0xffffu); KTT[(d + 1) * KTTS + c] = (bf16)(ko[t] >> 16);
                }
                *(LAS v4u*)(KT + c * QTS + d0) = (v4u){ko[0], ko[1], ko[2], ko[3]}; *(LAS v4u*)(KT + c * QTS + d0 + 8) = (v4u){ko[4], ko[5], ko[6], ko[7]};
                if (MODE == 1) { *(LAS v4u*)(QT + c * QTS + d0) = (v4u){qo[0], qo[1], qo[2], qo[3]}; *(LAS v4u*)(QT + c * QTS + d0 + 8) = (v4u){qo[4], qo[5], qo[6], qo[7]}; }
#pragma unroll
                for (int t = 0; t < 4; ++t) { const unsigned vw[4] = {vv[t].x, vv[t].y, vv[t].z, vv[t].w};
#pragma unroll
                    for (int s = 0; s < 4; ++s) { const int e = e0 + 8 * t + 2 * s; VT[e * VTS + c] = (bf16)(vw[s] & 0xffffu); VT[(e + 1) * VTS + c] = (bf16)(vw[s] >> 16); } }
            }
            __syncthreads(); __builtin_amdgcn_sched_barrier(0);
            f32x4 pacc[2];
#pragma unroll
            for (int dt = 0; dt < 8; ++dt) { const f32x4 emv = *(const LAS f32x4*)(em + 16 * dt + 4 * fq);
#pragma unroll
                for (int i = 0; i < 2; ++i) { sacc[dt][i] = sacc[dt][i] * emv;
                    if (MODE == 1) { const int e = 32 * w + 16 * i + fr; const int ck = (2 * dt + (fq >> 1)) ^ (e & 15);
                        v2u sw; sw.x = pk2(sacc[dt][i][0], sacc[dt][i][1]); sw.y = pk2(sacc[dt][i][2], sacc[dt][i][3]);
                        *(LAS v2u*)(ST + e * 256 + ck * 16 + (fq & 1) * 8) = sw; } } }
            if (MODE == 1) {
                const int mt = w & 3, ntp = w >> 2;
#pragma unroll
                for (int ii = 0; ii < 2; ++ii) { const int nt = 2 * ntp + ii; pacc[ii] = (f32x4){0.f, 0.f, 0.f, 0.f};
                    if (nt <= mt) {
#pragma unroll
                        for (int ks = 0; ks < 4; ++ks) { const bf16x8 kf = *(const LAS bf16x8*)(KT + (16 * nt + fr) * QTS + 32 * ks + 8 * fq); const bf16x8 qf = *(const LAS bf16x8*)(QT + (16 * mt + fr) * QTS + 32 * ks + 8 * fq);
                            pacc[ii] = __builtin_amdgcn_mfma_f32_16x16x32_bf16(kf, qf, pacc[ii], 0, 0, 0); }
                        if (nt == mt) {
#pragma unroll
                            for (int jj = 0; jj < 4; ++jj) if (4 * fq + jj > fr) pacc[ii][jj] = 0.f; }
                    } }
            }
            __syncthreads(); __builtin_amdgcn_sched_barrier(0);
            if (MODE == 1) { const int mt = w & 3, ntp = w >> 2;
#pragma unroll
                for (int ii = 0; ii < 2; ++ii) { const int nt = 2 * ntp + ii; v2u pw; pw.x = pk2(pacc[ii][0], pacc[ii][1]); pw.y = pk2(pacc[ii][2], pacc[ii][3]);
                    *(LAS v2u*)(PP + (16 * mt + fr) * PS + 16 * nt + 4 * fq) = pw; }
                __syncthreads(); __builtin_amdgcn_sched_barrier(0);
            }
            f32x4 oacc[8];
            if (MODE == 1) { const int mt = w & 3, eh = w >> 2;
                bf16x8 pf[2], qf[4];
#pragma unroll
                for (int ks = 0; ks < 2; ++ks) pf[ks] = *(const LAS bf16x8*)(PP + (16 * mt + fr) * PS + 32 * ks + 8 * fq);
#pragma unroll
                for (int ks = 0; ks < 4; ++ks) qf[ks] = *(const LAS bf16x8*)(QT + (16 * mt + fr) * QTS + 32 * ks + 8 * fq);
#pragma unroll
                for (int t = 0; t < 8; ++t) { const int e = 128 * eh + 16 * t + fr; f32x4 a = (f32x4){0.f, 0.f, 0.f, 0.f};
#pragma unroll
                    for (int ks = 0; ks < 2; ++ks) { const bf16x8 vf = *(const LAS bf16x8*)(VT + e * VTS + 32 * ks + 8 * fq); a = __builtin_amdgcn_mfma_f32_16x16x32_bf16(vf, pf[ks], a, 0, 0, 0); }
#pragma unroll
                    for (int ks = 0; ks < 4; ++ks) { const int ck = (4 * ks + fq) ^ (e & 15); const bf16x8 sf = *(const LAS bf16x8*)(ST + e * 256 + ck * 16); a = __builtin_amdgcn_mfma_f32_16x16x32_bf16(sf, qf[ks], a, 0, 0, 0); }
                    oacc[t] = a; }
            }
            { bf16x8 vf[2][2];
#pragma unroll
              for (int i = 0; i < 2; ++i)
#pragma unroll
                  for (int ks = 0; ks < 2; ++ks) vf[i][ks] = *(const LAS bf16x8*)(VT + (32 * w + 16 * i + fr) * VTS + 32 * ks + 8 * fq);
#pragma unroll
              for (int dt = 0; dt < 8; ++dt) { const f32x4 efv = *(const LAS f32x4*)(ef + 16 * dt + 4 * fq);
#pragma unroll
                  for (int ks = 0; ks < 2; ++ks) { const bf16x8 kf = *(const LAS bf16x8*)(KTT + (16 * dt + fr) * KTTS + 32 * ks + 8 * fq);
#pragma unroll
                      for (int i = 0; i < 2; ++i) sacc[dt][i] = __builtin_amdgcn_mfma_f32_16x16x32_bf16(kf, vf[i][ks], sacc[dt][i], 0, 0, 0); }
#pragma unroll
                  for (int i = 0; i < 2; ++i) sacc[dt][i] = sacc[dt][i] * efv; }
            }
            if (MODE == 1) { const int mt = w & 3, eh = w >> 2, c = 16 * mt + fr;
                float s1 = 0.f, s2 = 0.f;
#pragma unroll
                for (int t = 0; t < 8; ++t)
#pragma unroll
                    for (int jj = 0; jj < 4; ++jj) { s1 += oacc[t][jj]; s2 += oacc[t][jj] * oacc[t][jj]; }
                s1 += __shfl_xor(s1, 16); s1 += __shfl_xor(s1, 32); s2 += __shfl_xor(s2, 16); s2 += __shfl_xor(s2, 32);
                if (fq == 0) { stats[(c * 2 + eh) * 2 + 0] = s1; stats[(c * 2 + eh) * 2 + 1] = s2; }
                __syncthreads(); __builtin_amdgcn_sched_barrier(0);
                const float t1 = stats[(c * 2 + 0) * 2 + 0] + stats[(c * 2 + 1) * 2 + 0], t2 = stats[(c * 2 + 0) * 2 + 1] + stats[(c * 2 + 1) * 2 + 1];
                const float mean = t1 * (1.0f / GDV), var = fmaxf(t2 * (1.0f / GDV) - mean * mean, 0.f), rstd = 1.0f / sqrtf(var + LN_EPS);
                const bool valid = !meta || c >= 48; const int row = meta ? MMAIN + c - 48 : rbase + c;
                if (valid) {
#pragma unroll
                    for (int t = 0; t < 8; ++t) { const int e = 128 * eh + 16 * t + 4 * fq;
                        const v2u rw = *(const v2u*)(QKVR + (size_t)row * NGLA + 2 * GQK + GVD + h * GDV + e);
                        const f32x4 ng = *(const f32x4*)(normg + h * GDV + e);
                        const float r4[4] = {bflo(rw.x), bfhi(rw.x), bflo(rw.y), bfhi(rw.y)}; float o4[4];
#pragma unroll
                        for (int jj = 0; jj < 4; ++jj) o4[jj] = (oacc[t][jj] - mean) * rstd * ng[jj] * silu_f(r4[jj]);
                        v2u ow; ow.x = pk2(o4[0], o4[1]); ow.y = pk2(o4[2], o4[3]);
                        *(v2u*)(O + (size_t)row * D + h * GDV + e) = ow; } }
            }
            __syncthreads(); __builtin_amdgcn_sched_barrier(0);
        }
        if (MODE == 0) {
            int lofs2 = (4 * ((tid0 & 63) >> 4)) * GDV + 32 * (tid0 >> 6) + (tid0 & 15); asm volatile("" : "+v"(lofs2));
#pragma unroll
            for (int dt = 0; dt < 8; ++dt)
#pragma unroll
                for (int i = 0; i < 2; ++i)
#pragma unroll
                    for (int jj = 0; jj < 4; ++jj) KVS[(size_t)u * (GDK * GDV) + (size_t)((16 * dt + jj) * GDV + 16 * i) + lofs2] = sacc[dt][i][jj];
            if (tid0 < 128) DEC[(size_t)u * GDK + tid0] = dsum;
        }
    }
}
__device__ __forceinline__ void gla_scan_phase(Frame& F) {
    const float* KVS = (const float*)(F.ws + WS_S0 + S_KVS); float* SST = (float*)(F.ws + WS_S0 + S_SST); const float* DEC = (const float*)(F.ws + WS_S0 + S_DEC);
    constexpr int NEL = GDK * GDV;
    for (int idx = F.bx * NTHR + F.tid; idx < BATCH * GH * NEL; idx += F.G * NTHR) {
        const int bh = idx / NEL, el = idx - bh * NEL, d = el / GDV, h = bh % GH;
        float s = KVS[(size_t)(BATCH * GH * NSC_BH + h) * NEL + el];
        const size_t ub = (size_t)bh * NSC_BH;
        SST[ub * NEL + el] = s;
        for (int sc = 0; sc + 1 < NSC_BH; sc += 7) { float dv[7], kv[7];
#pragma unroll
            for (int t = 0; t < 7; ++t) { dv[t] = DEC[(ub + sc + t) * GDK + d]; kv[t] = KVS[(ub + sc + t) * NEL + el]; }
#pragma unroll
            for (int t = 0; t < 7; ++t) { s = __expf(dv[t]) * s + kv[t]; SST[(ub + sc + t + 1) * NEL + el] = s; } }
    }
}

#define GLA_PHASES \
        if (IN(pb + 10)) { if (on_gla) { \
            bf16* QKVR = (bf16*)(F.ws + WS_S0 + S_QKVR); EpiBf16Gelu E{QKVR, NGLA, 0}; \
            meta_gemm(F, HB + (size_t)MMAIN * D, D, D, (const bf16*)(wl + WL_GLAIN), NGLA / 16, E); \
            pg8::Gemm g{D, D}; pg8::DenseOrder S; S.init(HB, D, (const bf16*)(wl + WL_GLAIN), D, MMAIN / 256, NGLA / 256, F.G, F.bx); \
            pg8::gemm_phase<EpiBf16Gelu, pg8::DenseOrder>(F.lds, F.tid, g, S, E); } \
            SEAM(pb + 10); } \
        if (IN(pb + 11)) { if (on_gla) gla_phase<0>(F, args.in[12] + (size_t)j * GRANK * GQK, args.in[13] + (size_t)j * GQK, args.in[14] + (size_t)j * GVD); SEAM(pb + 11); } \
        if (IN(pb + 12)) { if (on_gla) gla_scan_phase(F); SEAM(pb + 12); } \
        if (IN(pb + 13)) { if (on_gla) gla_phase<1>(F, args.in[12] + (size_t)j * GRANK * GQK, args.in[13] + (size_t)j * GQK, args.in[14] + (size_t)j * GVD); SEAM(pb + 13); } \
        if (IN(pb + 14)) { if (on_gla) { \
            const bf16* O = (const bf16*)(F.ws + WS_S0 + S_O); EpiBf16Gelu E{MIX, D, 0}; \
            meta_gemm(F, O + (size_t)MMAIN * D, D, D, (const bf16*)(wl + WL_GLAOUT), D / 16, E); \
            pg8::Gemm g{D, D}; pg8::DenseOrder S; S.init(O, D, (const bf16*)(wl + WL_GLAOUT), D, MMAIN / 256, D / 256, F.G, F.bx); \
            pg8::gemm_phase<EpiBf16Gelu, pg8::DenseOrder>(F.lds, F.tid, g, S, E); } \
            SEAM(pb + 14); }

__device__ __forceinline__ void moe_panel_ends(const gu32* cnt, int (&pe)[8]) {
    int acc = 0;
#pragma unroll
    for (int e = 0; e < 8; ++e) { const int c = (int)__hip_atomic_load(cnt + e, RLX_AGENT); acc += (c + 255) >> 8; pe[e] = acc; }
}
__device__ __forceinline__ void moe_gather_phase(Frame& F, gu32* moe) {
    const bf16* HB = (const bf16*)(F.ws + WS_HB); bf16* AS = (bf16*)(F.ws + WS_S0 + S_AS);
    const int* E1 = (const int*)(F.ws + WS_RT); const int* E2 = E1 + MROWS; int* POS1 = (int*)(F.ws + WS_RT) + 4 * MROWS; int* POS2 = POS1 + MROWS;
    LAS unsigned* lcnt = (LAS unsigned*)F.lds; LAS unsigned* lbase = lcnt + 8; LAS int* lpos = (LAS int*)(F.lds + 256);
    const int per = (MROWS + F.G - 1) / F.G, t0 = F.bx * per, nt = (t0 + per <= MROWS) ? per : (MROWS - t0 > 0 ? MROWS - t0 : 0);
    if (F.tid < 8) lcnt[F.tid] = 0u;
    __syncthreads();
    int e1 = 0, e2 = 0; unsigned r1 = 0, r2 = 0;
    if (F.tid < nt) { e1 = E1[t0 + F.tid]; e2 = E2[t0 + F.tid];
        r1 = __hip_atomic_fetch_add(&lcnt[e1], 1u, __ATOMIC_RELAXED, __HIP_MEMORY_SCOPE_WORKGROUP); r2 = __hip_atomic_fetch_add(&lcnt[e2], 1u, __ATOMIC_RELAXED, __HIP_MEMORY_SCOPE_WORKGROUP); }
    __syncthreads();
    if (F.tid < 8) { int ps = 0, accp = 0;
#pragma unroll
        for (int e = 0; e < 8; ++e) { ps = (e == F.tid) ? accp : ps; accp += ((int)__hip_atomic_load(moe + e, RLX_AGENT) + 255) >> 8; }
        const unsigned c = lcnt[F.tid]; const unsigned off = c ? __hip_atomic_fetch_add(moe + 64 + F.tid, c, RLX_AGENT) : 0u;
        lbase[F.tid] = (unsigned)ps * 256u + off; }
    __syncthreads();
    if (F.tid < nt) { const int p1 = (int)(lbase[e1] + r1), p2 = (int)(lbase[e2] + r2); POS1[t0 + F.tid] = p1; POS2[t0 + F.tid] = p2; lpos[2 * F.tid] = p1; lpos[2 * F.tid + 1] = p2; }
    __syncthreads();
    for (int t = F.wave; t < nt; t += NWAVES) {
        const v4u* src = (const v4u*)(HB + (size_t)(t0 + t) * D); const v4u a = src[F.lane], b = src[64 + F.lane];
        v4u* d1 = (v4u*)(AS + (size_t)lpos[2 * t] * D); v4u* d2 = (v4u*)(AS + (size_t)lpos[2 * t + 1] * D);
        d1[F.lane] = a; d1[64 + F.lane] = b; d2[F.lane] = a; d2[64 + F.lane] = b;
    }
}

#define MOE_PHASES \
        if (IN(pb + 16)) { if (on_moe) moe_gather_phase(F, F.ctl + CW_MOE + 256 * j); SEAM(pb + 16); } \
        if (IN(pb + 17)) { if (on_moe) { \
            const bf16* AS = (const bf16*)(F.ws + WS_S0 + S_AS); bf16* HS = (bf16*)(F.ws + WS_S0 + S_HS); EpiSwiglu E{HS, FF}; \
            pg8::Gemm g{D, D}; pg8::MoeOrder S; moe_panel_ends(F.ctl + CW_MOE + 256 * j, S.pe); S.e_bytes = (size_t)NFF2 * D * 2; \
            S.init(AS, D, (const bf16*)(wl + WL_MOEIN), D, S.pe[7], NFF2 / 256, F.G, F.bx); \
            pg8::gemm_phase<EpiSwiglu, pg8::MoeOrder>(F.lds, F.tid, g, S, E); } \
            SEAM(pb + 17); } \
        if (IN(pb + 18)) { if (on_moe) { \
            const bf16* HS = (const bf16*)(F.ws + WS_S0 + S_HS); EpiBf16Gelu E{(bf16*)(F.ws + WS_S0 + S_YS), D, 0}; \
            pg8::Gemm g{FF, FF}; pg8::MoeOrder S; moe_panel_ends(F.ctl + CW_MOE + 256 * j, S.pe); S.e_bytes = (size_t)D * FF * 2; \
            S.init(HS, FF, (const bf16*)(wl + WL_MOEOUT), FF, S.pe[7], D / 256, F.G, F.bx); \
            pg8::gemm_phase<EpiBf16Gelu, pg8::MoeOrder>(F.lds, F.tid, g, S, E); } \
            SEAM(pb + 18); }

constexpr int NPHASE = 41;
#ifndef MK_PER_PHASE
#define MK_PER_PHASE 0
#endif
#ifndef MK_DBG
#define MK_DBG 0
#endif
#ifndef MK_SUBMASK
#define MK_SUBMASK 0xFFu
#endif

__global__ void __launch_bounds__(NTHR, 2) fwd(Args args) {
    extern __shared__ __attribute__((aligned(16))) unsigned char lds[];
    Frame F;
    F.lds = (LAS unsigned char*)lds; F.ws = args.ws; F.ctl = (gu32*)(args.ws + WS_CTL);
    F.tid = threadIdx.x; F.lane = F.tid & 63; F.wave = __builtin_amdgcn_readfirstlane(F.tid >> 6); F.G = gridDim.x; F.bx = blockIdx.x;
    volatile LAS unsigned* MISC = (volatile LAS unsigned*)(F.lds + MISC_OFF);
    if (F.tid < 16) MISC[F.tid] = 0u;
    __syncthreads();
    const int lo = args.ph_lo, hi = args.ph_hi;
    XcdBarrier bar; bar.bar = (unsigned*)(F.ctl + CW_BAR); bar.x = 0; bar.st = nullptr;
    if (hi - lo > 1) bar = xcd_barrier_post((unsigned*)(F.ctl + CW_BAR), MISC);
#define IN(k) (lo <= (k) && (k) < hi && (F.fresh(), true))
#define SEAM(k) do { if ((k) + 1 < hi) xcd_barrier(bar); } while (0)
    const unsigned submask = args.submask;
    const float* ln_gain = args.in[2]; const float* ln_bias = args.in[3];
    bf16* HB = (bf16*)(F.ws + WS_HB); bf16* MIX = (bf16*)(F.ws + WS_MIX);

    if (IN(0)) { p0_prologue(F, args); SEAM(0); }

    for (int j = 0; j < 2; ++j) {
        const int pb = 1 + 20 * j;
        unsigned char* wl = F.ws + WS_W + (size_t)j * WL_STRIDE;
        const bool on_rg = (submask >> (4 * j + 0)) & 1u, on_ffn = (submask >> (4 * j + 1)) & 1u, on_gla = (submask >> (4 * j + 2)) & 1u, on_moe = (submask >> (4 * j + 3)) & 1u;
        RG_PHASES
        if (IN(pb + 6)) { ln_phase(F, on_rg ? 1 : 0, ln_gain + (size_t)(2 * j) * 2 * D, ln_bias + (size_t)(2 * j) * 2 * D, 0, nullptr, 0, nullptr, nullptr); SEAM(pb + 6); }
        if (IN(pb + 7)) { if (on_ffn) {
            bf16* HID = (bf16*)(F.ws + WS_S0 + S_HID);
            EpiSwiglu E{HID, FF};
            if (!(MK_DBG & 1)) meta_gemm(F, HB + (size_t)MMAIN * D, D, D, (const bf16*)(wl + WL_FFNIN), (NFF2 / 256) * 8, E);
            pg8::Gemm g{D, D}; pg8::DenseOrder S; S.init(HB, D, (const bf16*)(wl + WL_FFNIN), D, MMAIN / 256, NFF2 / 256, F.G, F.bx);
            if (!(MK_DBG & 2)) pg8::gemm_phase<EpiSwiglu, pg8::DenseOrder>(F.lds, F.tid, g, S, E); }
            SEAM(pb + 7); }
        if (IN(pb + 8)) { if (on_ffn) {
            const bf16* HID = (const bf16*)(F.ws + WS_S0 + S_HID);
            EpiBf16Gelu E{MIX, D, 0};
            if (!(MK_DBG & 4)) meta_gemm(F, HID + (size_t)MMAIN * FF, FF, FF, (const bf16*)(wl + WL_FFNOUT), D / 16, E);
            pg8::Gemm g{FF, FF}; pg8::DenseOrder S; S.init(HID, FF, (const bf16*)(wl + WL_FFNOUT), FF, MMAIN / 256, D / 256, F.G, F.bx);
            if (!(MK_DBG & 8)) pg8::gemm_phase<EpiBf16Gelu, pg8::DenseOrder>(F.lds, F.tid, g, S, E); }
            SEAM(pb + 8); }
        if (IN(pb + 9)) { ln_phase(F, on_ffn ? 1 : 0, ln_gain + (size_t)(2 * j) * 2 * D + D, ln_bias + (size_t)(2 * j) * 2 * D + D, 1, args.in[11] + (size_t)j * D * GLAW + NGLA, GLAW, nullptr, nullptr); SEAM(pb + 9); }
        GLA_PHASES
        if (IN(pb + 15)) { ln_phase(F, on_gla ? 1 : 0, ln_gain + (size_t)(2 * j + 1) * 2 * D, ln_bias + (size_t)(2 * j + 1) * 2 * D, on_moe ? 2 : 0, args.in[18] + (size_t)j * D * NE, NE, nullptr, F.ctl + CW_MOE + 256 * j); SEAM(pb + 15); }
        MOE_PHASES
        if (IN(pb + 19)) { ln_phase(F, on_moe ? 2 : 0, ln_gain + (size_t)(2 * j + 1) * 2 * D + D, ln_bias + (size_t)(2 * j + 1) * 2 * D + D, 0, nullptr, 0, j == 1 ? args.out : nullptr, nullptr); SEAM(pb + 19); }
    }
#undef IN
#undef SEAM
}

static bool phase_enabled(int k, unsigned mask) {
    if (k == 0) return true;
    const int j = (k - 1) / 20, r = (k - 1) % 20;
    int sub;
    if (r <= 5) sub = 0; else if (r == 6) return true; else if (r <= 8) sub = 1; else if (r == 9) return true;
    else if (r <= 14) sub = 2; else if (r == 15) return true; else if (r <= 18) sub = 3; else return true;
    return (mask >> (4 * j + sub)) & 1u;
}
extern "C" void kernel_launch(void* const* d_in, const int* in_sizes, int n_in, void* d_out, int out_size, void* d_ws, size_t ws_size, hipStream_t stream) {
    static int grid = 0;
    if (grid == 0) {
        if (n_in != 21 || out_size != MMAIN * D || ws_size < WS_END) { fprintf(stderr, "kernel_launch: unexpected shapes: n_in %d out %d ws %zu (need %zu); nothing launched\n", n_in, out_size, ws_size, (size_t)WS_END); grid = -1; return; }
        int dev = 0, cus = 0, per_cu = 0;
        if (hipGetDevice(&dev) != hipSuccess || hipDeviceGetAttribute(&cus, hipDeviceAttributeMultiprocessorCount, dev) != hipSuccess) { grid = -1; return; }
        if (hipFuncSetAttribute((const void*)fwd, hipFuncAttributeMaxDynamicSharedMemorySize, LDS_BYTES) != hipSuccess) { fprintf(stderr, "kernel_launch: hipFuncSetAttribute failed\n"); grid = -1; return; }
        if (hipOccupancyMaxActiveBlocksPerMultiprocessor(&per_cu, (const void*)fwd, NTHR, LDS_BYTES) != hipSuccess || per_cu < 1) fprintf(stderr, "kernel_launch: note: occupancy query reports %d\n", per_cu);
        (void)hipGetLastError();
        grid = cus;
    }
    if (grid < 0) return;
    (void)hipMemsetAsync((char*)d_ws + WS_CTL, 0, CTL_ZERO_BYTES, stream);
    Args a{};
    for (int i = 0; i < 21; ++i) a.in[i] = (const float*)d_in[i];
    a.out = (float*)d_out; a.ws = (unsigned char*)d_ws; a.submask = MK_SUBMASK; a.pad = 0;
#if MK_PER_PHASE
    for (int k = 0; k < NPHASE; ++k) { if (!phase_enabled(k, MK_SUBMASK)) continue; a.ph_lo = k; a.ph_hi = k + 1; hipLaunchKernelGGL(fwd, dim3(grid), dim3(NTHR), LDS_BYTES, stream, a); }
#else
    a.ph_lo = 0; a.ph_hi = NPHASE; hipLaunchKernelGGL(fwd, dim3(grid), dim3(NTHR), LDS_BYTES, stream, a);
#ifdef MK_PROBE_LIST
    { const int pl[] = {MK_PROBE_LIST}; for (int k : pl) { a.ph_lo = k; a.ph_hi = k + 1; hipLaunchKernelGGL(fwd, dim3(grid), dim3(NTHR), LDS_BYTES, stream, a); } }
#endif
#endif
}
```

```cpp
#include <hip/hip_runtime.h>
#include <cstdio>
#include <cstdint>

#define GAS __attribute__((address_space(1)))
#define LAS __attribute__((address_space(3)))
typedef unsigned short bf16;
typedef unsigned v4u __attribute__((ext_vector_type(4)));
typedef unsigned v2u __attribute__((ext_vector_type(2)));
typedef float f32x4 __attribute__((ext_vector_type(4)));
typedef float f32x2 __attribute__((ext_vector_type(2)));
typedef short bf16x8 __attribute__((ext_vector_type(8)));
typedef short bf16x4 __attribute__((ext_vector_type(4)));
typedef GAS unsigned gu32;
#define RLX_AGENT __ATOMIC_RELAXED, __HIP_MEMORY_SCOPE_AGENT
#define LDS_WAIT() asm volatile("s_waitcnt lgkmcnt(0)" ::: "memory")
#define VM_WAIT() asm volatile("s_waitcnt vmcnt(0)" ::: "memory")

__device__ __forceinline__ unsigned f2bf(float f) { unsigned u = __builtin_bit_cast(unsigned, f); return (u + 0x7fffu + ((u >> 16) & 1u)) >> 16; }
__device__ __forceinline__ unsigned pk2(float lo, float hi) { return f2bf(lo) | (f2bf(hi) << 16); }
__device__ __forceinline__ float bflo(unsigned w) { return __builtin_bit_cast(float, w << 16); }
__device__ __forceinline__ float bfhi(unsigned w) { return __builtin_bit_cast(float, w & 0xffff0000u); }
__device__ __forceinline__ float bf2f(bf16 b) { return __builtin_bit_cast(float, (unsigned)b << 16); }
__device__ __forceinline__ unsigned cvt_pk_bf16(float lo, float hi) { unsigned r; asm volatile("v_cvt_pk_bf16_f32 %0, %1, %2" : "=v"(r) : "v"(lo), "v"(hi)); return r; }
__device__ __forceinline__ float fast_exp(float x) { return __builtin_amdgcn_exp2f(x * 1.44269504089f); }
__device__ __forceinline__ float sigmoid_f(float x) { return __builtin_amdgcn_rcpf(1.0f + fast_exp(-x)); }
__device__ __forceinline__ float silu_f(float x) { return x * sigmoid_f(x); }
__device__ __forceinline__ float gelu_tanh_f(float x) { const float u = 0.7978845608028654f * (x + 0.044715f * x * x * x); return x * sigmoid_f(2.0f * u); }
__device__ __forceinline__ float wave_sum(float v) {
#pragma unroll
    for (int o = 1; o < 64; o <<= 1) v += __shfl_xor(v, o);
    return v;
}

namespace pg8 {
constexpr int BM = 256, BK = 64, HALF = 128, HTB = HALF * BK * 2  , STAGE_BYTES = 8 * HTB, NXCD = 8, WGM = 8;
__host__ __device__ __forceinline__ int lds_byte(int r, int c) { const int st = (r >> 4) * 2 + (c >> 5), rr = r & 15, cc = c & 31, ob = rr * 64 + cc * 2; return st * 1024 + (ob ^ (((ob >> 9) & 1) << 5)); }
__host__ __device__ __forceinline__ void stage_rc(int b, int& R, int& C) { const int st = b / 1024, sb = b % 1024, swz = sb ^ (((sb >> 9) & 1) << 5); R = (st >> 1) * 16 + swz / 64; C = (st & 1) * 32 + (swz % 64) / 2; }
__host__ __device__ __forceinline__ int perm32(int rho) { const int n = rho >> 4, i = rho & 15; return 8 * (i >> 2) + 4 * n + (i & 3); }

struct Unit { int pm, pn; };
struct Gemm { int K, lda; };

struct OrderBase {
    int nM, nN, nwg, G, c;
    __device__ __forceinline__ void init_order(int nM_, int nN_, int G_, int c_) { nM = nM_; nN = nN_; nwg = nM * nN; G = G_; c = c_; }
    __device__ __forceinline__ bool next(int i, Unit& u) const {
        const long L = (long)i * G + c; if (L >= nwg) return false;
        int wgid = (int)L; { const int q = nwg / NXCD, r = nwg % NXCD, xcd = wgid % NXCD, off = wgid / NXCD; wgid = (xcd < r ? xcd * (q + 1) : r * (q + 1) + (xcd - r) * q) + off; }
        const int nig = WGM * nN, gid = wgid / nig, fm = gid * WGM, gsz = (nM - fm) < WGM ? (nM - fm) : WGM;
        u.pm = fm + ((wgid % nig) % gsz); u.pn = (wgid % nig) / gsz; return true;
    }
};
struct DenseOrder : OrderBase {
    const char* A; const char* Bt; size_t a_tile, b_tile;
    __device__ __forceinline__ void init(const bf16* A_, int lda, const bf16* Bt_, int K, int nM_, int nN_, int G_, int c_) { A = (const char*)A_; Bt = (const char*)Bt_; a_tile = (size_t)BM * lda * 2; b_tile = (size_t)BM * K * 2; init_order(nM_, nN_, G_, c_); }
    __device__ __forceinline__ const char* a_base(const Unit& u) const { return A + (size_t)u.pm * a_tile; }
    __device__ __forceinline__ const char* b_base(const Unit& u) const { return Bt + (size_t)u.pn * b_tile; }
};
struct GatesOrder : DenseOrder {
    __device__ __forceinline__ const char* a_base(const Unit& u) const { return A + (size_t)u.pm * a_tile + (size_t)(u.pn >> 1) * 512; }
};
struct MoeOrder : DenseOrder {
    int pe[8]; size_t e_bytes;
    __device__ __forceinline__ const char* b_base(const Unit& u) const {
        int e = 0;
#pragma unroll
        for (int j = 0; j < 7; ++j) e += (u.pm >= pe[j]) ? 1 : 0;
        return Bt + (size_t)e * e_bytes + (size_t)u.pn * b_tile;
    }
};

template <class Epi, class Sched, bool ALIGN_EPI = true>
__device__ __forceinline__ void gemm_phase(LAS unsigned char* lds, const int tid, const Gemm g, const Sched& S, const Epi& E) {
    const int wid = __builtin_amdgcn_readfirstlane(tid >> 6), lane = tid & 63, wr = wid >> 2, wc = wid & 3, fr = lane & 15, fq = lane >> 4;
    const int K = g.K, nt = K / BK;
    unsigned voffA[2], voffB[2];
#pragma unroll
    for (int i = 0; i < 2; ++i) { int R, C; stage_rc(tid * 16 + i * 8192, R, C); const int Rb = Epi::PERM ? ((R & ~31) + perm32(R & 31)) : R;
        voffA[i] = (unsigned)(R * g.lda + C) * 2u; voffB[i] = (unsigned)(Rb * K + C) * 2u; }
    const size_t kstep = (size_t)(BK * 2);
    const size_t hstepA = (size_t)HALF * g.lda * 2, hstepB = (size_t)HALF * K * 2;
    const unsigned ldsw = (unsigned)wid * 1024u;
    const int aoff = lds_byte(wr * 64 + fr, fq * 8), boff = lds_byte(wc * 32 + fr, fq * 8);
#define PG8_SA(b, h) (((b) * 2 + (h)) * HTB)
#define PG8_SB(b, h) ((4 + (b) * 2 + (h)) * HTB)
#define PG8_STAGE(bufoff, gbase, voff) do { _Pragma("unroll") for (int _i = 0; _i < 2; ++_i) \
        __builtin_amdgcn_global_load_lds((const unsigned*)((const char*)(gbase) + (voff)[_i]), (LAS unsigned*)(lds + (bufoff) + ldsw + _i * 8192), 16, 0, 0); } while (0)
#define PG8_LDA(dst, b, h) do { _Pragma("unroll") for (int m = 0; m < 4; ++m) _Pragma("unroll") for (int k = 0; k < 2; ++k) dst[m][k] = *(const LAS bf16x8*)(lds + PG8_SA(b, h) + aoff + m * 2048 + k * 1024); } while (0)
#define PG8_LDB(dst, b, h) do { _Pragma("unroll") for (int n = 0; n < 2; ++n) _Pragma("unroll") for (int k = 0; k < 2; ++k) dst[n][k] = *(const LAS bf16x8*)(lds + PG8_SB(b, h) + boff + n * 2048 + k * 1024); } while (0)
#define PG8_MMA(ai, bj, At, Bt) do { __builtin_amdgcn_s_setprio(1); _Pragma("unroll") for (int m = 0; m < 4; ++m) _Pragma("unroll") for (int n = 0; n < 2; ++n) _Pragma("unroll") for (int k = 0; k < 2; ++k) \
        acc[ai][bj][m][n] = __builtin_amdgcn_mfma_f32_16x16x32_bf16(Bt[n][k], At[m][k], acc[ai][bj][m][n], 0, 0, 0); __builtin_amdgcn_s_setprio(0); } while (0)
#define PG8_WAIT_V(n) asm volatile("s_waitcnt vmcnt(" #n ")" ::: "memory")
#define PG8_WAIT_L(n) asm volatile("s_waitcnt lgkmcnt(" #n ")" ::: "memory")
#define PG8_BAR __builtin_amdgcn_s_barrier()
#define PG8_SCHED __builtin_amdgcn_sched_barrier(0)
    Unit cur, nxt; int ui = 0;
    if (!S.next(0, cur)) return;
    f32x4 acc[2][2][4][2];
#pragma unroll
    for (int a = 0; a < 2; ++a)
#pragma unroll
        for (int b = 0; b < 2; ++b)
#pragma unroll
            for (int m = 0; m < 4; ++m)
#pragma unroll
                for (int n = 0; n < 2; ++n) acc[a][b][m][n] = (f32x4){0.f, 0.f, 0.f, 0.f};
    bf16x8 At[4][2], B0[2][2], B1[2][2];
    const char* cA = S.a_base(cur); const char* cB = S.b_base(cur);
    PG8_STAGE(PG8_SB(0, 0), cB, voffB); PG8_STAGE(PG8_SB(0, 1), cB + hstepB, voffB); PG8_STAGE(PG8_SA(0, 0), cA, voffA); PG8_STAGE(PG8_SA(0, 1), cA + hstepA, voffA);
    if (wr == 1) PG8_BAR;
    PG8_WAIT_V(2); PG8_BAR;
    PG8_STAGE(PG8_SB(1, 0), cB + kstep, voffB); PG8_STAGE(PG8_SA(1, 0), cA + kstep, voffA); PG8_STAGE(PG8_SB(1, 1), cB + hstepB + kstep, voffB);
    PG8_WAIT_V(6); PG8_BAR;
    for (;;) {
        const bool has_next = S.next(ui + 1, nxt);
        const char* nA = has_next ? S.a_base(nxt) : cA; const char* nB = has_next ? S.b_base(nxt) : cB;
#pragma nounroll
        for (int t = 0; t < nt; t += 2) {
            const bool last = (t == nt - 2);
            const char* a1 = cA + (size_t)(t + 1) * kstep;
            const char* a2 = last ? nA : cA + (size_t)(t + 2) * kstep; const char* b2 = last ? nB : cB + (size_t)(t + 2) * kstep;
            const char* a3 = a2 + kstep; const char* b3 = b2 + kstep;
            PG8_LDB(B0, 0, 0); PG8_LDB(B1, 0, 1); PG8_SCHED; PG8_LDA(At, 0, 0); PG8_STAGE(PG8_SA(1, 1), a1 + hstepA, voffA);
            PG8_WAIT_V(8); PG8_WAIT_L(0); PG8_BAR; PG8_MMA(0, 0, At, B0); PG8_MMA(0, 1, At, B1); PG8_BAR; PG8_SCHED;
            PG8_LDA(At, 0, 1); PG8_STAGE(PG8_SB(0, 0), b2, voffB); PG8_STAGE(PG8_SB(0, 1), b2 + hstepB, voffB); PG8_STAGE(PG8_SA(0, 0), a2, voffA);
            PG8_WAIT_V(8); PG8_WAIT_L(0); PG8_BAR; PG8_MMA(1, 0, At, B0); PG8_MMA(1, 1, At, B1); PG8_BAR; PG8_SCHED;
            PG8_LDB(B0, 1, 0); PG8_LDB(B1, 1, 1); PG8_SCHED; PG8_LDA(At, 1, 0); PG8_STAGE(PG8_SA(0, 1), a2 + hstepA, voffA);
            PG8_WAIT_V(8); PG8_WAIT_L(0); PG8_BAR; PG8_MMA(0, 0, At, B0); PG8_MMA(0, 1, At, B1); PG8_BAR; PG8_SCHED;
            PG8_LDA(At, 1, 1); PG8_STAGE(PG8_SB(1, 0), b3, voffB); PG8_STAGE(PG8_SB(1, 1), b3 + hstepB, voffB); PG8_STAGE(PG8_SA(1, 0), a3, voffA);
            PG8_WAIT_V(8); PG8_WAIT_L(0); PG8_BAR; PG8_MMA(1, 0, At, B0); PG8_MMA(1, 1, At, B1); PG8_BAR; PG8_SCHED;
        }
        if constexpr (ALIGN_EPI) { if (wr == 0) PG8_BAR; }
        E(acc, cur, wr, wc, fr, fq);
        if (!has_next) break;
#pragma unroll
        for (int a = 0; a < 2; ++a)
#pragma unroll
            for (int b = 0; b < 2; ++b)
#pragma unroll
                for (int m = 0; m < 4; ++m)
#pragma unroll
                    for (int n = 0; n < 2; ++n) acc[a][b][m][n] = (f32x4){0.f, 0.f, 0.f, 0.f};
        cur = nxt; cA = nA; cB = nB; ++ui;
        if constexpr (ALIGN_EPI) { if (wr == 1) PG8_BAR; }
    }
    PG8_WAIT_V(0);
    if constexpr (!ALIGN_EPI) { if (wr == 0) PG8_BAR; }
    PG8_BAR;
#undef PG8_SA
#undef PG8_SB
#undef PG8_STAGE
#undef PG8_LDA
#undef PG8_LDB
#undef PG8_MMA
#undef PG8_WAIT_V
#undef PG8_WAIT_L
#undef PG8_BAR
#undef PG8_SCHED
}
}
#define XB_TMO      128
#define XB_XCNT(j)  (256  + 64 * (j))
#define XB_XSUB(j)  (1280 + 64 * (j))
#define XB_XGEN(j)  (2304 + 64 * (j))
#define XB_TOP      3328
#define XB_TOPGEN   3392
#define XCD_BAR_WORDS 3456
#define XB_SPIN_CAP (1u << 18)

__device__ __forceinline__ unsigned xb_ld(unsigned* p)              { return __hip_atomic_load(p, __ATOMIC_RELAXED, __HIP_MEMORY_SCOPE_AGENT); }
__device__ __forceinline__ unsigned xb_add(unsigned* p, unsigned v) { return __hip_atomic_fetch_add(p, v, __ATOMIC_RELAXED, __HIP_MEMORY_SCOPE_AGENT); }
__device__ __forceinline__ unsigned xb_xcc_id() { return (unsigned)__builtin_amdgcn_s_getreg((3 << 11) | 20) & 0xFu; }
#define XB_SPIN(cond, bar) do { unsigned _sp = 0; while (cond) { __builtin_amdgcn_s_sleep(1); \
    if ((++_sp & 255u) == 0u) { if (xb_ld(&(bar)[XB_TMO])) break; if (_sp > XB_SPIN_CAP) { atomicAdd(&(bar)[XB_TMO], 1u); break; } } } } while (0)

struct XcdBarrier {
    unsigned* bar; unsigned x;
    volatile LAS unsigned* st;
};

__device__ __forceinline__ XcdBarrier xcd_barrier_post(unsigned* bar, volatile LAS unsigned* st) {
    XcdBarrier b; b.bar = bar; b.x = xb_xcc_id(); b.st = st;
    if (threadIdx.x == 0) (void)xb_add(&bar[XB_XCNT(b.x)], 1u);
    return b;
}
__device__ __forceinline__ void xcd_barrier_complete(unsigned* bar, unsigned x, unsigned& nloc, unsigned& nx) {
    const unsigned G = gridDim.x * gridDim.y * gridDim.z;
    unsigned sum, cnt, mine, sp = 0u;
    for (;;) {
        sum = 0u; cnt = 0u; mine = 0u;
#pragma unroll
        for (unsigned j = 0; j < 16; ++j) { const unsigned c = xb_ld(&bar[XB_XCNT(j)]); sum += c; cnt += (c > 0u) ? 1u : 0u; mine = (j == x) ? c : mine; }
        if (sum == G) break;
        __builtin_amdgcn_s_sleep(1);
        if ((++sp & 255u) == 0u) { if (xb_ld(&bar[XB_TMO])) break; if (sp > XB_SPIN_CAP) { atomicAdd(&bar[XB_TMO], 1u); break; } }
    }
    nloc = mine > 0u ? mine : 1u; nx = cnt > 0u ? cnt : 1u;
}

__device__ __forceinline__ void xcd_barrier(const XcdBarrier& b) {
    asm volatile("s_waitcnt vmcnt(0)" ::: "memory");
    __syncthreads();
    if (threadIdx.x == 0) {
        unsigned* bar = b.bar;
        __builtin_amdgcn_s_waitcnt(0);
        unsigned nloc = b.st[0], nx = b.st[1];
        if (nloc == 0u) { xcd_barrier_complete(bar, b.x, nloc, nx); b.st[0] = nloc; b.st[1] = nx; }
        const unsigned old = xb_add(&bar[XB_XSUB(b.x)], 1u);
        const unsigned gen = old / nloc;
        if (old + 1u == (gen + 1u) * nloc) {
            __builtin_amdgcn_fence(__ATOMIC_RELEASE, "agent");
            asm volatile("s_waitcnt vmcnt(0)" ::: "memory");
            const unsigned og = xb_add(&bar[XB_TOP], 1u);
            const unsigned tg = og / nx;
            if (og + 1u == (tg + 1u) * nx) xb_add(&bar[XB_TOPGEN], 1u);
            else XB_SPIN(xb_ld(&bar[XB_TOPGEN]) == tg, bar);
            __builtin_amdgcn_fence(__ATOMIC_ACQUIRE, "agent");
            xb_add(&bar[XB_XGEN(b.x)], 1u);
            asm volatile("s_waitcnt vmcnt(0)" ::: "memory");
        } else {
            XB_SPIN(xb_ld(&bar[XB_XGEN(b.x)]) == gen, bar);
            __builtin_amdgcn_fence(__ATOMIC_ACQUIRE, "agent");
            asm volatile("s_waitcnt vmcnt(0)" ::: "memory");
        }
    }
    __syncthreads();
}

constexpr int NWAVES = 8, NTHR = 512;
constexpr int D = 1024, BATCH = 2, SEQ = 16384, NMETA = 16;
constexpr int MMAIN = BATCH * SEQ;
constexpr int MROWS = MMAIN + NMETA;
constexpr int MPAD = MMAIN + 256;
constexpr int RGW = 1344, RGBW = 168, NRG = 2816  , KRGO = 1408  , NGT = 4096, KGT = 256, XCW = 2048;
constexpr int FF = 3584, NE = 8, NFF2 = 2 * FF;
constexpr int GH = 4, GDK = 128, GDV = 256, GQK = 512, GVD = 1024, NGLA = 3072, GLAW = 3088, GRANK = 16;
constexpr int MSORT = 265 * 256;
constexpr float LN_EPS = 1e-5f, ALPHA = 1.6817928305074290f;
constexpr int SEG = 128, NSEG_B = SEQ / SEG, NSEG = 1 + BATCH * NSEG_B;
constexpr int CPS = 4, NSC_BH = SEQ / (64 * CPS), NGU = BATCH * GH * NSC_BH + GH;

constexpr size_t MiB = 1u << 20;
constexpr size_t WS_CTL = 0, CTL_ZERO_BYTES = 1 * MiB;
constexpr size_t WL_RGIN = 0, WL_GATES = WL_RGIN + (size_t)NRG * D * 2, WL_RGOUT = WL_GATES + (size_t)NGT * KGT * 2, WL_GLAIN = WL_RGOUT + (size_t)D * KRGO * 2,
                 WL_GLAOUT = WL_GLAIN + (size_t)NGLA * D * 2, WL_FFNIN = WL_GLAOUT + (size_t)D * D * 2, WL_FFNOUT = WL_FFNIN + (size_t)NFF2 * D * 2,
                 WL_MOEIN = WL_FFNOUT + (size_t)D * FF * 2, WL_MOEOUT = WL_MOEIN + (size_t)NE * NFF2 * D * 2, WL_STRIDE = WL_MOEOUT + (size_t)NE * D * FF * 2;
constexpr size_t WS_W = 1 * MiB;
constexpr size_t WS_H = WS_W + 2 * WL_STRIDE;
constexpr size_t WS_HB = WS_H + (size_t)MPAD * D * 4;
constexpr size_t WS_MIX = WS_HB + (size_t)MPAD * D * 2;
constexpr size_t WS_Z = WS_MIX + (size_t)MPAD * D * 4;
constexpr size_t WS_RT = WS_Z + 3 * MiB;
constexpr size_t WS_AGG = WS_RT + 1 * MiB;
constexpr size_t WS_S0 = WS_AGG + 3 * MiB;
constexpr size_t S_PROJ = 0, S_XC = S_PROJ + (size_t)MPAD * NRG * 2, S_LOGA = S_XC + (size_t)MPAD * XCW * 2, S_U = S_LOGA + (size_t)MPAD * RGW * 4, S_Y = S_U + (size_t)MPAD * RGW * 4, S_RG_END = S_Y + (size_t)MPAD * KRGO * 2;
constexpr size_t S_HID = 0;
constexpr size_t S_QKVR = 0, S_KVS = S_QKVR + (size_t)MPAD * NGLA * 2, S_SST = S_KVS + (size_t)NGU * GDK * GDV * 4, S_O = S_SST + (size_t)NGU * GDK * GDV * 4, S_DEC = S_O + (size_t)MPAD * D * 2, S_GLA_END = S_DEC + 1 * MiB;
constexpr size_t S_AS = 0, S_HS = S_AS + (size_t)MSORT * D * 2, S_YS = S_HS + (size_t)MSORT * FF * 2, S_MOE_END = S_YS + (size_t)MSORT * D * 4;
constexpr size_t S_MAX = S_RG_END > S_MOE_END ? (S_RG_END > S_GLA_END ? S_RG_END : S_GLA_END) : (S_MOE_END > S_GLA_END ? S_MOE_END : S_GLA_END);
constexpr size_t WS_END = WS_S0 + S_MAX;
constexpr int CW_TMO = 0, CW_BAR = 4096, CW_MOE = 8192;

constexpr int LDS_BYTES = 163840, MISC_OFF = LDS_BYTES - 64;

struct Frame {
    LAS unsigned char* lds; gu32* ctl; unsigned char* ws;
    int tid, lane, wave, G, bx;
    __device__ __forceinline__ void fresh() { asm volatile("" : "+v"(tid)); asm volatile("" : "+s"(bx)); asm volatile("" : "+s"(ws)); lane = tid & 63; wave = __builtin_amdgcn_readfirstlane(tid >> 6); ctl = (gu32*)(ws + WS_CTL); }
};
struct Args { const float* in[21]; float* out; unsigned char* ws; int ph_lo, ph_hi; unsigned submask; int pad; };

struct EpiBf16Gelu {
    static constexpr bool PERM = true, PAIR = false;
    bf16* O; int ldc, gelu_cols;
    __device__ __forceinline__ void operator()(const f32x4 (&acc)[2][2][4][2], const pg8::Unit& u, int wr, int wc, int fr, int fq) const {
        const int row0 = u.pm * 256 + wr * 64 + fr, col0 = u.pn * 256 + wc * 32 + 8 * fq;
#pragma unroll
        for (int ai = 0; ai < 2; ++ai)
#pragma unroll
            for (int m = 0; m < 4; ++m) { bf16* rowp = O + (size_t)(row0 + ai * 128 + m * 16) * ldc + col0;
#pragma unroll
                for (int bj = 0; bj < 2; ++bj) { f32x4 v0 = acc[ai][bj][m][0], v1 = acc[ai][bj][m][1];
                    if (col0 + bj * 128 < gelu_cols) {
#pragma unroll
                        for (int j = 0; j < 4; ++j) { v0[j] = gelu_tanh_f(v0[j]); v1[j] = gelu_tanh_f(v1[j]); } }
                    v4u w; w.x = cvt_pk_bf16(v0[0], v0[1]); w.y = cvt_pk_bf16(v0[2], v0[3]); w.z = cvt_pk_bf16(v1[0], v1[1]); w.w = cvt_pk_bf16(v1[2], v1[3]);
                    *(v4u*)(rowp + bj * 128) = w; } }
    }
    __device__ __forceinline__ void meta_task(int task, int& r0, int& aoff) const { r0 = task * 16; aoff = 0; }
    __device__ __forceinline__ void meta(int task, f32x4 a0, f32x4, int fr, int fq) const {
        const int col = task * 16 + 4 * fq;
        if (col < gelu_cols) {
#pragma unroll
            for (int j = 0; j < 4; ++j) a0[j] = gelu_tanh_f(a0[j]); }
        v2u w; w.x = cvt_pk_bf16(a0[0], a0[1]); w.y = cvt_pk_bf16(a0[2], a0[3]);
        *(v2u*)(O + (size_t)(MMAIN + fr) * ldc + col) = w;
    }
};
struct EpiSwiglu {
    static constexpr bool PERM = true, PAIR = true;
    bf16* O; int ldc;
    __device__ __forceinline__ void operator()(const f32x4 (&acc)[2][2][4][2], const pg8::Unit& u, int wr, int wc, int fr, int fq) const {
        const int row0 = u.pm * 256 + wr * 64 + fr, col0 = u.pn * 128 + wc * 32 + 8 * fq;
#pragma unroll
        for (int ai = 0; ai < 2; ++ai)
#pragma unroll
            for (int m = 0; m < 4; ++m) { bf16* rowp = O + (size_t)(row0 + ai * 128 + m * 16) * ldc + col0;
                f32x4 g0 = acc[ai][0][m][0], g1 = acc[ai][0][m][1]; const f32x4 u0 = acc[ai][1][m][0], u1 = acc[ai][1][m][1];
#pragma unroll
                for (int j = 0; j < 4; ++j) { g0[j] = silu_f(g0[j]) * u0[j]; g1[j] = silu_f(g1[j]) * u1[j]; }
                v4u w; w.x = cvt_pk_bf16(g0[0], g0[1]); w.y = cvt_pk_bf16(g0[2], g0[3]); w.z = cvt_pk_bf16(g1[0], g1[1]); w.w = cvt_pk_bf16(g1[2], g1[3]);
                *(v4u*)rowp = w; }
    }
    __device__ __forceinline__ void meta_task(int task, int& r0, int& aoff) const { r0 = (task >> 3) * 256 + (task & 7) * 16; aoff = 0; }
    __device__ __forceinline__ void meta(int task, f32x4 a0, f32x4 a1, int fr, int fq) const {
        const int col = (task >> 3) * 128 + (task & 7) * 16 + 4 * fq;
#pragma unroll
        for (int j = 0; j < 4; ++j) a0[j] = silu_f(a0[j]) * a1[j];
        v2u w; w.x = cvt_pk_bf16(a0[0], a0[1]); w.y = cvt_pk_bf16(a0[2], a0[3]);
        *(v2u*)(O + (size_t)(MMAIN + fr) * ldc + col) = w;
    }
};
struct EpiF32 {
    static constexpr bool PERM = false, PAIR = false;
    float* C; int ldc;
    __device__ __forceinline__ void operator()(const f32x4 (&acc)[2][2][4][2], const pg8::Unit& u, int wr, int wc, int fr, int fq) const {
        const int row0 = u.pm * 256 + wr * 64 + fr, col0 = u.pn * 256 + wc * 32 + 4 * fq;
#pragma unroll
        for (int ai = 0; ai < 2; ++ai)
#pragma unroll
            for (int m = 0; m < 4; ++m) { float* rowp = C + (size_t)(row0 + ai * 128 + m * 16) * ldc + col0;
#pragma unroll
                for (int bj = 0; bj < 2; ++bj)
#pragma unroll
                    for (int n = 0; n < 2; ++n) *(f32x4*)(rowp + bj * 128 + n * 16) = acc[ai][bj][m][n]; }
    }
    __device__ __forceinline__ void meta_task(int task, int& r0, int& aoff) const { r0 = task * 16; aoff = 0; }
    __device__ __forceinline__ void meta(int task, f32x4 a0, f32x4, int fr, int fq) const { *(f32x4*)(C + (size_t)(MMAIN + fr) * ldc + task * 16 + 4 * fq) = a0; }
};

template <class Epi>
__device__ __forceinline__ void meta_gemm(Frame& F, const bf16* A16, int lda, int K, const bf16* Bt, int ntasks, const Epi& E) {
    const int fr = F.lane & 15, fq = F.lane >> 4;
    LAS f32x4* red = (LAS f32x4*)F.lds;
    for (int task = F.bx; task < ntasks; task += F.G) {
        int r0, aoff; E.meta_task(task, r0, aoff);
        f32x4 acc0 = (f32x4){0.f, 0.f, 0.f, 0.f}, acc1 = acc0;
        const bf16* ap = A16 + (size_t)fr * lda + aoff + fq * 8; const bf16* bp0 = Bt + (size_t)(r0 + fr) * K + fq * 8; const bf16* bp1 = bp0 + (size_t)128 * K;
        for (int ks = F.wave; ks < K / 32; ks += NWAVES) {
            const bf16x8 a = *(const bf16x8*)(ap + ks * 32); const bf16x8 b0 = *(const bf16x8*)(bp0 + ks * 32);
            acc0 = __builtin_amdgcn_mfma_f32_16x16x32_bf16(b0, a, acc0, 0, 0, 0);
            if (Epi::PAIR) { const bf16x8 b1 = *(const bf16x8*)(bp1 + ks * 32); acc1 = __builtin_amdgcn_mfma_f32_16x16x32_bf16(b1, a, acc1, 0, 0, 0); }
        }
        red[(F.wave * 2 + 0) * 64 + F.lane] = acc0; if (Epi::PAIR) red[(F.wave * 2 + 1) * 64 + F.lane] = acc1;
        __syncthreads();
        if (F.wave == 0) {
            f32x4 s0 = red[F.lane], s1 = Epi::PAIR ? red[64 + F.lane] : acc1;
#pragma unroll
            for (int w = 1; w < NWAVES; ++w) { s0 += red[(w * 2) * 64 + F.lane]; if (Epi::PAIR) s1 += red[(w * 2 + 1) * 64 + F.lane]; }
            E.meta(task, s0, s1, fr, fq);
        }
        __syncthreads();
    }
}

__device__ __forceinline__ void transpose_item(const float* W, int ldw, int Ksrc, int c0, int nvalid, bf16* WT, int Kdst, int n0, int k0, LAS float* scr, int lane) {
#pragma unroll 8
    for (int i = 0; i < 32; ++i) { const int kk = 2 * i + (lane >> 5), c = lane & 31;
        const bool ok = (k0 + kk < Ksrc) && (c < nvalid); const float v = W[ok ? (size_t)(k0 + kk) * ldw + c0 + c : (size_t)0];
        scr[kk * 33 + c] = ok ? v : 0.f; }
    LDS_WAIT(); asm volatile("" ::: "memory");
    const int c = lane & 7;
#pragma unroll
    for (int j = 0; j < 4; ++j) { const int n = (lane >> 3) + 8 * j; const LAS float* s = scr + (8 * c) * 33 + n;
        v4u o; o.x = pk2(s[0 * 33], s[1 * 33]); o.y = pk2(s[2 * 33], s[3 * 33]); o.z = pk2(s[4 * 33], s[5 * 33]); o.w = pk2(s[6 * 33], s[7 * 33]);
        *(v4u*)(WT + (size_t)(n0 + n) * Kdst + k0 + 8 * c) = o; }
    LDS_WAIT(); asm volatile("" ::: "memory");
}
__device__ __forceinline__ void map_id(int n0, int nsrc, int& c0, int& nv) { c0 = n0; nv = nsrc - n0; nv = nv < 0 ? 0 : (nv > 32 ? 32 : nv); if (nv == 0) c0 = 0; }
__device__ __forceinline__ void map_swiglu(int n0, int& c0, int& nv) { const int tile = n0 >> 8, rr = n0 & 255; c0 = rr < 128 ? tile * 128 + rr : FF + tile * 128 + rr - 128; nv = 32; }

__device__ __forceinline__ void p0_prologue(Frame& F, const Args& a) {
    LAS float* scr = (LAS float*)(F.lds + F.wave * 16384);
    const int gw = F.bx * NWAVES + F.wave, NGW = F.G * NWAVES;
    constexpr int I_RGIN = (D / 64) * (NRG / 32), I_GATES = (KGT / 64) * (NGT / 32), I_RGOUT = (KRGO / 64) * (D / 32), I_GLAIN = (D / 64) * (NGLA / 32), I_GLAOUT = (D / 64) * (D / 32),
                  I_FFNIN = (D / 64) * (NFF2 / 32), I_FFNOUT = (FF / 64) * (D / 32), I_MOEIN = NE * I_FFNIN, I_MOEOUT = NE * I_FFNOUT;
    constexpr int I_PER_J = I_RGIN + I_GATES + I_RGOUT + I_GLAIN + I_GLAOUT + I_FFNIN + I_FFNOUT + I_MOEIN + I_MOEOUT;
    for (int it = gw; it < 2 * I_PER_J; it += NGW) {
        const int j = it / I_PER_J; int r = it - j * I_PER_J;
        unsigned char* wl = F.ws + WS_W + (size_t)j * WL_STRIDE;
        int c0, nv;
        if (r < I_RGIN) { const int nb = r % (NRG / 32), kb = r / (NRG / 32); map_id(nb * 32, 2 * RGW, c0, nv);
            transpose_item(a.in[4] + (size_t)j * D * 2 * RGW, 2 * RGW, D, c0, nv, (bf16*)(wl + WL_RGIN), D, nb * 32, kb * 64, scr, F.lane); continue; } r -= I_RGIN;
        if (r < I_GATES) { const int nb = r % (NGT / 32), kb = r / (NGT / 32); const int n0 = nb * 32, pn = n0 >> 8, rr = n0 & 255, g = rr >> 7, cc = rr & 127, d0 = (pn & 1) * 128 + cc, blk = pn >> 1;
            nv = RGBW - d0; nv = nv < 0 ? 0 : (nv > 32 ? 32 : nv); c0 = nv ? d0 : 0;
            transpose_item(a.in[7] + ((size_t)(j * 2 + g) * 8 + blk) * RGBW * RGBW, RGBW, RGBW, c0, nv, (bf16*)(wl + WL_GATES), KGT, n0, kb * 64, scr, F.lane); continue; } r -= I_GATES;
        if (r < I_RGOUT) { const int nb = r % (D / 32), kb = r / (D / 32);
            transpose_item(a.in[10] + (size_t)j * RGW * D, D, RGW, nb * 32, 32, (bf16*)(wl + WL_RGOUT), KRGO, nb * 32, kb * 64, scr, F.lane); continue; } r -= I_RGOUT;
        if (r < I_GLAIN) { const int nb = r % (NGLA / 32), kb = r / (NGLA / 32);
            transpose_item(a.in[11] + (size_t)j * D * GLAW, GLAW, D, nb * 32, 32, (bf16*)(wl + WL_GLAIN), D, nb * 32, kb * 64, scr, F.lane); continue; } r -= I_GLAIN;
        if (r < I_GLAOUT) { const int nb = r % (D / 32), kb = r / (D / 32);
            transpose_item(a.in[15] + (size_t)j * D * D, D, D, nb * 32, 32, (bf16*)(wl + WL_GLAOUT), D, nb * 32, kb * 64, scr, F.lane); continue; } r -= I_GLAOUT;
        if (r < I_FFNIN) { const int nb = r % (NFF2 / 32), kb = r / (NFF2 / 32); map_swiglu(nb * 32, c0, nv);
            transpose_item(a.in[16] + (size_t)j * D * NFF2, NFF2, D, c0, nv, (bf16*)(wl + WL_FFNIN), D, nb * 32, kb * 64, scr, F.lane); continue; } r -= I_FFNIN;
        if (r < I_FFNOUT) { const int nb = r % (D / 32), kb = r / (D / 32);
            transpose_item(a.in[17] + (size_t)j * FF * D, D, FF, nb * 32, 32, (bf16*)(wl + WL_FFNOUT), FF, nb * 32, kb * 64, scr, F.lane); continue; } r -= I_FFNOUT;
        if (r < I_MOEIN) { const int e = r / I_FFNIN, r2 = r % I_FFNIN; const int nb = r2 % (NFF2 / 32), kb = r2 / (NFF2 / 32); map_swiglu(nb * 32, c0, nv);
            transpose_item(a.in[19] + ((size_t)j * NE + e) * D * NFF2, NFF2, D, c0, nv, (bf16*)(wl + WL_MOEIN) + (size_t)e * NFF2 * D, D, nb * 32, kb * 64, scr, F.lane); continue; } r -= I_MOEIN;
        { const int e = r / I_FFNOUT, r2 = r % I_FFNOUT; const int nb = r2 % (D / 32), kb = r2 / (D / 32);
            transpose_item(a.in[20] + ((size_t)j * NE + e) * FF * D, D, FF, nb * 32, 32, (bf16*)(wl + WL_MOEOUT) + (size_t)e * D * FF, FF, nb * 32, kb * 64, scr, F.lane); }
    }
    bf16* HB = (bf16*)(F.ws + WS_HB);
    for (int m = gw; m < MROWS; m += NGW) {
        const float* src = m < MMAIN ? a.in[0] + (size_t)m * D : a.in[1] + (size_t)(m - MMAIN) * D;
#pragma unroll
        for (int q = 0; q < 4; ++q) { const f32x4 v = *(const f32x4*)(src + 4 * F.lane + 256 * q);
            v2u w; w.x = pk2(v[0], v[1]); w.y = pk2(v[2], v[3]); *(v2u*)(HB + (size_t)m * D + 4 * F.lane + 256 * q) = w; }
    }
}

struct LnRow { v4u h[2], a[2], b[2]; float w1, w2; };
__device__ __forceinline__ void unpack8(const v4u& w, float* o) { o[0] = bflo(w.x); o[1] = bfhi(w.x); o[2] = bflo(w.y); o[3] = bfhi(w.y); o[4] = bflo(w.z); o[5] = bfhi(w.z); o[6] = bflo(w.w); o[7] = bfhi(w.w); }
__device__ __forceinline__ void ln_phase(Frame& F, int mixkind, const float* gam, const float* bet, int extra, const float* Wx, int ldx, float* outp, gu32* moe_cnt) {
    bf16* HB = (bf16*)(F.ws + WS_HB); const bf16* MIX = (const bf16*)(F.ws + WS_MIX);
    const bf16* YS = (const bf16*)(F.ws + WS_S0 + S_YS);
    int* E1 = (int*)(F.ws + WS_RT); int* E2 = E1 + MROWS; float* W1 = (float*)(E2 + MROWS); float* W2 = W1 + MROWS; int* POS1 = (int*)(W2 + MROWS); int* POS2 = POS1 + MROWS;
    float* Z = (float*)(F.ws + WS_Z);
    LAS float* WL = (LAS float*)F.lds;
    LAS unsigned* lcnt = (LAS unsigned*)(F.lds + 65536);
    const int NC = extra == 1 ? 16 : (extra == 2 ? 8 : 0);
    if (extra) { for (int i = F.tid; i < NC * D; i += NTHR) { const int e = i / D, c = i % D; WL[e * D + c] = Wx[(size_t)c * ldx + e]; }
        if (F.tid < 8) lcnt[F.tid] = 0u;
        __syncthreads(); }
    const int gw = F.bx * NWAVES + F.wave, NGW = F.G * NWAVES, lane = F.lane;
    float gv[16], bv[16];
#pragma unroll
    for (int q = 0; q < 2; ++q)
#pragma unroll
        for (int t = 0; t < 2; ++t) { const f32x4 g4 = *(const f32x4*)(gam + 512 * q + 8 * lane + 4 * t), b4 = *(const f32x4*)(bet + 512 * q + 8 * lane + 4 * t);
#pragma unroll
            for (int k = 0; k < 4; ++k) { gv[8 * q + 4 * t + k] = g4[k]; bv[8 * q + 4 * t + k] = b4[k]; } }
    unsigned mycnt = 0u;
    auto ln_load = [&](LnRow (&R)[2], int m0) {
#pragma unroll
        for (int r = 0; r < 2; ++r) { const int m = m0 + r * NGW; if (m < MROWS) {
            const bf16* hp = HB + (size_t)m * D + 8 * lane; R[r].h[0] = *(const v4u*)hp; R[r].h[1] = *(const v4u*)(hp + 512);
            if (mixkind == 1) { const bf16* mp = MIX + (size_t)m * D + 8 * lane; R[r].a[0] = *(const v4u*)mp; R[r].a[1] = *(const v4u*)(mp + 512); }
            if (mixkind == 2) { R[r].w1 = W1[m]; R[r].w2 = W2[m]; const bf16* y1 = YS + (size_t)POS1[m] * D + 8 * lane; const bf16* y2 = YS + (size_t)POS2[m] * D + 8 * lane;
                R[r].a[0] = *(const v4u*)y1; R[r].a[1] = *(const v4u*)(y1 + 512); R[r].b[0] = *(const v4u*)y2; R[r].b[1] = *(const v4u*)(y2 + 512); } } }
    };
    LnRow Rn[2];
    ln_load(Rn, gw);
    for (int m0 = gw; m0 < MROWS; m0 += 2 * NGW) {
        LnRow R[2];
#pragma unroll
        for (int r = 0; r < 2; ++r) R[r] = Rn[r];
        ln_load(Rn, m0 + 2 * NGW);
#pragma unroll
        for (int r = 0; r < 2; ++r) { const int m = m0 + r * NGW; if (m < MROWS) {
            float v[16]; unpack8(R[r].h[0], v); unpack8(R[r].h[1], v + 8);
#pragma unroll
            for (int k = 0; k < 16; ++k) v[k] *= ALPHA;
            if (mixkind == 1) { float t[16]; unpack8(R[r].a[0], t); unpack8(R[r].a[1], t + 8);
#pragma unroll
                for (int k = 0; k < 16; ++k) v[k] += t[k]; }
            if (mixkind == 2) { float t[16], u[16]; unpack8(R[r].a[0], t); unpack8(R[r].a[1], t + 8); unpack8(R[r].b[0], u); unpack8(R[r].b[1], u + 8);
#pragma unroll
                for (int k = 0; k < 16; ++k) v[k] += t[k] * R[r].w1 + u[k] * R[r].w2; }
            float s = 0.f;
#pragma unroll
            for (int k = 0; k < 16; ++k) s += v[k];
            const float mean = wave_sum(s) * (1.f / D); float s2 = 0.f;
#pragma unroll
            for (int k = 0; k < 16; ++k) { v[k] -= mean; s2 += v[k] * v[k]; }
            const float rstd = 1.f / sqrtf(wave_sum(s2) * (1.f / D) + LN_EPS);
#pragma unroll
            for (int k = 0; k < 16; ++k) v[k] = v[k] * rstd * gv[k] + bv[k];
            bf16* op = HB + (size_t)m * D + 8 * lane;
            *(v4u*)op = (v4u){pk2(v[0], v[1]), pk2(v[2], v[3]), pk2(v[4], v[5]), pk2(v[6], v[7])}; *(v4u*)(op + 512) = (v4u){pk2(v[8], v[9]), pk2(v[10], v[11]), pk2(v[12], v[13]), pk2(v[14], v[15])};
            if (outp && m < MMAIN) { float* o = outp + (size_t)m * D + 8 * lane;
                *(f32x4*)o = (f32x4){v[0], v[1], v[2], v[3]}; *(f32x4*)(o + 4) = (f32x4){v[4], v[5], v[6], v[7]}; *(f32x4*)(o + 512) = (f32x4){v[8], v[9], v[10], v[11]}; *(f32x4*)(o + 516) = (f32x4){v[12], v[13], v[14], v[15]}; }
            if (extra) {
                float pp[16];
#pragma unroll
                for (int e = 0; e < 16; ++e) { pp[e] = 0.f; if (e < NC) { float p = 0.f;
#pragma unroll
                        for (int q = 0; q < 2; ++q) { const f32x4 w0 = *(const LAS f32x4*)(WL + e * D + 512 * q + 8 * lane), w1 = *(const LAS f32x4*)(WL + e * D + 512 * q + 8 * lane + 4);
                            p += (v[8 * q + 0] * w0[0] + v[8 * q + 1] * w0[1]) + (v[8 * q + 2] * w0[2] + v[8 * q + 3] * w0[3]) + (v[8 * q + 4] * w1[0] + v[8 * q + 5] * w1[1]) + (v[8 * q + 6] * w1[2] + v[8 * q + 7] * w1[3]); }
                        pp[e] = p; } }
                float lg[8]; float zv;
                if (extra == 1) {
#pragma unroll
                    for (int k = 0; k < 8; ++k) { const bool up = lane & 32; const float snd = up ? pp[k] : pp[k + 8], kp = up ? pp[k + 8] : pp[k]; pp[k] = kp + __shfl_xor(snd, 32); }
#pragma unroll
                    for (int k = 0; k < 4; ++k) { const bool up = lane & 16; const float snd = up ? pp[k] : pp[k + 4], kp = up ? pp[k + 4] : pp[k]; pp[k] = kp + __shfl_xor(snd, 16); }
#pragma unroll
                    for (int k = 0; k < 2; ++k) { const bool up = lane & 8; const float snd = up ? pp[k] : pp[k + 2], kp = up ? pp[k + 2] : pp[k]; pp[k] = kp + __shfl_xor(snd, 8); }
                    { const bool up = lane & 4; const float snd = up ? pp[0] : pp[1], kp = up ? pp[1] : pp[0]; zv = kp + __shfl_xor(snd, 4); }
                    zv += __shfl_xor(zv, 2); zv += __shfl_xor(zv, 1);
                } else {
#pragma unroll
                    for (int k = 0; k < 4; ++k) { const bool up = lane & 32; const float snd = up ? pp[k] : pp[k + 4], kp = up ? pp[k + 4] : pp[k]; pp[k] = kp + __shfl_xor(snd, 32); }
#pragma unroll
                    for (int k = 0; k < 2; ++k) { const bool up = lane & 16; const float snd = up ? pp[k] : pp[k + 2], kp = up ? pp[k + 2] : pp[k]; pp[k] = kp + __shfl_xor(snd, 16); }
                    float rv; { const bool up = lane & 8; const float snd = up ? pp[0] : pp[1], kp = up ? pp[1] : pp[0]; rv = kp + __shfl_xor(snd, 8); }
                    rv += __shfl_xor(rv, 4); rv += __shfl_xor(rv, 2); rv += __shfl_xor(rv, 1);
#pragma unroll
                    for (int e = 0; e < 8; ++e) lg[e] = __int_as_float(__builtin_amdgcn_readlane(__float_as_int(rv), ((e >> 2) & 1) * 32 + ((e >> 1) & 1) * 16 + (e & 1) * 8));
                }
                if (extra == 1) { if ((lane & 3) == 0) Z[(size_t)m * 16 + ((lane >> 5) & 1) * 8 + ((lane >> 4) & 1) * 4 + ((lane >> 3) & 1) * 2 + ((lane >> 2) & 1)] = zv; }
                else { int e1 = 0; float l1 = lg[0];
#pragma unroll
                    for (int e = 1; e < 8; ++e) if (lg[e] > l1) { l1 = lg[e]; e1 = e; }
                    int e2 = -1; float l2 = -3.0e38f;
#pragma unroll
                    for (int e = 0; e < 8; ++e) if (e != e1 && lg[e] > l2) { l2 = lg[e]; e2 = e; }
                    const float w2 = 1.f / (1.f + __expf(l1 - l2)), w1 = 1.f - w2;
                    if (lane == 0) { E1[m] = e1; E2[m] = e2; W1[m] = w1; W2[m] = w2; }
                    mycnt += (lane == e1 || lane == e2) ? 1u : 0u; }
            } } }
    }
    if (extra == 2) { if (lane < 8 && mycnt) __hip_atomic_fetch_add(&lcnt[lane], mycnt, __ATOMIC_RELAXED, __HIP_MEMORY_SCOPE_WORKGROUP);
        __syncthreads();
        if (F.tid < 8 && lcnt[F.tid]) __hip_atomic_fetch_add(moe_cnt + F.tid, lcnt[F.tid], RLX_AGENT); }
}

struct EpiGates {
    static constexpr bool PERM = true, PAIR = true;
    bf16* LOGA; bf16* U; const bf16* XC; const float* bg; const float* lam;
    __device__ __forceinline__ void chan4(int ch, f32x4& br, f32x4& bi, f32x4& c8) const {
        br = *(const f32x4*)(bg + ch); bi = *(const f32x4*)(bg + RGW + ch); const f32x4 lm = *(const f32x4*)(lam + ch);
#pragma unroll
        for (int t = 0; t < 4; ++t) c8[t] = -8.0f * log1pf(__expf(-lm[t]));
    }
    __device__ __forceinline__ void elem4(int row, int blk, int d, f32x4 ra, f32x4 ia, const f32x4& br, const f32x4& bi, const f32x4& c8) const {
        const int ch = blk * RGBW + d;
        const v2u xw = *(const v2u*)(XC + (size_t)row * XCW + blk * 256 + d);
        const float xc[4] = {bflo(xw.x), bfhi(xw.x), bflo(xw.y), bfhi(xw.y)};
        f32x4 la, uu;
#pragma unroll
        for (int t = 0; t < 4; ++t) {
            const float r = sigmoid_f(ra[t] + br[t]), ig = sigmoid_f(ia[t] + bi[t]);
            const float l = c8[t] * r;
            const float a2 = fast_exp(2.0f * l);
            la[t] = l; uu[t] = sqrtf(fmaxf(1.0f - a2, 0.f)) * (ig * xc[t]);
        }
        *(v2u*)(LOGA + (size_t)row * RGW + ch) = (v2u){pk2(la[0], la[1]), pk2(la[2], la[3])}; *(v2u*)(U + (size_t)row * RGW + ch) = (v2u){pk2(uu[0], uu[1]), pk2(uu[2], uu[3])};
    }
    __device__ __forceinline__ void operator()(const f32x4 (&acc)[2][2][4][2], const pg8::Unit& u, int wr, int wc, int fr, int fq) const {
        const int row0 = u.pm * 256 + wr * 64 + fr, blk = u.pn >> 1, d0 = (u.pn & 1) * 128 + wc * 32 + 8 * fq;
#pragma unroll
        for (int n = 0; n < 2; ++n) { const int d = d0 + 4 * n; if (d < RGBW) {
            f32x4 br, bi, c8; chan4(blk * RGBW + d, br, bi, c8);
#pragma unroll
            for (int ai = 0; ai < 2; ++ai)
#pragma unroll
                for (int m = 0; m < 4; ++m) elem4(row0 + ai * 128 + m * 16, blk, d, acc[ai][0][m][n], acc[ai][1][m][n], br, bi, c8); } }
    }
    __device__ __forceinline__ void meta_task(int task, int& r0, int& aoff) const { const int pn = task >> 3; r0 = pn * 256 + (task & 7) * 16; aoff = (pn >> 1) * 256; }
    __device__ __forceinline__ void meta(int task, f32x4 a0, f32x4 a1, int fr, int fq) const {
        const int pn = task >> 3, d = (pn & 1) * 128 + (task & 7) * 16 + 4 * fq;
        if (d < RGBW) { f32x4 br, bi, c8; chan4((pn >> 1) * RGBW + d, br, bi, c8); elem4(MMAIN + fr, pn >> 1, d, a0, a1, br, bi, c8); }
    }
};

__device__ __forceinline__ int conv_src_row(int row, int delta) {
    if (row < MMAIN) { const int t = row & (SEQ - 1); return (t - delta >= 0) ? row - delta : MMAIN + NMETA + (t - delta); }
    const int jm = row - MMAIN; return (jm - delta >= 0) ? row - delta : -1;
}
__device__ __forceinline__ void rg_conv_phase(Frame& F, const float* cw, const float* cb) {
    const bf16* PROJ = (const bf16*)(F.ws + WS_S0 + S_PROJ); bf16* XC = (bf16*)(F.ws + WS_S0 + S_XC);
    const int g = F.tid & 255, blk = g >> 5, kk = (g & 31) * 8, ch = blk * RGBW + kk;
    constexpr int NIT = (MROWS / 4) * 256;
    const int stride = F.G * NTHR;
    if (kk < RGBW) {
        float w[4][8], bb[8];
        { const f32x4 b0 = *(const f32x4*)(cb + ch), b1 = *(const f32x4*)(cb + ch + 4);
#pragma unroll
          for (int k = 0; k < 4; ++k) { bb[k] = b0[k]; bb[4 + k] = b1[k]; } }
#pragma unroll
        for (int tap = 0; tap < 4; ++tap) { const f32x4 w0 = *(const f32x4*)(cw + tap * RGW + ch), w1 = *(const f32x4*)(cw + tap * RGW + ch + 4);
#pragma unroll
            for (int k = 0; k < 4; ++k) { w[tap][k] = w0[k]; w[tap][4 + k] = w1[k]; } }
        for (int idx = F.bx * NTHR + F.tid; idx < NIT; idx += 2 * stride) {
            v4u x[2][7];
#pragma unroll
            for (int it = 0; it < 2; ++it) { const int id2 = idx + it * stride; if (id2 < NIT) { const int r0 = (id2 >> 8) * 4;
#pragma unroll
                for (int t = 0; t < 3; ++t) { const int rr = conv_src_row(r0, 3 - t); x[it][t] = (v4u){0u, 0u, 0u, 0u}; if (rr >= 0) x[it][t] = *(const v4u*)(PROJ + (size_t)rr * NRG + RGW + ch); }
#pragma unroll
                for (int t = 0; t < 4; ++t) x[it][3 + t] = *(const v4u*)(PROJ + (size_t)(r0 + t) * NRG + RGW + ch); } }
#pragma unroll
            for (int it = 0; it < 2; ++it) { const int id2 = idx + it * stride; if (id2 < NIT) { const int r0 = (id2 >> 8) * 4;
                bf16* xo = XC + (size_t)r0 * XCW + blk * 256 + kk;
                float xf[7][8];
#pragma unroll
                for (int t = 0; t < 7; ++t) unpack8(x[it][t], xf[t]);
#pragma unroll
                for (int i = 0; i < 4; ++i) { float a[8];
#pragma unroll
                    for (int k = 0; k < 8; ++k) a[k] = bb[k] + xf[i][k] * w[0][k] + xf[i + 1][k] * w[1][k] + xf[i + 2][k] * w[2][k] + xf[i + 3][k] * w[3][k];
                    *(v4u*)(xo + (size_t)i * XCW) = (v4u){pk2(a[0], a[1]), pk2(a[2], a[3]), pk2(a[4], a[5]), pk2(a[6], a[7])}; } } }
        }
    } else {
        for (int idx = F.bx * NTHR + F.tid; idx < NIT; idx += stride) { bf16* xo = XC + (size_t)((idx >> 8) * 4) * XCW + blk * 256 + kk;
#pragma unroll
            for (int i = 0; i < 4; ++i) *(v4u*)(xo + (size_t)i * XCW) = (v4u){0u, 0u, 0u, 0u}; }
    }
}
template <bool FIX>
__device__ __forceinline__ void rg_scan_phase(Frame& F) {
    const bf16* LOGA = (const bf16*)(F.ws + WS_S0 + S_LOGA); const bf16* U = (const bf16*)(F.ws + WS_S0 + S_U);
    const bf16* PROJ = (const bf16*)(F.ws + WS_S0 + S_PROJ); bf16* Y = (bf16*)(F.ws + WS_S0 + S_Y);
    float* AGGA = (float*)(F.ws + WS_AGG); float* AGGH = AGGA + (size_t)NSEG * RGW;
    const int gw = F.bx * NWAVES + F.wave, NGW = F.G * NWAVES;
    constexpr int NCG = 11, RB = FIX ? 16 : 32;
    for (int task = gw; task < NSEG * NCG; task += NGW) {
        const int seg = task / NCG, cg = task - seg * NCG, ch = cg * 128 + 2 * F.lane;
        const int row0 = seg == 0 ? MMAIN : (seg - 1) * SEG, nrows = seg == 0 ? NMETA : SEG;
        if (ch >= RGW) {
            if (FIX) for (int r = 0; r < nrows; ++r) *(unsigned*)(Y + (size_t)(row0 + r) * KRGO + ch) = 0u;
            continue;
        }
        float h0 = 0.f, h1 = 0.f, c0 = 0.f, c1 = 0.f;
        if (FIX && seg > 0) {
            { const f32x2 hm = *(const f32x2*)(AGGH + ch); h0 = hm[0]; h1 = hm[1]; }
            const int sb = 1 + ((seg - 1) / NSEG_B) * NSEG_B, ns = (seg - 1) % NSEG_B;
            for (int q = 0; q < ns; q += 8) { f32x2 aa[8], hh[8];
#pragma unroll
                for (int t = 0; t < 8; ++t) { const int qq = (q + t < ns) ? q + t : ns - 1; aa[t] = *(const f32x2*)(AGGA + (size_t)(sb + qq) * RGW + ch); hh[t] = *(const f32x2*)(AGGH + (size_t)(sb + qq) * RGW + ch); }
#pragma unroll
                for (int t = 0; t < 8; ++t) if (q + t < ns) { h0 = __expf(aa[t][0]) * h0 + hh[t][0]; h1 = __expf(aa[t][1]) * h1 + hh[t][1]; } }
        }
        for (int r = 0; r < nrows; r += RB) {
            unsigned la[RB], uu[RB], gt[RB];
#pragma unroll
            for (int t = 0; t < RB; ++t) { const int rr = row0 + ((r + t < nrows) ? r + t : nrows - 1); const size_t o = (size_t)rr * RGW + ch; la[t] = *(const unsigned*)(LOGA + o); uu[t] = *(const unsigned*)(U + o); if (FIX) gt[t] = *(const unsigned*)(PROJ + (size_t)rr * NRG + ch); }
#pragma unroll
            for (int t = 0; t < RB; ++t) if (r + t < nrows) { const float l0 = bflo(la[t]), l1 = bfhi(la[t]);
                h0 = __expf(l0) * h0 + bflo(uu[t]); h1 = __expf(l1) * h1 + bfhi(uu[t]); c0 += l0; c1 += l1;
                if (FIX) *(unsigned*)(Y + (size_t)(row0 + r + t) * KRGO + ch) = pk2(h0 * bflo(gt[t]), h1 * bfhi(gt[t])); }
        }
        if (!FIX) { *(f32x2*)(AGGA + (size_t)seg * RGW + ch) = (f32x2){c0, c1}; *(f32x2*)(AGGH + (size_t)seg * RGW + ch) = (f32x2){h0, h1}; }
    }
}

#define RG_PHASES \
        if (IN(pb + 0)) { if (on_rg) { \
            bf16* PROJ = (bf16*)(F.ws + WS_S0 + S_PROJ); EpiBf16Gelu E{PROJ, NRG, RGW}; \
            meta_gemm(F, HB + (size_t)MMAIN * D, D, D, (const bf16*)(wl + WL_RGIN), NRG / 16, E); \
            pg8::Gemm g{D, D}; pg8::DenseOrder S; S.init(HB, D, (const bf16*)(wl + WL_RGIN), D, MMAIN / 256, NRG / 256, F.G, F.bx); \
            pg8::gemm_phase<EpiBf16Gelu, pg8::DenseOrder>(F.lds, F.tid, g, S, E); } \
            SEAM(pb + 0); } \
        if (IN(pb + 1)) { if (on_rg) rg_conv_phase(F, args.in[5] + (size_t)j * 4 * RGW, args.in[6] + (size_t)j * RGW); SEAM(pb + 1); } \
        if (IN(pb + 2)) { if (on_rg) { \
            const bf16* XC = (const bf16*)(F.ws + WS_S0 + S_XC); \
            EpiGates E{(bf16*)(F.ws + WS_S0 + S_LOGA), (bf16*)(F.ws + WS_S0 + S_U), XC, args.in[8] + (size_t)j * 2 * RGW, args.in[9] + (size_t)j * RGW}; \
            meta_gemm(F, XC + (size_t)MMAIN * XCW, XCW, KGT, (const bf16*)(wl + WL_GATES), (NGT / 256) * 8, E); \
            pg8::Gemm g{KGT, XCW}; pg8::GatesOrder S; S.init(XC, XCW, (const bf16*)(wl + WL_GATES), KGT, MMAIN / 256, NGT / 256, F.G, F.bx); \
            pg8::gemm_phase<EpiGates, pg8::GatesOrder>(F.lds, F.tid, g, S, E); } \
            SEAM(pb + 2); } \
        if (IN(pb + 3)) { if (on_rg) rg_scan_phase<false>(F); SEAM(pb + 3); } \
        if (IN(pb + 4)) { if (on_rg) rg_scan_phase<true>(F); SEAM(pb + 4); } \
        if (IN(pb + 5)) { if (on_rg) { \
            const bf16* Y = (const bf16*)(F.ws + WS_S0 + S_Y); EpiBf16Gelu E{MIX, D, 0}; \
            meta_gemm(F, Y + (size_t)MMAIN * KRGO, KRGO, KRGO, (const bf16*)(wl + WL_RGOUT), D / 16, E); \
            pg8::Gemm g{KRGO, KRGO}; pg8::DenseOrder S; S.init(Y, KRGO, (const bf16*)(wl + WL_RGOUT), KRGO, MMAIN / 256, D / 256, F.G, F.bx); \
            pg8::gemm_phase<EpiBf16Gelu, pg8::DenseOrder>(F.lds, F.tid, g, S, E); } \
            SEAM(pb + 5); }

constexpr int GL_QT = 0, GL_KT = 17408  , GL_KTT = 34816, GL_VT = 53248, GL_ST = 90112  , GL_SM = 155648;
constexpr int QTS = 136, KTTS = 72, VTS = 72, PS = 72, BS = 129;
constexpr int GL_NG = GL_SM + 2048  , GL_WG = GL_NG + 1024  ;
static_assert(GL_WG + 4096 <= MISC_OFF, "GLA LDS map (unit constants)");
static_assert(GL_SM + 2560 <= MISC_OFF, "GLA LDS map");

template <int MODE>
__device__ __forceinline__ void gla_phase(Frame& F, const float* wgu, const float* bgate, const float* normg) {
    const bf16* QKVR = (const bf16*)(F.ws + WS_S0 + S_QKVR); const float* Z = (const float*)(F.ws + WS_Z);
    float* KVS = (float*)(F.ws + WS_S0 + S_KVS); const float* SST = (const float*)(F.ws + WS_S0 + S_SST); float* DEC = (float*)(F.ws + WS_S0 + S_DEC);
    bf16* O = (bf16*)(F.ws + WS_S0 + S_O);
    LAS bf16* QT = (LAS bf16*)(F.lds + GL_QT); LAS bf16* KT = (LAS bf16*)(F.lds + GL_KT); LAS bf16* PP = (LAS bf16*)(F.lds + GL_KT);
    LAS bf16* KTT = (LAS bf16*)(F.lds + GL_KTT); LAS bf16* VT = (LAS bf16*)(F.lds + GL_VT); LAS unsigned char* ST = F.lds + GL_ST;
    LAS float* Bc = (LAS float*)(F.lds + GL_ST); LAS float* ZC = (LAS float*)(F.lds + GL_ST + 36864); LAS float* TOT = (LAS float*)(F.lds + GL_ST + 40960); LAS float* OFFM = (LAS float*)(F.lds + GL_ST + 43520);
    LAS float* em = (LAS float*)(F.lds + GL_SM); LAS float* ef = em + 128; LAS float* stats = ef + 128;
    LAS float* NGL = (LAS float*)(F.lds + GL_NG); LAS bf16* WGL = (LAS bf16*)(F.lds + GL_WG);
    const int tid0 = F.tid;
    for (int u = F.bx; u < NGU; u += F.G) {
        const bool meta = u >= BATCH * GH * NSC_BH;
        const int h = meta ? u - BATCH * GH * NSC_BH : (u / NSC_BH) % GH, b = meta ? 0 : u / (GH * NSC_BH), sc = meta ? 0 : u % NSC_BH;
        const int nch = meta ? 1 : CPS;
        f32x4 sacc[8][2];
        int lofs = (4 * ((tid0 & 63) >> 4)) * GDV + 32 * (tid0 >> 6) + (tid0 & 15); asm volatile("" : "+v"(lofs));
#pragma unroll
        for (int dt = 0; dt < 8; ++dt)
#pragma unroll
            for (int i = 0; i < 2; ++i) {
                sacc[dt][i] = (f32x4){0.f, 0.f, 0.f, 0.f};
                if (MODE == 1 && !meta) {
#pragma unroll
                    for (int jj = 0; jj < 4; ++jj) sacc[dt][i][jj] = SST[(size_t)u * (GDK * GDV) + (size_t)((16 * dt + jj) * GDV + 16 * i) + lofs]; }
            }
        float dsum = 0.f;
        if (MODE == 1 && tid0 < 256) NGL[tid0] = normg[h * GDV + tid0];
        for (int i = tid0; i < 16 * GDK; i += NTHR) WGL[i] = (bf16)f2bf(wgu[(size_t)(i >> 7) * GQK + h * GDK + (i & 127)]);
        const float bgv = bgate[h * GDK + (tid0 & 127)];
        for (int ci = 0; ci < nch; ++ci) {
            int tid = tid0; asm volatile("" : "+v"(tid));
            const int lane = tid & 63, w = __builtin_amdgcn_readfirstlane(tid >> 6), fr = lane & 15, fq = lane >> 4;
            const int rbase = meta ? 0 : b * SEQ + (sc * CPS + ci) * 64;
            if (tid < 256) { const int c = tid >> 2, part = tid & 3; const bool valid = !meta || c >= 48; const int row = meta ? MMAIN + c - 48 : rbase + c;
                f32x4 zv = (f32x4){0.f, 0.f, 0.f, 0.f}; if (valid) zv = *(const f32x4*)(Z + (size_t)row * 16 + 4 * part);
                *(LAS f32x4*)(ZC + c * 16 + 4 * part) = zv; }
            const int dA = tid & 127, cgp = tid >> 7;
            const int cC = tid & 63, grp = tid >> 6, d0 = grp * 16, e0 = grp * 32; const bool validC = !meta || cC >= 48; const int rowC = meta ? MMAIN + cC - 48 : rbase + cC;
            v4u q0 = (v4u){0u, 0u, 0u, 0u}, q1 = q0, k0 = q0, k1 = q0, vv[4] = {q0, q0, q0, q0};
            { const bf16* rp = QKVR + (size_t)rowC * NGLA;
              if (validC) { if (MODE == 1) { q0 = *(const v4u*)(rp + h * GDK + d0); q1 = *(const v4u*)(rp + h * GDK + d0 + 8); }
                  k0 = *(const v4u*)(rp + GQK + h * GDK + d0); k1 = *(const v4u*)(rp + GQK + h * GDK + d0 + 8);
#pragma unroll
                  for (int t = 0; t < 4; ++t) vv[t] = *(const v4u*)(rp + 2 * GQK + h * GDV + e0 + 8 * t); } }
            __syncthreads(); __builtin_amdgcn_sched_barrier(0);
            float wg[16];
#pragma unroll
            for (int i = 0; i < 16; ++i) wg[i] = bf2f(WGL[i * GDK + dA]);
            { float run = 0.f;
#pragma unroll 4
              for (int cc = 0; cc < 16; ++cc) { const int c = cgp * 16 + cc; float lg = bgv;
#pragma unroll
                for (int i4 = 0; i4 < 4; ++i4) { const f32x4 z4 = *(const LAS f32x4*)(ZC + c * 16 + 4 * i4); lg += (z4[0] * wg[4 * i4] + z4[1] * wg[4 * i4 + 1]) + (z4[2] * wg[4 * i4 + 2] + z4[3] * wg[4 * i4 + 3]); }
                float g = (fminf(lg, 0.f) - __logf(1.0f + __expf(-fabsf(lg)))) * (1.0f / 16.0f);
                if (meta && c < 48) g = 0.f;
                run += g; Bc[c * BS + dA] = run; }
              TOT[cgp * 129 + dA] = run; }
            __syncthreads(); __builtin_amdgcn_sched_barrier(0);
            if (tid < 128) { const float t0 = TOT[tid], t1 = TOT[129 + tid], t2 = TOT[258 + tid], t3 = TOT[387 + tid];
                const float bm = t0 + Bc[31 * BS + tid], bl = (t0 + t1) + (t2 + t3);
                em[tid] = __expf(bm); ef[tid] = __expf(bl - bm); dsum += bl;
                OFFM[tid] = -bm; OFFM[129 + tid] = t0 - bm; OFFM[258 + tid] = t0 + t1 - bm; OFFM[387 + tid] = t0 + t1 + t2 - bm; }
            __syncthreads(); __builtin_amdgcn_sched_barrier(0);
            { const int c = cC;
                const unsigned qw[8] = {q0.x, q0.y, q0.z, q0.w, q1.x, q1.y, q1.z, q1.w}, kw[8] = {k0.x, k0.y, k0.z, k0.w, k1.x, k1.y, k1.z, k1.w};
                unsigned qo[8], ko[8];
                const LAS float* bcr = Bc + c * BS + d0; const LAS float* ofr = OFFM + (c >> 4) * 129 + d0;
#pragma unroll
                for (int t = 0; t < 8; ++t) {
                    const int d = d0 + 2 * t;
                    const float x0 = bcr[2 * t] + ofr[2 * t], x1 = bcr[2 * t + 1] + ofr[2 * t + 1];
                    const float e0f = __expf(x0), e1f = __expf(x1), r0 = __expf(-x0), r1 = __expf(-x1);
                    const float ka = bflo(kw[t]) * r0, kb = bfhi(kw[t]) * r1;
                    ko[t] = pk2(ka, kb);
                    if (MODE == 1) qo[t] = pk2(bflo(qw[t]) * (0.08838834764831845f * e0f), bfhi(qw[t]) * (0.08838834764831845f * e1f));
                    KTT[(d) * KTTS + c] = (bf16)(ko[t] & 0xffffu); KTT[(d + 1) * KTTS + c] = (bf16)(ko[t] >> 16);
                }
                *(LAS v4u*)(KT + c * QTS + d0) = (v4u){ko[0], ko[1], ko[2], ko[3]}; *(LAS v4u*)(KT + c * QTS + d0 + 8) = (v4u){ko[4], ko[5], ko[6], ko[7]};
                if (MODE == 1) { *(LAS v4u*)(QT + c * QTS + d0) = (v4u){qo[0], qo[1], qo[2], qo[3]}; *(LAS v4u*)(QT + c * QTS + d0 + 8) = (v4u){qo[4], qo[5], qo[6], qo[7]}; }
#pragma unroll
                for (int t = 0; t < 4; ++t) { const unsigned vw[4] = {vv[t].x, vv[t].y, vv[t].z, vv[t].w};
#pragma unroll
                    for (int s = 0; s < 4; ++s) { const int e = e0 + 8 * t + 2 * s; VT[e * VTS + c] = (bf16)(vw[s] & 0xffffu); VT[(e + 1) * VTS + c] = (bf16)(vw[s] >> 16); } }
            }
            __syncthreads(); __builtin_amdgcn_sched_barrier(0);
            f32x4 pacc[2];
#pragma unroll
            for (int dt = 0; dt < 8; ++dt) { const f32x4 emv = *(const LAS f32x4*)(em + 16 * dt + 4 * fq);
#pragma unroll
                for (int i = 0; i < 2; ++i) { sacc[dt][i] = sacc[dt][i] * emv;
                    if (MODE == 1) { const int e = 32 * w + 16 * i + fr; const int ck = (2 * dt + (fq >> 1)) ^ (e & 15);
                        v2u sw; sw.x = pk2(sacc[dt][i][0], sacc[dt][i][1]); sw.y = pk2(sacc[dt][i][2], sacc[dt][i][3]);
                        *(LAS v2u*)(ST + e * 256 + ck * 16 + (fq & 1) * 8) = sw; } } }
            if (MODE == 1) {
                const int mt = w & 3, ntp = w >> 2;
#pragma unroll
                for (int ii = 0; ii < 2; ++ii) { const int nt = 2 * ntp + ii; pacc[ii] = (f32x4){0.f, 0.f, 0.f, 0.f};
                    if (nt <= mt) {
#pragma unroll
                        for (int ks = 0; ks < 4; ++ks) { const bf16x8 kf = *(const LAS bf16x8*)(KT + (16 * nt + fr) * QTS + 32 * ks + 8 * fq); const bf16x8 qf = *(const LAS bf16x8*)(QT + (16 * mt + fr) * QTS + 32 * ks + 8 * fq);
                            pacc[ii] = __builtin_amdgcn_mfma_f32_16x16x32_bf16(kf, qf, pacc[ii], 0, 0, 0); }
                        if (nt == mt) {
#pragma unroll
                            for (int jj = 0; jj < 4; ++jj) if (4 * fq + jj > fr) pacc[ii][jj] = 0.f; }
                    } }
            }
            __syncthreads(); __builtin_amdgcn_sched_barrier(0);
            if (MODE == 1) { const int mt = w & 3, ntp = w >> 2;
#pragma unroll
                for (int ii = 0; ii < 2; ++ii) { const int nt = 2 * ntp + ii; v2u pw; pw.x = pk2(pacc[ii][0], pacc[ii][1]); pw.y = pk2(pacc[ii][2], pacc[ii][3]);
                    *(LAS v2u*)(PP + (16 * mt + fr) * PS + 16 * nt + 4 * fq) = pw; }
                __syncthreads(); __builtin_amdgcn_sched_barrier(0);
            }
            f32x4 oacc[8];
            v2u rr[8];
            if (MODE == 1) { const int cF = 16 * (w & 3) + fr; const bool validF = !meta || cF >= 48; const int rowF = meta ? MMAIN + cF - 48 : rbase + cF;
#pragma unroll
                for (int t = 0; t < 8; ++t) { rr[t] = (v2u){0u, 0u}; if (validF) rr[t] = *(const v2u*)(QKVR + (size_t)rowF * NGLA + 2 * GQK + GVD + h * GDV + 128 * (w >> 2) + 16 * t + 4 * fq); } }
            if (MODE == 1) { const int mt = w & 3, eh = w >> 2;
                bf16x8 pf[2], qf[4];
#pragma unroll
                for (int ks = 0; ks < 2; ++ks) pf[ks] = *(const LAS bf16x8*)(PP + (16 * mt + fr) * PS + 32 * ks + 8 * fq);
#pragma unroll
                for (int ks = 0; ks < 4; ++ks) qf[ks] = *(const LAS bf16x8*)(QT + (16 * mt + fr) * QTS + 32 * ks + 8 * fq);
#pragma unroll
                for (int t = 0; t < 8; ++t) { const int e = 128 * eh + 16 * t + fr; f32x4 a = (f32x4){0.f, 0.f, 0.f, 0.f};
#pragma unroll
                    for (int ks = 0; ks < 2; ++ks) { const bf16x8 vf = *(const LAS bf16x8*)(VT + e * VTS + 32 * ks + 8 * fq); a = __builtin_amdgcn_mfma_f32_16x16x32_bf16(vf, pf[ks], a, 0, 0, 0); }
#pragma unroll
                    for (int ks = 0; ks < 4; ++ks) { const int ck = (4 * ks + fq) ^ (e & 15); const bf16x8 sf = *(const LAS bf16x8*)(ST + e * 256 + ck * 16); a = __builtin_amdgcn_mfma_f32_16x16x32_bf16(sf, qf[ks], a, 0, 0, 0); }
                    oacc[t] = a; }
            }
            { bf16x8 vf[2][2];
#pragma unroll
              for (int i = 0; i < 2; ++i)
#pragma unroll
                  for (int ks = 0; ks < 2; ++ks) vf[i][ks] = *(const LAS bf16x8*)(VT + (32 * w + 16 * i + fr) * VTS + 32 * ks + 8 * fq);
#pragma unroll
              for (int dt = 0; dt < 8; ++dt) { const f32x4 efv = *(const LAS f32x4*)(ef + 16 * dt + 4 * fq);
#pragma unroll
                  for (int ks = 0; ks < 2; ++ks) { const bf16x8 kf = *(const LAS bf16x8*)(KTT + (16 * dt + fr) * KTTS + 32 * ks + 8 * fq);
#pragma unroll
                      for (int i = 0; i < 2; ++i) sacc[dt][i] = __builtin_amdgcn_mfma_f32_16x16x32_bf16(kf, vf[i][ks], sacc[dt][i], 0, 0, 0); }
#pragma unroll
                  for (int i = 0; i < 2; ++i) sacc[dt][i] = sacc[dt][i] * efv; }
            }
            if (MODE == 1) { const int mt = w & 3, eh = w >> 2, c = 16 * mt + fr;
                float s1 = 0.f, s2 = 0.f;
#pragma unroll
                for (int t = 0; t < 8; ++t)
#pragma unroll
                    for (int jj = 0; jj < 4; ++jj) { s1 += oacc[t][jj]; s2 += oacc[t][jj] * oacc[t][jj]; }
                s1 += __shfl_xor(s1, 16); s1 += __shfl_xor(s1, 32); s2 += __shfl_xor(s2, 16); s2 += __shfl_xor(s2, 32);
                if (fq == 0) { stats[(c * 2 + eh) * 2 + 0] = s1; stats[(c * 2 + eh) * 2 + 1] = s2; }
                __syncthreads(); __builtin_amdgcn_sched_barrier(0);
                const float t1 = stats[(c * 2 + 0) * 2 + 0] + stats[(c * 2 + 1) * 2 + 0], t2 = stats[(c * 2 + 0) * 2 + 1] + stats[(c * 2 + 1) * 2 + 1];
                const float mean = t1 * (1.0f / GDV), var = fmaxf(t2 * (1.0f / GDV) - mean * mean, 0.f), rstd = 1.0f / sqrtf(var + LN_EPS);
                const bool valid = !meta || c >= 48; const int row = meta ? MMAIN + c - 48 : rbase + c;
                if (valid) {
#pragma unroll
                    for (int t = 0; t < 8; ++t) { const int e = 128 * eh + 16 * t + 4 * fq;
                        const v2u rw = rr[t];
                        const f32x4 ng = *(const LAS f32x4*)(NGL + e);
                        const float r4[4] = {bflo(rw.x), bfhi(rw.x), bflo(rw.y), bfhi(rw.y)}; float o4[4];
#pragma unroll
                        for (int jj = 0; jj < 4; ++jj) o4[jj] = (oacc[t][jj] - mean) * rstd * ng[jj] * silu_f(r4[jj]);
                        v2u ow; ow.x = pk2(o4[0], o4[1]); ow.y = pk2(o4[2], o4[3]);
                        *(v2u*)(O + (size_t)row * D + h * GDV + e) = ow; } }
            }
            __syncthreads(); __builtin_amdgcn_sched_barrier(0);
        }
        if (MODE == 0) {
            int lofs2 = (4 * ((tid0 & 63) >> 4)) * GDV + 32 * (tid0 >> 6) + (tid0 & 15); asm volatile("" : "+v"(lofs2));
#pragma unroll
            for (int dt = 0; dt < 8; ++dt)
#pragma unroll
                for (int i = 0; i < 2; ++i)
#pragma unroll
                    for (int jj = 0; jj < 4; ++jj) KVS[(size_t)u * (GDK * GDV) + (size_t)((16 * dt + jj) * GDV + 16 * i) + lofs2] = sacc[dt][i][jj];
            if (tid0 < 128) DEC[(size_t)u * GDK + tid0] = dsum;
        }
    }
}
__device__ __forceinline__ void gla_scan_phase(Frame& F) {
    const float* KVS = (const float*)(F.ws + WS_S0 + S_KVS); float* SST = (float*)(F.ws + WS_S0 + S_SST); const float* DEC = (const float*)(F.ws + WS_S0 + S_DEC);
    constexpr int NEL = GDK * GDV;
    for (int idx = F.bx * NTHR + F.tid; idx < BATCH * GH * NEL; idx += F.G * NTHR) {
        const int bh = idx / NEL, el = idx - bh * NEL, d = el / GDV, h = bh % GH;
        float s = KVS[(size_t)(BATCH * GH * NSC_BH + h) * NEL + el];
        const size_t ub = (size_t)bh * NSC_BH;
        SST[ub * NEL + el] = s;
        for (int sc = 0; sc + 1 < NSC_BH; sc += 7) { float dv[7], kv[7];
#pragma unroll
            for (int t = 0; t < 7; ++t) { dv[t] = DEC[(ub + sc + t) * GDK + d]; kv[t] = KVS[(ub + sc + t) * NEL + el]; }
#pragma unroll
            for (int t = 0; t < 7; ++t) { s = __expf(dv[t]) * s + kv[t]; SST[(ub + sc + t + 1) * NEL + el] = s; } }
    }
}

#define GLA_PHASES \
        if (IN(pb + 10)) { if (on_gla) { \
            bf16* QKVR = (bf16*)(F.ws + WS_S0 + S_QKVR); EpiBf16Gelu E{QKVR, NGLA, 0}; \
            meta_gemm(F, HB + (size_t)MMAIN * D, D, D, (const bf16*)(wl + WL_GLAIN), NGLA / 16, E); \
            pg8::Gemm g{D, D}; pg8::DenseOrder S; S.init(HB, D, (const bf16*)(wl + WL_GLAIN), D, MMAIN / 256, NGLA / 256, F.G, F.bx); \
            pg8::gemm_phase<EpiBf16Gelu, pg8::DenseOrder>(F.lds, F.tid, g, S, E); } \
            SEAM(pb + 10); } \
        if (IN(pb + 11)) { if (on_gla) gla_phase<0>(F, args.in[12] + (size_t)j * GRANK * GQK, args.in[13] + (size_t)j * GQK, args.in[14] + (size_t)j * GVD); SEAM(pb + 11); } \
        if (IN(pb + 12)) { if (on_gla) gla_scan_phase(F); SEAM(pb + 12); } \
        if (IN(pb + 13)) { if (on_gla) gla_phase<1>(F, args.in[12] + (size_t)j * GRANK * GQK, args.in[13] + (size_t)j * GQK, args.in[14] + (size_t)j * GVD); SEAM(pb + 13); } \
        if (IN(pb + 14)) { if (on_gla) { \
            const bf16* O = (const bf16*)(F.ws + WS_S0 + S_O); EpiBf16Gelu E{MIX, D, 0}; \
            meta_gemm(F, O + (size_t)MMAIN * D, D, D, (const bf16*)(wl + WL_GLAOUT), D / 16, E); \
            pg8::Gemm g{D, D}; pg8::DenseOrder S; S.init(O, D, (const bf16*)(wl + WL_GLAOUT), D, MMAIN / 256, D / 256, F.G, F.bx); \
            pg8::gemm_phase<EpiBf16Gelu, pg8::DenseOrder>(F.lds, F.tid, g, S, E); } \
            SEAM(pb + 14); }

__device__ __forceinline__ void moe_panel_ends(const gu32* cnt, int (&pe)[8]) {
    int acc = 0;
#pragma unroll
    for (int e = 0; e < 8; ++e) { const int c = (int)__hip_atomic_load(cnt + e, RLX_AGENT); acc += (c + 255) >> 8; pe[e] = acc; }
}
__device__ __forceinline__ void moe_gather_phase(Frame& F, gu32* moe) {
    const bf16* HB = (const bf16*)(F.ws + WS_HB); bf16* AS = (bf16*)(F.ws + WS_S0 + S_AS);
    const int* E1 = (const int*)(F.ws + WS_RT); const int* E2 = E1 + MROWS; int* POS1 = (int*)(F.ws + WS_RT) + 4 * MROWS; int* POS2 = POS1 + MROWS;
    LAS unsigned* lcnt = (LAS unsigned*)F.lds; LAS unsigned* lbase = lcnt + 8; LAS int* lpos = (LAS int*)(F.lds + 256);
    const int per = (MROWS + F.G - 1) / F.G, t0 = F.bx * per, nt = (t0 + per <= MROWS) ? per : (MROWS - t0 > 0 ? MROWS - t0 : 0);
    if (F.tid < 8) lcnt[F.tid] = 0u;
    __syncthreads();
    int e1 = 0, e2 = 0; unsigned r1 = 0, r2 = 0;
    if (F.tid < nt) { e1 = E1[t0 + F.tid]; e2 = E2[t0 + F.tid];
        r1 = __hip_atomic_fetch_add(&lcnt[e1], 1u, __ATOMIC_RELAXED, __HIP_MEMORY_SCOPE_WORKGROUP); r2 = __hip_atomic_fetch_add(&lcnt[e2], 1u, __ATOMIC_RELAXED, __HIP_MEMORY_SCOPE_WORKGROUP); }
    __syncthreads();
    if (F.tid < 8) { int ps = 0, accp = 0;
#pragma unroll
        for (int e = 0; e < 8; ++e) { ps = (e == F.tid) ? accp : ps; accp += ((int)__hip_atomic_load(moe + e, RLX_AGENT) + 255) >> 8; }
        const unsigned c = lcnt[F.tid]; const unsigned off = c ? __hip_atomic_fetch_add(moe + 64 + F.tid, c, RLX_AGENT) : 0u;
        lbase[F.tid] = (unsigned)ps * 256u + off; }
    __syncthreads();
    if (F.tid < nt) { const int p1 = (int)(lbase[e1] + r1), p2 = (int)(lbase[e2] + r2); POS1[t0 + F.tid] = p1; POS2[t0 + F.tid] = p2; lpos[2 * F.tid] = p1; lpos[2 * F.tid + 1] = p2; }
    __syncthreads();
    for (int t = F.wave; t < nt; t += NWAVES) {
        const v4u* src = (const v4u*)(HB + (size_t)(t0 + t) * D); const v4u a = src[F.lane], b = src[64 + F.lane];
        v4u* d1 = (v4u*)(AS + (size_t)lpos[2 * t] * D); v4u* d2 = (v4u*)(AS + (size_t)lpos[2 * t + 1] * D);
        d1[F.lane] = a; d1[64 + F.lane] = b; d2[F.lane] = a; d2[64 + F.lane] = b;
    }
}

#define MOE_PHASES \
        if (IN(pb + 16)) { if (on_moe) moe_gather_phase(F, F.ctl + CW_MOE + 256 * j); SEAM(pb + 16); } \
        if (IN(pb + 17)) { if (on_moe) { \
            const bf16* AS = (const bf16*)(F.ws + WS_S0 + S_AS); bf16* HS = (bf16*)(F.ws + WS_S0 + S_HS); EpiSwiglu E{HS, FF}; \
            pg8::Gemm g{D, D}; pg8::MoeOrder S; moe_panel_ends(F.ctl + CW_MOE + 256 * j, S.pe); S.e_bytes = (size_t)NFF2 * D * 2; \
            S.init(AS, D, (const bf16*)(wl + WL_MOEIN), D, S.pe[7], NFF2 / 256, F.G, F.bx); \
            pg8::gemm_phase<EpiSwiglu, pg8::MoeOrder>(F.lds, F.tid, g, S, E); } \
            SEAM(pb + 17); } \
        if (IN(pb + 18)) { if (on_moe) { \
            const bf16* HS = (const bf16*)(F.ws + WS_S0 + S_HS); EpiBf16Gelu E{(bf16*)(F.ws + WS_S0 + S_YS), D, 0}; \
            pg8::Gemm g{FF, FF}; pg8::MoeOrder S; moe_panel_ends(F.ctl + CW_MOE + 256 * j, S.pe); S.e_bytes = (size_t)D * FF * 2; \
            S.init(HS, FF, (const bf16*)(wl + WL_MOEOUT), FF, S.pe[7], D / 256, F.G, F.bx); \
            pg8::gemm_phase<EpiBf16Gelu, pg8::MoeOrder>(F.lds, F.tid, g, S, E); } \
            SEAM(pb + 18); }

constexpr int NPHASE = 41;
#ifndef MK_PER_PHASE
#define MK_PER_PHASE 0
#endif
#ifndef MK_DBG
#define MK_DBG 0
#endif
#ifndef MK_SUBMASK
#define MK_SUBMASK 0xFFu
#endif

__global__ void __launch_bounds__(NTHR, 2) fwd(Args args) {
    extern __shared__ __attribute__((aligned(16))) unsigned char lds[];
    Frame F;
    F.lds = (LAS unsigned char*)lds; F.ws = args.ws; F.ctl = (gu32*)(args.ws + WS_CTL);
    F.tid = threadIdx.x; F.lane = F.tid & 63; F.wave = __builtin_amdgcn_readfirstlane(F.tid >> 6); F.G = gridDim.x; F.bx = blockIdx.x;
    volatile LAS unsigned* MISC = (volatile LAS unsigned*)(F.lds + MISC_OFF);
    if (F.tid < 16) MISC[F.tid] = 0u;
    __syncthreads();
    const int lo = args.ph_lo, hi = args.ph_hi;
    XcdBarrier bar; bar.bar = (unsigned*)(F.ctl + CW_BAR); bar.x = 0; bar.st = nullptr;
    if (hi - lo > 1) bar = xcd_barrier_post((unsigned*)(F.ctl + CW_BAR), MISC);
#define IN(k) (lo <= (k) && (k) < hi && (F.fresh(), true))
#define SEAM(k) do { if ((k) + 1 < hi) xcd_barrier(bar); } while (0)
    const unsigned submask = args.submask;
    const float* ln_gain = args.in[2]; const float* ln_bias = args.in[3];
    bf16* HB = (bf16*)(F.ws + WS_HB); bf16* MIX = (bf16*)(F.ws + WS_MIX);

    if (IN(0)) { p0_prologue(F, args); SEAM(0); }

    for (int j = 0; j < 2; ++j) {
        const int pb = 1 + 20 * j;
        unsigned char* wl = F.ws + WS_W + (size_t)j * WL_STRIDE;
        const bool on_rg = (submask >> (4 * j + 0)) & 1u, on_ffn = (submask >> (4 * j + 1)) & 1u, on_gla = (submask >> (4 * j + 2)) & 1u, on_moe = (submask >> (4 * j + 3)) & 1u;
        RG_PHASES
        if (IN(pb + 6)) { ln_phase(F, on_rg ? 1 : 0, ln_gain + (size_t)(2 * j) * 2 * D, ln_bias + (size_t)(2 * j) * 2 * D, 0, nullptr, 0, nullptr, nullptr); SEAM(pb + 6); }
        if (IN(pb + 7)) { if (on_ffn) {
            bf16* HID = (bf16*)(F.ws + WS_S0 + S_HID);
            EpiSwiglu E{HID, FF};
            if (!(MK_DBG & 1)) meta_gemm(F, HB + (size_t)MMAIN * D, D, D, (const bf16*)(wl + WL_FFNIN), (NFF2 / 256) * 8, E);
            pg8::Gemm g{D, D}; pg8::DenseOrder S; S.init(HB, D, (const bf16*)(wl + WL_FFNIN), D, MMAIN / 256, NFF2 / 256, F.G, F.bx);
            if (!(MK_DBG & 2)) pg8::gemm_phase<EpiSwiglu, pg8::DenseOrder>(F.lds, F.tid, g, S, E); }
            SEAM(pb + 7); }
        if (IN(pb + 8)) { if (on_ffn) {
            const bf16* HID = (const bf16*)(F.ws + WS_S0 + S_HID);
            EpiBf16Gelu E{MIX, D, 0};
            if (!(MK_DBG & 4)) meta_gemm(F, HID + (size_t)MMAIN * FF, FF, FF, (const bf16*)(wl + WL_FFNOUT), D / 16, E);
            pg8::Gemm g{FF, FF}; pg8::DenseOrder S; S.init(HID, FF, (const bf16*)(wl + WL_FFNOUT), FF, MMAIN / 256, D / 256, F.G, F.bx);
            if (!(MK_DBG & 8)) pg8::gemm_phase<EpiBf16Gelu, pg8::DenseOrder>(F.lds, F.tid, g, S, E); }
            SEAM(pb + 8); }
        if (IN(pb + 9)) { ln_phase(F, on_ffn ? 1 : 0, ln_gain + (size_t)(2 * j) * 2 * D + D, ln_bias + (size_t)(2 * j) * 2 * D + D, 1, args.in[11] + (size_t)j * D * GLAW + NGLA, GLAW, nullptr, nullptr); SEAM(pb + 9); }
        GLA_PHASES
        if (IN(pb + 15)) { ln_phase(F, on_gla ? 1 : 0, ln_gain + (size_t)(2 * j + 1) * 2 * D, ln_bias + (size_t)(2 * j + 1) * 2 * D, on_moe ? 2 : 0, args.in[18] + (size_t)j * D * NE, NE, nullptr, F.ctl + CW_MOE + 256 * j); SEAM(pb + 15); }
        MOE_PHASES
        if (IN(pb + 19)) { ln_phase(F, on_moe ? 2 : 0, ln_gain + (size_t)(2 * j + 1) * 2 * D + D, ln_bias + (size_t)(2 * j + 1) * 2 * D + D, 0, nullptr, 0, j == 1 ? args.out : nullptr, nullptr); SEAM(pb + 19); }
    }
#undef IN
#undef SEAM
}

static bool phase_enabled(int k, unsigned mask) {
    if (k == 0) return true;
    const int j = (k - 1) / 20, r = (k - 1) % 20;
    int sub;
    if (r <= 5) sub = 0; else if (r == 6) return true; else if (r <= 8) sub = 1; else if (r == 9) return true;
    else if (r <= 14) sub = 2; else if (r == 15) return true; else if (r <= 18) sub = 3; else return true;
    return (mask >> (4 * j + sub)) & 1u;
}
extern "C" void kernel_launch(void* const* d_in, const int* in_sizes, int n_in, void* d_out, int out_size, void* d_ws, size_t ws_size, hipStream_t stream) {
    static int grid = 0;
    if (grid == 0) {
        if (n_in != 21 || out_size != MMAIN * D || ws_size < WS_END) { fprintf(stderr, "kernel_launch: unexpected shapes: n_in %d out %d ws %zu (need %zu); nothing launched\n", n_in, out_size, ws_size, (size_t)WS_END); grid = -1; return; }
        int dev = 0, cus = 0, per_cu = 0;
        if (hipGetDevice(&dev) != hipSuccess || hipDeviceGetAttribute(&cus, hipDeviceAttributeMultiprocessorCount, dev) != hipSuccess) { grid = -1; return; }
        if (hipFuncSetAttribute((const void*)fwd, hipFuncAttributeMaxDynamicSharedMemorySize, LDS_BYTES) != hipSuccess) { fprintf(stderr, "kernel_launch: hipFuncSetAttribute failed\n"); grid = -1; return; }
        if (hipOccupancyMaxActiveBlocksPerMultiprocessor(&per_cu, (const void*)fwd, NTHR, LDS_BYTES) != hipSuccess || per_cu < 1) fprintf(stderr, "kernel_launch: note: occupancy query reports %d\n", per_cu);
        (void)hipGetLastError();
        grid = cus;
    }
    if (grid < 0) return;
    (void)hipMemsetAsync((char*)d_ws + WS_CTL, 0, CTL_ZERO_BYTES, stream);
    Args a{};
    for (int i = 0; i < 21; ++i) a.in[i] = (const float*)d_in[i];
    a.out = (float*)d_out; a.ws = (unsigned char*)d_ws; a.submask = MK_SUBMASK; a.pad = 0;
#if MK_PER_PHASE
    for (int k = 0; k < NPHASE; ++k) { if (!phase_enabled(k, MK_SUBMASK)) continue; a.ph_lo = k; a.ph_hi = k + 1; hipLaunchKernelGGL(fwd, dim3(grid), dim3(NTHR), LDS_BYTES, stream, a); }
#else
    a.ph_lo = 0; a.ph_hi = NPHASE; hipLaunchKernelGGL(fwd, dim3(grid), dim3(NTHR), LDS_BYTES, stream, a);
#ifdef MK_PROBE_LIST
    { const int pl[] = {MK_PROBE_LIST}; for (int k : pl) { a.ph_lo = k; a.ph_hi = k + 1; hipLaunchKernelGGL(fwd, dim3(grid), dim3(NTHR), LDS_BYTES, stream, a); } }
#endif
#endif
}
```

```cpp
#include <hip/hip_runtime.h>
#include <cstdio>
#include <cstdint>

#define GAS __attribute__((address_space(1)))
#define LAS __attribute__((address_space(3)))
typedef unsigned short bf16;
typedef unsigned v4u __attribute__((ext_vector_type(4)));
typedef unsigned v2u __attribute__((ext_vector_type(2)));
typedef float f32x4 __attribute__((ext_vector_type(4)));
typedef float f32x2 __attribute__((ext_vector_type(2)));
typedef short bf16x8 __attribute__((ext_vector_type(8)));
typedef short bf16x4 __attribute__((ext_vector_type(4)));
typedef GAS unsigned gu32;
#define RLX_AGENT __ATOMIC_RELAXED, __HIP_MEMORY_SCOPE_AGENT
#define LDS_WAIT() asm volatile("s_waitcnt lgkmcnt(0)" ::: "memory")
#define VM_WAIT() asm volatile("s_waitcnt vmcnt(0)" ::: "memory")

__device__ __forceinline__ unsigned f2bf(float f) { unsigned u = __builtin_bit_cast(unsigned, f); return (u + 0x7fffu + ((u >> 16) & 1u)) >> 16; }
__device__ __forceinline__ unsigned pk2(float lo, float hi) { unsigned r; asm("v_cvt_pk_bf16_f32 %0, %1, %2" : "=v"(r) : "v"(lo), "v"(hi)); return r; }
__device__ __forceinline__ float bflo(unsigned w) { return __builtin_bit_cast(float, w << 16); }
__device__ __forceinline__ float bfhi(unsigned w) { return __builtin_bit_cast(float, w & 0xffff0000u); }
__device__ __forceinline__ float bf2f(bf16 b) { return __builtin_bit_cast(float, (unsigned)b << 16); }
__device__ __forceinline__ unsigned cvt_pk_bf16(float lo, float hi) { unsigned r; asm volatile("v_cvt_pk_bf16_f32 %0, %1, %2" : "=v"(r) : "v"(lo), "v"(hi)); return r; }
__device__ __forceinline__ float fast_exp(float x) { return __builtin_amdgcn_exp2f(x * 1.44269504089f); }
__device__ __forceinline__ float sigmoid_f(float x) { return __builtin_amdgcn_rcpf(1.0f + fast_exp(-x)); }
__device__ __forceinline__ float silu_f(float x) { return x * sigmoid_f(x); }
__device__ __forceinline__ float gelu_tanh_f(float x) { const float u = 0.7978845608028654f * (x + 0.044715f * x * x * x); return x * sigmoid_f(2.0f * u); }
__device__ __forceinline__ float wave_sum(float v) {
#pragma unroll
    for (int o = 1; o < 64; o <<= 1) v += __shfl_xor(v, o);
    return v;
}

namespace pg8 {
constexpr int BM = 256, BK = 64, HALF = 128, HTB = HALF * BK * 2  , STAGE_BYTES = 8 * HTB, NXCD = 8, WGM = 8;
__host__ __device__ __forceinline__ int lds_byte(int r, int c) { const int st = (r >> 4) * 2 + (c >> 5), rr = r & 15, cc = c & 31, ob = rr * 64 + cc * 2; return st * 1024 + (ob ^ (((ob >> 9) & 1) << 5)); }
__host__ __device__ __forceinline__ void stage_rc(int b, int& R, int& C) { const int st = b / 1024, sb = b % 1024, swz = sb ^ (((sb >> 9) & 1) << 5); R = (st >> 1) * 16 + swz / 64; C = (st & 1) * 32 + (swz % 64) / 2; }
__host__ __device__ __forceinline__ int perm32(int rho) { const int n = rho >> 4, i = rho & 15; return 8 * (i >> 2) + 4 * n + (i & 3); }

struct Unit { int pm, pn; };
struct Gemm { int K, lda; };

struct OrderBase {
    int nM, nN, nwg, G, c;
    __device__ __forceinline__ void init_order(int nM_, int nN_, int G_, int c_) { nM = nM_; nN = nN_; nwg = nM * nN; G = G_; c = c_; }
    __device__ __forceinline__ bool next(int i, Unit& u) const {
        const long L = (long)i * G + c; if (L >= nwg) return false;
        int wgid = (int)L; { const int q = nwg / NXCD, r = nwg % NXCD, xcd = wgid % NXCD, off = wgid / NXCD; wgid = (xcd < r ? xcd * (q + 1) : r * (q + 1) + (xcd - r) * q) + off; }
        const int nig = WGM * nN, gid = wgid / nig, fm = gid * WGM, gsz = (nM - fm) < WGM ? (nM - fm) : WGM;
        u.pm = fm + ((wgid % nig) % gsz); u.pn = (wgid % nig) / gsz; return true;
    }
};
struct DenseOrder : OrderBase {
    const char* A; const char* Bt; size_t a_tile, b_tile;
    __device__ __forceinline__ void init(const bf16* A_, int lda, const bf16* Bt_, int K, int nM_, int nN_, int G_, int c_) { A = (const char*)A_; Bt = (const char*)Bt_; a_tile = (size_t)BM * lda * 2; b_tile = (size_t)BM * K * 2; init_order(nM_, nN_, G_, c_); }
    __device__ __forceinline__ const char* a_base(const Unit& u) const { return A + (size_t)u.pm * a_tile; }
    __device__ __forceinline__ const char* b_base(const Unit& u) const { return Bt + (size_t)u.pn * b_tile; }
};
struct GatesOrder : DenseOrder {
    __device__ __forceinline__ const char* a_base(const Unit& u) const { return A + (size_t)u.pm * a_tile + (size_t)(u.pn >> 1) * 512; }
};
struct MoeOrder : DenseOrder {
    int pe[8]; size_t e_bytes;
    __device__ __forceinline__ const char* b_base(const Unit& u) const {
        int e = 0;
#pragma unroll
        for (int j = 0; j < 7; ++j) e += (u.pm >= pe[j]) ? 1 : 0;
        return Bt + (size_t)e * e_bytes + (size_t)u.pn * b_tile;
    }
};

template <class Epi, class Sched, bool ALIGN_EPI = true>
__device__ __forceinline__ void gemm_phase(LAS unsigned char* lds, const int tid, const Gemm g, const Sched& S, const Epi& E) {
    const int wid = __builtin_amdgcn_readfirstlane(tid >> 6), lane = tid & 63, wr = wid >> 2, wc = wid & 3, fr = lane & 15, fq = lane >> 4;
    const int K = g.K, nt = K / BK;
    unsigned voffA[2], voffB[2];
#pragma unroll
    for (int i = 0; i < 2; ++i) { int R, C; stage_rc(tid * 16 + i * 8192, R, C); const int Rb = Epi::PERM ? ((R & ~31) + perm32(R & 31)) : R;
        voffA[i] = (unsigned)(R * g.lda + C) * 2u; voffB[i] = (unsigned)(Rb * K + C) * 2u; }
    const size_t kstep = (size_t)(BK * 2);
    const size_t hstepA = (size_t)HALF * g.lda * 2, hstepB = (size_t)HALF * K * 2;
    const unsigned ldsw = (unsigned)wid * 1024u;
    const int aoff = lds_byte(wr * 64 + fr, fq * 8), boff = lds_byte(wc * 32 + fr, fq * 8);
#define PG8_SA(b, h) (((b) * 2 + (h)) * HTB)
#define PG8_SB(b, h) ((4 + (b) * 2 + (h)) * HTB)
#define PG8_STAGE(bufoff, gbase, voff) do { _Pragma("unroll") for (int _i = 0; _i < 2; ++_i) \
        __builtin_amdgcn_global_load_lds((const unsigned*)((const char*)(gbase) + (voff)[_i]), (LAS unsigned*)(lds + (bufoff) + ldsw + _i * 8192), 16, 0, 0); } while (0)
#define PG8_LDA(dst, b, h) do { _Pragma("unroll") for (int m = 0; m < 4; ++m) _Pragma("unroll") for (int k = 0; k < 2; ++k) dst[m][k] = *(const LAS bf16x8*)(lds + PG8_SA(b, h) + aoff + m * 2048 + k * 1024); } while (0)
#define PG8_LDB(dst, b, h) do { _Pragma("unroll") for (int n = 0; n < 2; ++n) _Pragma("unroll") for (int k = 0; k < 2; ++k) dst[n][k] = *(const LAS bf16x8*)(lds + PG8_SB(b, h) + boff + n * 2048 + k * 1024); } while (0)
#define PG8_MMA(ai, bj, At, Bt) do { __builtin_amdgcn_s_setprio(1); _Pragma("unroll") for (int m = 0; m < 4; ++m) _Pragma("unroll") for (int n = 0; n < 2; ++n) _Pragma("unroll") for (int k = 0; k < 2; ++k) \
        acc[ai][bj][m][n] = __builtin_amdgcn_mfma_f32_16x16x32_bf16(Bt[n][k], At[m][k], acc[ai][bj][m][n], 0, 0, 0); __builtin_amdgcn_s_setprio(0); } while (0)
#define PG8_WAIT_V(n) asm volatile("s_waitcnt vmcnt(" #n ")" ::: "memory")
#define PG8_WAIT_L(n) asm volatile("s_waitcnt lgkmcnt(" #n ")" ::: "memory")
#define PG8_BAR __builtin_amdgcn_s_barrier()
#define PG8_SCHED __builtin_amdgcn_sched_barrier(0)
    Unit cur, nxt; int ui = 0;
    if (!S.next(0, cur)) return;
    f32x4 acc[2][2][4][2];
#pragma unroll
    for (int a = 0; a < 2; ++a)
#pragma unroll
        for (int b = 0; b < 2; ++b)
#pragma unroll
            for (int m = 0; m < 4; ++m)
#pragma unroll
                for (int n = 0; n < 2; ++n) acc[a][b][m][n] = (f32x4){0.f, 0.f, 0.f, 0.f};
    bf16x8 At[4][2], B0[2][2], B1[2][2];
    const char* cA = S.a_base(cur); const char* cB = S.b_base(cur);
    PG8_STAGE(PG8_SB(0, 0), cB, voffB); PG8_STAGE(PG8_SB(0, 1), cB + hstepB, voffB); PG8_STAGE(PG8_SA(0, 0), cA, voffA); PG8_STAGE(PG8_SA(0, 1), cA + hstepA, voffA);
    if (wr == 1) PG8_BAR;
    PG8_WAIT_V(2); PG8_BAR;
    PG8_STAGE(PG8_SB(1, 0), cB + kstep, voffB); PG8_STAGE(PG8_SA(1, 0), cA + kstep, voffA); PG8_STAGE(PG8_SB(1, 1), cB + hstepB + kstep, voffB);
    PG8_WAIT_V(6); PG8_BAR;
    for (;;) {
        const bool has_next = S.next(ui + 1, nxt);
        const char* nA = has_next ? S.a_base(nxt) : cA; const char* nB = has_next ? S.b_base(nxt) : cB;
#pragma nounroll
        for (int t = 0; t < nt; t += 2) {
            const bool last = (t == nt - 2);
            const char* a1 = cA + (size_t)(t + 1) * kstep;
            const char* a2 = last ? nA : cA + (size_t)(t + 2) * kstep; const char* b2 = last ? nB : cB + (size_t)(t + 2) * kstep;
            const char* a3 = a2 + kstep; const char* b3 = b2 + kstep;
            PG8_LDB(B0, 0, 0); PG8_LDB(B1, 0, 1); PG8_SCHED; PG8_LDA(At, 0, 0); PG8_STAGE(PG8_SA(1, 1), a1 + hstepA, voffA);
            PG8_WAIT_V(8); PG8_WAIT_L(0); PG8_BAR; PG8_MMA(0, 0, At, B0); PG8_MMA(0, 1, At, B1); PG8_BAR; PG8_SCHED;
            PG8_LDA(At, 0, 1); PG8_STAGE(PG8_SB(0, 0), b2, voffB); PG8_STAGE(PG8_SB(0, 1), b2 + hstepB, voffB); PG8_STAGE(PG8_SA(0, 0), a2, voffA);
            PG8_WAIT_V(8); PG8_WAIT_L(0); PG8_BAR; PG8_MMA(1, 0, At, B0); PG8_MMA(1, 1, At, B1); PG8_BAR; PG8_SCHED;
            PG8_LDB(B0, 1, 0); PG8_LDB(B1, 1, 1); PG8_SCHED; PG8_LDA(At, 1, 0); PG8_STAGE(PG8_SA(0, 1), a2 + hstepA, voffA);
            PG8_WAIT_V(8); PG8_WAIT_L(0); PG8_BAR; PG8_MMA(0, 0, At, B0); PG8_MMA(0, 1, At, B1); PG8_BAR; PG8_SCHED;
            PG8_LDA(At, 1, 1); PG8_STAGE(PG8_SB(1, 0), b3, voffB); PG8_STAGE(PG8_SB(1, 1), b3 + hstepB, voffB); PG8_STAGE(PG8_SA(1, 0), a3, voffA);
            PG8_WAIT_V(8); PG8_WAIT_L(0); PG8_BAR; PG8_MMA(1, 0, At, B0); PG8_MMA(1, 1, At, B1); PG8_BAR; PG8_SCHED;
        }
        if constexpr (ALIGN_EPI) { if (wr == 0) PG8_BAR; }
        E(acc, cur, wr, wc, fr, fq);
        if (!has_next) break;
#pragma unroll
        for (int a = 0; a < 2; ++a)
#pragma unroll
            for (int b = 0; b < 2; ++b)
#pragma unroll
                for (int m = 0; m < 4; ++m)
#pragma unroll
                    for (int n = 0; n < 2; ++n) acc[a][b][m][n] = (f32x4){0.f, 0.f, 0.f, 0.f};
        cur = nxt; cA = nA; cB = nB; ++ui;
        if constexpr (ALIGN_EPI) { if (wr == 1) PG8_BAR; }
    }
    PG8_WAIT_V(0);
    if constexpr (!ALIGN_EPI) { if (wr == 0) PG8_BAR; }
    PG8_BAR;
#undef PG8_SA
#undef PG8_SB
#undef PG8_STAGE
#undef PG8_LDA
#undef PG8_LDB
#undef PG8_MMA
#undef PG8_WAIT_V
#undef PG8_WAIT_L
#undef PG8_BAR
#undef PG8_SCHED
}
}
#define XB_TMO      128
#define XB_XCNT(j)  (256  + 64 * (j))
#define XB_XSUB(j)  (1280 + 64 * (j))
#define XB_XGEN(j)  (2304 + 64 * (j))
#define XB_TOP      3328
#define XB_TOPGEN   3392
#define XCD_BAR_WORDS 3456
#define XB_SPIN_CAP (1u << 18)

__device__ __forceinline__ unsigned xb_ld(unsigned* p)              { return __hip_atomic_load(p, __ATOMIC_RELAXED, __HIP_MEMORY_SCOPE_AGENT); }
__device__ __forceinline__ unsigned xb_add(unsigned* p, unsigned v) { return __hip_atomic_fetch_add(p, v, __ATOMIC_RELAXED, __HIP_MEMORY_SCOPE_AGENT); }
__device__ __forceinline__ unsigned xb_xcc_id() { return (unsigned)__builtin_amdgcn_s_getreg((3 << 11) | 20) & 0xFu; }
#define XB_SPIN(cond, bar) do { unsigned _sp = 0; while (cond) { __builtin_amdgcn_s_sleep(1); \
    if ((++_sp & 255u) == 0u) { if (xb_ld(&(bar)[XB_TMO])) break; if (_sp > XB_SPIN_CAP) { atomicAdd(&(bar)[XB_TMO], 1u); break; } } } } while (0)

struct XcdBarrier {
    unsigned* bar; unsigned x;
    volatile LAS unsigned* st;
};

__device__ __forceinline__ XcdBarrier xcd_barrier_post(unsigned* bar, volatile LAS unsigned* st) {
    XcdBarrier b; b.bar = bar; b.x = xb_xcc_id(); b.st = st;
    if (threadIdx.x == 0) (void)xb_add(&bar[XB_XCNT(b.x)], 1u);
    return b;
}
__device__ __forceinline__ void xcd_barrier_complete(unsigned* bar, unsigned x, unsigned& nloc, unsigned& nx) {
    const unsigned G = gridDim.x * gridDim.y * gridDim.z;
    unsigned sum, cnt, mine, sp = 0u;
    for (;;) {
        sum = 0u; cnt = 0u; mine = 0u;
#pragma unroll
        for (unsigned j = 0; j < 16; ++j) { const unsigned c = xb_ld(&bar[XB_XCNT(j)]); sum += c; cnt += (c > 0u) ? 1u : 0u; mine = (j == x) ? c : mine; }
        if (sum == G) break;
        __builtin_amdgcn_s_sleep(1);
        if ((++sp & 255u) == 0u) { if (xb_ld(&bar[XB_TMO])) break; if (sp > XB_SPIN_CAP) { atomicAdd(&bar[XB_TMO], 1u); break; } }
    }
    nloc = mine > 0u ? mine : 1u; nx = cnt > 0u ? cnt : 1u;
}

__device__ __forceinline__ void xcd_barrier(const XcdBarrier& b) {
    asm volatile("s_waitcnt vmcnt(0)" ::: "memory");
    __syncthreads();
    if (threadIdx.x == 0) {
        unsigned* bar = b.bar;
        __builtin_amdgcn_s_waitcnt(0);
        unsigned nloc = b.st[0], nx = b.st[1];
        if (nloc == 0u) { xcd_barrier_complete(bar, b.x, nloc, nx); b.st[0] = nloc; b.st[1] = nx; }
        const unsigned old = xb_add(&bar[XB_XSUB(b.x)], 1u);
        const unsigned gen = old / nloc;
        if (old + 1u == (gen + 1u) * nloc) {
            __builtin_amdgcn_fence(__ATOMIC_RELEASE, "agent");
            asm volatile("s_waitcnt vmcnt(0)" ::: "memory");
            const unsigned og = xb_add(&bar[XB_TOP], 1u);
            const unsigned tg = og / nx;
            if (og + 1u == (tg + 1u) * nx) xb_add(&bar[XB_TOPGEN], 1u);
            else XB_SPIN(xb_ld(&bar[XB_TOPGEN]) == tg, bar);
            __builtin_amdgcn_fence(__ATOMIC_ACQUIRE, "agent");
            xb_add(&bar[XB_XGEN(b.x)], 1u);
            asm volatile("s_waitcnt vmcnt(0)" ::: "memory");
        } else {
            XB_SPIN(xb_ld(&bar[XB_XGEN(b.x)]) == gen, bar);
            __builtin_amdgcn_fence(__ATOMIC_ACQUIRE, "agent");
            asm volatile("s_waitcnt vmcnt(0)" ::: "memory");
        }
    }
    __syncthreads();
}

constexpr int NWAVES = 8, NTHR = 512;
constexpr int D = 1024, BATCH = 2, SEQ = 16384, NMETA = 16;
constexpr int MMAIN = BATCH * SEQ;
constexpr int MROWS = MMAIN + NMETA;
constexpr int MPAD = MMAIN + 256;
constexpr int RGW = 1344, RGBW = 168, NRG = 2816  , KRGO = 1408  , NGT = 4096, KGT = 256, XCW = 2048;
constexpr int FF = 3584, NE = 8, NFF2 = 2 * FF;
constexpr int GH = 4, GDK = 128, GDV = 256, GQK = 512, GVD = 1024, NGLA = 3072, GLAW = 3088, GRANK = 16;
constexpr int MSORT = 265 * 256;
constexpr float LN_EPS = 1e-5f, ALPHA = 1.6817928305074290f;
constexpr int SEG = 128, NSEG_B = SEQ / SEG, NSEG = 1 + BATCH * NSEG_B;
constexpr int CPS = 4, NSC_BH = SEQ / (64 * CPS), NGU = BATCH * GH * NSC_BH + GH;

constexpr size_t MiB = 1u << 20;
constexpr size_t WS_CTL = 0, CTL_ZERO_BYTES = 1 * MiB;
constexpr size_t WL_RGIN = 0, WL_GATES = WL_RGIN + (size_t)NRG * D * 2, WL_RGOUT = WL_GATES + (size_t)NGT * KGT * 2, WL_GLAIN = WL_RGOUT + (size_t)D * KRGO * 2,
                 WL_GLAOUT = WL_GLAIN + (size_t)NGLA * D * 2, WL_FFNIN = WL_GLAOUT + (size_t)D * D * 2, WL_FFNOUT = WL_FFNIN + (size_t)NFF2 * D * 2,
                 WL_MOEIN = WL_FFNOUT + (size_t)D * FF * 2, WL_MOEOUT = WL_MOEIN + (size_t)NE * NFF2 * D * 2, WL_STRIDE = WL_MOEOUT + (size_t)NE * D * FF * 2;
constexpr size_t WS_W = 1 * MiB;
constexpr size_t WS_H = WS_W + 2 * WL_STRIDE;
constexpr size_t WS_HB = WS_H + (size_t)MPAD * D * 4;
constexpr size_t WS_MIX = WS_HB + (size_t)MPAD * D * 2;
constexpr size_t WS_Z = WS_MIX + (size_t)MPAD * D * 4;
constexpr size_t WS_RT = WS_Z + 3 * MiB;
constexpr size_t WS_AGG = WS_RT + 1 * MiB;
constexpr size_t WS_S0 = WS_AGG + 3 * MiB;
constexpr size_t S_PROJ = 0, S_XC = S_PROJ + (size_t)MPAD * NRG * 2, S_LOGA = S_XC + (size_t)MPAD * XCW * 2, S_U = S_LOGA + (size_t)MPAD * RGW * 4, S_Y = S_U + (size_t)MPAD * RGW * 4, S_RG_END = S_Y + (size_t)MPAD * KRGO * 2;
constexpr size_t S_HID = 0;
constexpr size_t S_QKVR = 0, S_KVS = S_QKVR + (size_t)MPAD * NGLA * 2, S_SST = S_KVS + (size_t)NGU * GDK * GDV * 4, S_O = S_SST + (size_t)NGU * GDK * GDV * 4, S_DEC = S_O + (size_t)MPAD * D * 2, S_XB = S_DEC + 1 * MiB, S_EMF = S_XB + (size_t)(BATCH * GH * (SEQ / 64) + GH) * 64 * GDK * 4, S_GLA_END = S_EMF + 3 * MiB;
constexpr size_t S_AS = 0, S_HS = S_AS + (size_t)MSORT * D * 2, S_YS = S_HS + (size_t)MSORT * FF * 2, S_MOE_END = S_YS + (size_t)MSORT * D * 4;
constexpr size_t S_MAX = S_RG_END > S_MOE_END ? (S_RG_END > S_GLA_END ? S_RG_END : S_GLA_END) : (S_MOE_END > S_GLA_END ? S_MOE_END : S_GLA_END);
constexpr size_t WS_END = WS_S0 + S_MAX;
constexpr int CW_TMO = 0, CW_BAR = 4096, CW_MOE = 8192;

constexpr int LDS_BYTES = 163840, MISC_OFF = LDS_BYTES - 64;

struct Frame {
    LAS unsigned char* lds; gu32* ctl; unsigned char* ws;
    int tid, lane, wave, G, bx; unsigned long long dbg_acc;
    __device__ __forceinline__ void fresh() { asm volatile("" : "+v"(tid)); asm volatile("" : "+s"(bx)); asm volatile("" : "+s"(ws)); lane = tid & 63; wave = __builtin_amdgcn_readfirstlane(tid >> 6); ctl = (gu32*)(ws + WS_CTL); }
};
struct Args { const float* in[21]; float* out; unsigned char* ws; int ph_lo, ph_hi; unsigned submask; int pad; };

struct EpiBf16Gelu {
    static constexpr bool PERM = true, PAIR = false;
    bf16* O; int ldc, gelu_cols;
    __device__ __forceinline__ void operator()(const f32x4 (&acc)[2][2][4][2], const pg8::Unit& u, int wr, int wc, int fr, int fq) const {
        const int row0 = u.pm * 256 + wr * 64 + fr, col0 = u.pn * 256 + wc * 32 + 8 * fq;
#pragma unroll
        for (int ai = 0; ai < 2; ++ai)
#pragma unroll
            for (int m = 0; m < 4; ++m) { bf16* rowp = O + (size_t)(row0 + ai * 128 + m * 16) * ldc + col0;
#pragma unroll
                for (int bj = 0; bj < 2; ++bj) { f32x4 v0 = acc[ai][bj][m][0], v1 = acc[ai][bj][m][1];
                    if (col0 + bj * 128 < gelu_cols) {
#pragma unroll
                        for (int j = 0; j < 4; ++j) { v0[j] = gelu_tanh_f(v0[j]); v1[j] = gelu_tanh_f(v1[j]); } }
                    v4u w; w.x = cvt_pk_bf16(v0[0], v0[1]); w.y = cvt_pk_bf16(v0[2], v0[3]); w.z = cvt_pk_bf16(v1[0], v1[1]); w.w = cvt_pk_bf16(v1[2], v1[3]);
                    *(v4u*)(rowp + bj * 128) = w; } }
    }
    __device__ __forceinline__ void meta_task(int task, int& r0, int& aoff) const { r0 = task * 16; aoff = 0; }
    __device__ __forceinline__ void meta(int task, f32x4 a0, f32x4, int fr, int fq) const {
        const int col = task * 16 + 4 * fq;
        if (col < gelu_cols) {
#pragma unroll
            for (int j = 0; j < 4; ++j) a0[j] = gelu_tanh_f(a0[j]); }
        v2u w; w.x = cvt_pk_bf16(a0[0], a0[1]); w.y = cvt_pk_bf16(a0[2], a0[3]);
        *(v2u*)(O + (size_t)(MMAIN + fr) * ldc + col) = w;
    }
};
struct EpiSwiglu {
    static constexpr bool PERM = true, PAIR = true;
    bf16* O; int ldc;
    __device__ __forceinline__ void operator()(const f32x4 (&acc)[2][2][4][2], const pg8::Unit& u, int wr, int wc, int fr, int fq) const {
        const int row0 = u.pm * 256 + wr * 64 + fr, col0 = u.pn * 128 + wc * 32 + 8 * fq;
#pragma unroll
        for (int ai = 0; ai < 2; ++ai)
#pragma unroll
            for (int m = 0; m < 4; ++m) { bf16* rowp = O + (size_t)(row0 + ai * 128 + m * 16) * ldc + col0;
                f32x4 g0 = acc[ai][0][m][0], g1 = acc[ai][0][m][1]; const f32x4 u0 = acc[ai][1][m][0], u1 = acc[ai][1][m][1];
#pragma unroll
                for (int j = 0; j < 4; ++j) { g0[j] = silu_f(g0[j]) * u0[j]; g1[j] = silu_f(g1[j]) * u1[j]; }
                v4u w; w.x = cvt_pk_bf16(g0[0], g0[1]); w.y = cvt_pk_bf16(g0[2], g0[3]); w.z = cvt_pk_bf16(g1[0], g1[1]); w.w = cvt_pk_bf16(g1[2], g1[3]);
                *(v4u*)rowp = w; }
    }
    __device__ __forceinline__ void meta_task(int task, int& r0, int& aoff) const { r0 = (task >> 3) * 256 + (task & 7) * 16; aoff = 0; }
    __device__ __forceinline__ void meta(int task, f32x4 a0, f32x4 a1, int fr, int fq) const {
        const int col = (task >> 3) * 128 + (task & 7) * 16 + 4 * fq;
#pragma unroll
        for (int j = 0; j < 4; ++j) a0[j] = silu_f(a0[j]) * a1[j];
        v2u w; w.x = cvt_pk_bf16(a0[0], a0[1]); w.y = cvt_pk_bf16(a0[2], a0[3]);
        *(v2u*)(O + (size_t)(MMAIN + fr) * ldc + col) = w;
    }
};
struct EpiF32 {
    static constexpr bool PERM = false, PAIR = false;
    float* C; int ldc;
    __device__ __forceinline__ void operator()(const f32x4 (&acc)[2][2][4][2], const pg8::Unit& u, int wr, int wc, int fr, int fq) const {
        const int row0 = u.pm * 256 + wr * 64 + fr, col0 = u.pn * 256 + wc * 32 + 4 * fq;
#pragma unroll
        for (int ai = 0; ai < 2; ++ai)
#pragma unroll
            for (int m = 0; m < 4; ++m) { float* rowp = C + (size_t)(row0 + ai * 128 + m * 16) * ldc + col0;
#pragma unroll
                for (int bj = 0; bj < 2; ++bj)
#pragma unroll
                    for (int n = 0; n < 2; ++n) *(f32x4*)(rowp + bj * 128 + n * 16) = acc[ai][bj][m][n]; }
    }
    __device__ __forceinline__ void meta_task(int task, int& r0, int& aoff) const { r0 = task * 16; aoff = 0; }
    __device__ __forceinline__ void meta(int task, f32x4 a0, f32x4, int fr, int fq) const { *(f32x4*)(C + (size_t)(MMAIN + fr) * ldc + task * 16 + 4 * fq) = a0; }
};

template <class Epi>
__device__ __forceinline__ void meta_gemm(Frame& F, const bf16* A16, int lda, int K, const bf16* Bt, int ntasks, const Epi& E) {
    const int fr = F.lane & 15, fq = F.lane >> 4;
    LAS f32x4* red = (LAS f32x4*)F.lds;
    for (int task = F.bx; task < ntasks; task += F.G) {
        int r0, aoff; E.meta_task(task, r0, aoff);
        f32x4 acc0 = (f32x4){0.f, 0.f, 0.f, 0.f}, acc1 = acc0;
        const bf16* ap = A16 + (size_t)fr * lda + aoff + fq * 8; const bf16* bp0 = Bt + (size_t)(r0 + fr) * K + fq * 8; const bf16* bp1 = bp0 + (size_t)128 * K;
        for (int ks = F.wave; ks < K / 32; ks += NWAVES) {
            const bf16x8 a = *(const bf16x8*)(ap + ks * 32); const bf16x8 b0 = *(const bf16x8*)(bp0 + ks * 32);
            acc0 = __builtin_amdgcn_mfma_f32_16x16x32_bf16(b0, a, acc0, 0, 0, 0);
            if (Epi::PAIR) { const bf16x8 b1 = *(const bf16x8*)(bp1 + ks * 32); acc1 = __builtin_amdgcn_mfma_f32_16x16x32_bf16(b1, a, acc1, 0, 0, 0); }
        }
        red[(F.wave * 2 + 0) * 64 + F.lane] = acc0; if (Epi::PAIR) red[(F.wave * 2 + 1) * 64 + F.lane] = acc1;
        __syncthreads();
        if (F.wave == 0) {
            f32x4 s0 = red[F.lane], s1 = Epi::PAIR ? red[64 + F.lane] : acc1;
#pragma unroll
            for (int w = 1; w < NWAVES; ++w) { s0 += red[(w * 2) * 64 + F.lane]; if (Epi::PAIR) s1 += red[(w * 2 + 1) * 64 + F.lane]; }
            E.meta(task, s0, s1, fr, fq);
        }
        __syncthreads();
    }
}

__device__ __forceinline__ void transpose_item(const float* W, int ldw, int Ksrc, int c0, int nvalid, bf16* WT, int Kdst, int n0, int k0, LAS float* scr, int lane) {
#pragma unroll 8
    for (int i = 0; i < 32; ++i) { const int kk = 2 * i + (lane >> 5), c = lane & 31;
        const bool ok = (k0 + kk < Ksrc) && (c < nvalid); const float v = W[ok ? (size_t)(k0 + kk) * ldw + c0 + c : (size_t)0];
        scr[kk * 33 + c] = ok ? v : 0.f; }
    LDS_WAIT(); asm volatile("" ::: "memory");
    const int c = lane & 7;
#pragma unroll
    for (int j = 0; j < 4; ++j) { const int n = (lane >> 3) + 8 * j; const LAS float* s = scr + (8 * c) * 33 + n;
        v4u o; o.x = pk2(s[0 * 33], s[1 * 33]); o.y = pk2(s[2 * 33], s[3 * 33]); o.z = pk2(s[4 * 33], s[5 * 33]); o.w = pk2(s[6 * 33], s[7 * 33]);
        *(v4u*)(WT + (size_t)(n0 + n) * Kdst + k0 + 8 * c) = o; }
    LDS_WAIT(); asm volatile("" ::: "memory");
}
__device__ __forceinline__ void map_id(int n0, int nsrc, int& c0, int& nv) { c0 = n0; nv = nsrc - n0; nv = nv < 0 ? 0 : (nv > 32 ? 32 : nv); if (nv == 0) c0 = 0; }
__device__ __forceinline__ void map_swiglu(int n0, int& c0, int& nv) { const int tile = n0 >> 8, rr = n0 & 255; c0 = rr < 128 ? tile * 128 + rr : FF + tile * 128 + rr - 128; nv = 32; }

__device__ __forceinline__ void p0_prologue(Frame& F, const Args& a) {
    LAS float* scr = (LAS float*)(F.lds + F.wave * 16384);
    const int gw = F.bx * NWAVES + F.wave, NGW = F.G * NWAVES;
    constexpr int I_RGIN = (D / 64) * (NRG / 32), I_GATES = (KGT / 64) * (NGT / 32), I_RGOUT = (KRGO / 64) * (D / 32), I_GLAIN = (D / 64) * (NGLA / 32), I_GLAOUT = (D / 64) * (D / 32),
                  I_FFNIN = (D / 64) * (NFF2 / 32), I_FFNOUT = (FF / 64) * (D / 32), I_MOEIN = NE * I_FFNIN, I_MOEOUT = NE * I_FFNOUT;
    constexpr int I_PER_J = I_RGIN + I_GATES + I_RGOUT + I_GLAIN + I_GLAOUT + I_FFNIN + I_FFNOUT + I_MOEIN + I_MOEOUT;
    for (int it = gw; it < 2 * I_PER_J; it += NGW) {
        const int j = it / I_PER_J; int r = it - j * I_PER_J;
        unsigned char* wl = F.ws + WS_W + (size_t)j * WL_STRIDE;
        int c0, nv;
        if (r < I_RGIN) { const int nb = r % (NRG / 32), kb = r / (NRG / 32); map_id(nb * 32, 2 * RGW, c0, nv);
            transpose_item(a.in[4] + (size_t)j * D * 2 * RGW, 2 * RGW, D, c0, nv, (bf16*)(wl + WL_RGIN), D, nb * 32, kb * 64, scr, F.lane); continue; } r -= I_RGIN;
        if (r < I_GATES) { const int nb = r % (NGT / 32), kb = r / (NGT / 32); const int n0 = nb * 32, pn = n0 >> 8, rr = n0 & 255, g = rr >> 7, cc = rr & 127, d0 = (pn & 1) * 128 + cc, blk = pn >> 1;
            nv = RGBW - d0; nv = nv < 0 ? 0 : (nv > 32 ? 32 : nv); c0 = nv ? d0 : 0;
            transpose_item(a.in[7] + ((size_t)(j * 2 + g) * 8 + blk) * RGBW * RGBW, RGBW, RGBW, c0, nv, (bf16*)(wl + WL_GATES), KGT, n0, kb * 64, scr, F.lane); continue; } r -= I_GATES;
        if (r < I_RGOUT) { const int nb = r % (D / 32), kb = r / (D / 32);
            transpose_item(a.in[10] + (size_t)j * RGW * D, D, RGW, nb * 32, 32, (bf16*)(wl + WL_RGOUT), KRGO, nb * 32, kb * 64, scr, F.lane); continue; } r -= I_RGOUT;
        if (r < I_GLAIN) { const int nb = r % (NGLA / 32), kb = r / (NGLA / 32);
            transpose_item(a.in[11] + (size_t)j * D * GLAW, GLAW, D, nb * 32, 32, (bf16*)(wl + WL_GLAIN), D, nb * 32, kb * 64, scr, F.lane); continue; } r -= I_GLAIN;
        if (r < I_GLAOUT) { const int nb = r % (D / 32), kb = r / (D / 32);
            transpose_item(a.in[15] + (size_t)j * D * D, D, D, nb * 32, 32, (bf16*)(wl + WL_GLAOUT), D, nb * 32, kb * 64, scr, F.lane); continue; } r -= I_GLAOUT;
        if (r < I_FFNIN) { const int nb = r % (NFF2 / 32), kb = r / (NFF2 / 32); map_swiglu(nb * 32, c0, nv);
            transpose_item(a.in[16] + (size_t)j * D * NFF2, NFF2, D, c0, nv, (bf16*)(wl + WL_FFNIN), D, nb * 32, kb * 64, scr, F.lane); continue; } r -= I_FFNIN;
        if (r < I_FFNOUT) { const int nb = r % (D / 32), kb = r / (D / 32);
            transpose_item(a.in[17] + (size_t)j * FF * D, D, FF, nb * 32, 32, (bf16*)(wl + WL_FFNOUT), FF, nb * 32, kb * 64, scr, F.lane); continue; } r -= I_FFNOUT;
        if (r < I_MOEIN) { const int e = r / I_FFNIN, r2 = r % I_FFNIN; const int nb = r2 % (NFF2 / 32), kb = r2 / (NFF2 / 32); map_swiglu(nb * 32, c0, nv);
            transpose_item(a.in[19] + ((size_t)j * NE + e) * D * NFF2, NFF2, D, c0, nv, (bf16*)(wl + WL_MOEIN) + (size_t)e * NFF2 * D, D, nb * 32, kb * 64, scr, F.lane); continue; } r -= I_MOEIN;
        { const int e = r / I_FFNOUT, r2 = r % I_FFNOUT; const int nb = r2 % (D / 32), kb = r2 / (D / 32);
            transpose_item(a.in[20] + ((size_t)j * NE + e) * FF * D, D, FF, nb * 32, 32, (bf16*)(wl + WL_MOEOUT) + (size_t)e * D * FF, FF, nb * 32, kb * 64, scr, F.lane); }
    }
    bf16* HB = (bf16*)(F.ws + WS_HB);
    for (int m = gw; m < MROWS; m += NGW) {
        const float* src = m < MMAIN ? a.in[0] + (size_t)m * D : a.in[1] + (size_t)(m - MMAIN) * D;
#pragma unroll
        for (int q = 0; q < 4; ++q) { const f32x4 v = *(const f32x4*)(src + 4 * F.lane + 256 * q);
            v2u w; w.x = pk2(v[0], v[1]); w.y = pk2(v[2], v[3]); *(v2u*)(HB + (size_t)m * D + 4 * F.lane + 256 * q) = w; }
    }
}

struct LnRow { v4u h[2], a[2], b[2]; float w1, w2; };
__device__ __forceinline__ void unpack8(const v4u& w, float* o) { o[0] = bflo(w.x); o[1] = bfhi(w.x); o[2] = bflo(w.y); o[3] = bfhi(w.y); o[4] = bflo(w.z); o[5] = bfhi(w.z); o[6] = bflo(w.w); o[7] = bfhi(w.w); }
__device__ __forceinline__ void ln_phase(Frame& F, int mixkind, const float* gam, const float* bet, int extra, const float* Wx, int ldx, float* outp, gu32* moe_cnt) {
    bf16* HB = (bf16*)(F.ws + WS_HB); const bf16* MIX = (const bf16*)(F.ws + WS_MIX);
    const bf16* YS = (const bf16*)(F.ws + WS_S0 + S_YS);
    int* E1 = (int*)(F.ws + WS_RT); int* E2 = E1 + MROWS; float* W1 = (float*)(E2 + MROWS); float* W2 = W1 + MROWS; int* POS1 = (int*)(W2 + MROWS); int* POS2 = POS1 + MROWS;
    float* Z = (float*)(F.ws + WS_Z);
    LAS float* WL = (LAS float*)F.lds;
    LAS unsigned* lcnt = (LAS unsigned*)(F.lds + 65536);
    const int NC = extra == 1 ? 16 : (extra == 2 ? 8 : 0);
    if (extra) { for (int i = F.tid; i < NC * D; i += NTHR) { const int e = i / D, c = i % D; WL[e * D + c] = Wx[(size_t)c * ldx + e]; }
        if (F.tid < 8) lcnt[F.tid] = 0u;
        __syncthreads(); }
    const int gw = F.bx * NWAVES + F.wave, NGW = F.G * NWAVES, lane = F.lane;
    float gv[16], bv[16];
#pragma unroll
    for (int q = 0; q < 2; ++q)
#pragma unroll
        for (int t = 0; t < 2; ++t) { const f32x4 g4 = *(const f32x4*)(gam + 512 * q + 8 * lane + 4 * t), b4 = *(const f32x4*)(bet + 512 * q + 8 * lane + 4 * t);
#pragma unroll
            for (int k = 0; k < 4; ++k) { gv[8 * q + 4 * t + k] = g4[k]; bv[8 * q + 4 * t + k] = b4[k]; } }
    unsigned mycnt = 0u;
    auto ln_load = [&](LnRow (&R)[2], int m0) {
#pragma unroll
        for (int r = 0; r < 2; ++r) { const int m = m0 + r * NGW; if (m < MROWS) {
            const bf16* hp = HB + (size_t)m * D + 8 * lane; R[r].h[0] = *(const v4u*)hp; R[r].h[1] = *(const v4u*)(hp + 512);
            if (mixkind == 1) { const bf16* mp = MIX + (size_t)m * D + 8 * lane; R[r].a[0] = *(const v4u*)mp; R[r].a[1] = *(const v4u*)(mp + 512); }
            if (mixkind == 2) { R[r].w1 = W1[m]; R[r].w2 = W2[m]; const bf16* y1 = YS + (size_t)POS1[m] * D + 8 * lane; const bf16* y2 = YS + (size_t)POS2[m] * D + 8 * lane;
                R[r].a[0] = *(const v4u*)y1; R[r].a[1] = *(const v4u*)(y1 + 512); R[r].b[0] = *(const v4u*)y2; R[r].b[1] = *(const v4u*)(y2 + 512); } } }
    };
    LnRow Rn[2];
    ln_load(Rn, gw);
    for (int m0 = gw; m0 < MROWS; m0 += 2 * NGW) {
        LnRow R[2];
#pragma unroll
        for (int r = 0; r < 2; ++r) R[r] = Rn[r];
        ln_load(Rn, m0 + 2 * NGW);
#pragma unroll
        for (int r = 0; r < 2; ++r) { const int m = m0 + r * NGW; if (m < MROWS) {
            float v[16]; unpack8(R[r].h[0], v); unpack8(R[r].h[1], v + 8);
#pragma unroll
            for (int k = 0; k < 16; ++k) v[k] *= ALPHA;
            if (mixkind == 1) { float t[16]; unpack8(R[r].a[0], t); unpack8(R[r].a[1], t + 8);
#pragma unroll
                for (int k = 0; k < 16; ++k) v[k] += t[k]; }
            if (mixkind == 2) { float t[16], u[16]; unpack8(R[r].a[0], t); unpack8(R[r].a[1], t + 8); unpack8(R[r].b[0], u); unpack8(R[r].b[1], u + 8);
#pragma unroll
                for (int k = 0; k < 16; ++k) v[k] += t[k] * R[r].w1 + u[k] * R[r].w2; }
            float s = 0.f;
#pragma unroll
            for (int k = 0; k < 16; ++k) s += v[k];
            const float mean = wave_sum(s) * (1.f / D); float s2 = 0.f;
#pragma unroll
            for (int k = 0; k < 16; ++k) { v[k] -= mean; s2 += v[k] * v[k]; }
            const float rstd = __builtin_amdgcn_rsqf(wave_sum(s2) * (1.f / D) + LN_EPS);
#pragma unroll
            for (int k = 0; k < 16; ++k) v[k] = v[k] * rstd * gv[k] + bv[k];
            bf16* op = HB + (size_t)m * D + 8 * lane;
            *(v4u*)op = (v4u){pk2(v[0], v[1]), pk2(v[2], v[3]), pk2(v[4], v[5]), pk2(v[6], v[7])}; *(v4u*)(op + 512) = (v4u){pk2(v[8], v[9]), pk2(v[10], v[11]), pk2(v[12], v[13]), pk2(v[14], v[15])};
            if (outp && m < MMAIN) { float* o = outp + (size_t)m * D + 8 * lane;
                *(f32x4*)o = (f32x4){v[0], v[1], v[2], v[3]}; *(f32x4*)(o + 4) = (f32x4){v[4], v[5], v[6], v[7]}; *(f32x4*)(o + 512) = (f32x4){v[8], v[9], v[10], v[11]}; *(f32x4*)(o + 516) = (f32x4){v[12], v[13], v[14], v[15]}; }
            if (extra) {
                float pp[16];
#pragma unroll
                for (int e = 0; e < 16; ++e) { pp[e] = 0.f; if (e < NC) { float p = 0.f;
#pragma unroll
                        for (int q = 0; q < 2; ++q) { const f32x4 w0 = *(const LAS f32x4*)(WL + e * D + 512 * q + 8 * lane), w1 = *(const LAS f32x4*)(WL + e * D + 512 * q + 8 * lane + 4);
                            p += (v[8 * q + 0] * w0[0] + v[8 * q + 1] * w0[1]) + (v[8 * q + 2] * w0[2] + v[8 * q + 3] * w0[3]) + (v[8 * q + 4] * w1[0] + v[8 * q + 5] * w1[1]) + (v[8 * q + 6] * w1[2] + v[8 * q + 7] * w1[3]); }
                        pp[e] = p; } }
                float lg[8]; float zv;
                if (extra == 1) {
#pragma unroll
                    for (int k = 0; k < 8; ++k) { const bool up = lane & 32; const float snd = up ? pp[k] : pp[k + 8], kp = up ? pp[k + 8] : pp[k]; pp[k] = kp + __shfl_xor(snd, 32); }
#pragma unroll
                    for (int k = 0; k < 4; ++k) { const bool up = lane & 16; const float snd = up ? pp[k] : pp[k + 4], kp = up ? pp[k + 4] : pp[k]; pp[k] = kp + __shfl_xor(snd, 16); }
#pragma unroll
                    for (int k = 0; k < 2; ++k) { const bool up = lane & 8; const float snd = up ? pp[k] : pp[k + 2], kp = up ? pp[k + 2] : pp[k]; pp[k] = kp + __shfl_xor(snd, 8); }
                    { const bool up = lane & 4; const float snd = up ? pp[0] : pp[1], kp = up ? pp[1] : pp[0]; zv = kp + __shfl_xor(snd, 4); }
                    zv += __shfl_xor(zv, 2); zv += __shfl_xor(zv, 1);
                } else {
#pragma unroll
                    for (int k = 0; k < 4; ++k) { const bool up = lane & 32; const float snd = up ? pp[k] : pp[k + 4], kp = up ? pp[k + 4] : pp[k]; pp[k] = kp + __shfl_xor(snd, 32); }
#pragma unroll
                    for (int k = 0; k < 2; ++k) { const bool up = lane & 16; const float snd = up ? pp[k] : pp[k + 2], kp = up ? pp[k + 2] : pp[k]; pp[k] = kp + __shfl_xor(snd, 16); }
                    float rv; { const bool up = lane & 8; const float snd = up ? pp[0] : pp[1], kp = up ? pp[1] : pp[0]; rv = kp + __shfl_xor(snd, 8); }
                    rv += __shfl_xor(rv, 4); rv += __shfl_xor(rv, 2); rv += __shfl_xor(rv, 1);
#pragma unroll
                    for (int e = 0; e < 8; ++e) lg[e] = __int_as_float(__builtin_amdgcn_readlane(__float_as_int(rv), ((e >> 2) & 1) * 32 + ((e >> 1) & 1) * 16 + (e & 1) * 8));
                }
                if (extra == 1) { if ((lane & 3) == 0) Z[(size_t)m * 16 + ((lane >> 5) & 1) * 8 + ((lane >> 4) & 1) * 4 + ((lane >> 3) & 1) * 2 + ((lane >> 2) & 1)] = zv; }
                else { int e1 = 0; float l1 = lg[0];
#pragma unroll
                    for (int e = 1; e < 8; ++e) if (lg[e] > l1) { l1 = lg[e]; e1 = e; }
                    int e2 = -1; float l2 = -3.0e38f;
#pragma unroll
                    for (int e = 0; e < 8; ++e) if (e != e1 && lg[e] > l2) { l2 = lg[e]; e2 = e; }
                    const float w2 = 1.f / (1.f + __expf(l1 - l2)), w1 = 1.f - w2;
                    if (lane == 0) { E1[m] = e1; E2[m] = e2; W1[m] = w1; W2[m] = w2; }
                    mycnt += (lane == e1 || lane == e2) ? 1u : 0u; }
            } } }
    }
    if (extra == 2) { if (lane < 8 && mycnt) __hip_atomic_fetch_add(&lcnt[lane], mycnt, __ATOMIC_RELAXED, __HIP_MEMORY_SCOPE_WORKGROUP);
        __syncthreads();
        if (F.tid < 8 && lcnt[F.tid]) __hip_atomic_fetch_add(moe_cnt + F.tid, lcnt[F.tid], RLX_AGENT); }
}

struct EpiGates {
    static constexpr bool PERM = true, PAIR = true;
    bf16* LOGA; bf16* U; const bf16* XC; const float* bg; const float* lam;
    __device__ __forceinline__ void chan4(int ch, f32x4& br, f32x4& bi, f32x4& c8) const {
        br = *(const f32x4*)(bg + ch); bi = *(const f32x4*)(bg + RGW + ch); const f32x4 lm = *(const f32x4*)(lam + ch);
#pragma unroll
        for (int t = 0; t < 4; ++t) { const float x = __expf(-lm[t]); c8[t] = -8.0f * (x * (1.0f - x * (0.5f - x * (0.33333333f - 0.25f * x)))); }
    }
    __device__ __forceinline__ void elem4(int row, int blk, int d, f32x4 ra, f32x4 ia, const f32x4& br, const f32x4& bi, const f32x4& c8) const {
        const int ch = blk * RGBW + d;
        const v2u xw = *(const v2u*)(XC + (size_t)row * XCW + blk * 256 + d);
        const float xc[4] = {bflo(xw.x), bfhi(xw.x), bflo(xw.y), bfhi(xw.y)};
        f32x4 la, uu;
#pragma unroll
        for (int t = 0; t < 4; ++t) {
            const float r = sigmoid_f(ra[t] + br[t]), ig = sigmoid_f(ia[t] + bi[t]);
            const float l = c8[t] * r;
            const float a2 = fast_exp(2.0f * l);
            la[t] = l; uu[t] = __builtin_amdgcn_sqrtf(fmaxf(1.0f - a2, 0.f)) * (ig * xc[t]);
        }
        *(v2u*)(LOGA + (size_t)row * RGW + ch) = (v2u){pk2(la[0], la[1]), pk2(la[2], la[3])}; *(v2u*)(U + (size_t)row * RGW + ch) = (v2u){pk2(uu[0], uu[1]), pk2(uu[2], uu[3])};
    }
    __device__ __forceinline__ void operator()(const f32x4 (&acc)[2][2][4][2], const pg8::Unit& u, int wr, int wc, int fr, int fq) const {
        const int row0 = u.pm * 256 + wr * 64 + fr, blk = u.pn >> 1, d0 = (u.pn & 1) * 128 + wc * 32 + 8 * fq;
#pragma unroll
        for (int n = 0; n < 2; ++n) { const int d = d0 + 4 * n; if (d < RGBW) {
            f32x4 br, bi, c8; chan4(blk * RGBW + d, br, bi, c8);
#pragma unroll
            for (int ai = 0; ai < 2; ++ai)
#pragma unroll
                for (int m = 0; m < 4; ++m) elem4(row0 + ai * 128 + m * 16, blk, d, acc[ai][0][m][n], acc[ai][1][m][n], br, bi, c8); } }
    }
    __device__ __forceinline__ void meta_task(int task, int& r0, int& aoff) const { const int pn = task >> 3; r0 = pn * 256 + (task & 7) * 16; aoff = (pn >> 1) * 256; }
    __device__ __forceinline__ void meta(int task, f32x4 a0, f32x4 a1, int fr, int fq) const {
        const int pn = task >> 3, d = (pn & 1) * 128 + (task & 7) * 16 + 4 * fq;
        if (d < RGBW) { f32x4 br, bi, c8; chan4((pn >> 1) * RGBW + d, br, bi, c8); elem4(MMAIN + fr, pn >> 1, d, a0, a1, br, bi, c8); }
    }
};

__device__ __forceinline__ int conv_src_row(int row, int delta) {
    if (row < MMAIN) { const int t = row & (SEQ - 1); return (t - delta >= 0) ? row - delta : MMAIN + NMETA + (t - delta); }
    const int jm = row - MMAIN; return (jm - delta >= 0) ? row - delta : -1;
}
__device__ __forceinline__ void rg_conv_phase(Frame& F, const float* cw, const float* cb) {
    const bf16* PROJ = (const bf16*)(F.ws + WS_S0 + S_PROJ); bf16* XC = (bf16*)(F.ws + WS_S0 + S_XC);
    const int g = F.tid & 255, blk = g >> 5, kk = (g & 31) * 8, ch = blk * RGBW + kk;
    constexpr int NIT = (MROWS / 4) * 256;
    const int stride = F.G * NTHR;
    if (kk < RGBW) {
        float w[4][8], bb[8];
        { const f32x4 b0 = *(const f32x4*)(cb + ch), b1 = *(const f32x4*)(cb + ch + 4);
#pragma unroll
          for (int k = 0; k < 4; ++k) { bb[k] = b0[k]; bb[4 + k] = b1[k]; } }
#pragma unroll
        for (int tap = 0; tap < 4; ++tap) { const f32x4 w0 = *(const f32x4*)(cw + tap * RGW + ch), w1 = *(const f32x4*)(cw + tap * RGW + ch + 4);
#pragma unroll
            for (int k = 0; k < 4; ++k) { w[tap][k] = w0[k]; w[tap][4 + k] = w1[k]; } }
        for (int idx = F.bx * NTHR + F.tid; idx < NIT; idx += 2 * stride) {
            v4u x[2][7];
#pragma unroll
            for (int it = 0; it < 2; ++it) { const int id2 = idx + it * stride; if (id2 < NIT) { const int r0 = (id2 >> 8) * 4;
#pragma unroll
                for (int t = 0; t < 3; ++t) { const int rr = conv_src_row(r0, 3 - t); x[it][t] = (v4u){0u, 0u, 0u, 0u}; if (rr >= 0) x[it][t] = *(const v4u*)(PROJ + (size_t)rr * NRG + RGW + ch); }
#pragma unroll
                for (int t = 0; t < 4; ++t) x[it][3 + t] = *(const v4u*)(PROJ + (size_t)(r0 + t) * NRG + RGW + ch); } }
#pragma unroll
            for (int it = 0; it < 2; ++it) { const int id2 = idx + it * stride; if (id2 < NIT) { const int r0 = (id2 >> 8) * 4;
                bf16* xo = XC + (size_t)r0 * XCW + blk * 256 + kk;
                float xf[7][8];
#pragma unroll
                for (int t = 0; t < 7; ++t) unpack8(x[it][t], xf[t]);
#pragma unroll
                for (int i = 0; i < 4; ++i) { float a[8];
#pragma unroll
                    for (int k = 0; k < 8; ++k) a[k] = bb[k] + xf[i][k] * w[0][k] + xf[i + 1][k] * w[1][k] + xf[i + 2][k] * w[2][k] + xf[i + 3][k] * w[3][k];
                    *(v4u*)(xo + (size_t)i * XCW) = (v4u){pk2(a[0], a[1]), pk2(a[2], a[3]), pk2(a[4], a[5]), pk2(a[6], a[7])}; } } }
        }
    } else {
        for (int idx = F.bx * NTHR + F.tid; idx < NIT; idx += stride) { bf16* xo = XC + (size_t)((idx >> 8) * 4) * XCW + blk * 256 + kk;
#pragma unroll
            for (int i = 0; i < 4; ++i) *(v4u*)(xo + (size_t)i * XCW) = (v4u){0u, 0u, 0u, 0u}; }
    }
}
template <bool FIX>
__device__ __forceinline__ void rg_scan_phase(Frame& F) {
    const bf16* LOGA = (const bf16*)(F.ws + WS_S0 + S_LOGA); const bf16* U = (const bf16*)(F.ws + WS_S0 + S_U);
    const bf16* PROJ = (const bf16*)(F.ws + WS_S0 + S_PROJ); bf16* Y = (bf16*)(F.ws + WS_S0 + S_Y);
    float* AGGA = (float*)(F.ws + WS_AGG); float* AGGH = AGGA + (size_t)NSEG * RGW;
    const int gw = F.bx * NWAVES + F.wave, NGW = F.G * NWAVES;
    constexpr int NCG = 11, RB = FIX ? 16 : 32;
    for (int task = gw; task < NSEG * NCG; task += NGW) {
        const int seg = task / NCG, cg = task - seg * NCG, ch = cg * 128 + 2 * F.lane;
        const int row0 = seg == 0 ? MMAIN : (seg - 1) * SEG, nrows = seg == 0 ? NMETA : SEG;
        if (ch >= RGW) {
            if (FIX) for (int r = 0; r < nrows; ++r) *(unsigned*)(Y + (size_t)(row0 + r) * KRGO + ch) = 0u;
            continue;
        }
        float h0 = 0.f, h1 = 0.f, c0 = 0.f, c1 = 0.f;
        if (FIX && seg > 0) {
            { const f32x2 hm = *(const f32x2*)(AGGH + ch); h0 = hm[0]; h1 = hm[1]; }
            const int sb = 1 + ((seg - 1) / NSEG_B) * NSEG_B, ns = (seg - 1) % NSEG_B;
            for (int q = 0; q < ns; q += 8) { f32x2 aa[8], hh[8];
#pragma unroll
                for (int t = 0; t < 8; ++t) { const int qq = (q + t < ns) ? q + t : ns - 1; aa[t] = *(const f32x2*)(AGGA + (size_t)(sb + qq) * RGW + ch); hh[t] = *(const f32x2*)(AGGH + (size_t)(sb + qq) * RGW + ch); }
#pragma unroll
                for (int t = 0; t < 8; ++t) if (q + t < ns) { h0 = __expf(aa[t][0]) * h0 + hh[t][0]; h1 = __expf(aa[t][1]) * h1 + hh[t][1]; } }
        }
        for (int r = 0; r < nrows; r += RB) {
            unsigned la[RB], uu[RB], gt[RB];
#pragma unroll
            for (int t = 0; t < RB; ++t) { const int rr = row0 + ((r + t < nrows) ? r + t : nrows - 1); const size_t o = (size_t)rr * RGW + ch; la[t] = *(const unsigned*)(LOGA + o); uu[t] = *(const unsigned*)(U + o); if (FIX) gt[t] = *(const unsigned*)(PROJ + (size_t)rr * NRG + ch); }
#pragma unroll
            for (int t = 0; t < RB; ++t) if (r + t < nrows) { const float l0 = bflo(la[t]), l1 = bfhi(la[t]);
                h0 = __expf(l0) * h0 + bflo(uu[t]); h1 = __expf(l1) * h1 + bfhi(uu[t]); c0 += l0; c1 += l1;
                if (FIX) *(unsigned*)(Y + (size_t)(row0 + r + t) * KRGO + ch) = pk2(h0 * bflo(gt[t]), h1 * bfhi(gt[t])); }
        }
        if (!FIX) { *(f32x2*)(AGGA + (size_t)seg * RGW + ch) = (f32x2){c0, c1}; *(f32x2*)(AGGH + (size_t)seg * RGW + ch) = (f32x2){h0, h1}; }
    }
}

#define RG_PHASES \
        if (IN(pb + 0)) { if (on_rg) { \
            bf16* PROJ = (bf16*)(F.ws + WS_S0 + S_PROJ); EpiBf16Gelu E{PROJ, NRG, RGW}; \
            meta_gemm(F, HB + (size_t)MMAIN * D, D, D, (const bf16*)(wl + WL_RGIN), NRG / 16, E); \
            pg8::Gemm g{D, D}; pg8::DenseOrder S; S.init(HB, D, (const bf16*)(wl + WL_RGIN), D, MMAIN / 256, NRG / 256, F.G, F.bx); \
            pg8::gemm_phase<EpiBf16Gelu, pg8::DenseOrder>(F.lds, F.tid, g, S, E); } \
            SEAM(pb + 0); } \
        if (IN(pb + 1)) { if (on_rg) rg_conv_phase(F, args.in[5] + (size_t)j * 4 * RGW, args.in[6] + (size_t)j * RGW); SEAM(pb + 1); } \
        if (IN(pb + 2)) { if (on_rg) { \
            const bf16* XC = (const bf16*)(F.ws + WS_S0 + S_XC); \
            EpiGates E{(bf16*)(F.ws + WS_S0 + S_LOGA), (bf16*)(F.ws + WS_S0 + S_U), XC, args.in[8] + (size_t)j * 2 * RGW, args.in[9] + (size_t)j * RGW}; \
            meta_gemm(F, XC + (size_t)MMAIN * XCW, XCW, KGT, (const bf16*)(wl + WL_GATES), (NGT / 256) * 8, E); \
            pg8::Gemm g{KGT, XCW}; pg8::GatesOrder S; S.init(XC, XCW, (const bf16*)(wl + WL_GATES), KGT, MMAIN / 256, NGT / 256, F.G, F.bx); \
            pg8::gemm_phase<EpiGates, pg8::GatesOrder>(F.lds, F.tid, g, S, E); } \
            SEAM(pb + 2); } \
        if (IN(pb + 3)) { if (on_rg) rg_scan_phase<false>(F); SEAM(pb + 3); } \
        if (IN(pb + 4)) { if (on_rg) rg_scan_phase<true>(F); SEAM(pb + 4); } \
        if (IN(pb + 5)) { if (on_rg) { \
            const bf16* Y = (const bf16*)(F.ws + WS_S0 + S_Y); EpiBf16Gelu E{MIX, D, 0}; \
            meta_gemm(F, Y + (size_t)MMAIN * KRGO, KRGO, KRGO, (const bf16*)(wl + WL_RGOUT), D / 16, E); \
            pg8::Gemm g{KRGO, KRGO}; pg8::DenseOrder S; S.init(Y, KRGO, (const bf16*)(wl + WL_RGOUT), KRGO, MMAIN / 256, D / 256, F.G, F.bx); \
            pg8::gemm_phase<EpiBf16Gelu, pg8::DenseOrder>(F.lds, F.tid, g, S, E); } \
            SEAM(pb + 5); }

constexpr int GL_QT = 0, GL_KT = 17408  , GL_KTT = 34816, GL_VT = 53248, GL_ST = 90112  , GL_SM = 155648;
constexpr int QTS = 136, KTTS = 72, VTS = 72, PS = 72, BS = 129;
constexpr int GL_NG = GL_SM + 2048  , GL_WG = GL_NG + 1024  ;
static_assert(GL_WG + 4096 <= MISC_OFF, "GLA LDS map (unit constants)");
static_assert(GL_SM + 2560 <= MISC_OFF, "GLA LDS map");

#define GL_BAR() do { asm volatile("s_waitcnt lgkmcnt(0)" ::: "memory"); __builtin_amdgcn_s_barrier(); asm volatile("" ::: "memory"); __builtin_amdgcn_sched_barrier(0); } while (0)
template <int MODE>
__device__ __forceinline__ void gla_phase(Frame& F, const float* wgu, const float* bgate, const float* normg) {
    const bf16* QKVR = (const bf16*)(F.ws + WS_S0 + S_QKVR); const float* Z = (const float*)(F.ws + WS_Z);
    float* KVS = (float*)(F.ws + WS_S0 + S_KVS); const float* SST = (const float*)(F.ws + WS_S0 + S_SST); float* DEC = (float*)(F.ws + WS_S0 + S_DEC);
    bf16* O = (bf16*)(F.ws + WS_S0 + S_O);
    float* XB = (float*)(F.ws + WS_S0 + S_XB); float* EMF = (float*)(F.ws + WS_S0 + S_EMF);
    LAS bf16* QT = (LAS bf16*)(F.lds + GL_QT); LAS bf16* KT = (LAS bf16*)(F.lds + GL_KT); LAS bf16* PP = (LAS bf16*)(F.lds + GL_KT);
    LAS bf16* KTT = (LAS bf16*)(F.lds + GL_KTT); LAS bf16* VT = (LAS bf16*)(F.lds + GL_VT); LAS unsigned char* ST = F.lds + GL_ST;
    LAS float* Bc = (LAS float*)(F.lds + GL_ST); LAS float* ZC = (LAS float*)(F.lds + GL_ST + 36864); LAS float* TOT = (LAS float*)(F.lds + GL_ST + 40960); LAS float* OFFM = (LAS float*)(F.lds + GL_ST + 43520);
    LAS float* em = (LAS float*)(F.lds + GL_SM); LAS float* ef = em + 128; LAS float* stats = ef + 128;
    LAS float* NGL = (LAS float*)(F.lds + GL_NG); LAS bf16* WGL = (LAS bf16*)(F.lds + GL_WG);
    const int tid0 = F.tid;
#ifdef MK_GLA_SEG
    int glt_cur = -1; unsigned long long glt_t = 0ull;
#define GLT(n) do { if (MODE == (MK_GLA_MODE)) { const unsigned long long t_ = __builtin_amdgcn_s_memrealtime(); if (glt_cur == (MK_GLA_SEG)) F.dbg_acc += t_ - glt_t; glt_cur = (n); glt_t = t_; } } while (0)
#else
#define GLT(n)
#endif
    for (int u = F.bx; u < NGU; u += F.G) {
        const bool meta = u >= BATCH * GH * NSC_BH;
        const int h = meta ? u - BATCH * GH * NSC_BH : (u / NSC_BH) % GH, b = meta ? 0 : u / (GH * NSC_BH), sc = meta ? 0 : u % NSC_BH;
        const int nch = meta ? 1 : CPS;
        f32x4 sacc[8][2];
        int lofs = (4 * ((tid0 & 63) >> 4)) * GDV + 32 * (tid0 >> 6) + (tid0 & 15); asm volatile("" : "+v"(lofs));
#pragma unroll
        for (int dt = 0; dt < 8; ++dt)
#pragma unroll
            for (int i = 0; i < 2; ++i) {
                sacc[dt][i] = (f32x4){0.f, 0.f, 0.f, 0.f};
                if (MODE == 1 && !meta) {
#pragma unroll
                    for (int jj = 0; jj < 4; ++jj) sacc[dt][i][jj] = SST[(size_t)u * (GDK * GDV) + (size_t)((16 * dt + jj) * GDV + 16 * i) + lofs]; }
            }
        float dsum = 0.f;
        if (MODE == 1 && tid0 < 256) NGL[tid0] = normg[h * GDV + tid0];
        for (int i = tid0; i < 16 * GDK; i += NTHR) WGL[i] = (bf16)f2bf(wgu[(size_t)(i >> 7) * GQK + h * GDK + (i & 127)]);
        const float bgv = bgate[h * GDK + (tid0 & 127)];
        f32x4 px[4] = {(f32x4){0.f, 0.f, 0.f, 0.f}, (f32x4){0.f, 0.f, 0.f, 0.f}, (f32x4){0.f, 0.f, 0.f, 0.f}, (f32x4){0.f, 0.f, 0.f, 0.f}}; float pem = 0.f, pef = 0.f;
        f32x4 pz = (f32x4){0.f, 0.f, 0.f, 0.f}; v4u pq0 = (v4u){0u, 0u, 0u, 0u}, pq1 = pq0, pk0 = pq0, pk1 = pq0, pv[4] = {pq0, pq0, pq0, pq0};
#define GLA_PREFETCH(cix) do { const int rb_ = meta ? 0 : b * SEQ + (sc * CPS + (cix)) * 64; \
            const size_t chx_ = meta ? (size_t)(BATCH * GH * (SEQ / 64) + h) : (size_t)((b * GH + h) * (SEQ / 64) + sc * CPS + (cix)); \
            if (MODE == 1) { const float* xp_ = XB + chx_ * (64 * GDK) + (size_t)(tid0 & 63) * GDK + (tid0 >> 6) * 16; \
              _Pragma("unroll") for (int t_ = 0; t_ < 4; ++t_) px[t_] = *(const f32x4*)(xp_ + 4 * t_); \
              if (tid0 < 128) { pem = EMF[chx_ * 256 + tid0]; pef = EMF[chx_ * 256 + 128 + tid0]; } } \
            { const int c_ = tid0 >> 2, part_ = tid0 & 3; const bool ok_ = (tid0 < 256) && (!meta || c_ >= 48); const int row_ = meta ? MMAIN + c_ - 48 : rb_ + c_; \
              pz = (f32x4){0.f, 0.f, 0.f, 0.f}; if (MODE == 0 && ok_) pz = *(const f32x4*)(Z + (size_t)row_ * 16 + 4 * part_); } \
            { const int cC_ = tid0 & 63, g_ = tid0 >> 6; const bool ok_ = !meta || cC_ >= 48; const int row_ = meta ? MMAIN + cC_ - 48 : rb_ + cC_; const bf16* rp_ = QKVR + (size_t)row_ * NGLA; \
              pq0 = (v4u){0u, 0u, 0u, 0u}; pq1 = pq0; pk0 = pq0; pk1 = pq0; pv[0] = pq0; pv[1] = pq0; pv[2] = pq0; pv[3] = pq0; \
              if (ok_) { if (MODE == 1) { pq0 = *(const v4u*)(rp_ + h * GDK + g_ * 16); pq1 = *(const v4u*)(rp_ + h * GDK + g_ * 16 + 8); } \
                  pk0 = *(const v4u*)(rp_ + GQK + h * GDK + g_ * 16); pk1 = *(const v4u*)(rp_ + GQK + h * GDK + g_ * 16 + 8); \
                  _Pragma("unroll") for (int t_ = 0; t_ < 4; ++t_) pv[t_] = *(const v4u*)(rp_ + 2 * GQK + h * GDV + g_ * 32 + 8 * t_); } } } while (0)
        GLA_PREFETCH(0);
        for (int ci = 0; ci < nch; ++ci) {
            int tid = tid0; asm volatile("" : "+v"(tid));
            const int lane = tid & 63, w = __builtin_amdgcn_readfirstlane(tid >> 6), fr = lane & 15, fq = lane >> 4;
            const int rbase = meta ? 0 : b * SEQ + (sc * CPS + ci) * 64;
            GLT(0);
            const int dA = tid & 127, cgp = tid >> 7;
            const int cC = tid & 63, grp = tid >> 6, d0 = grp * 16, e0 = grp * 32;
            const v4u q0 = pq0, q1 = pq1, k0 = pk0, k1 = pk1, vv[4] = {pv[0], pv[1], pv[2], pv[3]};
            const size_t chx = meta ? (size_t)(BATCH * GH * (SEQ / 64) + h) : (size_t)((b * GH + h) * (SEQ / 64) + sc * CPS + ci);
            f32x4 xr4[4] = {px[0], px[1], px[2], px[3]};
            if (MODE == 1) { if (tid < 128) { em[tid] = pem; ef[tid] = pef; } }
            if (MODE == 0) {
            if (tid < 256) *(LAS f32x4*)(ZC + (tid >> 2) * 16 + 4 * (tid & 3)) = pz;
            GL_BAR();
            float wg[16];
#pragma unroll
            for (int i = 0; i < 16; ++i) wg[i] = bf2f(WGL[i * GDK + dA]);
            { float run = 0.f;
#pragma unroll 4
              for (int cc = 0; cc < 16; ++cc) { const int c = cgp * 16 + cc; float lg = bgv;
#pragma unroll
                for (int i4 = 0; i4 < 4; ++i4) { const f32x4 z4 = *(const LAS f32x4*)(ZC + c * 16 + 4 * i4); lg += (z4[0] * wg[4 * i4] + z4[1] * wg[4 * i4 + 1]) + (z4[2] * wg[4 * i4 + 2] + z4[3] * wg[4 * i4 + 3]); }
                float g = (fminf(lg, 0.f) - __logf(1.0f + __expf(-fabsf(lg)))) * (1.0f / 16.0f);
                if (meta && c < 48) g = 0.f;
                run += g; Bc[c * BS + dA] = run; }
              TOT[cgp * 129 + dA] = run; }
            GL_BAR();
            GLT(1);
            if (tid < 128) { const float t0 = TOT[tid], t1 = TOT[129 + tid], t2 = TOT[258 + tid], t3 = TOT[387 + tid];
                const float bm = t0 + Bc[31 * BS + tid], bl = (t0 + t1) + (t2 + t3);
                const float emv_ = __expf(bm), efv_ = __expf(bl - bm); em[tid] = emv_; ef[tid] = efv_; dsum += bl; EMF[chx * 256 + tid] = emv_; EMF[chx * 256 + 128 + tid] = efv_;
                OFFM[tid] = -bm; OFFM[129 + tid] = t0 - bm; OFFM[258 + tid] = t0 + t1 - bm; OFFM[387 + tid] = t0 + t1 + t2 - bm; }
            GL_BAR();
            }
            GLT(2);
            { const int c = cC;
                const unsigned qw[8] = {q0.x, q0.y, q0.z, q0.w, q1.x, q1.y, q1.z, q1.w}, kw[8] = {k0.x, k0.y, k0.z, k0.w, k1.x, k1.y, k1.z, k1.w};
                unsigned qo[8], ko[8];
                const LAS float* bcr = Bc + c * BS + d0; const LAS float* ofr = OFFM + (c >> 4) * 129 + d0;
#pragma unroll
                for (int t = 0; t < 8; ++t) {
                    const int d = d0 + 2 * t;
                    float x0, x1;
                    if (MODE == 0) { x0 = bcr[2 * t] + ofr[2 * t]; x1 = bcr[2 * t + 1] + ofr[2 * t + 1]; xr4[t >> 1][2 * (t & 1)] = x0; xr4[t >> 1][2 * (t & 1) + 1] = x1; }
                    else { x0 = xr4[t >> 1][2 * (t & 1)]; x1 = xr4[t >> 1][2 * (t & 1) + 1]; }
                    const float e0f = __expf(x0), e1f = __expf(x1), r0 = __expf(-x0), r1 = __expf(-x1);
                    const float ka = bflo(kw[t]) * r0, kb = bfhi(kw[t]) * r1;
                    ko[t] = pk2(ka, kb);
                    if (MODE == 1) qo[t] = pk2(bflo(qw[t]) * (0.08838834764831845f * e0f), bfhi(qw[t]) * (0.08838834764831845f * e1f));
                    KTT[(d) * KTTS + c] = (bf16)(ko[t] & 0xffffu); KTT[(d + 1) * KTTS + c] = (bf16)(ko[t] >> 16);
                }
                if (MODE == 0) { float* xp = XB + chx * (64 * GDK) + (size_t)c * GDK + d0;
#pragma unroll
                    for (int t = 0; t < 4; ++t) *(f32x4*)(xp + 4 * t) = xr4[t]; }
                *(LAS v4u*)(KT + c * QTS + d0) = (v4u){ko[0], ko[1], ko[2], ko[3]}; *(LAS v4u*)(KT + c * QTS + d0 + 8) = (v4u){ko[4], ko[5], ko[6], ko[7]};
                if (MODE == 1) { *(LAS v4u*)(QT + c * QTS + d0) = (v4u){qo[0], qo[1], qo[2], qo[3]}; *(LAS v4u*)(QT + c * QTS + d0 + 8) = (v4u){qo[4], qo[5], qo[6], qo[7]}; }
#pragma unroll
                for (int t = 0; t < 4; ++t) { const unsigned vw[4] = {vv[t].x, vv[t].y, vv[t].z, vv[t].w};
#pragma unroll
                    for (int s = 0; s < 4; ++s) { const int e = e0 + 8 * t + 2 * s; VT[e * VTS + c] = (bf16)(vw[s] & 0xffffu); VT[(e + 1) * VTS + c] = (bf16)(vw[s] >> 16); } }
            }
            GL_BAR();
            GLT(3);
            f32x4 pacc[2];
#pragma unroll
            for (int dt = 0; dt < 8; ++dt) { const f32x4 emv = *(const LAS f32x4*)(em + 16 * dt + 4 * fq);
#pragma unroll
                for (int i = 0; i < 2; ++i) { sacc[dt][i] = sacc[dt][i] * emv;
                    if (MODE == 1) { const int e = 32 * w + 16 * i + fr; const int ck = (2 * dt + (fq >> 1)) ^ (e & 15);
                        v2u sw; sw.x = pk2(sacc[dt][i][0], sacc[dt][i][1]); sw.y = pk2(sacc[dt][i][2], sacc[dt][i][3]);
                        *(LAS v2u*)(ST + e * 256 + ck * 16 + (fq & 1) * 8) = sw; } } }
            if (MODE == 1) {
                const int mt = w & 3, ntp = w >> 2;
#pragma unroll
                for (int ii = 0; ii < 2; ++ii) { const int nt = 2 * ntp + ii; pacc[ii] = (f32x4){0.f, 0.f, 0.f, 0.f};
                    if (nt <= mt) {
#pragma unroll
                        for (int ks = 0; ks < 4; ++ks) { const bf16x8 kf = *(const LAS bf16x8*)(KT + (16 * nt + fr) * QTS + 32 * ks + 8 * fq); const bf16x8 qf = *(const LAS bf16x8*)(QT + (16 * mt + fr) * QTS + 32 * ks + 8 * fq);
                            pacc[ii] = __builtin_amdgcn_mfma_f32_16x16x32_bf16(kf, qf, pacc[ii], 0, 0, 0); }
                        if (nt == mt) {
#pragma unroll
                            for (int jj = 0; jj < 4; ++jj) if (4 * fq + jj > fr) pacc[ii][jj] = 0.f; }
                    } }
            }
            GL_BAR();
            if (MODE == 1) { const int mt = w & 3, ntp = w >> 2;
#pragma unroll
                for (int ii = 0; ii < 2; ++ii) { const int nt = 2 * ntp + ii; v2u pw; pw.x = pk2(pacc[ii][0], pacc[ii][1]); pw.y = pk2(pacc[ii][2], pacc[ii][3]);
                    *(LAS v2u*)(PP + (16 * mt + fr) * PS + 16 * nt + 4 * fq) = pw; }
                GL_BAR();
            }
            GLT(4);
            f32x4 oacc[8];
            v2u rr[8];
            if (MODE == 1) { const int cF = 16 * (w & 3) + fr; const bool validF = !meta || cF >= 48; const int rowF = meta ? MMAIN + cF - 48 : rbase + cF;
#pragma unroll
                for (int t = 0; t < 8; ++t) { rr[t] = (v2u){0u, 0u}; if (validF) rr[t] = *(const v2u*)(QKVR + (size_t)rowF * NGLA + 2 * GQK + GVD + h * GDV + 128 * (w >> 2) + 16 * t + 4 * fq); } }
            if (MODE == 1) { const int mt = w & 3, eh = w >> 2;
                bf16x8 pf[2], qf[4];
#pragma unroll
                for (int ks = 0; ks < 2; ++ks) pf[ks] = *(const LAS bf16x8*)(PP + (16 * mt + fr) * PS + 32 * ks + 8 * fq);
#pragma unroll
                for (int ks = 0; ks < 4; ++ks) qf[ks] = *(const LAS bf16x8*)(QT + (16 * mt + fr) * QTS + 32 * ks + 8 * fq);
#pragma unroll
                for (int t = 0; t < 8; ++t) { const int e = 128 * eh + 16 * t + fr; f32x4 a = (f32x4){0.f, 0.f, 0.f, 0.f};
#pragma unroll
                    for (int ks = 0; ks < 2; ++ks) { const bf16x8 vf = *(const LAS bf16x8*)(VT + e * VTS + 32 * ks + 8 * fq); a = __builtin_amdgcn_mfma_f32_16x16x32_bf16(vf, pf[ks], a, 0, 0, 0); }
#pragma unroll
                    for (int ks = 0; ks < 4; ++ks) { const int ck = (4 * ks + fq) ^ (e & 15); const bf16x8 sf = *(const LAS bf16x8*)(ST + e * 256 + ck * 16); a = __builtin_amdgcn_mfma_f32_16x16x32_bf16(sf, qf[ks], a, 0, 0, 0); }
                    oacc[t] = a; }
            }
            { bf16x8 vf[2][2];
#pragma unroll
              for (int i = 0; i < 2; ++i)
#pragma unroll
                  for (int ks = 0; ks < 2; ++ks) vf[i][ks] = *(const LAS bf16x8*)(VT + (32 * w + 16 * i + fr) * VTS + 32 * ks + 8 * fq);
#pragma unroll
              for (int dt = 0; dt < 8; ++dt) { const f32x4 efv = *(const LAS f32x4*)(ef + 16 * dt + 4 * fq);
#pragma unroll
                  for (int ks = 0; ks < 2; ++ks) { const bf16x8 kf = *(const LAS bf16x8*)(KTT + (16 * dt + fr) * KTTS + 32 * ks + 8 * fq);
#pragma unroll
                      for (int i = 0; i < 2; ++i) sacc[dt][i] = __builtin_amdgcn_mfma_f32_16x16x32_bf16(kf, vf[i][ks], sacc[dt][i], 0, 0, 0); }
#pragma unroll
                  for (int i = 0; i < 2; ++i) sacc[dt][i] = sacc[dt][i] * efv; }
            }
            if (ci + 1 < nch) GLA_PREFETCH(ci + 1);
            GLT(5);
            if (MODE == 1) { const int mt = w & 3, eh = w >> 2, c = 16 * mt + fr;
                float s1 = 0.f, s2 = 0.f;
#pragma unroll
                for (int t = 0; t < 8; ++t)
#pragma unroll
                    for (int jj = 0; jj < 4; ++jj) { s1 += oacc[t][jj]; s2 += oacc[t][jj] * oacc[t][jj]; }
                s1 += __shfl_xor(s1, 16); s1 += __shfl_xor(s1, 32); s2 += __shfl_xor(s2, 16); s2 += __shfl_xor(s2, 32);
                if (fq == 0) { stats[(c * 2 + eh) * 2 + 0] = s1; stats[(c * 2 + eh) * 2 + 1] = s2; }
                GL_BAR();
                const float t1 = stats[(c * 2 + 0) * 2 + 0] + stats[(c * 2 + 1) * 2 + 0], t2 = stats[(c * 2 + 0) * 2 + 1] + stats[(c * 2 + 1) * 2 + 1];
                const float mean = t1 * (1.0f / GDV), var = fmaxf(t2 * (1.0f / GDV) - mean * mean, 0.f), rstd = __builtin_amdgcn_rsqf(var + LN_EPS);
                const bool valid = !meta || c >= 48; const int row = meta ? MMAIN + c - 48 : rbase + c;
                if (valid) {
#pragma unroll
                    for (int t = 0; t < 8; ++t) { const int e = 128 * eh + 16 * t + 4 * fq;
                        const v2u rw = rr[t];
                        const f32x4 ng = *(const LAS f32x4*)(NGL + e);
                        const float r4[4] = {bflo(rw.x), bfhi(rw.x), bflo(rw.y), bfhi(rw.y)}; float o4[4];
#pragma unroll
                        for (int jj = 0; jj < 4; ++jj) o4[jj] = (oacc[t][jj] - mean) * rstd * ng[jj] * silu_f(r4[jj]);
                        v2u ow; ow.x = pk2(o4[0], o4[1]); ow.y = pk2(o4[2], o4[3]);
                        *(v2u*)(O + (size_t)row * D + h * GDV + e) = ow; } }
            }
            GL_BAR();
            GLT(6);
        }
        if (MODE == 0) {
            int lofs2 = (4 * ((tid0 & 63) >> 4)) * GDV + 32 * (tid0 >> 6) + (tid0 & 15); asm volatile("" : "+v"(lofs2));
#pragma unroll
            for (int dt = 0; dt < 8; ++dt)
#pragma unroll
                for (int i = 0; i < 2; ++i)
#pragma unroll
                    for (int jj = 0; jj < 4; ++jj) KVS[(size_t)u * (GDK * GDV) + (size_t)((16 * dt + jj) * GDV + 16 * i) + lofs2] = sacc[dt][i][jj];
            if (tid0 < 128) DEC[(size_t)u * GDK + tid0] = dsum;
        }
    }
}
__device__ __forceinline__ void gla_scan_phase(Frame& F) {
    const float* KVS = (const float*)(F.ws + WS_S0 + S_KVS); float* SST = (float*)(F.ws + WS_S0 + S_SST); const float* DEC = (const float*)(F.ws + WS_S0 + S_DEC);
    constexpr int NEL = GDK * GDV;
    for (int idx = F.bx * NTHR + F.tid; idx < BATCH * GH * NEL; idx += F.G * NTHR) {
        const int bh = idx / NEL, el = idx - bh * NEL, d = el / GDV, h = bh % GH;
        float s = KVS[(size_t)(BATCH * GH * NSC_BH + h) * NEL + el];
        const size_t ub = (size_t)bh * NSC_BH;
        SST[ub * NEL + el] = s;
        for (int sc = 0; sc + 1 < NSC_BH; sc += 7) { float dv[7], kv[7];
#pragma unroll
            for (int t = 0; t < 7; ++t) { dv[t] = DEC[(ub + sc + t) * GDK + d]; kv[t] = KVS[(ub + sc + t) * NEL + el]; }
#pragma unroll
            for (int t = 0; t < 7; ++t) { s = __expf(dv[t]) * s + kv[t]; SST[(ub + sc + t + 1) * NEL + el] = s; } }
    }
}

#define GLA_PHASES \
        if (IN(pb + 10)) { if (on_gla) { \
            bf16* QKVR = (bf16*)(F.ws + WS_S0 + S_QKVR); EpiBf16Gelu E{QKVR, NGLA, 0}; \
            meta_gemm(F, HB + (size_t)MMAIN * D, D, D, (const bf16*)(wl + WL_GLAIN), NGLA / 16, E); \
            pg8::Gemm g{D, D}; pg8::DenseOrder S; S.init(HB, D, (const bf16*)(wl + WL_GLAIN), D, MMAIN / 256, NGLA / 256, F.G, F.bx); \
            pg8::gemm_phase<EpiBf16Gelu, pg8::DenseOrder>(F.lds, F.tid, g, S, E); } \
            SEAM(pb + 10); } \
        if (IN(pb + 11)) { if (on_gla) gla_phase<0>(F, args.in[12] + (size_t)j * GRANK * GQK, args.in[13] + (size_t)j * GQK, args.in[14] + (size_t)j * GVD); SEAM(pb + 11); } \
        if (IN(pb + 12)) { if (on_gla) gla_scan_phase(F); SEAM(pb + 12); } \
        if (IN(pb + 13)) { if (on_gla) gla_phase<1>(F, args.in[12] + (size_t)j * GRANK * GQK, args.in[13] + (size_t)j * GQK, args.in[14] + (size_t)j * GVD); SEAM(pb + 13); } \
        if (IN(pb + 14)) { if (on_gla) { \
            const bf16* O = (const bf16*)(F.ws + WS_S0 + S_O); EpiBf16Gelu E{MIX, D, 0}; \
            meta_gemm(F, O + (size_t)MMAIN * D, D, D, (const bf16*)(wl + WL_GLAOUT), D / 16, E); \
            pg8::Gemm g{D, D}; pg8::DenseOrder S; S.init(O, D, (const bf16*)(wl + WL_GLAOUT), D, MMAIN / 256, D / 256, F.G, F.bx); \
            pg8::gemm_phase<EpiBf16Gelu, pg8::DenseOrder>(F.lds, F.tid, g, S, E); } \
            SEAM(pb + 14); }

__device__ __forceinline__ void moe_panel_ends(const gu32* cnt, int (&pe)[8]) {
    int acc = 0;
#pragma unroll
    for (int e = 0; e < 8; ++e) { const int c = (int)__hip_atomic_load(cnt + e, RLX_AGENT); acc += (c + 255) >> 8; pe[e] = acc; }
}
__device__ __forceinline__ void moe_gather_phase(Frame& F, gu32* moe) {
    const bf16* HB = (const bf16*)(F.ws + WS_HB); bf16* AS = (bf16*)(F.ws + WS_S0 + S_AS);
    const int* E1 = (const int*)(F.ws + WS_RT); const int* E2 = E1 + MROWS; int* POS1 = (int*)(F.ws + WS_RT) + 4 * MROWS; int* POS2 = POS1 + MROWS;
    LAS unsigned* lcnt = (LAS unsigned*)F.lds; LAS unsigned* lbase = lcnt + 8; LAS int* lpos = (LAS int*)(F.lds + 256);
    const int per = (MROWS + F.G - 1) / F.G, t0 = F.bx * per, nt = (t0 + per <= MROWS) ? per : (MROWS - t0 > 0 ? MROWS - t0 : 0);
    if (F.tid < 8) lcnt[F.tid] = 0u;
    __syncthreads();
    int e1 = 0, e2 = 0; unsigned r1 = 0, r2 = 0;
    if (F.tid < nt) { e1 = E1[t0 + F.tid]; e2 = E2[t0 + F.tid];
        r1 = __hip_atomic_fetch_add(&lcnt[e1], 1u, __ATOMIC_RELAXED, __HIP_MEMORY_SCOPE_WORKGROUP); r2 = __hip_atomic_fetch_add(&lcnt[e2], 1u, __ATOMIC_RELAXED, __HIP_MEMORY_SCOPE_WORKGROUP); }
    __syncthreads();
    if (F.tid < 8) { int ps = 0, accp = 0;
#pragma unroll
        for (int e = 0; e < 8; ++e) { ps = (e == F.tid) ? accp : ps; accp += ((int)__hip_atomic_load(moe + e, RLX_AGENT) + 255) >> 8; }
        const unsigned c = lcnt[F.tid]; const unsigned off = c ? __hip_atomic_fetch_add(moe + 64 + F.tid, c, RLX_AGENT) : 0u;
        lbase[F.tid] = (unsigned)ps * 256u + off; }
    __syncthreads();
    if (F.tid < nt) { const int p1 = (int)(lbase[e1] + r1), p2 = (int)(lbase[e2] + r2); POS1[t0 + F.tid] = p1; POS2[t0 + F.tid] = p2; lpos[2 * F.tid] = p1; lpos[2 * F.tid + 1] = p2; }
    __syncthreads();
    for (int t = F.wave; t < nt; t += NWAVES) {
        const v4u* src = (const v4u*)(HB + (size_t)(t0 + t) * D); const v4u a = src[F.lane], b = src[64 + F.lane];
        v4u* d1 = (v4u*)(AS + (size_t)lpos[2 * t] * D); v4u* d2 = (v4u*)(AS + (size_t)lpos[2 * t + 1] * D);
        d1[F.lane] = a; d1[64 + F.lane] = b; d2[F.lane] = a; d2[64 + F.lane] = b;
    }
}

#ifdef MK_IDLE_TICKS
#define IDLE_PROBE { const unsigned long long t0_ = __builtin_amdgcn_s_memrealtime(); while (__builtin_amdgcn_s_memrealtime() - t0_ < (unsigned long long)(MK_IDLE_TICKS)) __builtin_amdgcn_s_sleep(64); }
#else
#define IDLE_PROBE
#endif
#define MOE_PHASES \
        if (IN(pb + 16)) { if (on_moe) moe_gather_phase(F, F.ctl + CW_MOE + 256 * j); IDLE_PROBE SEAM(pb + 16); } \
        if (IN(pb + 17)) { if (on_moe) { \
            const bf16* AS = (const bf16*)(F.ws + WS_S0 + S_AS); bf16* HS = (bf16*)(F.ws + WS_S0 + S_HS); EpiSwiglu E{HS, FF}; \
            pg8::Gemm g{D, D}; pg8::MoeOrder S; moe_panel_ends(F.ctl + CW_MOE + 256 * j, S.pe); S.e_bytes = (size_t)NFF2 * D * 2; \
            S.init(AS, D, (const bf16*)(wl + WL_MOEIN), D, S.pe[7], NFF2 / 256, F.G, F.bx); \
            pg8::gemm_phase<EpiSwiglu, pg8::MoeOrder>(F.lds, F.tid, g, S, E); } \
            SEAM(pb + 17); } \
        if (IN(pb + 18)) { if (on_moe) { \
            const bf16* HS = (const bf16*)(F.ws + WS_S0 + S_HS); EpiBf16Gelu E{(bf16*)(F.ws + WS_S0 + S_YS), D, 0}; \
            pg8::Gemm g{FF, FF}; pg8::MoeOrder S; moe_panel_ends(F.ctl + CW_MOE + 256 * j, S.pe); S.e_bytes = (size_t)D * FF * 2; \
            S.init(HS, FF, (const bf16*)(wl + WL_MOEOUT), FF, S.pe[7], D / 256, F.G, F.bx); \
            pg8::gemm_phase<EpiBf16Gelu, pg8::MoeOrder>(F.lds, F.tid, g, S, E); } \
            SEAM(pb + 18); }

constexpr int NPHASE = 41;
#ifndef MK_PER_PHASE
#define MK_PER_PHASE 0
#endif
#ifndef MK_DBG
#define MK_DBG 0
#endif
#ifndef MK_SUBMASK
#define MK_SUBMASK 0xFFu
#endif

__global__ void __launch_bounds__(NTHR, 2) fwd(Args args) {
    extern __shared__ __attribute__((aligned(16))) unsigned char lds[];
    Frame F;
    F.lds = (LAS unsigned char*)lds; F.ws = args.ws; F.ctl = (gu32*)(args.ws + WS_CTL);
    F.tid = threadIdx.x; F.lane = F.tid & 63; F.wave = __builtin_amdgcn_readfirstlane(F.tid >> 6); F.G = gridDim.x; F.bx = blockIdx.x; F.dbg_acc = 0ull;
    volatile LAS unsigned* MISC = (volatile LAS unsigned*)(F.lds + MISC_OFF);
    if (F.tid < 16) MISC[F.tid] = 0u;
    __syncthreads();
    const int lo = args.ph_lo, hi = args.ph_hi;
    XcdBarrier bar; bar.bar = (unsigned*)(F.ctl + CW_BAR); bar.x = 0; bar.st = nullptr;
    if (hi - lo > 1) bar = xcd_barrier_post((unsigned*)(F.ctl + CW_BAR), MISC);
#ifdef MK_STAMP_MASK
    unsigned long long st_acc = 0ull, st_t0 = 0ull;
#define ST_SEL(k) ((k) == 0 ? (((MK_STAMP_MASK) >> 20) & 1u) : ((((MK_STAMP_MASK) >> (((k) - 1) % 20)) & 1u)))
#define IN(k) (lo <= (k) && (k) < hi && (F.fresh(), st_t0 = __builtin_amdgcn_s_memrealtime(), true))
#define SEAM(k) do { const unsigned long long t1_ = __builtin_amdgcn_s_memrealtime(); if (ST_SEL(k)) st_acc += t1_ - st_t0; if ((k) + 1 < hi) xcd_barrier(bar); if (((MK_STAMP_MASK) >> 21) & 1u) st_acc += __builtin_amdgcn_s_memrealtime() - t1_; } while (0)
#else
#define IN(k) (lo <= (k) && (k) < hi && (F.fresh(), true))
#define SEAM(k) do { if ((k) + 1 < hi) xcd_barrier(bar); } while (0)
#endif
    const unsigned submask = args.submask;
    const float* ln_gain = args.in[2]; const float* ln_bias = args.in[3];
    bf16* HB = (bf16*)(F.ws + WS_HB); bf16* MIX = (bf16*)(F.ws + WS_MIX);

    if (IN(0)) { p0_prologue(F, args); SEAM(0); }

    for (int j = 0; j < 2; ++j) {
        const int pb = 1 + 20 * j;
        unsigned char* wl = F.ws + WS_W + (size_t)j * WL_STRIDE;
        const bool on_rg = (submask >> (4 * j + 0)) & 1u, on_ffn = (submask >> (4 * j + 1)) & 1u, on_gla = (submask >> (4 * j + 2)) & 1u, on_moe = (submask >> (4 * j + 3)) & 1u;
        RG_PHASES
        if (IN(pb + 6)) { ln_phase(F, on_rg ? 1 : 0, ln_gain + (size_t)(2 * j) * 2 * D, ln_bias + (size_t)(2 * j) * 2 * D, 0, nullptr, 0, nullptr, nullptr); SEAM(pb + 6); }
        if (IN(pb + 7)) { if (on_ffn) {
            bf16* HID = (bf16*)(F.ws + WS_S0 + S_HID);
            EpiSwiglu E{HID, FF};
            if (!(MK_DBG & 1)) meta_gemm(F, HB + (size_t)MMAIN * D, D, D, (const bf16*)(wl + WL_FFNIN), (NFF2 / 256) * 8, E);
            pg8::Gemm g{D, D}; pg8::DenseOrder S; S.init(HB, D, (const bf16*)(wl + WL_FFNIN), D, MMAIN / 256, NFF2 / 256, F.G, F.bx);
            if (!(MK_DBG & 2)) pg8::gemm_phase<EpiSwiglu, pg8::DenseOrder>(F.lds, F.tid, g, S, E); }
            SEAM(pb + 7); }
        if (IN(pb + 8)) { if (on_ffn) {
            const bf16* HID = (const bf16*)(F.ws + WS_S0 + S_HID);
            EpiBf16Gelu E{MIX, D, 0};
            if (!(MK_DBG & 4)) meta_gemm(F, HID + (size_t)MMAIN * FF, FF, FF, (const bf16*)(wl + WL_FFNOUT), D / 16, E);
            pg8::Gemm g{FF, FF}; pg8::DenseOrder S; S.init(HID, FF, (const bf16*)(wl + WL_FFNOUT), FF, MMAIN / 256, D / 256, F.G, F.bx);
            if (!(MK_DBG & 8)) pg8::gemm_phase<EpiBf16Gelu, pg8::DenseOrder>(F.lds, F.tid, g, S, E); }
            SEAM(pb + 8); }
        if (IN(pb + 9)) { ln_phase(F, on_ffn ? 1 : 0, ln_gain + (size_t)(2 * j) * 2 * D + D, ln_bias + (size_t)(2 * j) * 2 * D + D, 1, args.in[11] + (size_t)j * D * GLAW + NGLA, GLAW, nullptr, nullptr); SEAM(pb + 9); }
        GLA_PHASES
        if (IN(pb + 15)) { ln_phase(F, on_gla ? 1 : 0, ln_gain + (size_t)(2 * j + 1) * 2 * D, ln_bias + (size_t)(2 * j + 1) * 2 * D, on_moe ? 2 : 0, args.in[18] + (size_t)j * D * NE, NE, nullptr, F.ctl + CW_MOE + 256 * j); SEAM(pb + 15); }
        MOE_PHASES
        if (IN(pb + 19)) { ln_phase(F, on_moe ? 2 : 0, ln_gain + (size_t)(2 * j + 1) * 2 * D + D, ln_bias + (size_t)(2 * j + 1) * 2 * D + D, 0, nullptr, 0, j == 1 ? args.out : nullptr, nullptr); SEAM(pb + 19); }
    }
#ifdef MK_STAMP_MASK
    __syncthreads();
    if (blockIdx.x == 0 && threadIdx.x == 0) args.out[0] = (float)(st_acc + F.dbg_acc) * 0.01f * (MK_STAMP_SCALE);
#endif
#undef IN
#undef SEAM
}

static bool phase_enabled(int k, unsigned mask) {
    if (k == 0) return true;
    const int j = (k - 1) / 20, r = (k - 1) % 20;
    int sub;
    if (r <= 5) sub = 0; else if (r == 6) return true; else if (r <= 8) sub = 1; else if (r == 9) return true;
    else if (r <= 14) sub = 2; else if (r == 15) return true; else if (r <= 18) sub = 3; else return true;
    return (mask >> (4 * j + sub)) & 1u;
}
extern "C" void kernel_launch(void* const* d_in, const int* in_sizes, int n_in, void* d_out, int out_size, void* d_ws, size_t ws_size, hipStream_t stream) {
    static int grid = 0;
    if (grid == 0) {
        if (n_in != 21 || out_size != MMAIN * D || ws_size < WS_END) { fprintf(stderr, "kernel_launch: unexpected shapes: n_in %d out %d ws %zu (need %zu); nothing launched\n", n_in, out_size, ws_size, (size_t)WS_END); grid = -1; return; }
        int dev = 0, cus = 0, per_cu = 0;
        if (hipGetDevice(&dev) != hipSuccess || hipDeviceGetAttribute(&cus, hipDeviceAttributeMultiprocessorCount, dev) != hipSuccess) { grid = -1; return; }
        if (hipFuncSetAttribute((const void*)fwd, hipFuncAttributeMaxDynamicSharedMemorySize, LDS_BYTES) != hipSuccess) { fprintf(stderr, "kernel_launch: hipFuncSetAttribute failed\n"); grid = -1; return; }
        if (hipOccupancyMaxActiveBlocksPerMultiprocessor(&per_cu, (const void*)fwd, NTHR, LDS_BYTES) != hipSuccess || per_cu < 1) fprintf(stderr, "kernel_launch: note: occupancy query reports %d\n", per_cu);
        (void)hipGetLastError();
        grid = cus;
    }
    if (grid < 0) return;
    (void)hipMemsetAsync((char*)d_ws + WS_CTL, 0, CTL_ZERO_BYTES, stream);
    Args a{};
    for (int i = 0; i < 21; ++i) a.in[i] = (const float*)d_in[i];
    a.out = (float*)d_out; a.ws = (unsigned char*)d_ws; a.submask = MK_SUBMASK; a.pad = 0;
#if MK_PER_PHASE
    for (int k = 0; k < NPHASE; ++k) { if (!phase_enabled(k, MK_SUBMASK)) continue; a.ph_lo = k; a.ph_hi = k + 1; hipLaunchKernelGGL(fwd, dim3(grid), dim3(NTHR), LDS_BYTES, stream, a); }
#else
    a.ph_lo = 0; a.ph_hi = NPHASE; hipLaunchKernelGGL(fwd, dim3(grid), dim3(NTHR), LDS_BYTES, stream, a);
#ifdef MK_PROBE_LIST
    { const int pl[] = {MK_PROBE_LIST}; for (int k : pl) { a.ph_lo = k; a.ph_hi = k + 1; hipLaunchKernelGGL(fwd, dim3(grid), dim3(NTHR), LDS_BYTES, stream, a); } }
#endif
#endif
}
```

```cpp
#include <hip/hip_runtime.h>
#include <cstdio>
#include <cstdint>

#define GAS __attribute__((address_space(1)))
#define LAS __attribute__((address_space(3)))
typedef unsigned short bf16;
typedef unsigned v4u __attribute__((ext_vector_type(4)));
typedef unsigned v2u __attribute__((ext_vector_type(2)));
typedef float f32x4 __attribute__((ext_vector_type(4)));
typedef float f32x2 __attribute__((ext_vector_type(2)));
typedef short bf16x8 __attribute__((ext_vector_type(8)));
typedef short bf16x4 __attribute__((ext_vector_type(4)));
typedef GAS unsigned gu32;
#define RLX_AGENT __ATOMIC_RELAXED, __HIP_MEMORY_SCOPE_AGENT
#define LDS_WAIT() asm volatile("s_waitcnt lgkmcnt(0)" ::: "memory")
#define VM_WAIT() asm volatile("s_waitcnt vmcnt(0)" ::: "memory")

__device__ __forceinline__ unsigned f2bf(float f) { unsigned u = __builtin_bit_cast(unsigned, f); return (u + 0x7fffu + ((u >> 16) & 1u)) >> 16; }
__device__ __forceinline__ unsigned pk2(float lo, float hi) { unsigned r; asm("v_cvt_pk_bf16_f32 %0, %1, %2" : "=v"(r) : "v"(lo), "v"(hi)); return r; }
__device__ __forceinline__ float bflo(unsigned w) { return __builtin_bit_cast(float, w << 16); }
__device__ __forceinline__ float bfhi(unsigned w) { return __builtin_bit_cast(float, w & 0xffff0000u); }
__device__ __forceinline__ float bf2f(bf16 b) { return __builtin_bit_cast(float, (unsigned)b << 16); }
__device__ __forceinline__ unsigned cvt_pk_bf16(float lo, float hi) { unsigned r; asm volatile("v_cvt_pk_bf16_f32 %0, %1, %2" : "=v"(r) : "v"(lo), "v"(hi)); return r; }
__device__ __forceinline__ float fast_exp(float x) { return __builtin_amdgcn_exp2f(x * 1.44269504089f); }
__device__ __forceinline__ float sigmoid_f(float x) { return __builtin_amdgcn_rcpf(1.0f + fast_exp(-x)); }
__device__ __forceinline__ float silu_f(float x) { return x * sigmoid_f(x); }
__device__ __forceinline__ float gelu_tanh_f(float x) { const float u = 0.7978845608028654f * (x + 0.044715f * x * x * x); return x * sigmoid_f(2.0f * u); }
__device__ __forceinline__ float wave_sum(float v) {
#pragma unroll
    for (int o = 1; o < 64; o <<= 1) v += __shfl_xor(v, o);
    return v;
}

namespace pg8 {
constexpr int BM = 256, BK = 64, HALF = 128, HTB = HALF * BK * 2  , STAGE_BYTES = 8 * HTB, NXCD = 8, WGM = 8;
__host__ __device__ __forceinline__ int lds_byte(int r, int c) { const int st = (r >> 4) * 2 + (c >> 5), rr = r & 15, cc = c & 31, ob = rr * 64 + cc * 2; return st * 1024 + (ob ^ (((ob >> 9) & 1) << 5)); }
__host__ __device__ __forceinline__ void stage_rc(int b, int& R, int& C) { const int st = b / 1024, sb = b % 1024, swz = sb ^ (((sb >> 9) & 1) << 5); R = (st >> 1) * 16 + swz / 64; C = (st & 1) * 32 + (swz % 64) / 2; }
__host__ __device__ __forceinline__ int perm32(int rho) { const int n = rho >> 4, i = rho & 15; return 8 * (i >> 2) + 4 * n + (i & 3); }

struct Unit { int pm, pn; };
struct Gemm { int K, lda; };

struct OrderBase {
    int nM, nN, nwg, G, c;
    __device__ __forceinline__ void init_order(int nM_, int nN_, int G_, int c_) { nM = nM_; nN = nN_; nwg = nM * nN; G = G_; c = c_; }
    __device__ __forceinline__ bool next(int i, Unit& u) const {
        const long L = (long)i * G + c; if (L >= nwg) return false;
        int wgid = (int)L; { const int q = nwg / NXCD, r = nwg % NXCD, xcd = wgid % NXCD, off = wgid / NXCD; wgid = (xcd < r ? xcd * (q + 1) : r * (q + 1) + (xcd - r) * q) + off; }
        const int nig = WGM * nN, gid = wgid / nig, fm = gid * WGM, gsz = (nM - fm) < WGM ? (nM - fm) : WGM;
        u.pm = fm + ((wgid % nig) % gsz); u.pn = (wgid % nig) / gsz; return true;
    }
};
struct DenseOrder : OrderBase {
    const char* A; const char* Bt; size_t a_tile, b_tile;
    __device__ __forceinline__ void init(const bf16* A_, int lda, const bf16* Bt_, int K, int nM_, int nN_, int G_, int c_) { A = (const char*)A_; Bt = (const char*)Bt_; a_tile = (size_t)BM * lda * 2; b_tile = (size_t)BM * K * 2; init_order(nM_, nN_, G_, c_); }
    __device__ __forceinline__ const char* a_base(const Unit& u) const { return A + (size_t)u.pm * a_tile; }
    __device__ __forceinline__ const char* b_base(const Unit& u) const { return Bt + (size_t)u.pn * b_tile; }
};
struct GatesOrder : DenseOrder {
    __device__ __forceinline__ const char* a_base(const Unit& u) const { return A + (size_t)u.pm * a_tile + (size_t)(u.pn >> 1) * 512; }
};
struct MoeOrder : DenseOrder {
    int pe[8]; size_t e_bytes;
    __device__ __forceinline__ const char* b_base(const Unit& u) const {
        int e = 0;
#pragma unroll
        for (int j = 0; j < 7; ++j) e += (u.pm >= pe[j]) ? 1 : 0;
        return Bt + (size_t)e * e_bytes + (size_t)u.pn * b_tile;
    }
};

template <class Epi, class Sched, bool ALIGN_EPI = true>
__device__ __forceinline__ void gemm_phase(LAS unsigned char* lds, const int tid, const Gemm g, const Sched& S, const Epi& E) {
    const int wid = __builtin_amdgcn_readfirstlane(tid >> 6), lane = tid & 63, wr = wid >> 2, wc = wid & 3, fr = lane & 15, fq = lane >> 4;
    const int K = g.K, nt = K / BK;
    unsigned voffA[2], voffB[2];
#pragma unroll
    for (int i = 0; i < 2; ++i) { int R, C; stage_rc(tid * 16 + i * 8192, R, C); const int Rb = Epi::PERM ? ((R & ~31) + perm32(R & 31)) : R;
        voffA[i] = (unsigned)(R * g.lda + C) * 2u; voffB[i] = (unsigned)(Rb * K + C) * 2u; }
    const size_t kstep = (size_t)(BK * 2);
    const size_t hstepA = (size_t)HALF * g.lda * 2, hstepB = (size_t)HALF * K * 2;
    const unsigned ldsw = (unsigned)wid * 1024u;
    const int aoff = lds_byte(wr * 64 + fr, fq * 8), boff = lds_byte(wc * 32 + fr, fq * 8);
#define PG8_SA(b, h) (((b) * 2 + (h)) * HTB)
#define PG8_SB(b, h) ((4 + (b) * 2 + (h)) * HTB)
#define PG8_STAGE(bufoff, gbase, voff) do { _Pragma("unroll") for (int _i = 0; _i < 2; ++_i) \
        __builtin_amdgcn_global_load_lds((const unsigned*)((const char*)(gbase) + (voff)[_i]), (LAS unsigned*)(lds + (bufoff) + ldsw + _i * 8192), 16, 0, 0); } while (0)
#define PG8_LDA(dst, b, h) do { _Pragma("unroll") for (int m = 0; m < 4; ++m) _Pragma("unroll") for (int k = 0; k < 2; ++k) dst[m][k] = *(const LAS bf16x8*)(lds + PG8_SA(b, h) + aoff + m * 2048 + k * 1024); } while (0)
#define PG8_LDB(dst, b, h) do { _Pragma("unroll") for (int n = 0; n < 2; ++n) _Pragma("unroll") for (int k = 0; k < 2; ++k) dst[n][k] = *(const LAS bf16x8*)(lds + PG8_SB(b, h) + boff + n * 2048 + k * 1024); } while (0)
#define PG8_MMA(ai, bj, At, Bt) do { __builtin_amdgcn_s_setprio(1); _Pragma("unroll") for (int m = 0; m < 4; ++m) _Pragma("unroll") for (int n = 0; n < 2; ++n) _Pragma("unroll") for (int k = 0; k < 2; ++k) \
        acc[ai][bj][m][n] = __builtin_amdgcn_mfma_f32_16x16x32_bf16(Bt[n][k], At[m][k], acc[ai][bj][m][n], 0, 0, 0); __builtin_amdgcn_s_setprio(0); } while (0)
#define PG8_WAIT_V(n) asm volatile("s_waitcnt vmcnt(" #n ")" ::: "memory")
#define PG8_WAIT_L(n) asm volatile("s_waitcnt lgkmcnt(" #n ")" ::: "memory")
#define PG8_BAR __builtin_amdgcn_s_barrier()
#define PG8_SCHED __builtin_amdgcn_sched_barrier(0)
    Unit cur, nxt; int ui = 0;
    if (!S.next(0, cur)) return;
    f32x4 acc[2][2][4][2];
#pragma unroll
    for (int a = 0; a < 2; ++a)
#pragma unroll
        for (int b = 0; b < 2; ++b)
#pragma unroll
            for (int m = 0; m < 4; ++m)
#pragma unroll
                for (int n = 0; n < 2; ++n) acc[a][b][m][n] = (f32x4){0.f, 0.f, 0.f, 0.f};
    bf16x8 At[4][2], B0[2][2], B1[2][2];
    const char* cA = S.a_base(cur); const char* cB = S.b_base(cur);
    PG8_STAGE(PG8_SB(0, 0), cB, voffB); PG8_STAGE(PG8_SB(0, 1), cB + hstepB, voffB); PG8_STAGE(PG8_SA(0, 0), cA, voffA); PG8_STAGE(PG8_SA(0, 1), cA + hstepA, voffA);
    if (wr == 1) PG8_BAR;
    PG8_WAIT_V(2); PG8_BAR;
    PG8_STAGE(PG8_SB(1, 0), cB + kstep, voffB); PG8_STAGE(PG8_SA(1, 0), cA + kstep, voffA); PG8_STAGE(PG8_SB(1, 1), cB + hstepB + kstep, voffB);
    PG8_WAIT_V(6); PG8_BAR;
    for (;;) {
        const bool has_next = S.next(ui + 1, nxt);
        const char* nA = has_next ? S.a_base(nxt) : cA; const char* nB = has_next ? S.b_base(nxt) : cB;
#pragma nounroll
        for (int t = 0; t < nt; t += 2) {
            const bool last = (t == nt - 2);
            const char* a1 = cA + (size_t)(t + 1) * kstep;
            const char* a2 = last ? nA : cA + (size_t)(t + 2) * kstep; const char* b2 = last ? nB : cB + (size_t)(t + 2) * kstep;
            const char* a3 = a2 + kstep; const char* b3 = b2 + kstep;
            PG8_LDB(B0, 0, 0); PG8_LDB(B1, 0, 1); PG8_SCHED; PG8_LDA(At, 0, 0); PG8_STAGE(PG8_SA(1, 1), a1 + hstepA, voffA);
            PG8_WAIT_V(8); PG8_WAIT_L(0); PG8_BAR; PG8_MMA(0, 0, At, B0); PG8_MMA(0, 1, At, B1); PG8_BAR; PG8_SCHED;
            PG8_LDA(At, 0, 1); PG8_STAGE(PG8_SB(0, 0), b2, voffB); PG8_STAGE(PG8_SB(0, 1), b2 + hstepB, voffB); PG8_STAGE(PG8_SA(0, 0), a2, voffA);
            PG8_WAIT_V(8); PG8_WAIT_L(0); PG8_BAR; PG8_MMA(1, 0, At, B0); PG8_MMA(1, 1, At, B1); PG8_BAR; PG8_SCHED;
            PG8_LDB(B0, 1, 0); PG8_LDB(B1, 1, 1); PG8_SCHED; PG8_LDA(At, 1, 0); PG8_STAGE(PG8_SA(0, 1), a2 + hstepA, voffA);
            PG8_WAIT_V(8); PG8_WAIT_L(0); PG8_BAR; PG8_MMA(0, 0, At, B0); PG8_MMA(0, 1, At, B1); PG8_BAR; PG8_SCHED;
            PG8_LDA(At, 1, 1); PG8_STAGE(PG8_SB(1, 0), b3, voffB); PG8_STAGE(PG8_SB(1, 1), b3 + hstepB, voffB); PG8_STAGE(PG8_SA(1, 0), a3, voffA);
            PG8_WAIT_V(8); PG8_WAIT_L(0); PG8_BAR; PG8_MMA(1, 0, At, B0); PG8_MMA(1, 1, At, B1); PG8_BAR; PG8_SCHED;
        }
        if constexpr (ALIGN_EPI) { if (wr == 0) PG8_BAR; }
        E(acc, cur, wr, wc, fr, fq);
        if (!has_next) break;
#pragma unroll
        for (int a = 0; a < 2; ++a)
#pragma unroll
            for (int b = 0; b < 2; ++b)
#pragma unroll
                for (int m = 0; m < 4; ++m)
#pragma unroll
                    for (int n = 0; n < 2; ++n) acc[a][b][m][n] = (f32x4){0.f, 0.f, 0.f, 0.f};
        cur = nxt; cA = nA; cB = nB; ++ui;
        if constexpr (ALIGN_EPI) { if (wr == 1) PG8_BAR; }
    }
    PG8_WAIT_V(0);
    if constexpr (!ALIGN_EPI) { if (wr == 0) PG8_BAR; }
    PG8_BAR;
#undef PG8_SA
#undef PG8_SB
#undef PG8_STAGE
#undef PG8_LDA
#undef PG8_LDB
#undef PG8_MMA
#undef PG8_WAIT_V
#undef PG8_WAIT_L
#undef PG8_BAR
#undef PG8_SCHED
}
}
#define XB_TMO      128
#define XB_XCNT(j)  (256  + 64 * (j))
#define XB_XSUB(j)  (1280 + 64 * (j))
#define XB_XGEN(j)  (2304 + 64 * (j))
#define XB_TOP      3328
#define XB_TOPGEN   3392
#define XCD_BAR_WORDS 3456
#define XB_SPIN_CAP (1u << 18)

__device__ __forceinline__ unsigned xb_ld(unsigned* p)              { return __hip_atomic_load(p, __ATOMIC_RELAXED, __HIP_MEMORY_SCOPE_AGENT); }
__device__ __forceinline__ unsigned xb_add(unsigned* p, unsigned v) { return __hip_atomic_fetch_add(p, v, __ATOMIC_RELAXED, __HIP_MEMORY_SCOPE_AGENT); }
__device__ __forceinline__ unsigned xb_xcc_id() { return (unsigned)__builtin_amdgcn_s_getreg((3 << 11) | 20) & 0xFu; }
#define XB_SPIN(cond, bar) do { unsigned _sp = 0; while (cond) { __builtin_amdgcn_s_sleep(1); \
    if ((++_sp & 255u) == 0u) { if (xb_ld(&(bar)[XB_TMO])) break; if (_sp > XB_SPIN_CAP) { atomicAdd(&(bar)[XB_TMO], 1u); break; } } } } while (0)

struct XcdBarrier {
    unsigned* bar; unsigned x;
    volatile LAS unsigned* st;
};

__device__ __forceinline__ XcdBarrier xcd_barrier_post(unsigned* bar, volatile LAS unsigned* st) {
    XcdBarrier b; b.bar = bar; b.x = xb_xcc_id(); b.st = st;
    if (threadIdx.x == 0) (void)xb_add(&bar[XB_XCNT(b.x)], 1u);
    return b;
}
__device__ __forceinline__ void xcd_barrier_complete(unsigned* bar, unsigned x, unsigned& nloc, unsigned& nx) {
    const unsigned G = gridDim.x * gridDim.y * gridDim.z;
    unsigned sum, cnt, mine, sp = 0u;
    for (;;) {
        sum = 0u; cnt = 0u; mine = 0u;
#pragma unroll
        for (unsigned j = 0; j < 16; ++j) { const unsigned c = xb_ld(&bar[XB_XCNT(j)]); sum += c; cnt += (c > 0u) ? 1u : 0u; mine = (j == x) ? c : mine; }
        if (sum == G) break;
        __builtin_amdgcn_s_sleep(1);
        if ((++sp & 255u) == 0u) { if (xb_ld(&bar[XB_TMO])) break; if (sp > XB_SPIN_CAP) { atomicAdd(&bar[XB_TMO], 1u); break; } }
    }
    nloc = mine > 0u ? mine : 1u; nx = cnt > 0u ? cnt : 1u;
}

__device__ __forceinline__ void xcd_barrier(const XcdBarrier& b) {
    asm volatile("s_waitcnt vmcnt(0)" ::: "memory");
    __syncthreads();
    if (threadIdx.x == 0) {
        unsigned* bar = b.bar;
        __builtin_amdgcn_s_waitcnt(0);
        unsigned nloc = b.st[0], nx = b.st[1];
        if (nloc == 0u) { xcd_barrier_complete(bar, b.x, nloc, nx); b.st[0] = nloc; b.st[1] = nx; }
        const unsigned old = xb_add(&bar[XB_XSUB(b.x)], 1u);
        const unsigned gen = old / nloc;
        if (old + 1u == (gen + 1u) * nloc) {
            __builtin_amdgcn_fence(__ATOMIC_RELEASE, "agent");
            asm volatile("s_waitcnt vmcnt(0)" ::: "memory");
            const unsigned og = xb_add(&bar[XB_TOP], 1u);
            const unsigned tg = og / nx;
            if (og + 1u == (tg + 1u) * nx) xb_add(&bar[XB_TOPGEN], 1u);
            else XB_SPIN(xb_ld(&bar[XB_TOPGEN]) == tg, bar);
            __builtin_amdgcn_fence(__ATOMIC_ACQUIRE, "agent");
            xb_add(&bar[XB_XGEN(b.x)], 1u);
            asm volatile("s_waitcnt vmcnt(0)" ::: "memory");
        } else {
            XB_SPIN(xb_ld(&bar[XB_XGEN(b.x)]) == gen, bar);
            __builtin_amdgcn_fence(__ATOMIC_ACQUIRE, "agent");
            asm volatile("s_waitcnt vmcnt(0)" ::: "memory");
        }
    }
    __syncthreads();
}

constexpr int NWAVES = 8, NTHR = 512;
constexpr int D = 1024, BATCH = 2, SEQ = 16384, NMETA = 16;
constexpr int MMAIN = BATCH * SEQ;
constexpr int MROWS = MMAIN + NMETA;
constexpr int MPAD = MMAIN + 256;
constexpr int RGW = 1344, RGBW = 168, NRG = 2816  , KRGO = 1408  , NGT = 4096, KGT = 256, XCW = 2048;
constexpr int FF = 3584, NE = 8, NFF2 = 2 * FF;
constexpr int GH = 4, GDK = 128, GDV = 256, GQK = 512, GVD = 1024, NGLA = 3072, GLAW = 3088, GRANK = 16;
constexpr int MSORT = 265 * 256;
constexpr float LN_EPS = 1e-5f, ALPHA = 1.6817928305074290f;
constexpr int SEG = 128, NSEG_B = SEQ / SEG, NSEG = 1 + BATCH * NSEG_B;
constexpr int CPS = 4, NSC_BH = SEQ / (64 * CPS), NGU = BATCH * GH * NSC_BH + GH;

constexpr size_t MiB = 1u << 20;
constexpr size_t WS_CTL = 0, CTL_ZERO_BYTES = 1 * MiB;
constexpr size_t WL_RGIN = 0, WL_GATES = WL_RGIN + (size_t)NRG * D * 2, WL_RGOUT = WL_GATES + (size_t)NGT * KGT * 2, WL_GLAIN = WL_RGOUT + (size_t)D * KRGO * 2,
                 WL_GLAOUT = WL_GLAIN + (size_t)NGLA * D * 2, WL_FFNIN = WL_GLAOUT + (size_t)D * D * 2, WL_FFNOUT = WL_FFNIN + (size_t)NFF2 * D * 2,
                 WL_MOEIN = WL_FFNOUT + (size_t)D * FF * 2, WL_MOEOUT = WL_MOEIN + (size_t)NE * NFF2 * D * 2, WL_STRIDE = WL_MOEOUT + (size_t)NE * D * FF * 2;
constexpr size_t WS_W = 1 * MiB;
constexpr size_t WS_H = WS_W + 2 * WL_STRIDE;
constexpr size_t WS_HB = WS_H + (size_t)MPAD * D * 4;
constexpr size_t WS_MIX = WS_HB + (size_t)MPAD * D * 2;
constexpr size_t WS_Z = WS_MIX + (size_t)MPAD * D * 4;
constexpr size_t WS_RT = WS_Z + 3 * MiB;
constexpr size_t WS_AGG = WS_RT + 1 * MiB;
constexpr size_t WS_S0 = WS_AGG + 3 * MiB;
constexpr size_t S_PROJ = 0, S_XC = S_PROJ + (size_t)MPAD * NRG * 2, S_LOGA = S_XC + (size_t)MPAD * XCW * 2, S_U = S_LOGA + (size_t)MPAD * RGW * 4, S_Y = S_U + (size_t)MPAD * RGW * 4, S_RG_END = S_Y + (size_t)MPAD * KRGO * 2;
constexpr size_t S_HID = 0;
constexpr size_t S_QKVR = 0, S_KVS = S_QKVR + (size_t)MPAD * NGLA * 2, S_SST = S_KVS + (size_t)NGU * GDK * GDV * 4, S_O = S_SST + (size_t)NGU * GDK * GDV * 4, S_DEC = S_O + (size_t)MPAD * D * 2, S_XB = S_DEC + 1 * MiB, S_EMF = S_XB + (size_t)(BATCH * GH * (SEQ / 64) + GH) * 64 * GDK * 4, S_GLA_END = S_EMF + 3 * MiB;
constexpr size_t S_AS = 0, S_HS = S_AS + (size_t)MSORT * D * 2, S_YS = S_HS + (size_t)MSORT * FF * 2, S_MOE_END = S_YS + (size_t)MSORT * D * 4;
constexpr size_t S_MAX = S_RG_END > S_MOE_END ? (S_RG_END > S_GLA_END ? S_RG_END : S_GLA_END) : (S_MOE_END > S_GLA_END ? S_MOE_END : S_GLA_END);
constexpr size_t WS_END = WS_S0 + S_MAX;
constexpr int CW_TMO = 0, CW_BAR = 4096, CW_MOE = 8192;

constexpr int LDS_BYTES = 163840, MISC_OFF = LDS_BYTES - 64;

struct Frame {
    LAS unsigned char* lds; gu32* ctl; unsigned char* ws;
    int tid, lane, wave, G, bx; unsigned long long dbg_acc;
    __device__ __forceinline__ void fresh() { asm volatile("" : "+v"(tid)); asm volatile("" : "+s"(bx)); asm volatile("" : "+s"(ws)); lane = tid & 63; wave = __builtin_amdgcn_readfirstlane(tid >> 6); ctl = (gu32*)(ws + WS_CTL); }
};
struct Args { const float* in[21]; float* out; unsigned char* ws; int ph_lo, ph_hi; unsigned submask; int pad; };

struct EpiBf16Gelu {
    static constexpr bool PERM = true, PAIR = false;
    bf16* O; int ldc, gelu_cols;
    __device__ __forceinline__ void operator()(const f32x4 (&acc)[2][2][4][2], const pg8::Unit& u, int wr, int wc, int fr, int fq) const {
        const int row0 = u.pm * 256 + wr * 64 + fr, col0 = u.pn * 256 + wc * 32 + 8 * fq;
#pragma unroll
        for (int ai = 0; ai < 2; ++ai)
#pragma unroll
            for (int m = 0; m < 4; ++m) { bf16* rowp = O + (size_t)(row0 + ai * 128 + m * 16) * ldc + col0;
#pragma unroll
                for (int bj = 0; bj < 2; ++bj) { f32x4 v0 = acc[ai][bj][m][0], v1 = acc[ai][bj][m][1];
                    if (col0 + bj * 128 < gelu_cols) {
#pragma unroll
                        for (int j = 0; j < 4; ++j) { v0[j] = gelu_tanh_f(v0[j]); v1[j] = gelu_tanh_f(v1[j]); } }
                    v4u w; w.x = cvt_pk_bf16(v0[0], v0[1]); w.y = cvt_pk_bf16(v0[2], v0[3]); w.z = cvt_pk_bf16(v1[0], v1[1]); w.w = cvt_pk_bf16(v1[2], v1[3]);
                    *(v4u*)(rowp + bj * 128) = w; } }
    }
    __device__ __forceinline__ void meta_task(int task, int& r0, int& aoff) const { r0 = task * 16; aoff = 0; }
    __device__ __forceinline__ void meta(int task, f32x4 a0, f32x4, int fr, int fq) const {
        const int col = task * 16 + 4 * fq;
        if (col < gelu_cols) {
#pragma unroll
            for (int j = 0; j < 4; ++j) a0[j] = gelu_tanh_f(a0[j]); }
        v2u w; w.x = cvt_pk_bf16(a0[0], a0[1]); w.y = cvt_pk_bf16(a0[2], a0[3]);
        *(v2u*)(O + (size_t)(MMAIN + fr) * ldc + col) = w;
    }
};
struct EpiSwiglu {
    static constexpr bool PERM = true, PAIR = true;
    bf16* O; int ldc;
    __device__ __forceinline__ void operator()(const f32x4 (&acc)[2][2][4][2], const pg8::Unit& u, int wr, int wc, int fr, int fq) const {
        const int row0 = u.pm * 256 + wr * 64 + fr, col0 = u.pn * 128 + wc * 32 + 8 * fq;
#pragma unroll
        for (int ai = 0; ai < 2; ++ai)
#pragma unroll
            for (int m = 0; m < 4; ++m) { bf16* rowp = O + (size_t)(row0 + ai * 128 + m * 16) * ldc + col0;
                f32x4 g0 = acc[ai][0][m][0], g1 = acc[ai][0][m][1]; const f32x4 u0 = acc[ai][1][m][0], u1 = acc[ai][1][m][1];
#pragma unroll
                for (int j = 0; j < 4; ++j) { g0[j] = silu_f(g0[j]) * u0[j]; g1[j] = silu_f(g1[j]) * u1[j]; }
                v4u w; w.x = cvt_pk_bf16(g0[0], g0[1]); w.y = cvt_pk_bf16(g0[2], g0[3]); w.z = cvt_pk_bf16(g1[0], g1[1]); w.w = cvt_pk_bf16(g1[2], g1[3]);
                *(v4u*)rowp = w; }
    }
    __device__ __forceinline__ void meta_task(int task, int& r0, int& aoff) const { r0 = (task >> 3) * 256 + (task & 7) * 16; aoff = 0; }
    __device__ __forceinline__ void meta(int task, f32x4 a0, f32x4 a1, int fr, int fq) const {
        const int col = (task >> 3) * 128 + (task & 7) * 16 + 4 * fq;
#pragma unroll
        for (int j = 0; j < 4; ++j) a0[j] = silu_f(a0[j]) * a1[j];
        v2u w; w.x = cvt_pk_bf16(a0[0], a0[1]); w.y = cvt_pk_bf16(a0[2], a0[3]);
        *(v2u*)(O + (size_t)(MMAIN + fr) * ldc + col) = w;
    }
};
struct EpiF32 {
    static constexpr bool PERM = false, PAIR = false;
    float* C; int ldc;
    __device__ __forceinline__ void operator()(const f32x4 (&acc)[2][2][4][2], const pg8::Unit& u, int wr, int wc, int fr, int fq) const {
        const int row0 = u.pm * 256 + wr * 64 + fr, col0 = u.pn * 256 + wc * 32 + 4 * fq;
#pragma unroll
        for (int ai = 0; ai < 2; ++ai)
#pragma unroll
            for (int m = 0; m < 4; ++m) { float* rowp = C + (size_t)(row0 + ai * 128 + m * 16) * ldc + col0;
#pragma unroll
                for (int bj = 0; bj < 2; ++bj)
#pragma unroll
                    for (int n = 0; n < 2; ++n) *(f32x4*)(rowp + bj * 128 + n * 16) = acc[ai][bj][m][n]; }
    }
    __device__ __forceinline__ void meta_task(int task, int& r0, int& aoff) const { r0 = task * 16; aoff = 0; }
    __device__ __forceinline__ void meta(int task, f32x4 a0, f32x4, int fr, int fq) const { *(f32x4*)(C + (size_t)(MMAIN + fr) * ldc + task * 16 + 4 * fq) = a0; }
};

template <class Epi>
__device__ __forceinline__ void meta_gemm(Frame& F, const bf16* A16, int lda, int K, const bf16* Bt, int ntasks, const Epi& E) {
    const int fr = F.lane & 15, fq = F.lane >> 4;
    LAS f32x4* red = (LAS f32x4*)F.lds;
    for (int task = F.bx; task < ntasks; task += F.G) {
        int r0, aoff; E.meta_task(task, r0, aoff);
        f32x4 acc0 = (f32x4){0.f, 0.f, 0.f, 0.f}, acc1 = acc0;
        const bf16* ap = A16 + (size_t)fr * lda + aoff + fq * 8; const bf16* bp0 = Bt + (size_t)(r0 + fr) * K + fq * 8; const bf16* bp1 = bp0 + (size_t)128 * K;
        for (int ks = F.wave; ks < K / 32; ks += NWAVES) {
            const bf16x8 a = *(const bf16x8*)(ap + ks * 32); const bf16x8 b0 = *(const bf16x8*)(bp0 + ks * 32);
            acc0 = __builtin_amdgcn_mfma_f32_16x16x32_bf16(b0, a, acc0, 0, 0, 0);
            if (Epi::PAIR) { const bf16x8 b1 = *(const bf16x8*)(bp1 + ks * 32); acc1 = __builtin_amdgcn_mfma_f32_16x16x32_bf16(b1, a, acc1, 0, 0, 0); }
        }
        red[(F.wave * 2 + 0) * 64 + F.lane] = acc0; if (Epi::PAIR) red[(F.wave * 2 + 1) * 64 + F.lane] = acc1;
        __syncthreads();
        if (F.wave == 0) {
            f32x4 s0 = red[F.lane], s1 = Epi::PAIR ? red[64 + F.lane] : acc1;
#pragma unroll
            for (int w = 1; w < NWAVES; ++w) { s0 += red[(w * 2) * 64 + F.lane]; if (Epi::PAIR) s1 += red[(w * 2 + 1) * 64 + F.lane]; }
            E.meta(task, s0, s1, fr, fq);
        }
        __syncthreads();
    }
}

__device__ __forceinline__ void transpose_item(const float* W, int ldw, int Ksrc, int c0, int nvalid, bf16* WT, int Kdst, int n0, int k0, LAS float* scr, int lane) {
#pragma unroll 8
    for (int i = 0; i < 32; ++i) { const int kk = 2 * i + (lane >> 5), c = lane & 31;
        const bool ok = (k0 + kk < Ksrc) && (c < nvalid); const float v = W[ok ? (size_t)(k0 + kk) * ldw + c0 + c : (size_t)0];
        scr[kk * 33 + c] = ok ? v : 0.f; }
    LDS_WAIT(); asm volatile("" ::: "memory");
    const int c = lane & 7;
#pragma unroll
    for (int j = 0; j < 4; ++j) { const int n = (lane >> 3) + 8 * j; const LAS float* s = scr + (8 * c) * 33 + n;
        v4u o; o.x = pk2(s[0 * 33], s[1 * 33]); o.y = pk2(s[2 * 33], s[3 * 33]); o.z = pk2(s[4 * 33], s[5 * 33]); o.w = pk2(s[6 * 33], s[7 * 33]);
        *(v4u*)(WT + (size_t)(n0 + n) * Kdst + k0 + 8 * c) = o; }
    LDS_WAIT(); asm volatile("" ::: "memory");
}
__device__ __forceinline__ void map_id(int n0, int nsrc, int& c0, int& nv) { c0 = n0; nv = nsrc - n0; nv = nv < 0 ? 0 : (nv > 32 ? 32 : nv); if (nv == 0) c0 = 0; }
__device__ __forceinline__ void map_swiglu(int n0, int& c0, int& nv) { const int tile = n0 >> 8, rr = n0 & 255; c0 = rr < 128 ? tile * 128 + rr : FF + tile * 128 + rr - 128; nv = 32; }

__device__ __forceinline__ void p0_prologue(Frame& F, const Args& a) {
    LAS float* scr = (LAS float*)(F.lds + F.wave * 16384);
    const int gw = F.bx * NWAVES + F.wave, NGW = F.G * NWAVES;
    constexpr int I_RGIN = (D / 64) * (NRG / 32), I_GATES = (KGT / 64) * (NGT / 32), I_RGOUT = (KRGO / 64) * (D / 32), I_GLAIN = (D / 64) * (NGLA / 32), I_GLAOUT = (D / 64) * (D / 32),
                  I_FFNIN = (D / 64) * (NFF2 / 32), I_FFNOUT = (FF / 64) * (D / 32), I_MOEIN = NE * I_FFNIN, I_MOEOUT = NE * I_FFNOUT;
    constexpr int I_PER_J = I_RGIN + I_GATES + I_RGOUT + I_GLAIN + I_GLAOUT + I_FFNIN + I_FFNOUT + I_MOEIN + I_MOEOUT;
    for (int it = gw; it < 2 * I_PER_J; it += NGW) {
        const int j = it / I_PER_J; int r = it - j * I_PER_J;
        unsigned char* wl = F.ws + WS_W + (size_t)j * WL_STRIDE;
        int c0, nv;
        if (r < I_RGIN) { const int nb = r % (NRG / 32), kb = r / (NRG / 32); map_id(nb * 32, 2 * RGW, c0, nv);
            transpose_item(a.in[4] + (size_t)j * D * 2 * RGW, 2 * RGW, D, c0, nv, (bf16*)(wl + WL_RGIN), D, nb * 32, kb * 64, scr, F.lane); continue; } r -= I_RGIN;
        if (r < I_GATES) { const int nb = r % (NGT / 32), kb = r / (NGT / 32); const int n0 = nb * 32, pn = n0 >> 8, rr = n0 & 255, g = rr >> 7, cc = rr & 127, d0 = (pn & 1) * 128 + cc, blk = pn >> 1;
            nv = RGBW - d0; nv = nv < 0 ? 0 : (nv > 32 ? 32 : nv); c0 = nv ? d0 : 0;
            transpose_item(a.in[7] + ((size_t)(j * 2 + g) * 8 + blk) * RGBW * RGBW, RGBW, RGBW, c0, nv, (bf16*)(wl + WL_GATES), KGT, n0, kb * 64, scr, F.lane); continue; } r -= I_GATES;
        if (r < I_RGOUT) { const int nb = r % (D / 32), kb = r / (D / 32);
            transpose_item(a.in[10] + (size_t)j * RGW * D, D, RGW, nb * 32, 32, (bf16*)(wl + WL_RGOUT), KRGO, nb * 32, kb * 64, scr, F.lane); continue; } r -= I_RGOUT;
        if (r < I_GLAIN) { const int nb = r % (NGLA / 32), kb = r / (NGLA / 32);
            transpose_item(a.in[11] + (size_t)j * D * GLAW, GLAW, D, nb * 32, 32, (bf16*)(wl + WL_GLAIN), D, nb * 32, kb * 64, scr, F.lane); continue; } r -= I_GLAIN;
        if (r < I_GLAOUT) { const int nb = r % (D / 32), kb = r / (D / 32);
            transpose_item(a.in[15] + (size_t)j * D * D, D, D, nb * 32, 32, (bf16*)(wl + WL_GLAOUT), D, nb * 32, kb * 64, scr, F.lane); continue; } r -= I_GLAOUT;
        if (r < I_FFNIN) { const int nb = r % (NFF2 / 32), kb = r / (NFF2 / 32); map_swiglu(nb * 32, c0, nv);
            transpose_item(a.in[16] + (size_t)j * D * NFF2, NFF2, D, c0, nv, (bf16*)(wl + WL_FFNIN), D, nb * 32, kb * 64, scr, F.lane); continue; } r -= I_FFNIN;
        if (r < I_FFNOUT) { const int nb = r % (D / 32), kb = r / (D / 32);
            transpose_item(a.in[17] + (size_t)j * FF * D, D, FF, nb * 32, 32, (bf16*)(wl + WL_FFNOUT), FF, nb * 32, kb * 64, scr, F.lane); continue; } r -= I_FFNOUT;
        if (r < I_MOEIN) { const int e = r / I_FFNIN, r2 = r % I_FFNIN; const int nb = r2 % (NFF2 / 32), kb = r2 / (NFF2 / 32); map_swiglu(nb * 32, c0, nv);
            transpose_item(a.in[19] + ((size_t)j * NE + e) * D * NFF2, NFF2, D, c0, nv, (bf16*)(wl + WL_MOEIN) + (size_t)e * NFF2 * D, D, nb * 32, kb * 64, scr, F.lane); continue; } r -= I_MOEIN;
        { const int e = r / I_FFNOUT, r2 = r % I_FFNOUT; const int nb = r2 % (D / 32), kb = r2 / (D / 32);
            transpose_item(a.in[20] + ((size_t)j * NE + e) * FF * D, D, FF, nb * 32, 32, (bf16*)(wl + WL_MOEOUT) + (size_t)e * D * FF, FF, nb * 32, kb * 64, scr, F.lane); }
    }
    bf16* HB = (bf16*)(F.ws + WS_HB);
    for (int m = gw; m < MROWS; m += NGW) {
        const float* src = m < MMAIN ? a.in[0] + (size_t)m * D : a.in[1] + (size_t)(m - MMAIN) * D;
#pragma unroll
        for (int q = 0; q < 4; ++q) { const f32x4 v = *(const f32x4*)(src + 4 * F.lane + 256 * q);
            v2u w; w.x = pk2(v[0], v[1]); w.y = pk2(v[2], v[3]); *(v2u*)(HB + (size_t)m * D + 4 * F.lane + 256 * q) = w; }
    }
}

struct LnRow { v4u h[2], a[2], b[2]; float w1, w2; };
__device__ __forceinline__ void unpack8(const v4u& w, float* o) { o[0] = bflo(w.x); o[1] = bfhi(w.x); o[2] = bflo(w.y); o[3] = bfhi(w.y); o[4] = bflo(w.z); o[5] = bfhi(w.z); o[6] = bflo(w.w); o[7] = bfhi(w.w); }
__device__ __forceinline__ void ln_phase(Frame& F, int mixkind, const float* gam, const float* bet, int extra, const float* Wx, int ldx, float* outp, gu32* moe_cnt) {
    bf16* HB = (bf16*)(F.ws + WS_HB); const bf16* MIX = (const bf16*)(F.ws + WS_MIX);
    const bf16* YS = (const bf16*)(F.ws + WS_S0 + S_YS);
    int* E1 = (int*)(F.ws + WS_RT); int* E2 = E1 + MROWS; float* W1 = (float*)(E2 + MROWS); float* W2 = W1 + MROWS; int* POS1 = (int*)(W2 + MROWS); int* POS2 = POS1 + MROWS;
    float* Z = (float*)(F.ws + WS_Z);
    LAS float* WL = (LAS float*)F.lds;
    LAS unsigned* lcnt = (LAS unsigned*)(F.lds + 65536);
    const int NC = extra == 1 ? 16 : (extra == 2 ? 8 : 0);
    if (extra) { for (int i = F.tid; i < NC * D; i += NTHR) { const int c = i / NC, e = i - c * NC; WL[e * D + c] = Wx[(size_t)c * ldx + e]; }
        if (F.tid < 8) lcnt[F.tid] = 0u;
        __syncthreads(); }
    const int gw = F.bx * NWAVES + F.wave, NGW = F.G * NWAVES, lane = F.lane;
    float gv[16], bv[16];
#pragma unroll
    for (int q = 0; q < 2; ++q)
#pragma unroll
        for (int t = 0; t < 2; ++t) { const f32x4 g4 = *(const f32x4*)(gam + 512 * q + 8 * lane + 4 * t), b4 = *(const f32x4*)(bet + 512 * q + 8 * lane + 4 * t);
#pragma unroll
            for (int k = 0; k < 4; ++k) { gv[8 * q + 4 * t + k] = g4[k]; bv[8 * q + 4 * t + k] = b4[k]; } }
    unsigned mycnt = 0u;
    auto ln_load = [&](LnRow (&R)[2], int m0) {
#pragma unroll
        for (int r = 0; r < 2; ++r) { const int m = m0 + r * NGW; if (m < MROWS) {
            const bf16* hp = HB + (size_t)m * D + 8 * lane; R[r].h[0] = *(const v4u*)hp; R[r].h[1] = *(const v4u*)(hp + 512);
            if (mixkind == 1) { const bf16* mp = MIX + (size_t)m * D + 8 * lane; R[r].a[0] = *(const v4u*)mp; R[r].a[1] = *(const v4u*)(mp + 512); }
            if (mixkind == 2) { R[r].w1 = W1[m]; R[r].w2 = W2[m]; const bf16* y1 = YS + (size_t)POS1[m] * D + 8 * lane; const bf16* y2 = YS + (size_t)POS2[m] * D + 8 * lane;
                R[r].a[0] = *(const v4u*)y1; R[r].a[1] = *(const v4u*)(y1 + 512); R[r].b[0] = *(const v4u*)y2; R[r].b[1] = *(const v4u*)(y2 + 512); } } }
    };
    LnRow Rn[2];
    ln_load(Rn, gw);
    for (int m0 = gw; m0 < MROWS; m0 += 2 * NGW) {
        LnRow R[2];
#pragma unroll
        for (int r = 0; r < 2; ++r) R[r] = Rn[r];
        ln_load(Rn, m0 + 2 * NGW);
#pragma unroll
        for (int r = 0; r < 2; ++r) { const int m = m0 + r * NGW; if (m < MROWS) {
            float v[16]; unpack8(R[r].h[0], v); unpack8(R[r].h[1], v + 8);
#pragma unroll
            for (int k = 0; k < 16; ++k) v[k] *= ALPHA;
            if (mixkind == 1) { float t[16]; unpack8(R[r].a[0], t); unpack8(R[r].a[1], t + 8);
#pragma unroll
                for (int k = 0; k < 16; ++k) v[k] += t[k]; }
            if (mixkind == 2) { float t[16], u[16]; unpack8(R[r].a[0], t); unpack8(R[r].a[1], t + 8); unpack8(R[r].b[0], u); unpack8(R[r].b[1], u + 8);
#pragma unroll
                for (int k = 0; k < 16; ++k) v[k] += t[k] * R[r].w1 + u[k] * R[r].w2; }
            float s = 0.f;
#pragma unroll
            for (int k = 0; k < 16; ++k) s += v[k];
            const float mean = wave_sum(s) * (1.f / D); float s2 = 0.f;
#pragma unroll
            for (int k = 0; k < 16; ++k) { v[k] -= mean; s2 += v[k] * v[k]; }
            const float rstd = __builtin_amdgcn_rsqf(wave_sum(s2) * (1.f / D) + LN_EPS);
#pragma unroll
            for (int k = 0; k < 16; ++k) v[k] = v[k] * rstd * gv[k] + bv[k];
            bf16* op = HB + (size_t)m * D + 8 * lane;
            *(v4u*)op = (v4u){pk2(v[0], v[1]), pk2(v[2], v[3]), pk2(v[4], v[5]), pk2(v[6], v[7])}; *(v4u*)(op + 512) = (v4u){pk2(v[8], v[9]), pk2(v[10], v[11]), pk2(v[12], v[13]), pk2(v[14], v[15])};
            if (outp && m < MMAIN) { float* o = outp + (size_t)m * D + 8 * lane;
                *(f32x4*)o = (f32x4){v[0], v[1], v[2], v[3]}; *(f32x4*)(o + 4) = (f32x4){v[4], v[5], v[6], v[7]}; *(f32x4*)(o + 512) = (f32x4){v[8], v[9], v[10], v[11]}; *(f32x4*)(o + 516) = (f32x4){v[12], v[13], v[14], v[15]}; }
            if (extra) {
                float pp[16];
#pragma unroll
                for (int e = 0; e < 16; ++e) { pp[e] = 0.f; if (e < NC) { float p = 0.f;
#pragma unroll
                        for (int q = 0; q < 2; ++q) { const f32x4 w0 = *(const LAS f32x4*)(WL + e * D + 512 * q + 8 * lane), w1 = *(const LAS f32x4*)(WL + e * D + 512 * q + 8 * lane + 4);
                            p += (v[8 * q + 0] * w0[0] + v[8 * q + 1] * w0[1]) + (v[8 * q + 2] * w0[2] + v[8 * q + 3] * w0[3]) + (v[8 * q + 4] * w1[0] + v[8 * q + 5] * w1[1]) + (v[8 * q + 6] * w1[2] + v[8 * q + 7] * w1[3]); }
                        pp[e] = p; } }
                float lg[8]; float zv;
                if (extra == 1) {
#pragma unroll
                    for (int k = 0; k < 8; ++k) { const bool up = lane & 32; const float snd = up ? pp[k] : pp[k + 8], kp = up ? pp[k + 8] : pp[k]; pp[k] = kp + __shfl_xor(snd, 32); }
#pragma unroll
                    for (int k = 0; k < 4; ++k) { const bool up = lane & 16; const float snd = up ? pp[k] : pp[k + 4], kp = up ? pp[k + 4] : pp[k]; pp[k] = kp + __shfl_xor(snd, 16); }
#pragma unroll
                    for (int k = 0; k < 2; ++k) { const bool up = lane & 8; const float snd = up ? pp[k] : pp[k + 2], kp = up ? pp[k + 2] : pp[k]; pp[k] = kp + __shfl_xor(snd, 8); }
                    { const bool up = lane & 4; const float snd = up ? pp[0] : pp[1], kp = up ? pp[1] : pp[0]; zv = kp + __shfl_xor(snd, 4); }
                    zv += __shfl_xor(zv, 2); zv += __shfl_xor(zv, 1);
                } else {
#pragma unroll
                    for (int k = 0; k < 4; ++k) { const bool up = lane & 32; const float snd = up ? pp[k] : pp[k + 4], kp = up ? pp[k + 4] : pp[k]; pp[k] = kp + __shfl_xor(snd, 32); }
#pragma unroll
                    for (int k = 0; k < 2; ++k) { const bool up = lane & 16; const float snd = up ? pp[k] : pp[k + 2], kp = up ? pp[k + 2] : pp[k]; pp[k] = kp + __shfl_xor(snd, 16); }
                    float rv; { const bool up = lane & 8; const float snd = up ? pp[0] : pp[1], kp = up ? pp[1] : pp[0]; rv = kp + __shfl_xor(snd, 8); }
                    rv += __shfl_xor(rv, 4); rv += __shfl_xor(rv, 2); rv += __shfl_xor(rv, 1);
#pragma unroll
                    for (int e = 0; e < 8; ++e) lg[e] = __int_as_float(__builtin_amdgcn_readlane(__float_as_int(rv), ((e >> 2) & 1) * 32 + ((e >> 1) & 1) * 16 + (e & 1) * 8));
                }
                if (extra == 1) { if ((lane & 3) == 0) Z[(size_t)m * 16 + ((lane >> 5) & 1) * 8 + ((lane >> 4) & 1) * 4 + ((lane >> 3) & 1) * 2 + ((lane >> 2) & 1)] = zv; }
                else { int e1 = 0; float l1 = lg[0];
#pragma unroll
                    for (int e = 1; e < 8; ++e) if (lg[e] > l1) { l1 = lg[e]; e1 = e; }
                    int e2 = -1; float l2 = -3.0e38f;
#pragma unroll
                    for (int e = 0; e < 8; ++e) if (e != e1 && lg[e] > l2) { l2 = lg[e]; e2 = e; }
                    const float w2 = 1.f / (1.f + __expf(l1 - l2)), w1 = 1.f - w2;
                    if (lane == 0) { E1[m] = e1; E2[m] = e2; W1[m] = w1; W2[m] = w2; }
                    mycnt += (lane == e1 || lane == e2) ? 1u : 0u; }
            } } }
    }
    if (extra == 2) { if (lane < 8 && mycnt) __hip_atomic_fetch_add(&lcnt[lane], mycnt, __ATOMIC_RELAXED, __HIP_MEMORY_SCOPE_WORKGROUP);
        __syncthreads();
        if (F.tid < 8 && lcnt[F.tid]) __hip_atomic_fetch_add(moe_cnt + F.tid, lcnt[F.tid], RLX_AGENT); }
}

struct EpiGates {
    static constexpr bool PERM = true, PAIR = true;
    bf16* LOGA; bf16* U; const bf16* XC; const float* bg; const float* lam;
    __device__ __forceinline__ void chan4(int ch, f32x4& br, f32x4& bi, f32x4& c8) const {
        br = *(const f32x4*)(bg + ch); bi = *(const f32x4*)(bg + RGW + ch); const f32x4 lm = *(const f32x4*)(lam + ch);
#pragma unroll
        for (int t = 0; t < 4; ++t) { const float x = __expf(-lm[t]); c8[t] = -8.0f * (x * (1.0f - x * (0.5f - x * (0.33333333f - 0.25f * x)))); }
    }
    __device__ __forceinline__ void elem4(int row, int blk, int d, f32x4 ra, f32x4 ia, const f32x4& br, const f32x4& bi, const f32x4& c8) const {
        const int ch = blk * RGBW + d;
        const v2u xw = *(const v2u*)(XC + (size_t)row * XCW + blk * 256 + d);
        const float xc[4] = {bflo(xw.x), bfhi(xw.x), bflo(xw.y), bfhi(xw.y)};
        f32x4 la, uu;
#pragma unroll
        for (int t = 0; t < 4; ++t) {
            const float r = sigmoid_f(ra[t] + br[t]), ig = sigmoid_f(ia[t] + bi[t]);
            const float l = c8[t] * r;
            const float a2 = fast_exp(2.0f * l);
            la[t] = l; uu[t] = __builtin_amdgcn_sqrtf(fmaxf(1.0f - a2, 0.f)) * (ig * xc[t]);
        }
        *(v2u*)(LOGA + (size_t)row * RGW + ch) = (v2u){pk2(la[0], la[1]), pk2(la[2], la[3])}; *(v2u*)(U + (size_t)row * RGW + ch) = (v2u){pk2(uu[0], uu[1]), pk2(uu[2], uu[3])};
    }
    __device__ __forceinline__ void elem8(int row, int blk, int d, f32x4 ra0, f32x4 ia0, f32x4 ra1, f32x4 ia1, const f32x4 (&br)[2], const f32x4 (&bi)[2], const f32x4 (&c8)[2]) const {
        const int ch = blk * RGBW + d;
        const v4u xw = *(const v4u*)(XC + (size_t)row * XCW + blk * 256 + d);
        float xc[8]; unpack8(xw, xc);
        float la[8], uu[8];
#pragma unroll
        for (int t = 0; t < 8; ++t) {
            const float rav = t < 4 ? ra0[t & 3] : ra1[t & 3], iav = t < 4 ? ia0[t & 3] : ia1[t & 3];
            const float r = sigmoid_f(rav + br[t >> 2][t & 3]), ig = sigmoid_f(iav + bi[t >> 2][t & 3]);
            const float l = c8[t >> 2][t & 3] * r;
            const float a2 = fast_exp(2.0f * l);
            la[t] = l; uu[t] = __builtin_amdgcn_sqrtf(fmaxf(1.0f - a2, 0.f)) * (ig * xc[t]);
        }
        *(v4u*)(LOGA + (size_t)row * RGW + ch) = (v4u){pk2(la[0], la[1]), pk2(la[2], la[3]), pk2(la[4], la[5]), pk2(la[6], la[7])};
        *(v4u*)(U + (size_t)row * RGW + ch) = (v4u){pk2(uu[0], uu[1]), pk2(uu[2], uu[3]), pk2(uu[4], uu[5]), pk2(uu[6], uu[7])};
    }
    __device__ __forceinline__ void operator()(const f32x4 (&acc)[2][2][4][2], const pg8::Unit& u, int wr, int wc, int fr, int fq) const {
        const int row0 = u.pm * 256 + wr * 64 + fr, blk = u.pn >> 1, d0 = (u.pn & 1) * 128 + wc * 32 + 8 * fq;
        if (d0 < RGBW) {
            f32x4 br[2], bi[2], c8[2]; chan4(blk * RGBW + d0, br[0], bi[0], c8[0]); chan4(blk * RGBW + d0 + 4, br[1], bi[1], c8[1]);
#pragma unroll
            for (int ai = 0; ai < 2; ++ai)
#pragma unroll
                for (int m = 0; m < 4; ++m) elem8(row0 + ai * 128 + m * 16, blk, d0, acc[ai][0][m][0], acc[ai][1][m][0], acc[ai][0][m][1], acc[ai][1][m][1], br, bi, c8); }
    }
    __device__ __forceinline__ void meta_task(int task, int& r0, int& aoff) const { const int pn = task >> 3; r0 = pn * 256 + (task & 7) * 16; aoff = (pn >> 1) * 256; }
    __device__ __forceinline__ void meta(int task, f32x4 a0, f32x4 a1, int fr, int fq) const {
        const int pn = task >> 3, d = (pn & 1) * 128 + (task & 7) * 16 + 4 * fq;
        if (d < RGBW) { f32x4 br, bi, c8; chan4((pn >> 1) * RGBW + d, br, bi, c8); elem4(MMAIN + fr, pn >> 1, d, a0, a1, br, bi, c8); }
    }
};

__device__ __forceinline__ int conv_src_row(int row, int delta) {
    if (row < MMAIN) { const int t = row & (SEQ - 1); return (t - delta >= 0) ? row - delta : MMAIN + NMETA + (t - delta); }
    const int jm = row - MMAIN; return (jm - delta >= 0) ? row - delta : -1;
}
__device__ __forceinline__ void rg_conv_phase(Frame& F, const float* cw, const float* cb) {
    const bf16* PROJ = (const bf16*)(F.ws + WS_S0 + S_PROJ); bf16* XC = (bf16*)(F.ws + WS_S0 + S_XC);
    const int g = F.tid & 255, blk = g >> 5, kk = (g & 31) * 8, ch = blk * RGBW + kk;
    constexpr int NIT = (MROWS / 4) * 256;
    const int stride = F.G * NTHR;
    if (kk < RGBW) {
        float w[4][8], bb[8];
        { const f32x4 b0 = *(const f32x4*)(cb + ch), b1 = *(const f32x4*)(cb + ch + 4);
#pragma unroll
          for (int k = 0; k < 4; ++k) { bb[k] = b0[k]; bb[4 + k] = b1[k]; } }
#pragma unroll
        for (int tap = 0; tap < 4; ++tap) { const f32x4 w0 = *(const f32x4*)(cw + tap * RGW + ch), w1 = *(const f32x4*)(cw + tap * RGW + ch + 4);
#pragma unroll
            for (int k = 0; k < 4; ++k) { w[tap][k] = w0[k]; w[tap][4 + k] = w1[k]; } }
        for (int idx = F.bx * NTHR + F.tid; idx < NIT; idx += 2 * stride) {
            v4u x[2][7];
#pragma unroll
            for (int it = 0; it < 2; ++it) { const int id2 = idx + it * stride; if (id2 < NIT) { const int r0 = (id2 >> 8) * 4;
#pragma unroll
                for (int t = 0; t < 3; ++t) { const int rr = conv_src_row(r0, 3 - t); x[it][t] = (v4u){0u, 0u, 0u, 0u}; if (rr >= 0) x[it][t] = *(const v4u*)(PROJ + (size_t)rr * NRG + RGW + ch); }
#pragma unroll
                for (int t = 0; t < 4; ++t) x[it][3 + t] = *(const v4u*)(PROJ + (size_t)(r0 + t) * NRG + RGW + ch); } }
#pragma unroll
            for (int it = 0; it < 2; ++it) { const int id2 = idx + it * stride; if (id2 < NIT) { const int r0 = (id2 >> 8) * 4;
                bf16* xo = XC + (size_t)r0 * XCW + blk * 256 + kk;
                float xf[7][8];
#pragma unroll
                for (int t = 0; t < 7; ++t) unpack8(x[it][t], xf[t]);
#pragma unroll
                for (int i = 0; i < 4; ++i) { float a[8];
#pragma unroll
                    for (int k = 0; k < 8; ++k) a[k] = bb[k] + xf[i][k] * w[0][k] + xf[i + 1][k] * w[1][k] + xf[i + 2][k] * w[2][k] + xf[i + 3][k] * w[3][k];
                    *(v4u*)(xo + (size_t)i * XCW) = (v4u){pk2(a[0], a[1]), pk2(a[2], a[3]), pk2(a[4], a[5]), pk2(a[6], a[7])}; } } }
        }
    } else {
        for (int idx = F.bx * NTHR + F.tid; idx < NIT; idx += stride) { bf16* xo = XC + (size_t)((idx >> 8) * 4) * XCW + blk * 256 + kk;
#pragma unroll
            for (int i = 0; i < 4; ++i) *(v4u*)(xo + (size_t)i * XCW) = (v4u){0u, 0u, 0u, 0u}; }
    }
}
template <bool FIX>
__device__ __forceinline__ void rg_scan_phase(Frame& F) {
    const bf16* LOGA = (const bf16*)(F.ws + WS_S0 + S_LOGA); const bf16* U = (const bf16*)(F.ws + WS_S0 + S_U);
    const bf16* PROJ = (const bf16*)(F.ws + WS_S0 + S_PROJ); bf16* Y = (bf16*)(F.ws + WS_S0 + S_Y);
    float* AGGA = (float*)(F.ws + WS_AGG); float* AGGH = AGGA + (size_t)NSEG * RGW;
    const int gw = F.bx * NWAVES + F.wave, NGW = F.G * NWAVES;
    constexpr int NCG = 11, RB = FIX ? 16 : 32;
    for (int task = gw; task < NSEG * NCG; task += NGW) {
        const int seg = task / NCG, cg = task - seg * NCG, ch = cg * 128 + 2 * F.lane;
        const int row0 = seg == 0 ? MMAIN : (seg - 1) * SEG, nrows = seg == 0 ? NMETA : SEG;
        if (ch >= RGW) {
            if (FIX) for (int r = 0; r < nrows; ++r) *(unsigned*)(Y + (size_t)(row0 + r) * KRGO + ch) = 0u;
            continue;
        }
        float h0 = 0.f, h1 = 0.f, c0 = 0.f, c1 = 0.f;
        if (FIX && seg > 0) {
            { const f32x2 hm = *(const f32x2*)(AGGH + ch); h0 = hm[0]; h1 = hm[1]; }
            const int sb = 1 + ((seg - 1) / NSEG_B) * NSEG_B, ns = (seg - 1) % NSEG_B;
            for (int q = 0; q < ns; q += 8) { f32x2 aa[8], hh[8];
#pragma unroll
                for (int t = 0; t < 8; ++t) { const int qq = (q + t < ns) ? q + t : ns - 1; aa[t] = *(const f32x2*)(AGGA + (size_t)(sb + qq) * RGW + ch); hh[t] = *(const f32x2*)(AGGH + (size_t)(sb + qq) * RGW + ch); }
#pragma unroll
                for (int t = 0; t < 8; ++t) if (q + t < ns) { h0 = __expf(aa[t][0]) * h0 + hh[t][0]; h1 = __expf(aa[t][1]) * h1 + hh[t][1]; } }
        }
        for (int r = 0; r < nrows; r += RB) {
            unsigned la[RB], uu[RB], gt[RB];
#pragma unroll
            for (int t = 0; t < RB; ++t) { const int rr = row0 + ((r + t < nrows) ? r + t : nrows - 1); const size_t o = (size_t)rr * RGW + ch; la[t] = *(const unsigned*)(LOGA + o); uu[t] = *(const unsigned*)(U + o); if (FIX) gt[t] = *(const unsigned*)(PROJ + (size_t)rr * NRG + ch); }
#pragma unroll
            for (int t = 0; t < RB; ++t) if (r + t < nrows) { const float l0 = bflo(la[t]), l1 = bfhi(la[t]);
                h0 = __expf(l0) * h0 + bflo(uu[t]); h1 = __expf(l1) * h1 + bfhi(uu[t]); c0 += l0; c1 += l1;
                if (FIX) *(unsigned*)(Y + (size_t)(row0 + r + t) * KRGO + ch) = pk2(h0 * bflo(gt[t]), h1 * bfhi(gt[t])); }
        }
        if (!FIX) { *(f32x2*)(AGGA + (size_t)seg * RGW + ch) = (f32x2){c0, c1}; *(f32x2*)(AGGH + (size_t)seg * RGW + ch) = (f32x2){h0, h1}; }
    }
}

#define RG_PHASES \
        if (IN(pb + 0)) { if (on_rg) { \
            bf16* PROJ = (bf16*)(F.ws + WS_S0 + S_PROJ); EpiBf16Gelu E{PROJ, NRG, RGW}; \
            meta_gemm(F, HB + (size_t)MMAIN * D, D, D, (const bf16*)(wl + WL_RGIN), NRG / 16, E); \
            pg8::Gemm g{D, D}; pg8::DenseOrder S; S.init(HB, D, (const bf16*)(wl + WL_RGIN), D, MMAIN / 256, NRG / 256, F.G, F.bx); \
            pg8::gemm_phase<EpiBf16Gelu, pg8::DenseOrder>(F.lds, F.tid, g, S, E); } \
            SEAM(pb + 0); } \
        if (IN(pb + 1)) { if (on_rg) rg_conv_phase(F, args.in[5] + (size_t)j * 4 * RGW, args.in[6] + (size_t)j * RGW); SEAM(pb + 1); } \
        if (IN(pb + 2)) { if (on_rg) { \
            const bf16* XC = (const bf16*)(F.ws + WS_S0 + S_XC); \
            EpiGates E{(bf16*)(F.ws + WS_S0 + S_LOGA), (bf16*)(F.ws + WS_S0 + S_U), XC, args.in[8] + (size_t)j * 2 * RGW, args.in[9] + (size_t)j * RGW}; \
            meta_gemm(F, XC + (size_t)MMAIN * XCW, XCW, KGT, (const bf16*)(wl + WL_GATES), (NGT / 256) * 8, E); \
            pg8::Gemm g{KGT, XCW}; pg8::GatesOrder S; S.init(XC, XCW, (const bf16*)(wl + WL_GATES), KGT, MMAIN / 256, NGT / 256, F.G, F.bx); \
            pg8::gemm_phase<EpiGates, pg8::GatesOrder>(F.lds, F.tid, g, S, E); } \
            SEAM(pb + 2); } \
        if (IN(pb + 3)) { if (on_rg) rg_scan_phase<false>(F); SEAM(pb + 3); } \
        if (IN(pb + 4)) { if (on_rg) rg_scan_phase<true>(F); SEAM(pb + 4); } \
        if (IN(pb + 5)) { if (on_rg) { \
            const bf16* Y = (const bf16*)(F.ws + WS_S0 + S_Y); EpiBf16Gelu E{MIX, D, 0}; \
            meta_gemm(F, Y + (size_t)MMAIN * KRGO, KRGO, KRGO, (const bf16*)(wl + WL_RGOUT), D / 16, E); \
            pg8::Gemm g{KRGO, KRGO}; pg8::DenseOrder S; S.init(Y, KRGO, (const bf16*)(wl + WL_RGOUT), KRGO, MMAIN / 256, D / 256, F.G, F.bx); \
            pg8::gemm_phase<EpiBf16Gelu, pg8::DenseOrder>(F.lds, F.tid, g, S, E); } \
            SEAM(pb + 5); }

constexpr int GL_QT = 0, GL_KT = 17408  , GL_KTT = 34816, GL_VT = 53248, GL_ST = 90112  , GL_SM = 155648;
constexpr int QTS = 136, KTTS = 72, VTS = 72, PS = 72, BS = 129;
constexpr int GL_NG = GL_SM + 2048  , GL_WG = GL_NG + 1024  ;
static_assert(GL_WG + 4096 <= MISC_OFF, "GLA LDS map (unit constants)");
static_assert(GL_SM + 2560 <= MISC_OFF, "GLA LDS map");

#define GL_BAR() do { asm volatile("s_waitcnt lgkmcnt(0)" ::: "memory"); __builtin_amdgcn_s_barrier(); asm volatile("" ::: "memory"); __builtin_amdgcn_sched_barrier(0); } while (0)
template <int MODE>
__device__ __forceinline__ void gla_phase(Frame& F, const float* wgu, const float* bgate, const float* normg) {
    const bf16* QKVR = (const bf16*)(F.ws + WS_S0 + S_QKVR); const float* Z = (const float*)(F.ws + WS_Z);
    float* KVS = (float*)(F.ws + WS_S0 + S_KVS); const float* SST = (const float*)(F.ws + WS_S0 + S_SST); float* DEC = (float*)(F.ws + WS_S0 + S_DEC);
    bf16* O = (bf16*)(F.ws + WS_S0 + S_O);
    float* XB = (float*)(F.ws + WS_S0 + S_XB); float* EMF = (float*)(F.ws + WS_S0 + S_EMF);
    LAS bf16* QT = (LAS bf16*)(F.lds + GL_QT); LAS bf16* KT = (LAS bf16*)(F.lds + GL_KT); LAS bf16* PP = (LAS bf16*)(F.lds + GL_KT);
    LAS bf16* KTT = (LAS bf16*)(F.lds + GL_KTT); LAS bf16* VT = (LAS bf16*)(F.lds + GL_VT); LAS unsigned char* ST = F.lds + GL_ST;
    LAS float* Bc = (LAS float*)(F.lds + GL_ST); LAS float* ZC = (LAS float*)(F.lds + GL_ST + 36864); LAS float* TOT = (LAS float*)(F.lds + GL_ST + 40960); LAS float* OFFM = (LAS float*)(F.lds + GL_ST + 43520);
    LAS float* em = (LAS float*)(F.lds + GL_SM); LAS float* ef = em + 128; LAS float* stats = ef + 128;
    LAS float* NGL = (LAS float*)(F.lds + GL_NG); LAS bf16* WGL = (LAS bf16*)(F.lds + GL_WG);
    const int tid0 = F.tid;
#ifdef MK_GLA_SEG
    int glt_cur = -1; unsigned long long glt_t = 0ull;
#define GLT(n) do { if (MODE == (MK_GLA_MODE)) { const unsigned long long t_ = __builtin_amdgcn_s_memrealtime(); if (glt_cur == (MK_GLA_SEG)) F.dbg_acc += t_ - glt_t; glt_cur = (n); glt_t = t_; } } while (0)
#else
#define GLT(n)
#endif
    for (int u = F.bx; u < NGU; u += F.G) {
        const bool meta = u >= BATCH * GH * NSC_BH;
        const int h = meta ? u - BATCH * GH * NSC_BH : (u / NSC_BH) % GH, b = meta ? 0 : u / (GH * NSC_BH), sc = meta ? 0 : u % NSC_BH;
        const int nch = meta ? 1 : CPS;
        f32x4 sacc[8][2];
        int lofs = (4 * ((tid0 & 63) >> 4)) * GDV + 32 * (tid0 >> 6) + (tid0 & 15); asm volatile("" : "+v"(lofs));
#pragma unroll
        for (int dt = 0; dt < 8; ++dt)
#pragma unroll
            for (int i = 0; i < 2; ++i) {
                sacc[dt][i] = (f32x4){0.f, 0.f, 0.f, 0.f};
                if (MODE == 1 && !meta) {
#pragma unroll
                    for (int jj = 0; jj < 4; ++jj) sacc[dt][i][jj] = SST[(size_t)u * (GDK * GDV) + (size_t)((16 * dt + jj) * GDV + 16 * i) + lofs]; }
            }
        float dsum = 0.f;
        if (MODE == 1 && tid0 < 256) NGL[tid0] = normg[h * GDV + tid0];
        for (int i = tid0; i < 16 * GDK; i += NTHR) WGL[i] = (bf16)f2bf(wgu[(size_t)(i >> 7) * GQK + h * GDK + (i & 127)]);
        const float bgv = bgate[h * GDK + (tid0 & 127)];
        f32x4 px[4] = {(f32x4){0.f, 0.f, 0.f, 0.f}, (f32x4){0.f, 0.f, 0.f, 0.f}, (f32x4){0.f, 0.f, 0.f, 0.f}, (f32x4){0.f, 0.f, 0.f, 0.f}}; float pem = 0.f, pef = 0.f;
        f32x4 pz = (f32x4){0.f, 0.f, 0.f, 0.f}; v4u pq0 = (v4u){0u, 0u, 0u, 0u}, pq1 = pq0, pk0 = pq0, pk1 = pq0, pv[4] = {pq0, pq0, pq0, pq0};
#define GLA_PREFETCH(cix) do { const int rb_ = meta ? 0 : b * SEQ + (sc * CPS + (cix)) * 64; \
            const size_t chx_ = meta ? (size_t)(BATCH * GH * (SEQ / 64) + h) : (size_t)((b * GH + h) * (SEQ / 64) + sc * CPS + (cix)); \
            if (MODE == 1) { const float* xp_ = XB + chx_ * (64 * GDK) + (size_t)tid0 * 16; \
              _Pragma("unroll") for (int t_ = 0; t_ < 4; ++t_) px[t_] = *(const f32x4*)(xp_ + 4 * t_); \
              if (tid0 < 128) { pem = EMF[chx_ * 256 + tid0]; pef = EMF[chx_ * 256 + 128 + tid0]; } } \
            { const int c_ = tid0 >> 2, part_ = tid0 & 3; const bool ok_ = (tid0 < 256) && (!meta || c_ >= 48); const int row_ = meta ? MMAIN + c_ - 48 : rb_ + c_; \
              pz = (f32x4){0.f, 0.f, 0.f, 0.f}; if (MODE == 0 && ok_) pz = *(const f32x4*)(Z + (size_t)row_ * 16 + 4 * part_); } \
            { const int cC_ = tid0 & 63, g_ = tid0 >> 6; const bool ok_ = !meta || cC_ >= 48; const int row_ = meta ? MMAIN + cC_ - 48 : rb_ + cC_; const bf16* rp_ = QKVR + (size_t)row_ * NGLA; \
              pq0 = (v4u){0u, 0u, 0u, 0u}; pq1 = pq0; pk0 = pq0; pk1 = pq0; pv[0] = pq0; pv[1] = pq0; pv[2] = pq0; pv[3] = pq0; \
              if (ok_) { if (MODE == 1) { pq0 = *(const v4u*)(rp_ + h * GDK + g_ * 16); pq1 = *(const v4u*)(rp_ + h * GDK + g_ * 16 + 8); } \
                  pk0 = *(const v4u*)(rp_ + GQK + h * GDK + g_ * 16); pk1 = *(const v4u*)(rp_ + GQK + h * GDK + g_ * 16 + 8); \
                  _Pragma("unroll") for (int t_ = 0; t_ < 4; ++t_) pv[t_] = *(const v4u*)(rp_ + 2 * GQK + h * GDV + g_ * 32 + 8 * t_); } } } while (0)
        GLA_PREFETCH(0);
        for (int ci = 0; ci < nch; ++ci) {
            int tid = tid0; asm volatile("" : "+v"(tid));
            const int lane = tid & 63, w = __builtin_amdgcn_readfirstlane(tid >> 6), fr = lane & 15, fq = lane >> 4;
            const int rbase = meta ? 0 : b * SEQ + (sc * CPS + ci) * 64;
            GLT(0);
            const int dA = tid & 127, cgp = tid >> 7;
            const int cC = tid & 63, grp = tid >> 6, d0 = grp * 16, e0 = grp * 32;
            const v4u q0 = pq0, q1 = pq1, k0 = pk0, k1 = pk1, vv[4] = {pv[0], pv[1], pv[2], pv[3]};
            const size_t chx = meta ? (size_t)(BATCH * GH * (SEQ / 64) + h) : (size_t)((b * GH + h) * (SEQ / 64) + sc * CPS + ci);
            f32x4 xr4[4] = {px[0], px[1], px[2], px[3]};
            if (MODE == 1) { if (tid < 128) { em[tid] = pem; ef[tid] = pef; } }
            if (MODE == 0) {
            if (tid < 256) *(LAS f32x4*)(ZC + (tid >> 2) * 16 + 4 * (tid & 3)) = pz;
            GL_BAR();
            float wg[16];
#pragma unroll
            for (int i = 0; i < 16; ++i) wg[i] = bf2f(WGL[i * GDK + dA]);
            { float run = 0.f;
#pragma unroll 4
              for (int cc = 0; cc < 16; ++cc) { const int c = cgp * 16 + cc; float lg = bgv;
#pragma unroll
                for (int i4 = 0; i4 < 4; ++i4) { const f32x4 z4 = *(const LAS f32x4*)(ZC + c * 16 + 4 * i4); lg += (z4[0] * wg[4 * i4] + z4[1] * wg[4 * i4 + 1]) + (z4[2] * wg[4 * i4 + 2] + z4[3] * wg[4 * i4 + 3]); }
                float g = (fminf(lg, 0.f) - __logf(1.0f + __expf(-fabsf(lg)))) * (1.0f / 16.0f);
                if (meta && c < 48) g = 0.f;
                run += g; Bc[c * BS + dA] = run; }
              TOT[cgp * 129 + dA] = run; }
            GL_BAR();
            GLT(1);
            if (tid < 128) { const float t0 = TOT[tid], t1 = TOT[129 + tid], t2 = TOT[258 + tid], t3 = TOT[387 + tid];
                const float bm = t0 + Bc[31 * BS + tid], bl = (t0 + t1) + (t2 + t3);
                const float emv_ = __expf(bm), efv_ = __expf(bl - bm); em[tid] = emv_; ef[tid] = efv_; dsum += bl; EMF[chx * 256 + tid] = emv_; EMF[chx * 256 + 128 + tid] = efv_;
                OFFM[tid] = -bm; OFFM[129 + tid] = t0 - bm; OFFM[258 + tid] = t0 + t1 - bm; OFFM[387 + tid] = t0 + t1 + t2 - bm; }
            GL_BAR();
            }
            GLT(2);
            { const int c = cC;
                const unsigned qw[8] = {q0.x, q0.y, q0.z, q0.w, q1.x, q1.y, q1.z, q1.w}, kw[8] = {k0.x, k0.y, k0.z, k0.w, k1.x, k1.y, k1.z, k1.w};
                unsigned qo[8], ko[8];
                const LAS float* bcr = Bc + c * BS + d0; const LAS float* ofr = OFFM + (c >> 4) * 129 + d0;
#pragma unroll
                for (int t = 0; t < 8; ++t) {
                    const int d = d0 + 2 * t;
                    float x0, x1;
                    if (MODE == 0) { x0 = bcr[2 * t] + ofr[2 * t]; x1 = bcr[2 * t + 1] + ofr[2 * t + 1]; xr4[t >> 1][2 * (t & 1)] = x0; xr4[t >> 1][2 * (t & 1) + 1] = x1; }
                    else { x0 = xr4[t >> 1][2 * (t & 1)]; x1 = xr4[t >> 1][2 * (t & 1) + 1]; }
                    const float e0f = __expf(x0), e1f = __expf(x1), r0 = __expf(-x0), r1 = __expf(-x1);
                    const float ka = bflo(kw[t]) * r0, kb = bfhi(kw[t]) * r1;
                    ko[t] = pk2(ka, kb);
                    if (MODE == 1) qo[t] = pk2(bflo(qw[t]) * (0.08838834764831845f * e0f), bfhi(qw[t]) * (0.08838834764831845f * e1f));
                    KTT[(d) * KTTS + c] = (bf16)(ko[t] & 0xffffu); KTT[(d + 1) * KTTS + c] = (bf16)(ko[t] >> 16);
                }
                if (MODE == 0) { float* xp = XB + chx * (64 * GDK) + (size_t)tid * 16;
#pragma unroll
                    for (int t = 0; t < 4; ++t) *(f32x4*)(xp + 4 * t) = xr4[t]; }
                *(LAS v4u*)(KT + c * QTS + d0) = (v4u){ko[0], ko[1], ko[2], ko[3]}; *(LAS v4u*)(KT + c * QTS + d0 + 8) = (v4u){ko[4], ko[5], ko[6], ko[7]};
                if (MODE == 1) { *(LAS v4u*)(QT + c * QTS + d0) = (v4u){qo[0], qo[1], qo[2], qo[3]}; *(LAS v4u*)(QT + c * QTS + d0 + 8) = (v4u){qo[4], qo[5], qo[6], qo[7]}; }
#pragma unroll
                for (int t = 0; t < 4; ++t) { const unsigned vw[4] = {vv[t].x, vv[t].y, vv[t].z, vv[t].w};
#pragma unroll
                    for (int s = 0; s < 4; ++s) { const int e = e0 + 8 * t + 2 * s; VT[e * VTS + c] = (bf16)(vw[s] & 0xffffu); VT[(e + 1) * VTS + c] = (bf16)(vw[s] >> 16); } }
            }
            GL_BAR();
            GLT(3);
            f32x4 pacc[2];
#pragma unroll
            for (int dt = 0; dt < 8; ++dt) { const f32x4 emv = *(const LAS f32x4*)(em + 16 * dt + 4 * fq);
#pragma unroll
                for (int i = 0; i < 2; ++i) { sacc[dt][i] = sacc[dt][i] * emv;
                    if (MODE == 1) { const int e = 32 * w + 16 * i + fr; const int ck = (2 * dt + (fq >> 1)) ^ (e & 15);
                        v2u sw; sw.x = pk2(sacc[dt][i][0], sacc[dt][i][1]); sw.y = pk2(sacc[dt][i][2], sacc[dt][i][3]);
                        *(LAS v2u*)(ST + e * 256 + ck * 16 + (fq & 1) * 8) = sw; } } }
            if (MODE == 1) {
                const int mt = w & 3, ntp = w >> 2;
#pragma unroll
                for (int ii = 0; ii < 2; ++ii) { const int nt = 2 * ntp + ii; pacc[ii] = (f32x4){0.f, 0.f, 0.f, 0.f};
                    if (nt <= mt) {
#pragma unroll
                        for (int ks = 0; ks < 4; ++ks) { const bf16x8 kf = *(const LAS bf16x8*)(KT + (16 * nt + fr) * QTS + 32 * ks + 8 * fq); const bf16x8 qf = *(const LAS bf16x8*)(QT + (16 * mt + fr) * QTS + 32 * ks + 8 * fq);
                            pacc[ii] = __builtin_amdgcn_mfma_f32_16x16x32_bf16(kf, qf, pacc[ii], 0, 0, 0); }
                        if (nt == mt) {
#pragma unroll
                            for (int jj = 0; jj < 4; ++jj) if (4 * fq + jj > fr) pacc[ii][jj] = 0.f; }
                    } }
            }
            GL_BAR();
            if (MODE == 1) { const int mt = w & 3, ntp = w >> 2;
#pragma unroll
                for (int ii = 0; ii < 2; ++ii) { const int nt = 2 * ntp + ii; v2u pw; pw.x = pk2(pacc[ii][0], pacc[ii][1]); pw.y = pk2(pacc[ii][2], pacc[ii][3]);
                    *(LAS v2u*)(PP + (16 * mt + fr) * PS + 16 * nt + 4 * fq) = pw; }
                GL_BAR();
            }
            GLT(4);
            f32x4 oacc[8];
            v2u rr[8];
            if (MODE == 1) { const int cF = 16 * (w & 3) + fr; const bool validF = !meta || cF >= 48; const int rowF = meta ? MMAIN + cF - 48 : rbase + cF;
#pragma unroll
                for (int t = 0; t < 8; ++t) { rr[t] = (v2u){0u, 0u}; if (validF) rr[t] = *(const v2u*)(QKVR + (size_t)rowF * NGLA + 2 * GQK + GVD + h * GDV + 128 * (w >> 2) + 16 * t + 4 * fq); } }
            if (MODE == 1) { const int mt = w & 3, eh = w >> 2;
                bf16x8 pf[2], qf[4];
#pragma unroll
                for (int ks = 0; ks < 2; ++ks) pf[ks] = *(const LAS bf16x8*)(PP + (16 * mt + fr) * PS + 32 * ks + 8 * fq);
#pragma unroll
                for (int ks = 0; ks < 4; ++ks) qf[ks] = *(const LAS bf16x8*)(QT + (16 * mt + fr) * QTS + 32 * ks + 8 * fq);
#pragma unroll
                for (int t = 0; t < 8; ++t) { const int e = 128 * eh + 16 * t + fr; f32x4 a = (f32x4){0.f, 0.f, 0.f, 0.f};
#pragma unroll
                    for (int ks = 0; ks < 2; ++ks) { const bf16x8 vf = *(const LAS bf16x8*)(VT + e * VTS + 32 * ks + 8 * fq); a = __builtin_amdgcn_mfma_f32_16x16x32_bf16(vf, pf[ks], a, 0, 0, 0); }
#pragma unroll
                    for (int ks = 0; ks < 4; ++ks) { const int ck = (4 * ks + fq) ^ (e & 15); const bf16x8 sf = *(const LAS bf16x8*)(ST + e * 256 + ck * 16); a = __builtin_amdgcn_mfma_f32_16x16x32_bf16(sf, qf[ks], a, 0, 0, 0); }
                    oacc[t] = a; }
            }
            { bf16x8 vf[2][2];
#pragma unroll
              for (int i = 0; i < 2; ++i)
#pragma unroll
                  for (int ks = 0; ks < 2; ++ks) vf[i][ks] = *(const LAS bf16x8*)(VT + (32 * w + 16 * i + fr) * VTS + 32 * ks + 8 * fq);
#pragma unroll
              for (int dt = 0; dt < 8; ++dt) { const f32x4 efv = *(const LAS f32x4*)(ef + 16 * dt + 4 * fq);
#pragma unroll
                  for (int ks = 0; ks < 2; ++ks) { const bf16x8 kf = *(const LAS bf16x8*)(KTT + (16 * dt + fr) * KTTS + 32 * ks + 8 * fq);
#pragma unroll
                      for (int i = 0; i < 2; ++i) sacc[dt][i] = __builtin_amdgcn_mfma_f32_16x16x32_bf16(kf, vf[i][ks], sacc[dt][i], 0, 0, 0); }
#pragma unroll
                  for (int i = 0; i < 2; ++i) sacc[dt][i] = sacc[dt][i] * efv; }
            }
            if (ci + 1 < nch) GLA_PREFETCH(ci + 1);
            GLT(5);
            if (MODE == 1) { const int mt = w & 3, eh = w >> 2, c = 16 * mt + fr;
                float s1 = 0.f, s2 = 0.f;
#pragma unroll
                for (int t = 0; t < 8; ++t)
#pragma unroll
                    for (int jj = 0; jj < 4; ++jj) { s1 += oacc[t][jj]; s2 += oacc[t][jj] * oacc[t][jj]; }
                s1 += __shfl_xor(s1, 16); s1 += __shfl_xor(s1, 32); s2 += __shfl_xor(s2, 16); s2 += __shfl_xor(s2, 32);
                if (fq == 0) { stats[(c * 2 + eh) * 2 + 0] = s1; stats[(c * 2 + eh) * 2 + 1] = s2; }
                GL_BAR();
                const float t1 = stats[(c * 2 + 0) * 2 + 0] + stats[(c * 2 + 1) * 2 + 0], t2 = stats[(c * 2 + 0) * 2 + 1] + stats[(c * 2 + 1) * 2 + 1];
                const float mean = t1 * (1.0f / GDV), var = fmaxf(t2 * (1.0f / GDV) - mean * mean, 0.f), rstd = __builtin_amdgcn_rsqf(var + LN_EPS);
                const bool valid = !meta || c >= 48; const int row = meta ? MMAIN + c - 48 : rbase + c;
                if (valid) {
#pragma unroll
                    for (int t = 0; t < 8; ++t) { const int e = 128 * eh + 16 * t + 4 * fq;
                        const v2u rw = rr[t];
                        const f32x4 ng = *(const LAS f32x4*)(NGL + e);
                        const float r4[4] = {bflo(rw.x), bfhi(rw.x), bflo(rw.y), bfhi(rw.y)}; float o4[4];
#pragma unroll
                        for (int jj = 0; jj < 4; ++jj) o4[jj] = (oacc[t][jj] - mean) * rstd * ng[jj] * silu_f(r4[jj]);
                        v2u ow; ow.x = pk2(o4[0], o4[1]); ow.y = pk2(o4[2], o4[3]);
                        *(v2u*)(O + (size_t)row * D + h * GDV + e) = ow; } }
            }
            GL_BAR();
            GLT(6);
        }
        if (MODE == 0) {
            int lofs2 = (4 * ((tid0 & 63) >> 4)) * GDV + 32 * (tid0 >> 6) + (tid0 & 15); asm volatile("" : "+v"(lofs2));
#pragma unroll
            for (int dt = 0; dt < 8; ++dt)
#pragma unroll
                for (int i = 0; i < 2; ++i)
#pragma unroll
                    for (int jj = 0; jj < 4; ++jj) KVS[(size_t)u * (GDK * GDV) + (size_t)((16 * dt + jj) * GDV + 16 * i) + lofs2] = sacc[dt][i][jj];
            if (tid0 < 128) DEC[(size_t)u * GDK + tid0] = dsum;
        }
    }
}
__device__ __forceinline__ void gla_scan_phase(Frame& F) {
    const float* KVS = (const float*)(F.ws + WS_S0 + S_KVS); float* SST = (float*)(F.ws + WS_S0 + S_SST); const float* DEC = (const float*)(F.ws + WS_S0 + S_DEC);
    constexpr int NEL = GDK * GDV;
    for (int idx = F.bx * NTHR + F.tid; idx < BATCH * GH * NEL; idx += F.G * NTHR) {
        const int bh = idx / NEL, el = idx - bh * NEL, d = el / GDV, h = bh % GH;
        float s = KVS[(size_t)(BATCH * GH * NSC_BH + h) * NEL + el];
        const size_t ub = (size_t)bh * NSC_BH;
        SST[ub * NEL + el] = s;
        for (int sc = 0; sc + 1 < NSC_BH; sc += 7) { float dv[7], kv[7];
#pragma unroll
            for (int t = 0; t < 7; ++t) { dv[t] = DEC[(ub + sc + t) * GDK + d]; kv[t] = KVS[(ub + sc + t) * NEL + el]; }
#pragma unroll
            for (int t = 0; t < 7; ++t) { s = __expf(dv[t]) * s + kv[t]; SST[(ub + sc + t + 1) * NEL + el] = s; } }
    }
}

#define GLA_PHASES \
        if (IN(pb + 10)) { if (on_gla) { \
            bf16* QKVR = (bf16*)(F.ws + WS_S0 + S_QKVR); EpiBf16Gelu E{QKVR, NGLA, 0}; \
            meta_gemm(F, HB + (size_t)MMAIN * D, D, D, (const bf16*)(wl + WL_GLAIN), NGLA / 16, E); \
            pg8::Gemm g{D, D}; pg8::DenseOrder S; S.init(HB, D, (const bf16*)(wl + WL_GLAIN), D, MMAIN / 256, NGLA / 256, F.G, F.bx); \
            pg8::gemm_phase<EpiBf16Gelu, pg8::DenseOrder>(F.lds, F.tid, g, S, E); } \
            SEAM(pb + 10); } \
        if (IN(pb + 11)) { if (on_gla) gla_phase<0>(F, args.in[12] + (size_t)j * GRANK * GQK, args.in[13] + (size_t)j * GQK, args.in[14] + (size_t)j * GVD); SEAM(pb + 11); } \
        if (IN(pb + 12)) { if (on_gla) gla_scan_phase(F); SEAM(pb + 12); } \
        if (IN(pb + 13)) { if (on_gla) gla_phase<1>(F, args.in[12] + (size_t)j * GRANK * GQK, args.in[13] + (size_t)j * GQK, args.in[14] + (size_t)j * GVD); SEAM(pb + 13); } \
        if (IN(pb + 14)) { if (on_gla) { \
            const bf16* O = (const bf16*)(F.ws + WS_S0 + S_O); EpiBf16Gelu E{MIX, D, 0}; \
            meta_gemm(F, O + (size_t)MMAIN * D, D, D, (const bf16*)(wl + WL_GLAOUT), D / 16, E); \
            pg8::Gemm g{D, D}; pg8::DenseOrder S; S.init(O, D, (const bf16*)(wl + WL_GLAOUT), D, MMAIN / 256, D / 256, F.G, F.bx); \
            pg8::gemm_phase<EpiBf16Gelu, pg8::DenseOrder>(F.lds, F.tid, g, S, E); } \
            SEAM(pb + 14); }

__device__ __forceinline__ void moe_panel_ends(const gu32* cnt, int (&pe)[8]) {
    int acc = 0;
#pragma unroll
    for (int e = 0; e < 8; ++e) { const int c = (int)__hip_atomic_load(cnt + e, RLX_AGENT); acc += (c + 255) >> 8; pe[e] = acc; }
}
__device__ __forceinline__ void moe_gather_phase(Frame& F, gu32* moe) {
    const bf16* HB = (const bf16*)(F.ws + WS_HB); bf16* AS = (bf16*)(F.ws + WS_S0 + S_AS);
    const int* E1 = (const int*)(F.ws + WS_RT); const int* E2 = E1 + MROWS; int* POS1 = (int*)(F.ws + WS_RT) + 4 * MROWS; int* POS2 = POS1 + MROWS;
    LAS unsigned* lcnt = (LAS unsigned*)F.lds; LAS unsigned* lbase = lcnt + 8; LAS int* lpos = (LAS int*)(F.lds + 256);
    const int per = (MROWS + F.G - 1) / F.G, t0 = F.bx * per, nt = (t0 + per <= MROWS) ? per : (MROWS - t0 > 0 ? MROWS - t0 : 0);
    if (F.tid < 8) lcnt[F.tid] = 0u;
    __syncthreads();
    int e1 = 0, e2 = 0; unsigned r1 = 0, r2 = 0;
    if (F.tid < nt) { e1 = E1[t0 + F.tid]; e2 = E2[t0 + F.tid];
        r1 = __hip_atomic_fetch_add(&lcnt[e1], 1u, __ATOMIC_RELAXED, __HIP_MEMORY_SCOPE_WORKGROUP); r2 = __hip_atomic_fetch_add(&lcnt[e2], 1u, __ATOMIC_RELAXED, __HIP_MEMORY_SCOPE_WORKGROUP); }
    __syncthreads();
    if (F.tid < 8) { int ps = 0, accp = 0;
#pragma unroll
        for (int e = 0; e < 8; ++e) { ps = (e == F.tid) ? accp : ps; accp += ((int)__hip_atomic_load(moe + e, RLX_AGENT) + 255) >> 8; }
        const unsigned c = lcnt[F.tid]; const unsigned off = c ? __hip_atomic_fetch_add(moe + 64 + F.tid, c, RLX_AGENT) : 0u;
        lbase[F.tid] = (unsigned)ps * 256u + off; }
    __syncthreads();
    if (F.tid < nt) { const int p1 = (int)(lbase[e1] + r1), p2 = (int)(lbase[e2] + r2); POS1[t0 + F.tid] = p1; POS2[t0 + F.tid] = p2; lpos[2 * F.tid] = p1; lpos[2 * F.tid + 1] = p2; }
    __syncthreads();
    for (int t = F.wave; t < nt; t += NWAVES) {
        const v4u* src = (const v4u*)(HB + (size_t)(t0 + t) * D); const v4u a = src[F.lane], b = src[64 + F.lane];
        v4u* d1 = (v4u*)(AS + (size_t)lpos[2 * t] * D); v4u* d2 = (v4u*)(AS + (size_t)lpos[2 * t + 1] * D);
        d1[F.lane] = a; d1[64 + F.lane] = b; d2[F.lane] = a; d2[64 + F.lane] = b;
    }
}

#ifdef MK_IDLE_TICKS
#define IDLE_PROBE { const unsigned long long t0_ = __builtin_amdgcn_s_memrealtime(); while (__builtin_amdgcn_s_memrealtime() - t0_ < (unsigned long long)(MK_IDLE_TICKS)) __builtin_amdgcn_s_sleep(64); }
#else
#define IDLE_PROBE
#endif
#define MOE_PHASES \
        if (IN(pb + 16)) { if (on_moe) moe_gather_phase(F, F.ctl + CW_MOE + 256 * j); IDLE_PROBE SEAM(pb + 16); } \
        if (IN(pb + 17)) { if (on_moe) { \
            const bf16* AS = (const bf16*)(F.ws + WS_S0 + S_AS); bf16* HS = (bf16*)(F.ws + WS_S0 + S_HS); EpiSwiglu E{HS, FF}; \
            pg8::Gemm g{D, D}; pg8::MoeOrder S; moe_panel_ends(F.ctl + CW_MOE + 256 * j, S.pe); S.e_bytes = (size_t)NFF2 * D * 2; \
            S.init(AS, D, (const bf16*)(wl + WL_MOEIN), D, S.pe[7], NFF2 / 256, F.G, F.bx); \
            pg8::gemm_phase<EpiSwiglu, pg8::MoeOrder>(F.lds, F.tid, g, S, E); } \
            SEAM(pb + 17); } \
        if (IN(pb + 18)) { if (on_moe) { \
            const bf16* HS = (const bf16*)(F.ws + WS_S0 + S_HS); EpiBf16Gelu E{(bf16*)(F.ws + WS_S0 + S_YS), D, 0}; \
            pg8::Gemm g{FF, FF}; pg8::MoeOrder S; moe_panel_ends(F.ctl + CW_MOE + 256 * j, S.pe); S.e_bytes = (size_t)D * FF * 2; \
            S.init(HS, FF, (const bf16*)(wl + WL_MOEOUT), FF, S.pe[7], D / 256, F.G, F.bx); \
            pg8::gemm_phase<EpiBf16Gelu, pg8::MoeOrder>(F.lds, F.tid, g, S, E); } \
            SEAM(pb + 18); }

constexpr int NPHASE = 41;
#ifndef MK_PER_PHASE
#define MK_PER_PHASE 0
#endif
#ifndef MK_DBG
#define MK_DBG 0
#endif
#ifndef MK_SUBMASK
#define MK_SUBMASK 0xFFu
#endif

__global__ void __launch_bounds__(NTHR, 2) fwd(Args args) {
    extern __shared__ __attribute__((aligned(16))) unsigned char lds[];
    Frame F;
    F.lds = (LAS unsigned char*)lds; F.ws = args.ws; F.ctl = (gu32*)(args.ws + WS_CTL);
    F.tid = threadIdx.x; F.lane = F.tid & 63; F.wave = __builtin_amdgcn_readfirstlane(F.tid >> 6); F.G = gridDim.x; F.bx = blockIdx.x; F.dbg_acc = 0ull;
    volatile LAS unsigned* MISC = (volatile LAS unsigned*)(F.lds + MISC_OFF);
    if (F.tid < 16) MISC[F.tid] = 0u;
    __syncthreads();
    const int lo = args.ph_lo, hi = args.ph_hi;
    XcdBarrier bar; bar.bar = (unsigned*)(F.ctl + CW_BAR); bar.x = 0; bar.st = nullptr;
    if (hi - lo > 1) bar = xcd_barrier_post((unsigned*)(F.ctl + CW_BAR), MISC);
#ifdef MK_STAMP_MASK
    unsigned long long st_acc = 0ull, st_t0 = 0ull;
#define ST_SEL(k) ((k) == 0 ? (((MK_STAMP_MASK) >> 20) & 1u) : ((((MK_STAMP_MASK) >> (((k) - 1) % 20)) & 1u)))
#define IN(k) (lo <= (k) && (k) < hi && (F.fresh(), st_t0 = __builtin_amdgcn_s_memrealtime(), true))
#define SEAM(k) do { const unsigned long long t1_ = __builtin_amdgcn_s_memrealtime(); if (ST_SEL(k)) st_acc += t1_ - st_t0; if ((k) + 1 < hi) xcd_barrier(bar); if (((MK_STAMP_MASK) >> 21) & 1u) st_acc += __builtin_amdgcn_s_memrealtime() - t1_; } while (0)
#else
#define IN(k) (lo <= (k) && (k) < hi && (F.fresh(), true))
#define SEAM(k) do { if ((k) + 1 < hi) xcd_barrier(bar); } while (0)
#endif
    const unsigned submask = args.submask;
    const float* ln_gain = args.in[2]; const float* ln_bias = args.in[3];
    bf16* HB = (bf16*)(F.ws + WS_HB); bf16* MIX = (bf16*)(F.ws + WS_MIX);

    if (IN(0)) { p0_prologue(F, args); SEAM(0); }

    for (int j = 0; j < 2; ++j) {
        const int pb = 1 + 20 * j;
        unsigned char* wl = F.ws + WS_W + (size_t)j * WL_STRIDE;
        const bool on_rg = (submask >> (4 * j + 0)) & 1u, on_ffn = (submask >> (4 * j + 1)) & 1u, on_gla = (submask >> (4 * j + 2)) & 1u, on_moe = (submask >> (4 * j + 3)) & 1u;
        RG_PHASES
        if (IN(pb + 6)) { ln_phase(F, on_rg ? 1 : 0, ln_gain + (size_t)(2 * j) * 2 * D, ln_bias + (size_t)(2 * j) * 2 * D, 0, nullptr, 0, nullptr, nullptr); SEAM(pb + 6); }
        if (IN(pb + 7)) { if (on_ffn) {
            bf16* HID = (bf16*)(F.ws + WS_S0 + S_HID);
            EpiSwiglu E{HID, FF};
            if (!(MK_DBG & 1)) meta_gemm(F, HB + (size_t)MMAIN * D, D, D, (const bf16*)(wl + WL_FFNIN), (NFF2 / 256) * 8, E);
            pg8::Gemm g{D, D}; pg8::DenseOrder S; S.init(HB, D, (const bf16*)(wl + WL_FFNIN), D, MMAIN / 256, NFF2 / 256, F.G, F.bx);
            if (!(MK_DBG & 2)) pg8::gemm_phase<EpiSwiglu, pg8::DenseOrder>(F.lds, F.tid, g, S, E); }
            SEAM(pb + 7); }
        if (IN(pb + 8)) { if (on_ffn) {
            const bf16* HID = (const bf16*)(F.ws + WS_S0 + S_HID);
            EpiBf16Gelu E{MIX, D, 0};
            if (!(MK_DBG & 4)) meta_gemm(F, HID + (size_t)MMAIN * FF, FF, FF, (const bf16*)(wl + WL_FFNOUT), D / 16, E);
            pg8::Gemm g{FF, FF}; pg8::DenseOrder S; S.init(HID, FF, (const bf16*)(wl + WL_FFNOUT), FF, MMAIN / 256, D / 256, F.G, F.bx);
            if (!(MK_DBG & 8)) pg8::gemm_phase<EpiBf16Gelu, pg8::DenseOrder>(F.lds, F.tid, g, S, E); }
            SEAM(pb + 8); }
        if (IN(pb + 9)) { ln_phase(F, on_ffn ? 1 : 0, ln_gain + (size_t)(2 * j) * 2 * D + D, ln_bias + (size_t)(2 * j) * 2 * D + D, 1, args.in[11] + (size_t)j * D * GLAW + NGLA, GLAW, nullptr, nullptr); SEAM(pb + 9); }
        GLA_PHASES
        if (IN(pb + 15)) { ln_phase(F, on_gla ? 1 : 0, ln_gain + (size_t)(2 * j + 1) * 2 * D, ln_bias + (size_t)(2 * j + 1) * 2 * D, on_moe ? 2 : 0, args.in[18] + (size_t)j * D * NE, NE, nullptr, F.ctl + CW_MOE + 256 * j); SEAM(pb + 15); }
        MOE_PHASES
        if (IN(pb + 19)) { ln_phase(F, on_moe ? 2 : 0, ln_gain + (size_t)(2 * j + 1) * 2 * D + D, ln_bias + (size_t)(2 * j + 1) * 2 * D + D, 0, nullptr, 0, j == 1 ? args.out : nullptr, nullptr); SEAM(pb + 19); }
    }
#ifdef MK_STAMP_MASK
    __syncthreads();
    if (blockIdx.x == 0 && threadIdx.x == 0) args.out[0] = (float)(st_acc + F.dbg_acc) * 0.01f * (MK_STAMP_SCALE);
#endif
#undef IN
#undef SEAM
}

static bool phase_enabled(int k, unsigned mask) {
    if (k == 0) return true;
    const int j = (k - 1) / 20, r = (k - 1) % 20;
    int sub;
    if (r <= 5) sub = 0; else if (r == 6) return true; else if (r <= 8) sub = 1; else if (r == 9) return true;
    else if (r <= 14) sub = 2; else if (r == 15) return true; else if (r <= 18) sub = 3; else return true;
    return (mask >> (4 * j + sub)) & 1u;
}
extern "C" void kernel_launch(void* const* d_in, const int* in_sizes, int n_in, void* d_out, int out_size, void* d_ws, size_t ws_size, hipStream_t stream) {
    static int grid = 0;
    if (grid == 0) {
        if (n_in != 21 || out_size != MMAIN * D || ws_size < WS_END) { fprintf(stderr, "kernel_launch: unexpected shapes: n_in %d out %d ws %zu (need %zu); nothing launched\n", n_in, out_size, ws_size, (size_t)WS_END); grid = -1; return; }
        int dev = 0, cus = 0, per_cu = 0;
        if (hipGetDevice(&dev) != hipSuccess || hipDeviceGetAttribute(&cus, hipDeviceAttributeMultiprocessorCount, dev) != hipSuccess) { grid = -1; return; }
        if (hipFuncSetAttribute((const void*)fwd, hipFuncAttributeMaxDynamicSharedMemorySize, LDS_BYTES) != hipSuccess) { fprintf(stderr, "kernel_launch: hipFuncSetAttribute failed\n"); grid = -1; return; }
        if (hipOccupancyMaxActiveBlocksPerMultiprocessor(&per_cu, (const void*)fwd, NTHR, LDS_BYTES) != hipSuccess || per_cu < 1) fprintf(stderr, "kernel_launch: note: occupancy query reports %d\n", per_cu);
        (void)hipGetLastError();
        grid = cus;
    }
    if (grid < 0) return;
    (void)hipMemsetAsync((char*)d_ws + WS_CTL, 0, CTL_ZERO_BYTES, stream);
    Args a{};
    for (int i = 0; i < 21; ++i) a.in[i] = (const float*)d_in[i];
    a.out = (float*)d_out; a.ws = (unsigned char*)d_ws; a.submask = MK_SUBMASK; a.pad = 0;
#if MK_PER_PHASE
    for (int k = 0; k < NPHASE; ++k) { if (!phase_enabled(k, MK_SUBMASK)) continue; a.ph_lo = k; a.ph_hi = k + 1; hipLaunchKernelGGL(fwd, dim3(grid), dim3(NTHR), LDS_BYTES, stream, a); }
#else
    a.ph_lo = 0; a.ph_hi = NPHASE; hipLaunchKernelGGL(fwd, dim3(grid), dim3(NTHR), LDS_BYTES, stream, a);
#ifdef MK_PROBE_LIST
    { const int pl[] = {MK_PROBE_LIST}; for (int k : pl) { a.ph_lo = k; a.ph_hi = k + 1; hipLaunchKernelGGL(fwd, dim3(grid), dim3(NTHR), LDS_BYTES, stream, a); } }
#endif
#endif
}
```

```cpp
#include <hip/hip_runtime.h>
#include <cstdio>
#include <cstdint>

#define GAS __attribute__((address_space(1)))
#define LAS __attribute__((address_space(3)))
typedef unsigned short bf16;
typedef unsigned v4u __attribute__((ext_vector_type(4)));
typedef unsigned v2u __attribute__((ext_vector_type(2)));
typedef float f32x4 __attribute__((ext_vector_type(4)));
typedef float f32x2 __attribute__((ext_vector_type(2)));
typedef short bf16x8 __attribute__((ext_vector_type(8)));
typedef short bf16x4 __attribute__((ext_vector_type(4)));
typedef GAS unsigned gu32;
#define RLX_AGENT __ATOMIC_RELAXED, __HIP_MEMORY_SCOPE_AGENT
#define LDS_WAIT() asm volatile("s_waitcnt lgkmcnt(0)" ::: "memory")
#define VM_WAIT() asm volatile("s_waitcnt vmcnt(0)" ::: "memory")

__device__ __forceinline__ unsigned f2bf(float f) { unsigned u = __builtin_bit_cast(unsigned, f); return (u + 0x7fffu + ((u >> 16) & 1u)) >> 16; }
__device__ __forceinline__ unsigned pk2(float lo, float hi) { unsigned r; asm("v_cvt_pk_bf16_f32 %0, %1, %2" : "=v"(r) : "v"(lo), "v"(hi)); return r; }
__device__ __forceinline__ float bflo(unsigned w) { return __builtin_bit_cast(float, w << 16); }
__device__ __forceinline__ float bfhi(unsigned w) { return __builtin_bit_cast(float, w & 0xffff0000u); }
__device__ __forceinline__ float bf2f(bf16 b) { return __builtin_bit_cast(float, (unsigned)b << 16); }
__device__ __forceinline__ unsigned cvt_pk_bf16(float lo, float hi) { unsigned r; asm volatile("v_cvt_pk_bf16_f32 %0, %1, %2" : "=v"(r) : "v"(lo), "v"(hi)); return r; }
__device__ __forceinline__ float fast_exp(float x) { return __builtin_amdgcn_exp2f(x * 1.44269504089f); }
__device__ __forceinline__ float sigmoid_f(float x) { return __builtin_amdgcn_rcpf(1.0f + fast_exp(-x)); }
__device__ __forceinline__ float silu_f(float x) { return x * sigmoid_f(x); }
__device__ __forceinline__ float gelu_tanh_f(float x) { const float u = 0.7978845608028654f * (x + 0.044715f * x * x * x); return x * sigmoid_f(2.0f * u); }
__device__ __forceinline__ float shx(float v, int m, int lane) { return __int_as_float(__builtin_amdgcn_ds_bpermute((lane ^ m) << 2, __float_as_int(v))); }
__device__ __forceinline__ float wave_sum(float v, int lane) {
#pragma unroll
    for (int o = 1; o < 64; o <<= 1) v += shx(v, o, lane);
    return v;
}

namespace pg8 {
constexpr int BM = 256, BK = 64, HALF = 128, HTB = HALF * BK * 2  , STAGE_BYTES = 8 * HTB, NXCD = 8, WGM = 8;
__host__ __device__ __forceinline__ int lds_byte(int r, int c) { const int st = (r >> 4) * 2 + (c >> 5), rr = r & 15, cc = c & 31, ob = rr * 64 + cc * 2; return st * 1024 + (ob ^ (((ob >> 9) & 1) << 5)); }
__host__ __device__ __forceinline__ void stage_rc(int b, int& R, int& C) { const int st = b / 1024, sb = b % 1024, swz = sb ^ (((sb >> 9) & 1) << 5); R = (st >> 1) * 16 + swz / 64; C = (st & 1) * 32 + (swz % 64) / 2; }
__host__ __device__ __forceinline__ int perm32(int rho) { const int n = rho >> 4, i = rho & 15; return 8 * (i >> 2) + 4 * n + (i & 3); }

struct Unit { int pm, pn; };
struct Gemm { int K, lda, esz; };

struct OrderBase {
    int nM, nN, nwg, G, c;
    __device__ __forceinline__ void init_order(int nM_, int nN_, int G_, int c_) { nM = nM_; nN = nN_; nwg = nM * nN; G = G_; c = c_; }
    __device__ __forceinline__ bool next(int i, Unit& u) const {
        const long L = (long)i * G + c; if (L >= nwg) return false;
        int wgid = (int)L; { const int q = nwg / NXCD, r = nwg % NXCD, xcd = wgid % NXCD, off = wgid / NXCD; wgid = (xcd < r ? xcd * (q + 1) : r * (q + 1) + (xcd - r) * q) + off; }
        const int nig = WGM * nN, gid = wgid / nig, fm = gid * WGM, gsz = (nM - fm) < WGM ? (nM - fm) : WGM;
        u.pm = __builtin_amdgcn_readfirstlane(fm + ((wgid % nig) % gsz)); u.pn = __builtin_amdgcn_readfirstlane((wgid % nig) / gsz); return true;
    }
};
struct DenseOrder : OrderBase {
    const char* A; const char* Bt; size_t a_tile, b_tile;
    __device__ __forceinline__ void init(const void* A_, int lda, const void* Bt_, int K, int nM_, int nN_, int G_, int c_, int esz = 2) { A = (const char*)A_; Bt = (const char*)Bt_; a_tile = (size_t)BM * lda * esz; b_tile = (size_t)BM * K * esz; init_order(nM_, nN_, G_, c_); }
    __device__ __forceinline__ const char* a_base(const Unit& u) const { return A + (size_t)u.pm * a_tile; }
    __device__ __forceinline__ const char* b_base(const Unit& u) const { return Bt + (size_t)u.pn * b_tile; }
};
struct GatesOrder : DenseOrder {
    __device__ __forceinline__ const char* a_base(const Unit& u) const { return A + (size_t)u.pm * a_tile + (size_t)(u.pn >> 1) * 512; }
};
struct MoeOrder : DenseOrder {
    int pe[8]; size_t e_bytes;
    __device__ __forceinline__ const char* b_base(const Unit& u) const {
        int e = 0;
#pragma unroll
        for (int j = 0; j < 7; ++j) e += (u.pm >= pe[j]) ? 1 : 0;
        return Bt + (size_t)e * e_bytes + (size_t)u.pn * b_tile;
    }
};

typedef int v8i __attribute__((ext_vector_type(8)));
typedef int v4i __attribute__((ext_vector_type(4)));
template <class Epi, class Sched, bool ALIGN_EPI = true, bool FP8 = false, int SCALE_W = 127>
__device__ __forceinline__ void gemm_phase(LAS unsigned char* lds, const int tid, const Gemm g, const Sched& S, const Epi& E) {
    const int wid = __builtin_amdgcn_readfirstlane(tid >> 6), lane = tid & 63, wr = wid >> 2, wc = wid & 3, fr = lane & 15, fq = lane >> 4;
    const int K = g.K, nt = FP8 ? K / 128 : K / BK;
    unsigned voffA[1], voffB[1];
#pragma unroll
    for (int i = 0; i < 1; ++i) { int R, C; stage_rc(tid * 16 + i * 8192, R, C); const int Rb = Epi::PERM ? ((R & ~31) + perm32(R & 31)) : R;
        voffA[i] = FP8 ? (unsigned)(R * g.lda + 2 * C) : (unsigned)(R * g.lda + C) * 2u; voffB[i] = FP8 ? (unsigned)(Rb * K + 2 * C) : (unsigned)(Rb * K + C) * 2u; }
    const size_t kstep = (size_t)(BK * 2);
    const size_t hstepA = (size_t)HALF * g.lda * (FP8 ? 1 : 2), hstepB = (size_t)HALF * K * (FP8 ? 1 : 2);
    const size_t qstepA = hstepA / 2, qstepB = hstepB / 2;
    const unsigned ldsw = (unsigned)wid * 1024u;
    const int aoff = FP8 ? lds_byte(wr * 64 + fr, 16 * (fq & 1)) + (fq >> 1) * 1024 : lds_byte(wr * 64 + fr, fq * 8), boff = FP8 ? lds_byte(wc * 32 + fr, 16 * (fq & 1)) + (fq >> 1) * 1024 : lds_byte(wc * 32 + fr, fq * 8);
#define PG8_SA(b, h) (((b) * 2 + (h)) * HTB)
#define PG8_SB(b, h) ((4 + (b) * 2 + (h)) * HTB)
#define PG8_STAGE(bufoff, gbase, voff) do { _Pragma("unroll") for (int _i = 0; _i < 2; ++_i) \
        __builtin_amdgcn_global_load_lds((const unsigned*)((const char*)(gbase) + (size_t)_i * ((voff) == voffA ? qstepA : qstepB) + (voff)[0]), (LAS unsigned*)(lds + (bufoff) + ldsw + _i * 8192), 16, 0, 0); } while (0)
#define PG8_LDA(dst, b, h) do { if constexpr (FP8) { _Pragma("unroll") for (int m = 0; m < 4; ++m) dst##8[m] = __builtin_shufflevector(*(const LAS v4i*)(lds + PG8_SA(b, h) + aoff + m * 2048), *(const LAS v4i*)(lds + PG8_SA(b, h) + aoff + m * 2048 + 16), 0, 1, 2, 3, 4, 5, 6, 7); } else { _Pragma("unroll") for (int m = 0; m < 4; ++m) _Pragma("unroll") for (int k = 0; k < 2; ++k) dst[m][k] = *(const LAS bf16x8*)(lds + PG8_SA(b, h) + aoff + m * 2048 + k * 1024); } } while (0)
#define PG8_LDB(dst, b, h) do { if constexpr (FP8) { _Pragma("unroll") for (int n = 0; n < 2; ++n) dst##8[n] = __builtin_shufflevector(*(const LAS v4i*)(lds + PG8_SB(b, h) + boff + n * 2048), *(const LAS v4i*)(lds + PG8_SB(b, h) + boff + n * 2048 + 16), 0, 1, 2, 3, 4, 5, 6, 7); } else { _Pragma("unroll") for (int n = 0; n < 2; ++n) _Pragma("unroll") for (int k = 0; k < 2; ++k) dst[n][k] = *(const LAS bf16x8*)(lds + PG8_SB(b, h) + boff + n * 2048 + k * 1024); } } while (0)
#define PG8_MMA(ai, bj, At, Bt) do { __builtin_amdgcn_s_setprio(1); if constexpr (FP8) { _Pragma("unroll") for (int m = 0; m < 4; ++m) _Pragma("unroll") for (int n = 0; n < 2; ++n) \
            acc[ai][bj][m][n] = __builtin_amdgcn_mfma_scale_f32_16x16x128_f8f6f4(Bt##8[n], At##8[m], acc[ai][bj][m][n], 0, 0, 0, 0, 0, 0); } else { \
        _Pragma("unroll") for (int m = 0; m < 4; ++m) _Pragma("unroll") for (int n = 0; n < 2; ++n) _Pragma("unroll") for (int k = 0; k < 2; ++k) \
        acc[ai][bj][m][n] = __builtin_amdgcn_mfma_f32_16x16x32_bf16(Bt[n][k], At[m][k], acc[ai][bj][m][n], 0, 0, 0); } __builtin_amdgcn_s_setprio(0); } while (0)
#define PG8_WAIT_V(n) asm volatile("s_waitcnt vmcnt(" #n ")" ::: "memory")
#define PG8_WAIT_L(n) asm volatile("s_waitcnt lgkmcnt(" #n ")" ::: "memory")
#define PG8_BAR __builtin_amdgcn_s_barrier()
#define PG8_SCHED __builtin_amdgcn_sched_barrier(0)
    Unit cur, nxt; int ui = 0;
    if (!S.next(0, cur)) return;
    f32x4 acc[2][2][4][2];
#pragma unroll
    for (int a = 0; a < 2; ++a)
#pragma unroll
        for (int b = 0; b < 2; ++b)
#pragma unroll
            for (int m = 0; m < 4; ++m)
#pragma unroll
                for (int n = 0; n < 2; ++n) acc[a][b][m][n] = (f32x4){0.f, 0.f, 0.f, 0.f};
    bf16x8 At[4][2], B0[2][2], B1[2][2]; v8i At8[4], B08[2], B18[2];
    const char* cA = S.a_base(cur); const char* cB = S.b_base(cur);
    PG8_STAGE(PG8_SB(0, 0), cB, voffB); PG8_STAGE(PG8_SB(0, 1), cB + hstepB, voffB); PG8_STAGE(PG8_SA(0, 0), cA, voffA); PG8_STAGE(PG8_SA(0, 1), cA + hstepA, voffA);
    if (wr == 1) PG8_BAR;
    PG8_WAIT_V(2); PG8_BAR;
    PG8_STAGE(PG8_SB(1, 0), cB + kstep, voffB); PG8_STAGE(PG8_SA(1, 0), cA + kstep, voffA); PG8_STAGE(PG8_SB(1, 1), cB + hstepB + kstep, voffB);
    PG8_WAIT_V(6); PG8_BAR;
    for (;;) {
        const bool has_next = S.next(ui + 1, nxt);
        const char* nA = has_next ? S.a_base(nxt) : cA; const char* nB = has_next ? S.b_base(nxt) : cB;
#pragma nounroll
        for (int t = 0; t < nt; t += 2) {
            const bool last = (t == nt - 2);
            asm volatile("" : "+v"(voffA[0]), "+v"(voffB[0]));
            const char* a1 = cA + (size_t)(t + 1) * kstep;
            const char* a2 = last ? nA : cA + (size_t)(t + 2) * kstep; const char* b2 = last ? nB : cB + (size_t)(t + 2) * kstep;
            const char* a3 = a2 + kstep; const char* b3 = b2 + kstep;
            PG8_LDB(B0, 0, 0); PG8_LDB(B1, 0, 1); PG8_SCHED; PG8_LDA(At, 0, 0); PG8_STAGE(PG8_SA(1, 1), a1 + hstepA, voffA);
            PG8_WAIT_V(8); PG8_WAIT_L(0); PG8_BAR; PG8_MMA(0, 0, At, B0); PG8_MMA(0, 1, At, B1); PG8_BAR; PG8_SCHED;
            PG8_LDA(At, 0, 1); PG8_STAGE(PG8_SB(0, 0), b2, voffB); PG8_STAGE(PG8_SB(0, 1), b2 + hstepB, voffB); PG8_STAGE(PG8_SA(0, 0), a2, voffA);
            PG8_WAIT_V(8); PG8_WAIT_L(0); PG8_BAR; PG8_MMA(1, 0, At, B0); PG8_MMA(1, 1, At, B1); PG8_BAR; PG8_SCHED;
            PG8_LDB(B0, 1, 0); PG8_LDB(B1, 1, 1); PG8_SCHED; PG8_LDA(At, 1, 0); PG8_STAGE(PG8_SA(0, 1), a2 + hstepA, voffA);
            PG8_WAIT_V(8); PG8_WAIT_L(0); PG8_BAR; PG8_MMA(0, 0, At, B0); PG8_MMA(0, 1, At, B1); PG8_BAR; PG8_SCHED;
            PG8_LDA(At, 1, 1); PG8_STAGE(PG8_SB(1, 0), b3, voffB); PG8_STAGE(PG8_SB(1, 1), b3 + hstepB, voffB); PG8_STAGE(PG8_SA(1, 0), a3, voffA);
            PG8_WAIT_V(8); PG8_WAIT_L(0); PG8_BAR; PG8_MMA(1, 0, At, B0); PG8_MMA(1, 1, At, B1); PG8_BAR; PG8_SCHED;
        }
        if constexpr (ALIGN_EPI) { if (wr == 0) PG8_BAR; }
        { int ln_; asm volatile("v_mbcnt_lo_u32_b32 %0, -1, 0\n\tv_mbcnt_hi_u32_b32 %0, -1, %0" : "=v"(ln_)); E(acc, cur, wr, wc, ln_ & 15, ln_ >> 4); }
        if (!has_next) break;
#pragma unroll
        for (int a = 0; a < 2; ++a)
#pragma unroll
            for (int b = 0; b < 2; ++b)
#pragma unroll
                for (int m = 0; m < 4; ++m)
#pragma unroll
                    for (int n = 0; n < 2; ++n) acc[a][b][m][n] = (f32x4){0.f, 0.f, 0.f, 0.f};
        cur = nxt; cA = nA; cB = nB; ++ui;
        { int t_; asm volatile("v_mbcnt_lo_u32_b32 %0, -1, 0\n\tv_mbcnt_hi_u32_b32 %0, -1, %0" : "=v"(t_)); t_ |= wid << 6; int R, C; stage_rc(t_ * 16, R, C); const int Rb = Epi::PERM ? ((R & ~31) + perm32(R & 31)) : R;
          voffA[0] = FP8 ? (unsigned)(R * g.lda + 2 * C) : (unsigned)(R * g.lda + C) * 2u; voffB[0] = FP8 ? (unsigned)(Rb * K + 2 * C) : (unsigned)(Rb * K + C) * 2u; }
        if constexpr (ALIGN_EPI) { if (wr == 1) PG8_BAR; }
    }
    PG8_WAIT_V(0);
    if constexpr (!ALIGN_EPI) { if (wr == 0) PG8_BAR; }
    PG8_BAR;
#undef PG8_SA
#undef PG8_SB
#undef PG8_STAGE
#undef PG8_LDA
#undef PG8_LDB
#undef PG8_MMA
#undef PG8_WAIT_V
#undef PG8_WAIT_L
#undef PG8_BAR
#undef PG8_SCHED
}
}
#define XB_TMO      128
#define XB_XCNT(j)  (256  + 64 * (j))
#define XB_XSUB(j)  (1280 + 64 * (j))
#define XB_XGEN(j)  (2304 + 64 * (j))
#define XB_TOP      3328
#define XB_TOPGEN   3392
#define XCD_BAR_WORDS 3456
#define XB_SPIN_CAP (1u << 18)

__device__ __forceinline__ unsigned xb_ld(unsigned* p)              { return __hip_atomic_load(p, __ATOMIC_RELAXED, __HIP_MEMORY_SCOPE_AGENT); }
__device__ __forceinline__ unsigned xb_add(unsigned* p, unsigned v) { return __hip_atomic_fetch_add(p, v, __ATOMIC_RELAXED, __HIP_MEMORY_SCOPE_AGENT); }
__device__ __forceinline__ unsigned xb_xcc_id() { return (unsigned)__builtin_amdgcn_s_getreg((3 << 11) | 20) & 0xFu; }
#define XB_SPIN(cond, bar) do { unsigned _sp = 0; while (cond) { __builtin_amdgcn_s_sleep(1); \
    if ((++_sp & 255u) == 0u) { if (xb_ld(&(bar)[XB_TMO])) break; if (_sp > XB_SPIN_CAP) { atomicAdd(&(bar)[XB_TMO], 1u); break; } } } } while (0)

struct XcdBarrier {
    unsigned* bar; unsigned x;
    volatile LAS unsigned* st;
};

__device__ __forceinline__ XcdBarrier xcd_barrier_post(unsigned* bar, volatile LAS unsigned* st) {
    XcdBarrier b; b.bar = bar; b.x = xb_xcc_id(); b.st = st;
    if (threadIdx.x == 0) (void)xb_add(&bar[XB_XCNT(b.x)], 1u);
    return b;
}
__device__ __forceinline__ void xcd_barrier_complete(unsigned* bar, unsigned x, unsigned& nloc, unsigned& nx) {
    const unsigned G = gridDim.x * gridDim.y * gridDim.z;
    unsigned sum, cnt, mine, sp = 0u;
    for (;;) {
        sum = 0u; cnt = 0u; mine = 0u;
#pragma unroll
        for (unsigned j = 0; j < 16; ++j) { const unsigned c = xb_ld(&bar[XB_XCNT(j)]); sum += c; cnt += (c > 0u) ? 1u : 0u; mine = (j == x) ? c : mine; }
        if (sum == G) break;
        __builtin_amdgcn_s_sleep(1);
        if ((++sp & 255u) == 0u) { if (xb_ld(&bar[XB_TMO])) break; if (sp > XB_SPIN_CAP) { atomicAdd(&bar[XB_TMO], 1u); break; } }
    }
    nloc = mine > 0u ? mine : 1u; nx = cnt > 0u ? cnt : 1u;
}

__device__ __forceinline__ void xcd_barrier(const XcdBarrier& b) {
    asm volatile("s_waitcnt vmcnt(0)" ::: "memory");
    __syncthreads();
    if (threadIdx.x == 0) {
        unsigned* bar = b.bar;
        __builtin_amdgcn_s_waitcnt(0);
        unsigned nloc = b.st[0], nx = b.st[1];
        if (nloc == 0u) { xcd_barrier_complete(bar, b.x, nloc, nx); b.st[0] = nloc; b.st[1] = nx; }
        const unsigned old = xb_add(&bar[XB_XSUB(b.x)], 1u);
        const unsigned gen = old / nloc;
        if (old + 1u == (gen + 1u) * nloc) {
            __builtin_amdgcn_fence(__ATOMIC_RELEASE, "agent");
            asm volatile("s_waitcnt vmcnt(0)" ::: "memory");
            const unsigned og = xb_add(&bar[XB_TOP], 1u);
            const unsigned tg = og / nx;
            if (og + 1u == (tg + 1u) * nx) xb_add(&bar[XB_TOPGEN], 1u);
            else XB_SPIN(xb_ld(&bar[XB_TOPGEN]) == tg, bar);
            __builtin_amdgcn_fence(__ATOMIC_ACQUIRE, "agent");
            xb_add(&bar[XB_XGEN(b.x)], 1u);
            asm volatile("s_waitcnt vmcnt(0)" ::: "memory");
        } else {
            XB_SPIN(xb_ld(&bar[XB_XGEN(b.x)]) == gen, bar);
            __builtin_amdgcn_fence(__ATOMIC_ACQUIRE, "agent");
            asm volatile("s_waitcnt vmcnt(0)" ::: "memory");
        }
    }
    __syncthreads();
}

constexpr int NWAVES = 8, NTHR = 512;
constexpr int D = 1024, BATCH = 2, SEQ = 16384, NMETA = 16;
constexpr int MMAIN = BATCH * SEQ;
constexpr int MROWS = MMAIN + NMETA;
constexpr int MPAD = MMAIN + 256;
constexpr int RGW = 1344, RGBW = 168, NRG = 2816  , KRGO = 1408  , NGT = 4096, KGT = 256, XCW = 2048;
constexpr int FF = 3584, NE = 8, NFF2 = 2 * FF;
constexpr int GH = 4, GDK = 128, GDV = 256, GQK = 512, GVD = 1024, NGLA = 3072, GLAW = 3088, GRANK = 16;
constexpr int MSORT = 265 * 256;
constexpr float LN_EPS = 1e-5f, ALPHA = 1.6817928305074290f;
constexpr int SEG = 128, NSEG_B = SEQ / SEG, NSEG = 1 + BATCH * NSEG_B;
constexpr int CPS = 8, NSC_BH = SEQ / (64 * CPS), NGU = BATCH * GH * NSC_BH + GH;

constexpr size_t MiB = 1u << 20;
constexpr size_t WS_CTL = 0, CTL_ZERO_BYTES = 1 * MiB;
constexpr size_t WL_RGIN = 0, WL_GATES = WL_RGIN + (size_t)NRG * D * 2, WL_RGOUT = WL_GATES + (size_t)NGT * KGT * 2, WL_GLAIN = WL_RGOUT + (size_t)D * KRGO * 2,
                 WL_GLAOUT = WL_GLAIN + (size_t)NGLA * D * 2, WL_FFNIN = WL_GLAOUT + (size_t)D * D * 2, WL_FFNOUT = WL_FFNIN + (size_t)NFF2 * D * 2,
                 WL_MOEIN = WL_FFNOUT + (size_t)D * FF * 2, WL_MOEOUT = WL_MOEIN + (size_t)NE * NFF2 * D * 2, WL_STRIDE = WL_MOEOUT + (size_t)NE * D * FF * 2;
constexpr size_t WS_W = 1 * MiB;
constexpr size_t WS_H = WS_W + 2 * WL_STRIDE;
constexpr size_t WS_HB = WS_H + (size_t)MPAD * D * 4;
constexpr size_t WS_MIX = WS_HB + (size_t)MPAD * D * 2;
constexpr size_t WS_Z = WS_MIX + (size_t)MPAD * D * 4;
constexpr size_t WS_RT = WS_Z + 3 * MiB;
constexpr size_t WS_AGG = WS_RT + 1 * MiB;
constexpr size_t WS_S0 = WS_AGG + 3 * MiB;
constexpr size_t S_PROJ = 0, S_XC = S_PROJ + (size_t)MPAD * NRG * 2, S_LOGA = S_XC + (size_t)MPAD * XCW * 2, S_U = S_LOGA + (size_t)MPAD * RGW * 4, S_Y = S_U + (size_t)MPAD * RGW * 4, S_RG_END = S_Y + (size_t)MPAD * KRGO * 2;
constexpr size_t S_HID = 0;
constexpr size_t S_QKVR = 0, S_KVS = S_QKVR + (size_t)MPAD * NGLA * 2, S_SST = S_KVS + (size_t)NGU * GDK * GDV * 4, S_O = S_SST + (size_t)NGU * GDK * GDV * 4, S_DEC = S_O + (size_t)MPAD * D * 2, S_XB = S_DEC + 1 * MiB, S_EMF = S_XB + (size_t)(BATCH * GH * (SEQ / 64) + GH) * 64 * GDK * 4, S_GLA_END = S_EMF + 3 * MiB;
constexpr size_t S_AS = 0, S_HS = S_AS + (size_t)MSORT * D * 2, S_YS = S_HS + (size_t)MSORT * FF * 2, S_MOE_END = S_YS + (size_t)MSORT * D * 4;
constexpr size_t S_MAX = S_RG_END > S_MOE_END ? (S_RG_END > S_GLA_END ? S_RG_END : S_GLA_END) : (S_MOE_END > S_GLA_END ? S_MOE_END : S_GLA_END);
constexpr size_t WS_END = WS_S0 + S_MAX;
constexpr int CW_TMO = 0, CW_BAR = 4096, CW_MOE = 8192;

constexpr int LDS_BYTES = 163840, MISC_OFF = LDS_BYTES - 64;

struct Frame {
    LAS unsigned char* lds; gu32* ctl; unsigned char* ws;
    int tid, lane, wave, G, bx; unsigned long long dbg_acc;
    __device__ __forceinline__ void fresh() { asm volatile("" : "+s"(wave)); asm volatile("" : "+s"(bx)); asm volatile("" : "+s"(ws));
        asm volatile("v_mbcnt_lo_u32_b32 %0, -1, 0\n\tv_mbcnt_hi_u32_b32 %0, -1, %0" : "=v"(lane));
        tid = (wave << 6) | lane; ctl = (gu32*)(ws + WS_CTL); }
};
struct Args { const float* in[21]; float* out; unsigned char* ws; int ph_lo, ph_hi; unsigned submask; int pad; };

struct EpiBf16Gelu {
    static constexpr bool PERM = true, PAIR = false;
    bf16* O; int ldc, gelu_cols;
    __device__ __forceinline__ void operator()(const f32x4 (&acc)[2][2][4][2], const pg8::Unit& u, int wr, int wc, int fr, int fq) const {
        const int row0 = u.pm * 256 + wr * 64 + fr, col0 = u.pn * 256 + wc * 32 + 8 * fq;
#pragma unroll
        for (int ai = 0; ai < 2; ++ai)
#pragma unroll
            for (int m = 0; m < 4; ++m) { bf16* rowp = O + (size_t)(row0 + ai * 128 + m * 16) * ldc + col0;
#pragma unroll
                for (int bj = 0; bj < 2; ++bj) { f32x4 v0 = acc[ai][bj][m][0], v1 = acc[ai][bj][m][1];
                    if (col0 + bj * 128 < gelu_cols) {
#pragma unroll
                        for (int j = 0; j < 4; ++j) { v0[j] = gelu_tanh_f(v0[j]); v1[j] = gelu_tanh_f(v1[j]); } }
                    v4u w; w.x = cvt_pk_bf16(v0[0], v0[1]); w.y = cvt_pk_bf16(v0[2], v0[3]); w.z = cvt_pk_bf16(v1[0], v1[1]); w.w = cvt_pk_bf16(v1[2], v1[3]);
                    *(v4u*)(rowp + bj * 128) = w; } }
    }
    __device__ __forceinline__ void meta_task(int task, int& r0, int& aoff) const { r0 = task * 16; aoff = 0; }
    __device__ __forceinline__ void meta(int task, f32x4 a0, f32x4, int fr, int fq) const {
        const int col = task * 16 + 4 * fq;
        if (col < gelu_cols) {
#pragma unroll
            for (int j = 0; j < 4; ++j) a0[j] = gelu_tanh_f(a0[j]); }
        v2u w; w.x = cvt_pk_bf16(a0[0], a0[1]); w.y = cvt_pk_bf16(a0[2], a0[3]);
        *(v2u*)(O + (size_t)(MMAIN + fr) * ldc + col) = w;
    }
};
struct EpiSwiglu {
    static constexpr bool PERM = true, PAIR = true;
    bf16* O; int ldc; float sc;
    __device__ __forceinline__ void operator()(const f32x4 (&acc)[2][2][4][2], const pg8::Unit& u, int wr, int wc, int fr, int fq) const {
        const int row0 = u.pm * 256 + wr * 64 + fr, col0 = u.pn * 128 + wc * 32 + 8 * fq;
        float scl = sc; asm volatile("" : "+v"(scl));
#pragma unroll
        for (int ai = 0; ai < 2; ++ai)
#pragma unroll
            for (int m = 0; m < 4; ++m) { bf16* rowp = O + (size_t)(row0 + ai * 128 + m * 16) * ldc + col0;
                f32x4 g0 = acc[ai][0][m][0] * scl, g1 = acc[ai][0][m][1] * scl; const f32x4 u0 = acc[ai][1][m][0] * scl, u1 = acc[ai][1][m][1] * scl;
#pragma unroll
                for (int j = 0; j < 4; ++j) { g0[j] = silu_f(g0[j]) * u0[j]; g1[j] = silu_f(g1[j]) * u1[j]; }
                v4u w; w.x = cvt_pk_bf16(g0[0], g0[1]); w.y = cvt_pk_bf16(g0[2], g0[3]); w.z = cvt_pk_bf16(g1[0], g1[1]); w.w = cvt_pk_bf16(g1[2], g1[3]);
                *(v4u*)rowp = w; }
    }
    __device__ __forceinline__ void meta_task(int task, int& r0, int& aoff) const { r0 = (task >> 3) * 256 + (task & 7) * 16; aoff = 0; }
    __device__ __forceinline__ void meta(int task, f32x4 a0, f32x4 a1, int fr, int fq) const {
        const int col = (task >> 3) * 128 + (task & 7) * 16 + 4 * fq;
#pragma unroll
        for (int j = 0; j < 4; ++j) a0[j] = silu_f(a0[j] * sc) * (a1[j] * sc);
        v2u w; w.x = cvt_pk_bf16(a0[0], a0[1]); w.y = cvt_pk_bf16(a0[2], a0[3]);
        *(v2u*)(O + (size_t)(MMAIN + fr) * ldc + col) = w;
    }
};
struct EpiF32 {
    static constexpr bool PERM = false, PAIR = false;
    float* C; int ldc;
    __device__ __forceinline__ void operator()(const f32x4 (&acc)[2][2][4][2], const pg8::Unit& u, int wr, int wc, int fr, int fq) const {
        const int row0 = u.pm * 256 + wr * 64 + fr, col0 = u.pn * 256 + wc * 32 + 4 * fq;
#pragma unroll
        for (int ai = 0; ai < 2; ++ai)
#pragma unroll
            for (int m = 0; m < 4; ++m) { float* rowp = C + (size_t)(row0 + ai * 128 + m * 16) * ldc + col0;
#pragma unroll
                for (int bj = 0; bj < 2; ++bj)
#pragma unroll
                    for (int n = 0; n < 2; ++n) *(f32x4*)(rowp + bj * 128 + n * 16) = acc[ai][bj][m][n]; }
    }
    __device__ __forceinline__ void meta_task(int task, int& r0, int& aoff) const { r0 = task * 16; aoff = 0; }
    __device__ __forceinline__ void meta(int task, f32x4 a0, f32x4, int fr, int fq) const { *(f32x4*)(C + (size_t)(MMAIN + fr) * ldc + task * 16 + 4 * fq) = a0; }
};

template <class Epi>
__device__ __forceinline__ void meta_gemm(Frame& F, const bf16* A16, int lda, int K, const bf16* Bt, int ntasks, const Epi& E) {
    const int fr = F.lane & 15, fq = F.lane >> 4;
    LAS f32x4* red = (LAS f32x4*)F.lds;
    for (int task = F.bx; task < ntasks; task += F.G) {
        int r0, aoff; E.meta_task(task, r0, aoff);
        f32x4 acc0 = (f32x4){0.f, 0.f, 0.f, 0.f}, acc1 = acc0;
        const bf16* ap = A16 + (size_t)fr * lda + aoff + fq * 8; const bf16* bp0 = Bt + (size_t)(r0 + fr) * K + fq * 8; const bf16* bp1 = bp0 + (size_t)128 * K;
        for (int ks = F.wave; ks < K / 32; ks += NWAVES) {
            const bf16x8 a = *(const bf16x8*)(ap + ks * 32); const bf16x8 b0 = *(const bf16x8*)(bp0 + ks * 32);
            acc0 = __builtin_amdgcn_mfma_f32_16x16x32_bf16(b0, a, acc0, 0, 0, 0);
            if (Epi::PAIR) { const bf16x8 b1 = *(const bf16x8*)(bp1 + ks * 32); acc1 = __builtin_amdgcn_mfma_f32_16x16x32_bf16(b1, a, acc1, 0, 0, 0); }
        }
        red[(F.wave * 2 + 0) * 64 + F.lane] = acc0; if (Epi::PAIR) red[(F.wave * 2 + 1) * 64 + F.lane] = acc1;
        __syncthreads();
        if (F.wave == 0) {
            f32x4 s0 = red[F.lane], s1 = Epi::PAIR ? red[64 + F.lane] : acc1;
#pragma unroll
            for (int w = 1; w < NWAVES; ++w) { s0 += red[(w * 2) * 64 + F.lane]; if (Epi::PAIR) s1 += red[(w * 2 + 1) * 64 + F.lane]; }
            E.meta(task, s0, s1, fr, fq);
        }
        __syncthreads();
    }
}

__device__ __forceinline__ void transpose_item(const float* W, int ldw, int Ksrc, int c0, int nvalid, bf16* WT, int Kdst, int n0, int k0, LAS float* scr, int lane) {
#pragma unroll 8
    for (int i = 0; i < 32; ++i) { const int kk = 2 * i + (lane >> 5), c = lane & 31;
        const bool ok = (k0 + kk < Ksrc) && (c < nvalid); const float v = W[ok ? (size_t)(k0 + kk) * ldw + c0 + c : (size_t)0];
        scr[kk * 33 + c] = ok ? v : 0.f; }
    LDS_WAIT(); asm volatile("" ::: "memory");
    const int c = lane & 7;
#pragma unroll
    for (int j = 0; j < 4; ++j) { const int n = (lane >> 3) + 8 * j; const LAS float* s = scr + (8 * c) * 33 + n;
        v4u o; o.x = pk2(s[0 * 33], s[1 * 33]); o.y = pk2(s[2 * 33], s[3 * 33]); o.z = pk2(s[4 * 33], s[5 * 33]); o.w = pk2(s[6 * 33], s[7 * 33]);
        *(v4u*)(WT + (size_t)(n0 + n) * Kdst + k0 + 8 * c) = o; }
    LDS_WAIT(); asm volatile("" ::: "memory");
}
__device__ __forceinline__ unsigned pk4_fp8(float a, float b, float c, float d) { int w = 0; w = __builtin_amdgcn_cvt_pk_fp8_f32(a, b, w, false); w = __builtin_amdgcn_cvt_pk_fp8_f32(c, d, w, true); return (unsigned)w; }
__device__ __forceinline__ void transpose_item_fp8(const float* W, int ldw, int Ksrc, int c0, int nvalid, unsigned char* WT, int Kdst, int n0, int k0, float scale, LAS float* scr, int lane) {
#pragma unroll 8
    for (int i = 0; i < 32; ++i) { const int kk = 2 * i + (lane >> 5), c = lane & 31;
        const bool ok = (k0 + kk < Ksrc) && (c < nvalid); const float v = W[ok ? (size_t)(k0 + kk) * ldw + c0 + c : (size_t)0];
        scr[kk * 33 + c] = ok ? v * scale : 0.f; }
    LDS_WAIT(); asm volatile("" ::: "memory");
    const int c4 = lane & 3;
#pragma unroll
    for (int j = 0; j < 2; ++j) { const int n = (lane >> 2) + 16 * j; const LAS float* sp = scr + (16 * c4) * 33 + n;
        v4u o; o.x = pk4_fp8(sp[0 * 33], sp[1 * 33], sp[2 * 33], sp[3 * 33]); o.y = pk4_fp8(sp[4 * 33], sp[5 * 33], sp[6 * 33], sp[7 * 33]);
        o.z = pk4_fp8(sp[8 * 33], sp[9 * 33], sp[10 * 33], sp[11 * 33]); o.w = pk4_fp8(sp[12 * 33], sp[13 * 33], sp[14 * 33], sp[15 * 33]);
        *(v4u*)(WT + (size_t)(n0 + n) * Kdst + k0 + 16 * c4) = o; }
    LDS_WAIT(); asm volatile("" ::: "memory");
}
__device__ __forceinline__ void map_id(int n0, int nsrc, int& c0, int& nv) { c0 = n0; nv = nsrc - n0; nv = nv < 0 ? 0 : (nv > 32 ? 32 : nv); if (nv == 0) c0 = 0; }
__device__ __forceinline__ void map_swiglu(int n0, int& c0, int& nv) { const int tile = n0 >> 8, rr = n0 & 255; c0 = rr < 128 ? tile * 128 + rr : FF + tile * 128 + rr - 128; nv = 32; }

__device__ __forceinline__ void p0_prologue(Frame& F, const Args& a) {
    LAS float* scr = (LAS float*)(F.lds + F.wave * 16384);
    const int gw = F.bx * NWAVES + F.wave, NGW = F.G * NWAVES;
    constexpr int I_RGIN = (D / 64) * (NRG / 32), I_GATES = (KGT / 64) * (NGT / 32), I_RGOUT = (KRGO / 64) * (D / 32), I_GLAIN = (D / 64) * (NGLA / 32), I_GLAOUT = (D / 64) * (D / 32),
                  I_FFNIN = (D / 64) * (NFF2 / 32), I_FFNOUT = (FF / 64) * (D / 32), I_MOEIN = NE * I_FFNIN, I_MOEOUT = NE * I_FFNOUT;
    constexpr int I_PER_J = I_RGIN + I_GATES + I_RGOUT + I_GLAIN + I_GLAOUT + I_FFNIN + I_FFNOUT + I_MOEIN + I_MOEOUT;
    for (int it = gw; it < 2 * I_PER_J; it += NGW) {
        const int j = it / I_PER_J; int r = it - j * I_PER_J;
        unsigned char* wl = F.ws + WS_W + (size_t)j * WL_STRIDE;
        int c0, nv;
        if (r < I_RGIN) { const int nb = r % (NRG / 32), kb = r / (NRG / 32); map_id(nb * 32, 2 * RGW, c0, nv);
            transpose_item(a.in[4] + (size_t)j * D * 2 * RGW, 2 * RGW, D, c0, nv, (bf16*)(wl + WL_RGIN), D, nb * 32, kb * 64, scr, F.lane); continue; } r -= I_RGIN;
        if (r < I_GATES) { const int nb = r % (NGT / 32), kb = r / (NGT / 32); const int n0 = nb * 32, pn = n0 >> 8, rr = n0 & 255, g = rr >> 7, cc = rr & 127, d0 = (pn & 1) * 128 + cc, blk = pn >> 1;
            nv = RGBW - d0; nv = nv < 0 ? 0 : (nv > 32 ? 32 : nv); c0 = nv ? d0 : 0;
            transpose_item(a.in[7] + ((size_t)(j * 2 + g) * 8 + blk) * RGBW * RGBW, RGBW, RGBW, c0, nv, (bf16*)(wl + WL_GATES), KGT, n0, kb * 64, scr, F.lane); continue; } r -= I_GATES;
        if (r < I_RGOUT) { const int nb = r % (D / 32), kb = r / (D / 32);
            transpose_item(a.in[10] + (size_t)j * RGW * D, D, RGW, nb * 32, 32, (bf16*)(wl + WL_RGOUT), KRGO, nb * 32, kb * 64, scr, F.lane); continue; } r -= I_RGOUT;
        if (r < I_GLAIN) { const int nb = r % (NGLA / 32), kb = r / (NGLA / 32);
            transpose_item(a.in[11] + (size_t)j * D * GLAW, GLAW, D, nb * 32, 32, (bf16*)(wl + WL_GLAIN), D, nb * 32, kb * 64, scr, F.lane); continue; } r -= I_GLAIN;
        if (r < I_GLAOUT) { const int nb = r % (D / 32), kb = r / (D / 32);
            transpose_item(a.in[15] + (size_t)j * D * D, D, D, nb * 32, 32, (bf16*)(wl + WL_GLAOUT), D, nb * 32, kb * 64, scr, F.lane); continue; } r -= I_GLAOUT;
        if (r < I_FFNIN) { const int nb = r % (NFF2 / 32), kb = r / (NFF2 / 32); map_swiglu(nb * 32, c0, nv);
            transpose_item(a.in[16] + (size_t)j * D * NFF2, NFF2, D, c0, nv, (bf16*)(wl + WL_FFNIN), D, nb * 32, kb * 64, scr, F.lane); continue; } r -= I_FFNIN;
        if (r < I_FFNOUT) { const int nb = r % (D / 32), kb = r / (D / 32);
            transpose_item(a.in[17] + (size_t)j * FF * D, D, FF, nb * 32, 32, (bf16*)(wl + WL_FFNOUT), FF, nb * 32, kb * 64, scr, F.lane); continue; } r -= I_FFNOUT;
        if (r < I_MOEIN) { const int e = r / I_FFNIN, r2 = r % I_FFNIN; const int nb = r2 % (NFF2 / 32), kb = r2 / (NFF2 / 32); map_swiglu(nb * 32, c0, nv);
            transpose_item_fp8(a.in[19] + ((size_t)j * NE + e) * D * NFF2, NFF2, D, c0, nv, (unsigned char*)(wl + WL_MOEIN) + (size_t)e * NFF2 * D, D, nb * 32, kb * 64, 64.0f, scr, F.lane); continue; } r -= I_MOEIN;
        { const int e = r / I_FFNOUT, r2 = r % I_FFNOUT; const int nb = r2 % (D / 32), kb = r2 / (D / 32);
            transpose_item(a.in[20] + ((size_t)j * NE + e) * FF * D, D, FF, nb * 32, 32, (bf16*)(wl + WL_MOEOUT) + (size_t)e * D * FF, FF, nb * 32, kb * 64, scr, F.lane); }
    }
    bf16* HB = (bf16*)(F.ws + WS_HB);
    for (int m = gw; m < MROWS; m += NGW) {
        const float* src = m < MMAIN ? a.in[0] + (size_t)m * D : a.in[1] + (size_t)(m - MMAIN) * D;
#pragma unroll
        for (int q = 0; q < 4; ++q) { const f32x4 v = *(const f32x4*)(src + 4 * F.lane + 256 * q);
            v2u w; w.x = pk2(v[0], v[1]); w.y = pk2(v[2], v[3]); *(v2u*)(HB + (size_t)m * D + 4 * F.lane + 256 * q) = w; }
    }
}

struct LnRow { v4u h[2], a[2], b[2]; float w1, w2; };
__device__ __forceinline__ void unpack8(const v4u& w, float* o) { o[0] = bflo(w.x); o[1] = bfhi(w.x); o[2] = bflo(w.y); o[3] = bfhi(w.y); o[4] = bflo(w.z); o[5] = bfhi(w.z); o[6] = bflo(w.w); o[7] = bfhi(w.w); }
__device__ __forceinline__ void ln_phase(Frame& F, int mixkind, const float* gam, const float* bet, int extra, const float* Wx, int ldx, float* outp, gu32* moe_cnt) {
    bf16* HB = (bf16*)(F.ws + WS_HB); const bf16* MIX = (const bf16*)(F.ws + WS_MIX);
    const bf16* YS = (const bf16*)(F.ws + WS_S0 + S_YS);
    int* E1 = (int*)(F.ws + WS_RT); int* E2 = E1 + MROWS; float* W1 = (float*)(E2 + MROWS); float* W2 = W1 + MROWS; int* POS1 = (int*)(W2 + MROWS); int* POS2 = POS1 + MROWS;
    float* Z = (float*)(F.ws + WS_Z);
    LAS float* WL = (LAS float*)F.lds;
    LAS unsigned* lcnt = (LAS unsigned*)(F.lds + 65536);
    const int NC = extra == 1 ? 16 : (extra == 2 ? 8 : 0);
    if (extra) { for (int i = F.tid; i < NC * D; i += NTHR) { const int c = i / NC, e = i - c * NC; WL[e * D + c] = Wx[(size_t)c * ldx + e]; }
        if (F.tid < 8) lcnt[F.tid] = 0u;
        __syncthreads(); }
    const int gw = F.bx * NWAVES + F.wave, NGW = F.G * NWAVES, lane = F.lane;
    float gv[16], bv[16];
#pragma unroll
    for (int q = 0; q < 2; ++q)
#pragma unroll
        for (int t = 0; t < 2; ++t) { const f32x4 g4 = *(const f32x4*)(gam + 512 * q + 8 * lane + 4 * t), b4 = *(const f32x4*)(bet + 512 * q + 8 * lane + 4 * t);
#pragma unroll
            for (int k = 0; k < 4; ++k) { gv[8 * q + 4 * t + k] = g4[k]; bv[8 * q + 4 * t + k] = b4[k]; } }
    unsigned mycnt = 0u;
    auto ln_load = [&](LnRow (&R)[2], int m0) {
#pragma unroll
        for (int r = 0; r < 2; ++r) { const int m = m0 + r * NGW; if (m < MROWS) {
            const bf16* hp = HB + (size_t)m * D + 8 * lane; R[r].h[0] = *(const v4u*)hp; R[r].h[1] = *(const v4u*)(hp + 512);
            if (mixkind == 1) { const bf16* mp = MIX + (size_t)m * D + 8 * lane; R[r].a[0] = *(const v4u*)mp; R[r].a[1] = *(const v4u*)(mp + 512); }
            if (mixkind == 2) { R[r].w1 = W1[m]; R[r].w2 = W2[m]; const bf16* y1 = YS + (size_t)POS1[m] * D + 8 * lane; const bf16* y2 = YS + (size_t)POS2[m] * D + 8 * lane;
                R[r].a[0] = *(const v4u*)y1; R[r].a[1] = *(const v4u*)(y1 + 512); R[r].b[0] = *(const v4u*)y2; R[r].b[1] = *(const v4u*)(y2 + 512); } } }
    };
    LnRow Rn[2];
    ln_load(Rn, gw);
    for (int m0 = gw; m0 < MROWS; m0 += 2 * NGW) {
        LnRow R[2];
#pragma unroll
        for (int r = 0; r < 2; ++r) R[r] = Rn[r];
        ln_load(Rn, m0 + 2 * NGW);
#pragma unroll
        for (int r = 0; r < 2; ++r) { const int m = m0 + r * NGW; if (m < MROWS) {
            float v[16]; unpack8(R[r].h[0], v); unpack8(R[r].h[1], v + 8);
#pragma unroll
            for (int k = 0; k < 16; ++k) v[k] *= ALPHA;
            if (mixkind == 1) { float t[16]; unpack8(R[r].a[0], t); unpack8(R[r].a[1], t + 8);
#pragma unroll
                for (int k = 0; k < 16; ++k) v[k] += t[k]; }
            if (mixkind == 2) { float t[16], u[16]; unpack8(R[r].a[0], t); unpack8(R[r].a[1], t + 8); unpack8(R[r].b[0], u); unpack8(R[r].b[1], u + 8);
#pragma unroll
                for (int k = 0; k < 16; ++k) v[k] += t[k] * R[r].w1 + u[k] * R[r].w2; }
            float s = 0.f;
#pragma unroll
            for (int k = 0; k < 16; ++k) s += v[k];
            const float mean = wave_sum(s, lane) * (1.f / D); float s2 = 0.f;
#pragma unroll
            for (int k = 0; k < 16; ++k) { v[k] -= mean; s2 += v[k] * v[k]; }
            const float rstd = __builtin_amdgcn_rsqf(wave_sum(s2, lane) * (1.f / D) + LN_EPS);
#pragma unroll
            for (int k = 0; k < 16; ++k) v[k] = v[k] * rstd * gv[k] + bv[k];
            bf16* op = HB + (size_t)m * D + 8 * lane;
            *(v4u*)op = (v4u){pk2(v[0], v[1]), pk2(v[2], v[3]), pk2(v[4], v[5]), pk2(v[6], v[7])}; *(v4u*)(op + 512) = (v4u){pk2(v[8], v[9]), pk2(v[10], v[11]), pk2(v[12], v[13]), pk2(v[14], v[15])};
            if (outp && m < MMAIN) { float* o = outp + (size_t)m * D + 8 * lane;
                *(f32x4*)o = (f32x4){v[0], v[1], v[2], v[3]}; *(f32x4*)(o + 4) = (f32x4){v[4], v[5], v[6], v[7]}; *(f32x4*)(o + 512) = (f32x4){v[8], v[9], v[10], v[11]}; *(f32x4*)(o + 516) = (f32x4){v[12], v[13], v[14], v[15]}; }
            if (extra) {
                float pp[16];
#pragma unroll
                for (int e = 0; e < 16; ++e) { pp[e] = 0.f; if (e < NC) { float p = 0.f;
#pragma unroll
                        for (int q = 0; q < 2; ++q) { const f32x4 w0 = *(const LAS f32x4*)(WL + e * D + 512 * q + 8 * lane), w1 = *(const LAS f32x4*)(WL + e * D + 512 * q + 8 * lane + 4);
                            p += (v[8 * q + 0] * w0[0] + v[8 * q + 1] * w0[1]) + (v[8 * q + 2] * w0[2] + v[8 * q + 3] * w0[3]) + (v[8 * q + 4] * w1[0] + v[8 * q + 5] * w1[1]) + (v[8 * q + 6] * w1[2] + v[8 * q + 7] * w1[3]); }
                        pp[e] = p; } }
                float lg[8]; float zv;
                if (extra == 1) {
#pragma unroll
                    for (int k = 0; k < 8; ++k) { const bool up = lane & 32; const float snd = up ? pp[k] : pp[k + 8], kp = up ? pp[k + 8] : pp[k]; pp[k] = kp + shx(snd, 32, lane); }
#pragma unroll
                    for (int k = 0; k < 4; ++k) { const bool up = lane & 16; const float snd = up ? pp[k] : pp[k + 4], kp = up ? pp[k + 4] : pp[k]; pp[k] = kp + shx(snd, 16, lane); }
#pragma unroll
                    for (int k = 0; k < 2; ++k) { const bool up = lane & 8; const float snd = up ? pp[k] : pp[k + 2], kp = up ? pp[k + 2] : pp[k]; pp[k] = kp + shx(snd, 8, lane); }
                    { const bool up = lane & 4; const float snd = up ? pp[0] : pp[1], kp = up ? pp[1] : pp[0]; zv = kp + shx(snd, 4, lane); }
                    zv += shx(zv, 2, lane); zv += shx(zv, 1, lane);
                } else {
#pragma unroll
                    for (int k = 0; k < 4; ++k) { const bool up = lane & 32; const float snd = up ? pp[k] : pp[k + 4], kp = up ? pp[k + 4] : pp[k]; pp[k] = kp + shx(snd, 32, lane); }
#pragma unroll
                    for (int k = 0; k < 2; ++k) { const bool up = lane & 16; const float snd = up ? pp[k] : pp[k + 2], kp = up ? pp[k + 2] : pp[k]; pp[k] = kp + shx(snd, 16, lane); }
                    float rv; { const bool up = lane & 8; const float snd = up ? pp[0] : pp[1], kp = up ? pp[1] : pp[0]; rv = kp + shx(snd, 8, lane); }
                    rv += shx(rv, 4, lane); rv += shx(rv, 2, lane); rv += shx(rv, 1, lane);
#pragma unroll
                    for (int e = 0; e < 8; ++e) lg[e] = __int_as_float(__builtin_amdgcn_readlane(__float_as_int(rv), ((e >> 2) & 1) * 32 + ((e >> 1) & 1) * 16 + (e & 1) * 8));
                }
                if (extra == 1) { if ((lane & 3) == 0) Z[(size_t)m * 16 + ((lane >> 5) & 1) * 8 + ((lane >> 4) & 1) * 4 + ((lane >> 3) & 1) * 2 + ((lane >> 2) & 1)] = zv; }
                else { int e1 = 0; float l1 = lg[0];
#pragma unroll
                    for (int e = 1; e < 8; ++e) if (lg[e] > l1) { l1 = lg[e]; e1 = e; }
                    int e2 = -1; float l2 = -3.0e38f;
#pragma unroll
                    for (int e = 0; e < 8; ++e) if (e != e1 && lg[e] > l2) { l2 = lg[e]; e2 = e; }
                    const float w2 = 1.f / (1.f + __expf(l1 - l2)), w1 = 1.f - w2;
                    if (lane == 0) { E1[m] = e1; E2[m] = e2; W1[m] = w1; W2[m] = w2; }
                    mycnt += (lane == e1 || lane == e2) ? 1u : 0u; }
            } } }
    }
    if (extra == 2) { if (lane < 8 && mycnt) __hip_atomic_fetch_add(&lcnt[lane], mycnt, __ATOMIC_RELAXED, __HIP_MEMORY_SCOPE_WORKGROUP);
        __syncthreads();
        if (F.tid < 8 && lcnt[F.tid]) __hip_atomic_fetch_add(moe_cnt + F.tid, lcnt[F.tid], RLX_AGENT); }
}

struct EpiGates {
    static constexpr bool PERM = true, PAIR = true;
    bf16* LOGA; bf16* U; const bf16* XC; const float* bg; const float* lam;
    __device__ __forceinline__ void chan4(int ch, f32x4& br, f32x4& bi, f32x4& c8) const {
        br = *(const f32x4*)(bg + ch); bi = *(const f32x4*)(bg + RGW + ch); const f32x4 lm = *(const f32x4*)(lam + ch);
#pragma unroll
        for (int t = 0; t < 4; ++t) { const float x = __expf(-lm[t]); c8[t] = -8.0f * (x * (1.0f - x * (0.5f - x * (0.33333333f - 0.25f * x)))); }
    }
    __device__ __forceinline__ void elem4(int row, int blk, int d, f32x4 ra, f32x4 ia, const f32x4& br, const f32x4& bi, const f32x4& c8) const {
        const int ch = blk * RGBW + d;
        const v2u xw = *(const v2u*)(XC + (size_t)row * XCW + blk * 256 + d);
        const float xc[4] = {bflo(xw.x), bfhi(xw.x), bflo(xw.y), bfhi(xw.y)};
        f32x4 la, uu;
#pragma unroll
        for (int t = 0; t < 4; ++t) {
            const float r = sigmoid_f(ra[t] + br[t]), ig = sigmoid_f(ia[t] + bi[t]);
            const float l = c8[t] * r;
            const float a2 = fast_exp(2.0f * l);
            la[t] = l; uu[t] = __builtin_amdgcn_sqrtf(fmaxf(1.0f - a2, 0.f)) * (ig * xc[t]);
        }
        *(v2u*)(LOGA + (size_t)row * RGW + ch) = (v2u){pk2(la[0], la[1]), pk2(la[2], la[3])}; *(v2u*)(U + (size_t)row * RGW + ch) = (v2u){pk2(uu[0], uu[1]), pk2(uu[2], uu[3])};
    }
    __device__ __forceinline__ void elem8(int row, int blk, int d, f32x4 ra0, f32x4 ia0, f32x4 ra1, f32x4 ia1, const f32x4 (&br)[2], const f32x4 (&bi)[2], const f32x4 (&c8)[2]) const {
        const int ch = blk * RGBW + d;
        const v4u xw = *(const v4u*)(XC + (size_t)row * XCW + blk * 256 + d);
        float xc[8]; unpack8(xw, xc);
        float la[8], uu[8];
#pragma unroll
        for (int t = 0; t < 8; ++t) {
            const float rav = t < 4 ? ra0[t & 3] : ra1[t & 3], iav = t < 4 ? ia0[t & 3] : ia1[t & 3];
            const float r = sigmoid_f(rav + br[t >> 2][t & 3]), ig = sigmoid_f(iav + bi[t >> 2][t & 3]);
            const float l = c8[t >> 2][t & 3] * r;
            const float a2 = fast_exp(2.0f * l);
            la[t] = l; uu[t] = __builtin_amdgcn_sqrtf(fmaxf(1.0f - a2, 0.f)) * (ig * xc[t]);
        }
        *(v4u*)(LOGA + (size_t)row * RGW + ch) = (v4u){pk2(la[0], la[1]), pk2(la[2], la[3]), pk2(la[4], la[5]), pk2(la[6], la[7])};
        *(v4u*)(U + (size_t)row * RGW + ch) = (v4u){pk2(uu[0], uu[1]), pk2(uu[2], uu[3]), pk2(uu[4], uu[5]), pk2(uu[6], uu[7])};
    }
    __device__ __forceinline__ void operator()(const f32x4 (&acc)[2][2][4][2], const pg8::Unit& u, int wr, int wc, int fr, int fq) const {
        const int row0 = u.pm * 256 + wr * 64 + fr, blk = u.pn >> 1, d0 = (u.pn & 1) * 128 + wc * 32 + 8 * fq;
        if (d0 < RGBW) {
            f32x4 br[2], bi[2], c8[2]; chan4(blk * RGBW + d0, br[0], bi[0], c8[0]); chan4(blk * RGBW + d0 + 4, br[1], bi[1], c8[1]);
#pragma unroll
            for (int ai = 0; ai < 2; ++ai)
#pragma unroll
                for (int m = 0; m < 4; ++m) elem8(row0 + ai * 128 + m * 16, blk, d0, acc[ai][0][m][0], acc[ai][1][m][0], acc[ai][0][m][1], acc[ai][1][m][1], br, bi, c8); }
    }
    __device__ __forceinline__ void meta_task(int task, int& r0, int& aoff) const { const int pn = task >> 3; r0 = pn * 256 + (task & 7) * 16; aoff = (pn >> 1) * 256; }
    __device__ __forceinline__ void meta(int task, f32x4 a0, f32x4 a1, int fr, int fq) const {
        const int pn = task >> 3, d = (pn & 1) * 128 + (task & 7) * 16 + 4 * fq;
        if (d < RGBW) { f32x4 br, bi, c8; chan4((pn >> 1) * RGBW + d, br, bi, c8); elem4(MMAIN + fr, pn >> 1, d, a0, a1, br, bi, c8); }
    }
};

__device__ __forceinline__ int conv_src_row(int row, int delta) {
    if (row < MMAIN) { const int t = row & (SEQ - 1); return (t - delta >= 0) ? row - delta : MMAIN + NMETA + (t - delta); }
    const int jm = row - MMAIN; return (jm - delta >= 0) ? row - delta : -1;
}
__device__ __forceinline__ void rg_conv_phase(Frame& F, const float* cw, const float* cb) {
    const bf16* PROJ = (const bf16*)(F.ws + WS_S0 + S_PROJ); bf16* XC = (bf16*)(F.ws + WS_S0 + S_XC);
    const int g = F.tid & 255, blk = g >> 5, kk = (g & 31) * 8, ch = blk * RGBW + kk;
    constexpr int NIT = (MROWS / 4) * 256;
    const int stride = F.G * NTHR;
    if (kk < RGBW) {
        float w[4][8], bb[8];
        { const f32x4 b0 = *(const f32x4*)(cb + ch), b1 = *(const f32x4*)(cb + ch + 4);
#pragma unroll
          for (int k = 0; k < 4; ++k) { bb[k] = b0[k]; bb[4 + k] = b1[k]; } }
#pragma unroll
        for (int tap = 0; tap < 4; ++tap) { const f32x4 w0 = *(const f32x4*)(cw + tap * RGW + ch), w1 = *(const f32x4*)(cw + tap * RGW + ch + 4);
#pragma unroll
            for (int k = 0; k < 4; ++k) { w[tap][k] = w0[k]; w[tap][4 + k] = w1[k]; } }
        for (int idx = F.bx * NTHR + F.tid; idx < NIT; idx += 2 * stride) {
            v4u x[2][7];
#pragma unroll
            for (int it = 0; it < 2; ++it) { const int id2 = idx + it * stride; if (id2 < NIT) { const int r0 = (id2 >> 8) * 4;
#pragma unroll
                for (int t = 0; t < 3; ++t) { const int rr = conv_src_row(r0, 3 - t); x[it][t] = (v4u){0u, 0u, 0u, 0u}; if (rr >= 0) x[it][t] = *(const v4u*)(PROJ + (size_t)rr * NRG + RGW + ch); }
#pragma unroll
                for (int t = 0; t < 4; ++t) x[it][3 + t] = *(const v4u*)(PROJ + (size_t)(r0 + t) * NRG + RGW + ch); } }
#pragma unroll
            for (int it = 0; it < 2; ++it) { const int id2 = idx + it * stride; if (id2 < NIT) { const int r0 = (id2 >> 8) * 4;
                bf16* xo = XC + (size_t)r0 * XCW + blk * 256 + kk;
                float xf[7][8];
#pragma unroll
                for (int t = 0; t < 7; ++t) unpack8(x[it][t], xf[t]);
#pragma unroll
                for (int i = 0; i < 4; ++i) { float a[8];
#pragma unroll
                    for (int k = 0; k < 8; ++k) a[k] = bb[k] + xf[i][k] * w[0][k] + xf[i + 1][k] * w[1][k] + xf[i + 2][k] * w[2][k] + xf[i + 3][k] * w[3][k];
                    *(v4u*)(xo + (size_t)i * XCW) = (v4u){pk2(a[0], a[1]), pk2(a[2], a[3]), pk2(a[4], a[5]), pk2(a[6], a[7])}; } } }
        }
    } else {
        for (int idx = F.bx * NTHR + F.tid; idx < NIT; idx += stride) { bf16* xo = XC + (size_t)((idx >> 8) * 4) * XCW + blk * 256 + kk;
#pragma unroll
            for (int i = 0; i < 4; ++i) *(v4u*)(xo + (size_t)i * XCW) = (v4u){0u, 0u, 0u, 0u}; }
    }
}
template <bool FIX>
__device__ __forceinline__ void rg_scan_phase(Frame& F) {
    const bf16* LOGA = (const bf16*)(F.ws + WS_S0 + S_LOGA); const bf16* U = (const bf16*)(F.ws + WS_S0 + S_U);
    const bf16* PROJ = (const bf16*)(F.ws + WS_S0 + S_PROJ); bf16* Y = (bf16*)(F.ws + WS_S0 + S_Y);
    float* AGGA = (float*)(F.ws + WS_AGG); float* AGGH = AGGA + (size_t)NSEG * RGW;
    const int gw = F.bx * NWAVES + F.wave, NGW = F.G * NWAVES;
    constexpr int NCG = 11, RB = FIX ? 16 : 32;
    for (int task = gw; task < NSEG * NCG; task += NGW) {
        const int seg = task / NCG, cg = task - seg * NCG, ch = cg * 128 + 2 * F.lane;
        const int row0 = seg == 0 ? MMAIN : (seg - 1) * SEG, nrows = seg == 0 ? NMETA : SEG;
        if (ch >= RGW) {
            if (FIX) for (int r = 0; r < nrows; ++r) *(unsigned*)(Y + (size_t)(row0 + r) * KRGO + ch) = 0u;
            continue;
        }
        float h0 = 0.f, h1 = 0.f, c0 = 0.f, c1 = 0.f;
        if (FIX && seg > 0) {
            { const f32x2 hm = *(const f32x2*)(AGGH + ch); h0 = hm[0]; h1 = hm[1]; }
            const int sb = 1 + ((seg - 1) / NSEG_B) * NSEG_B, ns = (seg - 1) % NSEG_B;
            for (int q = 0; q < ns; q += 8) { f32x2 aa[8], hh[8];
#pragma unroll
                for (int t = 0; t < 8; ++t) { const int qq = (q + t < ns) ? q + t : ns - 1; aa[t] = *(const f32x2*)(AGGA + (size_t)(sb + qq) * RGW + ch); hh[t] = *(const f32x2*)(AGGH + (size_t)(sb + qq) * RGW + ch); }
#pragma unroll
                for (int t = 0; t < 8; ++t) if (q + t < ns) { h0 = __expf(aa[t][0]) * h0 + hh[t][0]; h1 = __expf(aa[t][1]) * h1 + hh[t][1]; } }
        }
        for (int r = 0; r < nrows; r += RB) {
            unsigned la[RB], uu[RB], gt[RB];
#pragma unroll
            for (int t = 0; t < RB; ++t) { const int rr = row0 + ((r + t < nrows) ? r + t : nrows - 1); const size_t o = (size_t)rr * RGW + ch; la[t] = *(const unsigned*)(LOGA + o); uu[t] = *(const unsigned*)(U + o); if (FIX) gt[t] = *(const unsigned*)(PROJ + (size_t)rr * NRG + ch); }
#pragma unroll
            for (int t = 0; t < RB; ++t) if (r + t < nrows) { const float l0 = bflo(la[t]), l1 = bfhi(la[t]);
                h0 = __expf(l0) * h0 + bflo(uu[t]); h1 = __expf(l1) * h1 + bfhi(uu[t]); c0 += l0; c1 += l1;
                if (FIX) *(unsigned*)(Y + (size_t)(row0 + r + t) * KRGO + ch) = pk2(h0 * bflo(gt[t]), h1 * bfhi(gt[t])); }
        }
        if (!FIX) { *(f32x2*)(AGGA + (size_t)seg * RGW + ch) = (f32x2){c0, c1}; *(f32x2*)(AGGH + (size_t)seg * RGW + ch) = (f32x2){h0, h1}; }
    }
}

#define RG_PHASES \
        if (IN(pb + 0)) { if (on_rg) { \
            bf16* PROJ = (bf16*)(F.ws + WS_S0 + S_PROJ); EpiBf16Gelu E{PROJ, NRG, RGW}; \
            meta_gemm(F, HB + (size_t)MMAIN * D, D, D, (const bf16*)(wl + WL_RGIN), NRG / 16, E); \
            pg8::Gemm g{D, D}; pg8::DenseOrder S; S.init(HB, D, (const bf16*)(wl + WL_RGIN), D, MMAIN / 256, NRG / 256, F.G, F.bx); \
            pg8::gemm_phase<EpiBf16Gelu, pg8::DenseOrder>(F.lds, F.tid, g, S, E); } \
            SEAM(pb + 0); } \
        if (IN(pb + 1)) { if (on_rg) rg_conv_phase(F, args.in[5] + (size_t)j * 4 * RGW, args.in[6] + (size_t)j * RGW); SEAM(pb + 1); } \
        if (IN(pb + 2)) { if (on_rg) { \
            const bf16* XC = (const bf16*)(F.ws + WS_S0 + S_XC); \
            EpiGates E{(bf16*)(F.ws + WS_S0 + S_LOGA), (bf16*)(F.ws + WS_S0 + S_U), XC, args.in[8] + (size_t)j * 2 * RGW, args.in[9] + (size_t)j * RGW}; \
            meta_gemm(F, XC + (size_t)MMAIN * XCW, XCW, KGT, (const bf16*)(wl + WL_GATES), (NGT / 256) * 8, E); \
            pg8::Gemm g{KGT, XCW}; pg8::GatesOrder S; S.init(XC, XCW, (const bf16*)(wl + WL_GATES), KGT, MMAIN / 256, NGT / 256, F.G, F.bx); \
            pg8::gemm_phase<EpiGates, pg8::GatesOrder>(F.lds, F.tid, g, S, E); } \
            SEAM(pb + 2); } \
        if (IN(pb + 3)) { if (on_rg) rg_scan_phase<false>(F); SEAM(pb + 3); } \
        if (IN(pb + 4)) { if (on_rg) rg_scan_phase<true>(F); SEAM(pb + 4); } \
        if (IN(pb + 5)) { if (on_rg) { \
            const bf16* Y = (const bf16*)(F.ws + WS_S0 + S_Y); EpiBf16Gelu E{MIX, D, 0}; \
            meta_gemm(F, Y + (size_t)MMAIN * KRGO, KRGO, KRGO, (const bf16*)(wl + WL_RGOUT), D / 16, E); \
            pg8::Gemm g{KRGO, KRGO}; pg8::DenseOrder S; S.init(Y, KRGO, (const bf16*)(wl + WL_RGOUT), KRGO, MMAIN / 256, D / 256, F.G, F.bx); \
            pg8::gemm_phase<EpiBf16Gelu, pg8::DenseOrder>(F.lds, F.tid, g, S, E); } \
            SEAM(pb + 5); }

constexpr int GL_QT = 0, GL_KT = 17408  , GL_KTT = 34816, GL_VT = 53248, GL_ST = 90112  , GL_SM = 155648;
constexpr int QTS = 136, KTTS = 72, VTS = 72, PS = 72, BS = 129;
constexpr int GL_NG = GL_SM + 2048  , GL_WG = GL_NG + 1024  ;
static_assert(GL_WG + 4096 <= MISC_OFF, "GLA LDS map (unit constants)");
static_assert(GL_SM + 2560 <= MISC_OFF, "GLA LDS map");

#define GL_BAR() do { asm volatile("s_waitcnt lgkmcnt(0)" ::: "memory"); __builtin_amdgcn_s_barrier(); asm volatile("" ::: "memory"); __builtin_amdgcn_sched_barrier(0); } while (0)
template <int MODE>
__device__ __forceinline__ void gla_phase(Frame& F, const float* wgu, const float* bgate, const float* normg) {
    const bf16* QKVR = (const bf16*)(F.ws + WS_S0 + S_QKVR); const float* Z = (const float*)(F.ws + WS_Z);
    float* KVS = (float*)(F.ws + WS_S0 + S_KVS); const float* SST = (const float*)(F.ws + WS_S0 + S_SST); float* DEC = (float*)(F.ws + WS_S0 + S_DEC);
    bf16* O = (bf16*)(F.ws + WS_S0 + S_O);
    float* XB = (float*)(F.ws + WS_S0 + S_XB); float* EMF = (float*)(F.ws + WS_S0 + S_EMF);
    LAS bf16* QT = (LAS bf16*)(F.lds + GL_QT); LAS bf16* KT = (LAS bf16*)(F.lds + GL_KT); LAS bf16* PP = (LAS bf16*)(F.lds + GL_KT);
    LAS bf16* KTT = (LAS bf16*)(F.lds + GL_KTT); LAS bf16* VT = (LAS bf16*)(F.lds + GL_VT); LAS unsigned char* ST = F.lds + GL_ST;
    LAS float* Bc = (LAS float*)(F.lds + GL_ST); LAS float* ZC = (LAS float*)(F.lds + GL_ST + 36864); LAS float* TOT = (LAS float*)(F.lds + GL_ST + 40960); LAS float* OFFM = (LAS float*)(F.lds + GL_ST + 43520);
    LAS float* em = (LAS float*)(F.lds + GL_SM); LAS float* ef = em + 128; LAS float* stats = ef + 128;
    LAS float* NGL = (LAS float*)(F.lds + GL_NG); LAS bf16* WGL = (LAS bf16*)(F.lds + GL_WG);
    const int tid0 = F.tid;
#ifdef MK_GLA_SEG
    int glt_cur = -1; unsigned long long glt_t = 0ull;
#define GLT(n) do { if (MODE == (MK_GLA_MODE)) { const unsigned long long t_ = __builtin_amdgcn_s_memrealtime(); if (glt_cur == (MK_GLA_SEG)) F.dbg_acc += t_ - glt_t; glt_cur = (n); glt_t = t_; } } while (0)
#else
#define GLT(n)
#endif
    for (int u = F.bx; u < NGU; u += F.G) {
        const bool meta = u >= BATCH * GH * NSC_BH;
        const int h = meta ? u - BATCH * GH * NSC_BH : (u / NSC_BH) % GH, b = meta ? 0 : u / (GH * NSC_BH), sc = meta ? 0 : u % NSC_BH;
        const int nch = meta ? 1 : CPS;
        f32x4 sacc[8][2];
        int lofs = (4 * ((tid0 & 63) >> 4)) * GDV + 32 * (tid0 >> 6) + (tid0 & 15); asm volatile("" : "+v"(lofs));
#pragma unroll
        for (int dt = 0; dt < 8; ++dt)
#pragma unroll
            for (int i = 0; i < 2; ++i) {
                sacc[dt][i] = (f32x4){0.f, 0.f, 0.f, 0.f};
                if (MODE == 1 && !meta) {
#pragma unroll
                    for (int jj = 0; jj < 4; ++jj) sacc[dt][i][jj] = SST[(size_t)u * (GDK * GDV) + (size_t)((16 * dt + jj) * GDV + 16 * i) + lofs]; }
            }
        float dsum = 0.f;
        if (MODE == 1 && tid0 < 256) NGL[tid0] = normg[h * GDV + tid0];
        for (int i = tid0; i < 16 * GDK; i += NTHR) WGL[i] = (bf16)f2bf(wgu[(size_t)(i >> 7) * GQK + h * GDK + (i & 127)]);
        const float bgv = bgate[h * GDK + (tid0 & 127)];
        f32x4 px[4] = {(f32x4){0.f, 0.f, 0.f, 0.f}, (f32x4){0.f, 0.f, 0.f, 0.f}, (f32x4){0.f, 0.f, 0.f, 0.f}, (f32x4){0.f, 0.f, 0.f, 0.f}}; float pem = 0.f, pef = 0.f;
        f32x4 pz = (f32x4){0.f, 0.f, 0.f, 0.f}; v4u pq0 = (v4u){0u, 0u, 0u, 0u}, pq1 = pq0, pk0 = pq0, pk1 = pq0, pv[4] = {pq0, pq0, pq0, pq0};
#define GLA_PREFETCH(cix) do { const int rb_ = meta ? 0 : b * SEQ + (sc * CPS + (cix)) * 64; \
            const size_t chx_ = meta ? (size_t)(BATCH * GH * (SEQ / 64) + h) : (size_t)((b * GH + h) * (SEQ / 64) + sc * CPS + (cix)); \
            if (MODE == 1) { const float* xp_ = XB + chx_ * (64 * GDK) + (size_t)tid0 * 16; \
              _Pragma("unroll") for (int t_ = 0; t_ < 4; ++t_) px[t_] = *(const f32x4*)(xp_ + 4 * t_); \
              if (tid0 < 128) { pem = EMF[chx_ * 256 + tid0]; pef = EMF[chx_ * 256 + 128 + tid0]; } } \
            { const int c_ = tid0 >> 2, part_ = tid0 & 3; const bool ok_ = (tid0 < 256) && (!meta || c_ >= 48); const int row_ = meta ? MMAIN + c_ - 48 : rb_ + c_; \
              pz = (f32x4){0.f, 0.f, 0.f, 0.f}; if (MODE == 0 && ok_) pz = *(const f32x4*)(Z + (size_t)row_ * 16 + 4 * part_); } \
            { const int cC_ = tid0 & 63, g_ = tid0 >> 6; const bool ok_ = !meta || cC_ >= 48; const int row_ = meta ? MMAIN + cC_ - 48 : rb_ + cC_; const bf16* rp_ = QKVR + (size_t)row_ * NGLA; \
              pq0 = (v4u){0u, 0u, 0u, 0u}; pq1 = pq0; pk0 = pq0; pk1 = pq0; pv[0] = pq0; pv[1] = pq0; pv[2] = pq0; pv[3] = pq0; \
              if (ok_) { if (MODE == 1) { pq0 = *(const v4u*)(rp_ + h * GDK + g_ * 16); pq1 = *(const v4u*)(rp_ + h * GDK + g_ * 16 + 8); } \
                  pk0 = *(const v4u*)(rp_ + GQK + h * GDK + g_ * 16); pk1 = *(const v4u*)(rp_ + GQK + h * GDK + g_ * 16 + 8); \
                  _Pragma("unroll") for (int t_ = 0; t_ < 4; ++t_) pv[t_] = *(const v4u*)(rp_ + 2 * GQK + h * GDV + g_ * 32 + 8 * t_); } } } while (0)
        GLA_PREFETCH(0);
        for (int ci = 0; ci < nch; ++ci) {
            int tid = tid0; asm volatile("" : "+v"(tid));
            const int lane = tid & 63, w = __builtin_amdgcn_readfirstlane(tid >> 6), fr = lane & 15, fq = lane >> 4;
            const int rbase = meta ? 0 : b * SEQ + (sc * CPS + ci) * 64;
            GLT(0);
            const int dA = tid & 127, cgp = tid >> 7;
            const int cC = tid & 63, grp = tid >> 6, d0 = grp * 16, e0 = grp * 32;
            const v4u q0 = pq0, q1 = pq1, k0 = pk0, k1 = pk1, vv[4] = {pv[0], pv[1], pv[2], pv[3]};
            const size_t chx = meta ? (size_t)(BATCH * GH * (SEQ / 64) + h) : (size_t)((b * GH + h) * (SEQ / 64) + sc * CPS + ci);
            f32x4 xr4[4] = {px[0], px[1], px[2], px[3]};
            if (MODE == 1) { if (tid < 128) { em[tid] = pem; ef[tid] = pef; } }
            if (MODE == 0) {
            if (tid < 256) *(LAS f32x4*)(ZC + (tid >> 2) * 16 + 4 * (tid & 3)) = pz;
            GL_BAR();
            float wg[16];
#pragma unroll
            for (int i = 0; i < 16; ++i) wg[i] = bf2f(WGL[i * GDK + dA]);
            { float run = 0.f;
#pragma unroll 4
              for (int cc = 0; cc < 16; ++cc) { const int c = cgp * 16 + cc; float lg = bgv;
#pragma unroll
                for (int i4 = 0; i4 < 4; ++i4) { const f32x4 z4 = *(const LAS f32x4*)(ZC + c * 16 + 4 * i4); lg += (z4[0] * wg[4 * i4] + z4[1] * wg[4 * i4 + 1]) + (z4[2] * wg[4 * i4 + 2] + z4[3] * wg[4 * i4 + 3]); }
                float g = (fminf(lg, 0.f) - __logf(1.0f + __expf(-fabsf(lg)))) * (1.0f / 16.0f);
                if (meta && c < 48) g = 0.f;
                run += g; Bc[c * BS + dA] = run; }
              TOT[cgp * 129 + dA] = run; }
            GL_BAR();
            GLT(1);
            if (tid < 128) { const float t0 = TOT[tid], t1 = TOT[129 + tid], t2 = TOT[258 + tid], t3 = TOT[387 + tid];
                const float bm = t0 + Bc[31 * BS + tid], bl = (t0 + t1) + (t2 + t3);
                const float emv_ = __expf(bm), efv_ = __expf(bl - bm); em[tid] = emv_; ef[tid] = efv_; dsum += bl; EMF[chx * 256 + tid] = emv_; EMF[chx * 256 + 128 + tid] = efv_;
                OFFM[tid] = -bm; OFFM[129 + tid] = t0 - bm; OFFM[258 + tid] = t0 + t1 - bm; OFFM[387 + tid] = t0 + t1 + t2 - bm; }
            GL_BAR();
            }
            GLT(2);
            { const int c = cC;
                const unsigned qw[8] = {q0.x, q0.y, q0.z, q0.w, q1.x, q1.y, q1.z, q1.w}, kw[8] = {k0.x, k0.y, k0.z, k0.w, k1.x, k1.y, k1.z, k1.w};
                unsigned qo[8], ko[8];
                const LAS float* bcr = Bc + c * BS + d0; const LAS float* ofr = OFFM + (c >> 4) * 129 + d0;
#pragma unroll
                for (int t = 0; t < 8; ++t) {
                    const int d = d0 + 2 * t;
                    float x0, x1;
                    if (MODE == 0) { x0 = bcr[2 * t] + ofr[2 * t]; x1 = bcr[2 * t + 1] + ofr[2 * t + 1]; xr4[t >> 1][2 * (t & 1)] = x0; xr4[t >> 1][2 * (t & 1) + 1] = x1; }
                    else { x0 = xr4[t >> 1][2 * (t & 1)]; x1 = xr4[t >> 1][2 * (t & 1) + 1]; }
                    const float e0f = __expf(x0), e1f = __expf(x1), r0 = __expf(-x0), r1 = __expf(-x1);
                    const float ka = bflo(kw[t]) * r0, kb = bfhi(kw[t]) * r1;
                    ko[t] = pk2(ka, kb);
                    if (MODE == 1) qo[t] = pk2(bflo(qw[t]) * (0.08838834764831845f * e0f), bfhi(qw[t]) * (0.08838834764831845f * e1f));
                    KTT[(d) * KTTS + c] = (bf16)(ko[t] & 0xffffu); KTT[(d + 1) * KTTS + c] = (bf16)(ko[t] >> 16);
                }
                if (MODE == 0) { float* xp = XB + chx * (64 * GDK) + (size_t)tid * 16;
#pragma unroll
                    for (int t = 0; t < 4; ++t) *(f32x4*)(xp + 4 * t) = xr4[t]; }
                *(LAS v4u*)(KT + c * QTS + d0) = (v4u){ko[0], ko[1], ko[2], ko[3]}; *(LAS v4u*)(KT + c * QTS + d0 + 8) = (v4u){ko[4], ko[5], ko[6], ko[7]};
                if (MODE == 1) { *(LAS v4u*)(QT + c * QTS + d0) = (v4u){qo[0], qo[1], qo[2], qo[3]}; *(LAS v4u*)(QT + c * QTS + d0 + 8) = (v4u){qo[4], qo[5], qo[6], qo[7]}; }
#pragma unroll
                for (int t = 0; t < 4; ++t) { const unsigned vw[4] = {vv[t].x, vv[t].y, vv[t].z, vv[t].w};
#pragma unroll
                    for (int s = 0; s < 4; ++s) { const int e = e0 + 8 * t + 2 * s; VT[e * VTS + c] = (bf16)(vw[s] & 0xffffu); VT[(e + 1) * VTS + c] = (bf16)(vw[s] >> 16); } }
            }
            GL_BAR();
            GLT(3);
            f32x4 pacc[2];
#pragma unroll
            for (int dt = 0; dt < 8; ++dt) { const f32x4 emv = *(const LAS f32x4*)(em + 16 * dt + 4 * fq);
#pragma unroll
                for (int i = 0; i < 2; ++i) { sacc[dt][i] = sacc[dt][i] * emv;
                    if (MODE == 1) { const int e = 32 * w + 16 * i + fr; const int ck = (2 * dt + (fq >> 1)) ^ (e & 15);
                        v2u sw; sw.x = pk2(sacc[dt][i][0], sacc[dt][i][1]); sw.y = pk2(sacc[dt][i][2], sacc[dt][i][3]);
                        *(LAS v2u*)(ST + e * 256 + ck * 16 + (fq & 1) * 8) = sw; } } }
            if (MODE == 1) {
                const int mt = w & 3, ntp = w >> 2;
#pragma unroll
                for (int ii = 0; ii < 2; ++ii) { const int nt = 2 * ntp + ii; pacc[ii] = (f32x4){0.f, 0.f, 0.f, 0.f};
                    if (nt <= mt) {
#pragma unroll
                        for (int ks = 0; ks < 4; ++ks) { const bf16x8 kf = *(const LAS bf16x8*)(KT + (16 * nt + fr) * QTS + 32 * ks + 8 * fq); const bf16x8 qf = *(const LAS bf16x8*)(QT + (16 * mt + fr) * QTS + 32 * ks + 8 * fq);
                            pacc[ii] = __builtin_amdgcn_mfma_f32_16x16x32_bf16(kf, qf, pacc[ii], 0, 0, 0); }
                        if (nt == mt) {
#pragma unroll
                            for (int jj = 0; jj < 4; ++jj) if (4 * fq + jj > fr) pacc[ii][jj] = 0.f; }
                    } }
            }
            GL_BAR();
            if (MODE == 1) { const int mt = w & 3, ntp = w >> 2;
#pragma unroll
                for (int ii = 0; ii < 2; ++ii) { const int nt = 2 * ntp + ii; v2u pw; pw.x = pk2(pacc[ii][0], pacc[ii][1]); pw.y = pk2(pacc[ii][2], pacc[ii][3]);
                    *(LAS v2u*)(PP + (16 * mt + fr) * PS + 16 * nt + 4 * fq) = pw; }
                GL_BAR();
            }
            GLT(4);
            f32x4 oacc[8];
            v2u rr[8];
            if (MODE == 1) { const int cF = 16 * (w & 3) + fr; const bool validF = !meta || cF >= 48; const int rowF = meta ? MMAIN + cF - 48 : rbase + cF;
#pragma unroll
                for (int t = 0; t < 8; ++t) { rr[t] = (v2u){0u, 0u}; if (validF) rr[t] = *(const v2u*)(QKVR + (size_t)rowF * NGLA + 2 * GQK + GVD + h * GDV + 128 * (w >> 2) + 16 * t + 4 * fq); } }
            if (MODE == 1) { const int mt = w & 3, eh = w >> 2;
                bf16x8 pf[2], qf[4];
#pragma unroll
                for (int ks = 0; ks < 2; ++ks) pf[ks] = *(const LAS bf16x8*)(PP + (16 * mt + fr) * PS + 32 * ks + 8 * fq);
#pragma unroll
                for (int ks = 0; ks < 4; ++ks) qf[ks] = *(const LAS bf16x8*)(QT + (16 * mt + fr) * QTS + 32 * ks + 8 * fq);
#pragma unroll
                for (int t = 0; t < 8; ++t) { const int e = 128 * eh + 16 * t + fr; f32x4 a = (f32x4){0.f, 0.f, 0.f, 0.f};
#pragma unroll
                    for (int ks = 0; ks < 2; ++ks) { const bf16x8 vf = *(const LAS bf16x8*)(VT + e * VTS + 32 * ks + 8 * fq); a = __builtin_amdgcn_mfma_f32_16x16x32_bf16(vf, pf[ks], a, 0, 0, 0); }
#pragma unroll
                    for (int ks = 0; ks < 4; ++ks) { const int ck = (4 * ks + fq) ^ (e & 15); const bf16x8 sf = *(const LAS bf16x8*)(ST + e * 256 + ck * 16); a = __builtin_amdgcn_mfma_f32_16x16x32_bf16(sf, qf[ks], a, 0, 0, 0); }
                    oacc[t] = a; }
            }
            { bf16x8 vf[2][2];
#pragma unroll
              for (int i = 0; i < 2; ++i)
#pragma unroll
                  for (int ks = 0; ks < 2; ++ks) vf[i][ks] = *(const LAS bf16x8*)(VT + (32 * w + 16 * i + fr) * VTS + 32 * ks + 8 * fq);
#pragma unroll
              for (int dt = 0; dt < 8; ++dt) { const f32x4 efv = *(const LAS f32x4*)(ef + 16 * dt + 4 * fq);
#pragma unroll
                  for (int ks = 0; ks < 2; ++ks) { const bf16x8 kf = *(const LAS bf16x8*)(KTT + (16 * dt + fr) * KTTS + 32 * ks + 8 * fq);
#pragma unroll
                      for (int i = 0; i < 2; ++i) sacc[dt][i] = __builtin_amdgcn_mfma_f32_16x16x32_bf16(kf, vf[i][ks], sacc[dt][i], 0, 0, 0); }
#pragma unroll
                  for (int i = 0; i < 2; ++i) sacc[dt][i] = sacc[dt][i] * efv; }
            }
            if (ci + 1 < nch) GLA_PREFETCH(ci + 1);
            GLT(5);
            if (MODE == 1) { const int mt = w & 3, eh = w >> 2, c = 16 * mt + fr;
                float s1 = 0.f, s2 = 0.f;
#pragma unroll
                for (int t = 0; t < 8; ++t)
#pragma unroll
                    for (int jj = 0; jj < 4; ++jj) { s1 += oacc[t][jj]; s2 += oacc[t][jj] * oacc[t][jj]; }
                s1 += shx(s1, 16, lane); s1 += shx(s1, 32, lane); s2 += shx(s2, 16, lane); s2 += shx(s2, 32, lane);
                if (fq == 0) { stats[(c * 2 + eh) * 2 + 0] = s1; stats[(c * 2 + eh) * 2 + 1] = s2; }
                GL_BAR();
                const float t1 = stats[(c * 2 + 0) * 2 + 0] + stats[(c * 2 + 1) * 2 + 0], t2 = stats[(c * 2 + 0) * 2 + 1] + stats[(c * 2 + 1) * 2 + 1];
                float inv_dv = 1.0f / GDV; asm volatile("" : "+v"(inv_dv));
                const float mean = t1 * inv_dv, var = fmaxf(t2 * inv_dv - mean * mean, 0.f), rstd = __builtin_amdgcn_rsqf(var + LN_EPS);
                const bool valid = !meta || c >= 48; const int row = meta ? MMAIN + c - 48 : rbase + c;
                if (valid) {
#pragma unroll
                    for (int t = 0; t < 8; ++t) { const int e = 128 * eh + 16 * t + 4 * fq;
                        const v2u rw = rr[t];
                        const f32x4 ng = *(const LAS f32x4*)(NGL + e);
                        const float r4[4] = {bflo(rw.x), bfhi(rw.x), bflo(rw.y), bfhi(rw.y)}; float o4[4];
#pragma unroll
                        for (int jj = 0; jj < 4; ++jj) o4[jj] = (oacc[t][jj] - mean) * rstd * ng[jj] * silu_f(r4[jj]);
                        v2u ow; ow.x = pk2(o4[0], o4[1]); ow.y = pk2(o4[2], o4[3]);
                        *(v2u*)(O + (size_t)row * D + h * GDV + e) = ow; } }
            }
            GL_BAR();
            GLT(6);
        }
        if (MODE == 0) {
            int lofs2 = (4 * ((tid0 & 63) >> 4)) * GDV + 32 * (tid0 >> 6) + (tid0 & 15); asm volatile("" : "+v"(lofs2));
#pragma unroll
            for (int dt = 0; dt < 8; ++dt)
#pragma unroll
                for (int i = 0; i < 2; ++i)
#pragma unroll
                    for (int jj = 0; jj < 4; ++jj) KVS[(size_t)u * (GDK * GDV) + (size_t)((16 * dt + jj) * GDV + 16 * i) + lofs2] = sacc[dt][i][jj];
            if (tid0 < 128) DEC[(size_t)u * GDK + tid0] = dsum;
        }
    }
}
__device__ __forceinline__ void gla_scan_phase(Frame& F) {
    const float* KVS = (const float*)(F.ws + WS_S0 + S_KVS); float* SST = (float*)(F.ws + WS_S0 + S_SST); const float* DEC = (const float*)(F.ws + WS_S0 + S_DEC);
    constexpr int NEL = GDK * GDV;
    for (int idx = F.bx * NTHR + F.tid; idx < BATCH * GH * NEL; idx += F.G * NTHR) {
        const int bh = idx / NEL, el = idx - bh * NEL, d = el / GDV, h = bh % GH;
        float s = KVS[(size_t)(BATCH * GH * NSC_BH + h) * NEL + el];
        const size_t ub = (size_t)bh * NSC_BH;
        SST[ub * NEL + el] = s;
        for (int sc = 0; sc + 1 < NSC_BH; sc += 7) { float dv[7], kv[7];
#pragma unroll
            for (int t = 0; t < 7; ++t) { const int q = (sc + t + 1 < NSC_BH) ? sc + t : NSC_BH - 2; dv[t] = DEC[(ub + q) * GDK + d]; kv[t] = KVS[(ub + q) * NEL + el]; }
#pragma unroll
            for (int t = 0; t < 7; ++t) if (sc + t + 1 < NSC_BH) { s = __expf(dv[t]) * s + kv[t]; SST[(ub + sc + t + 1) * NEL + el] = s; } }
    }
}

#define GLA_PHASES \
        if (IN(pb + 10)) { if (on_gla) { \
            bf16* QKVR = (bf16*)(F.ws + WS_S0 + S_QKVR); EpiBf16Gelu E{QKVR, NGLA, 0}; \
            meta_gemm(F, HB + (size_t)MMAIN * D, D, D, (const bf16*)(wl + WL_GLAIN), NGLA / 16, E); \
            pg8::Gemm g{D, D}; pg8::DenseOrder S; S.init(HB, D, (const bf16*)(wl + WL_GLAIN), D, MMAIN / 256, NGLA / 256, F.G, F.bx); \
            pg8::gemm_phase<EpiBf16Gelu, pg8::DenseOrder>(F.lds, F.tid, g, S, E); } \
            SEAM(pb + 10); } \
        if (IN(pb + 11)) { if (on_gla) gla_phase<0>(F, args.in[12] + (size_t)j * GRANK * GQK, args.in[13] + (size_t)j * GQK, args.in[14] + (size_t)j * GVD); SEAM(pb + 11); } \
        if (IN(pb + 12)) { if (on_gla) gla_scan_phase(F); SEAM(pb + 12); } \
        if (IN(pb + 13)) { if (on_gla) gla_phase<1>(F, args.in[12] + (size_t)j * GRANK * GQK, args.in[13] + (size_t)j * GQK, args.in[14] + (size_t)j * GVD); SEAM(pb + 13); } \
        if (IN(pb + 14)) { if (on_gla) { \
            const bf16* O = (const bf16*)(F.ws + WS_S0 + S_O); EpiBf16Gelu E{MIX, D, 0}; \
            meta_gemm(F, O + (size_t)MMAIN * D, D, D, (const bf16*)(wl + WL_GLAOUT), D / 16, E); \
            pg8::Gemm g{D, D}; pg8::DenseOrder S; S.init(O, D, (const bf16*)(wl + WL_GLAOUT), D, MMAIN / 256, D / 256, F.G, F.bx); \
            pg8::gemm_phase<EpiBf16Gelu, pg8::DenseOrder>(F.lds, F.tid, g, S, E); } \
            SEAM(pb + 14); }

__device__ __forceinline__ void moe_panel_ends(const gu32* cnt, int (&pe)[8]) {
    int acc = 0;
#pragma unroll
    for (int e = 0; e < 8; ++e) { const int c = __builtin_amdgcn_readfirstlane((int)__hip_atomic_load(cnt + e, RLX_AGENT)); acc += (c + 255) >> 8; pe[e] = acc; }
}
__device__ __forceinline__ void moe_gather_phase(Frame& F, gu32* moe) {
    const bf16* HB = (const bf16*)(F.ws + WS_HB); bf16* AS = (bf16*)(F.ws + WS_S0 + S_AS);
    const int* E1 = (const int*)(F.ws + WS_RT); const int* E2 = E1 + MROWS; int* POS1 = (int*)(F.ws + WS_RT) + 4 * MROWS; int* POS2 = POS1 + MROWS;
    LAS unsigned* lcnt = (LAS unsigned*)F.lds; LAS unsigned* lbase = lcnt + 8; LAS int* lpos = (LAS int*)(F.lds + 256);
    const int per = (MROWS + F.G - 1) / F.G, t0 = F.bx * per, nt = (t0 + per <= MROWS) ? per : (MROWS - t0 > 0 ? MROWS - t0 : 0);
    if (F.tid < 8) lcnt[F.tid] = 0u;
    __syncthreads();
    int e1 = 0, e2 = 0; unsigned r1 = 0, r2 = 0;
    if (F.tid < nt) { e1 = E1[t0 + F.tid]; e2 = E2[t0 + F.tid];
        r1 = __hip_atomic_fetch_add(&lcnt[e1], 1u, __ATOMIC_RELAXED, __HIP_MEMORY_SCOPE_WORKGROUP); r2 = __hip_atomic_fetch_add(&lcnt[e2], 1u, __ATOMIC_RELAXED, __HIP_MEMORY_SCOPE_WORKGROUP); }
    __syncthreads();
    if (F.tid < 8) { int ps = 0, accp = 0;
#pragma unroll
        for (int e = 0; e < 8; ++e) { ps = (e == F.tid) ? accp : ps; accp += ((int)__hip_atomic_load(moe + e, RLX_AGENT) + 255) >> 8; }
        const unsigned c = lcnt[F.tid]; const unsigned off = c ? __hip_atomic_fetch_add(moe + 64 + F.tid, c, RLX_AGENT) : 0u;
        lbase[F.tid] = (unsigned)ps * 256u + off; }
    __syncthreads();
    if (F.tid < nt) { const int p1 = (int)(lbase[e1] + r1), p2 = (int)(lbase[e2] + r2); POS1[t0 + F.tid] = p1; POS2[t0 + F.tid] = p2; lpos[2 * F.tid] = p1; lpos[2 * F.tid + 1] = p2; }
    __syncthreads();
    for (int t = F.wave; t < nt; t += NWAVES) {
        const v4u* src = (const v4u*)(HB + (size_t)(t0 + t) * D); const v4u a = src[2 * F.lane], b = src[2 * F.lane + 1];
        float x[16]; unpack8(a, x); unpack8(b, x + 8);
        const v4u o = (v4u){pk4_fp8(x[0], x[1], x[2], x[3]), pk4_fp8(x[4], x[5], x[6], x[7]), pk4_fp8(x[8], x[9], x[10], x[11]), pk4_fp8(x[12], x[13], x[14], x[15])};
        unsigned char* AS8 = (unsigned char*)AS;
        *(v4u*)(AS8 + (size_t)lpos[2 * t] * D + 16 * F.lane) = o; *(v4u*)(AS8 + (size_t)lpos[2 * t + 1] * D + 16 * F.lane) = o;
    }
}

#ifdef MK_IDLE_TICKS
#define IDLE_PROBE { const unsigned long long t0_ = __builtin_amdgcn_s_memrealtime(); while (__builtin_amdgcn_s_memrealtime() - t0_ < (unsigned long long)(MK_IDLE_TICKS)) __builtin_amdgcn_s_sleep(64); }
#else
#define IDLE_PROBE
#endif
#define MOE_PHASES \
        if (IN(pb + 16)) { if (on_moe) moe_gather_phase(F, F.ctl + CW_MOE + 256 * j); IDLE_PROBE SEAM(pb + 16); } \
        if (IN(pb + 17)) { if (on_moe) { \
            const bf16* AS = (const bf16*)(F.ws + WS_S0 + S_AS); bf16* HS = (bf16*)(F.ws + WS_S0 + S_HS); EpiSwiglu E{HS, FF, 0.015625f}; \
            pg8::Gemm g{D, D}; pg8::MoeOrder S; moe_panel_ends(F.ctl + CW_MOE + 256 * j, S.pe); S.e_bytes = (size_t)NFF2 * D; \
            S.init(AS, D, (const bf16*)(wl + WL_MOEIN), D, S.pe[7], NFF2 / 256, F.G, F.bx, 1); \
            pg8::gemm_phase<EpiSwiglu, pg8::MoeOrder, true, true, 121>(F.lds, F.tid, g, S, E); } \
            SEAM(pb + 17); } \
        if (IN(pb + 18)) { if (on_moe) { \
            const bf16* HS = (const bf16*)(F.ws + WS_S0 + S_HS); EpiBf16Gelu E{(bf16*)(F.ws + WS_S0 + S_YS), D, 0}; \
            pg8::Gemm g{FF, FF}; pg8::MoeOrder S; moe_panel_ends(F.ctl + CW_MOE + 256 * j, S.pe); S.e_bytes = (size_t)D * FF * 2; \
            S.init(HS, FF, (const bf16*)(wl + WL_MOEOUT), FF, S.pe[7], D / 256, F.G, F.bx); \
            pg8::gemm_phase<EpiBf16Gelu, pg8::MoeOrder>(F.lds, F.tid, g, S, E); } \
            SEAM(pb + 18); }

constexpr int NPHASE = 41;
#ifndef MK_PER_PHASE
#define MK_PER_PHASE 0
#endif
#ifndef MK_DBG
#define MK_DBG 0
#endif
#ifndef MK_SUBMASK
#define MK_SUBMASK 0xFFu
#endif

__global__ void __launch_bounds__(NTHR, 2) fwd(Args args) {
    extern __shared__ __attribute__((aligned(16))) unsigned char lds[];
    Frame F;
    F.lds = (LAS unsigned char*)lds; F.ws = args.ws; F.ctl = (gu32*)(args.ws + WS_CTL);
    F.tid = threadIdx.x; F.lane = F.tid & 63; F.wave = __builtin_amdgcn_readfirstlane(F.tid >> 6); F.G = gridDim.x; F.bx = blockIdx.x; F.dbg_acc = 0ull;
    volatile LAS unsigned* MISC = (volatile LAS unsigned*)(F.lds + MISC_OFF);
    if (F.tid < 16) MISC[F.tid] = 0u;
    __syncthreads();
    const int lo = args.ph_lo, hi = args.ph_hi;
    XcdBarrier bar; bar.bar = (unsigned*)(F.ctl + CW_BAR); bar.x = 0; bar.st = nullptr;
    if (hi - lo > 1) bar = xcd_barrier_post((unsigned*)(F.ctl + CW_BAR), MISC);
#ifndef MK_STAMP_BARMASK
#define MK_STAMP_BARMASK 0xFFFFFu
#endif
#ifdef MK_STAMP_MASK
    unsigned long long st_acc = 0ull, st_t0 = 0ull;
#define ST_SEL(k) ((k) == 0 ? (((MK_STAMP_MASK) >> 20) & 1u) : ((((MK_STAMP_MASK) >> (((k) - 1) % 20)) & 1u)))
#define IN(k) (lo <= (k) && (k) < hi && (F.fresh(), st_t0 = __builtin_amdgcn_s_memrealtime(), true))
#define SEAM(k) do { const unsigned long long t1_ = __builtin_amdgcn_s_memrealtime(); if (ST_SEL(k)) st_acc += t1_ - st_t0; if ((k) + 1 < hi) xcd_barrier(bar); if ((((MK_STAMP_MASK) >> 21) & 1u) && ((k) == 0 || (((MK_STAMP_BARMASK) >> (((k) - 1) % 20)) & 1u))) st_acc += __builtin_amdgcn_s_memrealtime() - t1_; } while (0)
#else
#define IN(k) (lo <= (k) && (k) < hi && (F.fresh(), true))
#define SEAM(k) do { if ((k) + 1 < hi) xcd_barrier(bar); } while (0)
#endif
    const unsigned submask = args.submask;
    const float* ln_gain = args.in[2]; const float* ln_bias = args.in[3];
    bf16* HB = (bf16*)(F.ws + WS_HB); bf16* MIX = (bf16*)(F.ws + WS_MIX);

    if (IN(0)) { p0_prologue(F, args); SEAM(0); }

    for (int j = 0; j < 2; ++j) {
        const int pb = 1 + 20 * j;
        unsigned char* wl = F.ws + WS_W + (size_t)j * WL_STRIDE;
        const bool on_rg = (submask >> (4 * j + 0)) & 1u, on_ffn = (submask >> (4 * j + 1)) & 1u, on_gla = (submask >> (4 * j + 2)) & 1u, on_moe = (submask >> (4 * j + 3)) & 1u;
        RG_PHASES
        if (IN(pb + 6)) { ln_phase(F, on_rg ? 1 : 0, ln_gain + (size_t)(2 * j) * 2 * D, ln_bias + (size_t)(2 * j) * 2 * D, 0, nullptr, 0, nullptr, nullptr); SEAM(pb + 6); }
        if (IN(pb + 7)) { if (on_ffn) {
            bf16* HID = (bf16*)(F.ws + WS_S0 + S_HID);
            EpiSwiglu E{HID, FF, 1.0f};
            if (!(MK_DBG & 1)) meta_gemm(F, HB + (size_t)MMAIN * D, D, D, (const bf16*)(wl + WL_FFNIN), (NFF2 / 256) * 8, E);
            pg8::Gemm g{D, D}; pg8::DenseOrder S; S.init(HB, D, (const bf16*)(wl + WL_FFNIN), D, MMAIN / 256, NFF2 / 256, F.G, F.bx);
            if (!(MK_DBG & 2)) pg8::gemm_phase<EpiSwiglu, pg8::DenseOrder>(F.lds, F.tid, g, S, E); }
            SEAM(pb + 7); }
        if (IN(pb + 8)) { if (on_ffn) {
            const bf16* HID = (const bf16*)(F.ws + WS_S0 + S_HID);
            EpiBf16Gelu E{MIX, D, 0};
            if (!(MK_DBG & 4)) meta_gemm(F, HID + (size_t)MMAIN * FF, FF, FF, (const bf16*)(wl + WL_FFNOUT), D / 16, E);
            pg8::Gemm g{FF, FF}; pg8::DenseOrder S; S.init(HID, FF, (const bf16*)(wl + WL_FFNOUT), FF, MMAIN / 256, D / 256, F.G, F.bx);
            if (!(MK_DBG & 8)) pg8::gemm_phase<EpiBf16Gelu, pg8::DenseOrder>(F.lds, F.tid, g, S, E); }
            SEAM(pb + 8); }
        if (IN(pb + 9)) { ln_phase(F, on_ffn ? 1 : 0, ln_gain + (size_t)(2 * j) * 2 * D + D, ln_bias + (size_t)(2 * j) * 2 * D + D, 1, args.in[11] + (size_t)j * D * GLAW + NGLA, GLAW, nullptr, nullptr); SEAM(pb + 9); }
        GLA_PHASES
        if (IN(pb + 15)) { ln_phase(F, on_gla ? 1 : 0, ln_gain + (size_t)(2 * j + 1) * 2 * D, ln_bias + (size_t)(2 * j + 1) * 2 * D, on_moe ? 2 : 0, args.in[18] + (size_t)j * D * NE, NE, nullptr, F.ctl + CW_MOE + 256 * j); SEAM(pb + 15); }
        MOE_PHASES
        if (IN(pb + 19)) { ln_phase(F, on_moe ? 2 : 0, ln_gain + (size_t)(2 * j + 1) * 2 * D + D, ln_bias + (size_t)(2 * j + 1) * 2 * D + D, 0, nullptr, 0, j == 1 ? args.out : nullptr, nullptr); SEAM(pb + 19); }
    }
#ifdef MK_STAMP_MASK
    __syncthreads();
    if (blockIdx.x == 0 && threadIdx.x == 0) args.out[0] = (float)(st_acc + F.dbg_acc) * 0.01f * (MK_STAMP_SCALE);
#endif
#undef IN
#undef SEAM
}

static bool phase_enabled(int k, unsigned mask) {
    if (k == 0) return true;
    const int j = (k - 1) / 20, r = (k - 1) % 20;
    int sub;
    if (r <= 5) sub = 0; else if (r == 6) return true; else if (r <= 8) sub = 1; else if (r == 9) return true;
    else if (r <= 14) sub = 2; else if (r == 15) return true; else if (r <= 18) sub = 3; else return true;
    return (mask >> (4 * j + sub)) & 1u;
}
extern "C" void kernel_launch(void* const* d_in, const int* in_sizes, int n_in, void* d_out, int out_size, void* d_ws, size_t ws_size, hipStream_t stream) {
    static int grid = 0;
    if (grid == 0) {
        if (n_in != 21 || out_size != MMAIN * D || ws_size < WS_END) { fprintf(stderr, "kernel_launch: unexpected shapes: n_in %d out %d ws %zu (need %zu); nothing launched\n", n_in, out_size, ws_size, (size_t)WS_END); grid = -1; return; }
        int dev = 0, cus = 0, per_cu = 0;
        if (hipGetDevice(&dev) != hipSuccess || hipDeviceGetAttribute(&cus, hipDeviceAttributeMultiprocessorCount, dev) != hipSuccess) { grid = -1; return; }
        if (hipFuncSetAttribute((const void*)fwd, hipFuncAttributeMaxDynamicSharedMemorySize, LDS_BYTES) != hipSuccess) { fprintf(stderr, "kernel_launch: hipFuncSetAttribute failed\n"); grid = -1; return; }
        if (hipOccupancyMaxActiveBlocksPerMultiprocessor(&per_cu, (const void*)fwd, NTHR, LDS_BYTES) != hipSuccess || per_cu < 1) fprintf(stderr, "kernel_launch: note: occupancy query reports %d\n", per_cu);
        (void)hipGetLastError();
        grid = cus;
    }
    if (grid < 0) return;
    (void)hipMemsetAsync((char*)d_ws + WS_CTL, 0, CTL_ZERO_BYTES, stream);
    Args a{};
    for (int i = 0; i < 21; ++i) a.in[i] = (const float*)d_in[i];
    a.out = (float*)d_out; a.ws = (unsigned char*)d_ws; a.submask = MK_SUBMASK; a.pad = 0;
#if MK_PER_PHASE
    for (int k = 0; k < NPHASE; ++k) { if (!phase_enabled(k, MK_SUBMASK)) continue; a.ph_lo = k; a.ph_hi = k + 1; hipLaunchKernelGGL(fwd, dim3(grid), dim3(NTHR), LDS_BYTES, stream, a); }
#else
    a.ph_lo = 0; a.ph_hi = NPHASE; hipLaunchKernelGGL(fwd, dim3(grid), dim3(NTHR), LDS_BYTES, stream, a);
#ifdef MK_PROBE_LIST
    { const int pl[] = {MK_PROBE_LIST}; for (int k : pl) { a.ph_lo = k; a.ph_hi = k + 1; hipLaunchKernelGGL(fwd, dim3(grid), dim3(NTHR), LDS_BYTES, stream, a); } }
#endif
#endif
}
```

```cpp
#include <hip/hip_runtime.h>
#include <cstdio>
#include <cstdint>

#define GAS __attribute__((address_space(1)))
#define LAS __attribute__((address_space(3)))
typedef unsigned short bf16;
typedef unsigned v4u __attribute__((ext_vector_type(4)));
typedef unsigned v2u __attribute__((ext_vector_type(2)));
typedef float f32x4 __attribute__((ext_vector_type(4)));
typedef float f32x2 __attribute__((ext_vector_type(2)));
typedef short bf16x8 __attribute__((ext_vector_type(8)));
typedef short bf16x4 __attribute__((ext_vector_type(4)));
typedef GAS unsigned gu32;
#define RLX_AGENT __ATOMIC_RELAXED, __HIP_MEMORY_SCOPE_AGENT
#define LDS_WAIT() asm volatile("s_waitcnt lgkmcnt(0)" ::: "memory")
#define VM_WAIT() asm volatile("s_waitcnt vmcnt(0)" ::: "memory")

__device__ __forceinline__ unsigned f2bf(float f) { unsigned u = __builtin_bit_cast(unsigned, f); return (u + 0x7fffu + ((u >> 16) & 1u)) >> 16; }
__device__ __forceinline__ unsigned pk2(float lo, float hi) { unsigned r; asm("v_cvt_pk_bf16_f32 %0, %1, %2" : "=v"(r) : "v"(lo), "v"(hi)); return r; }
__device__ __forceinline__ float bflo(unsigned w) { return __builtin_bit_cast(float, w << 16); }
__device__ __forceinline__ float bfhi(unsigned w) { return __builtin_bit_cast(float, w & 0xffff0000u); }
__device__ __forceinline__ float bf2f(bf16 b) { return __builtin_bit_cast(float, (unsigned)b << 16); }
__device__ __forceinline__ unsigned cvt_pk_bf16(float lo, float hi) { unsigned r; asm volatile("v_cvt_pk_bf16_f32 %0, %1, %2" : "=v"(r) : "v"(lo), "v"(hi)); return r; }
__device__ __forceinline__ unsigned pk4_fp8(float a, float b, float c, float d) { int w = 0; w = __builtin_amdgcn_cvt_pk_fp8_f32(a, b, w, false); w = __builtin_amdgcn_cvt_pk_fp8_f32(c, d, w, true); return (unsigned)w; }
__device__ __forceinline__ float fast_exp(float x) { return __builtin_amdgcn_exp2f(x * 1.44269504089f); }
__device__ __forceinline__ float sigmoid_f(float x) { return __builtin_amdgcn_rcpf(1.0f + fast_exp(-x)); }
__device__ __forceinline__ float silu_f(float x) { return x * sigmoid_f(x); }
__device__ __forceinline__ float gelu_tanh_f(float x) { const float u = 0.7978845608028654f * (x + 0.044715f * x * x * x); return x * sigmoid_f(2.0f * u); }
__device__ __forceinline__ float shx(float v, int m, int lane) { return __int_as_float(__builtin_amdgcn_ds_bpermute((lane ^ m) << 2, __float_as_int(v))); }
__device__ __forceinline__ float wave_sum(float v, int lane) {
#pragma unroll
    for (int o = 1; o < 64; o <<= 1) v += shx(v, o, lane);
    return v;
}

namespace pg8 {
constexpr int BM = 256, BK = 64, HALF = 128, HTB = HALF * BK * 2  , STAGE_BYTES = 8 * HTB, NXCD = 8, WGM = 8;
__host__ __device__ __forceinline__ int lds_byte(int r, int c) { const int st = (r >> 4) * 2 + (c >> 5), rr = r & 15, cc = c & 31, ob = rr * 64 + cc * 2; return st * 1024 + (ob ^ (((ob >> 9) & 1) << 5)); }
__host__ __device__ __forceinline__ void stage_rc(int b, int& R, int& C) { const int st = b / 1024, sb = b % 1024, swz = sb ^ (((sb >> 9) & 1) << 5); R = (st >> 1) * 16 + swz / 64; C = (st & 1) * 32 + (swz % 64) / 2; }
__host__ __device__ __forceinline__ int perm32(int rho) { const int n = rho >> 4, i = rho & 15; return 8 * (i >> 2) + 4 * n + (i & 3); }

struct Unit { int pm, pn; };
struct Gemm { int K, lda, esz; };

struct OrderBase {
    int nM, nN, nwg, G, c;
    __device__ __forceinline__ void init_order(int nM_, int nN_, int G_, int c_) { nM = nM_; nN = nN_; nwg = nM * nN; G = G_; c = c_; }
    __device__ __forceinline__ bool next(int i, Unit& u) const {
        const long L = (long)i * G + c; if (L >= nwg) return false;
        int wgid = (int)L; { const int q = nwg / NXCD, r = nwg % NXCD, xcd = wgid % NXCD, off = wgid / NXCD; wgid = (xcd < r ? xcd * (q + 1) : r * (q + 1) + (xcd - r) * q) + off; }
        const int nig = WGM * nN, gid = wgid / nig, fm = gid * WGM, gsz = (nM - fm) < WGM ? (nM - fm) : WGM;
        u.pm = __builtin_amdgcn_readfirstlane(fm + ((wgid % nig) % gsz)); u.pn = __builtin_amdgcn_readfirstlane((wgid % nig) / gsz); return true;
    }
};
struct DenseOrder : OrderBase {
    const char* A; const char* Bt; size_t a_tile, b_tile;
    __device__ __forceinline__ void init(const void* A_, int lda, const void* Bt_, int K, int nM_, int nN_, int G_, int c_, int esz = 2) { A = (const char*)A_; Bt = (const char*)Bt_; a_tile = (size_t)BM * lda * esz; b_tile = (size_t)BM * K * esz; init_order(nM_, nN_, G_, c_); }
    __device__ __forceinline__ const char* a_base(const Unit& u) const { return A + (size_t)u.pm * a_tile; }
    __device__ __forceinline__ const char* b_base(const Unit& u) const { return Bt + (size_t)u.pn * b_tile; }
};
struct GatesOrder : DenseOrder {
    __device__ __forceinline__ const char* a_base(const Unit& u) const { return A + (size_t)u.pm * a_tile + (size_t)(u.pn >> 1) * 512; }
};
struct MoeOrder : DenseOrder {
    int pe[8]; size_t e_bytes;
    __device__ __forceinline__ const char* b_base(const Unit& u) const {
        int e = 0;
#pragma unroll
        for (int j = 0; j < 7; ++j) e += (u.pm >= pe[j]) ? 1 : 0;
        return Bt + (size_t)e * e_bytes + (size_t)u.pn * b_tile;
    }
};

typedef int v8i __attribute__((ext_vector_type(8)));
typedef int v4i __attribute__((ext_vector_type(4)));
template <class Epi, class Sched, bool ALIGN_EPI = true, bool FP8 = false, int SCALE_W = 127>
__device__ __forceinline__ void gemm_phase(LAS unsigned char* lds, const int tid, const Gemm g, const Sched& S, const Epi& E) {
    const int wid = __builtin_amdgcn_readfirstlane(tid >> 6), lane = tid & 63, wr = wid >> 2, wc = wid & 3, fr = lane & 15, fq = lane >> 4;
    const int K = g.K, nt = FP8 ? K / 128 : K / BK;
    unsigned voffA[1], voffB[1];
#pragma unroll
    for (int i = 0; i < 1; ++i) { int R, C; stage_rc(tid * 16 + i * 8192, R, C); const int Rb = Epi::PERM ? ((R & ~31) + perm32(R & 31)) : R;
        voffA[i] = FP8 ? (unsigned)(R * g.lda + 2 * C) : (unsigned)(R * g.lda + C) * 2u; voffB[i] = FP8 ? (unsigned)(Rb * K + 2 * C) : (unsigned)(Rb * K + C) * 2u; }
    const size_t kstep = (size_t)(BK * 2);
    const size_t hstepA = (size_t)HALF * g.lda * (FP8 ? 1 : 2), hstepB = (size_t)HALF * K * (FP8 ? 1 : 2);
    const size_t qstepA = hstepA / 2, qstepB = hstepB / 2;
    const unsigned ldsw = (unsigned)wid * 1024u;
    const int aoff = FP8 ? lds_byte(wr * 64 + fr, 16 * (fq & 1)) + (fq >> 1) * 1024 : lds_byte(wr * 64 + fr, fq * 8), boff = FP8 ? lds_byte(wc * 32 + fr, 16 * (fq & 1)) + (fq >> 1) * 1024 : lds_byte(wc * 32 + fr, fq * 8);
#define PG8_SA(b, h) (((b) * 2 + (h)) * HTB)
#define PG8_SB(b, h) ((4 + (b) * 2 + (h)) * HTB)
#define PG8_STAGE(bufoff, gbase, voff) do { _Pragma("unroll") for (int _i = 0; _i < 2; ++_i) \
        __builtin_amdgcn_global_load_lds((const unsigned*)((const char*)(gbase) + (size_t)_i * ((voff) == voffA ? qstepA : qstepB) + (voff)[0]), (LAS unsigned*)(lds + (bufoff) + ldsw + _i * 8192), 16, 0, 0); } while (0)
#define PG8_LDA(dst, b, h) do { if constexpr (FP8) { _Pragma("unroll") for (int m = 0; m < 4; ++m) dst##8[m] = __builtin_shufflevector(*(const LAS v4i*)(lds + PG8_SA(b, h) + aoff + m * 2048), *(const LAS v4i*)(lds + PG8_SA(b, h) + aoff + m * 2048 + 16), 0, 1, 2, 3, 4, 5, 6, 7); } else { _Pragma("unroll") for (int m = 0; m < 4; ++m) _Pragma("unroll") for (int k = 0; k < 2; ++k) dst[m][k] = *(const LAS bf16x8*)(lds + PG8_SA(b, h) + aoff + m * 2048 + k * 1024); } } while (0)
#define PG8_LDB(dst, b, h) do { if constexpr (FP8) { _Pragma("unroll") for (int n = 0; n < 2; ++n) dst##8[n] = __builtin_shufflevector(*(const LAS v4i*)(lds + PG8_SB(b, h) + boff + n * 2048), *(const LAS v4i*)(lds + PG8_SB(b, h) + boff + n * 2048 + 16), 0, 1, 2, 3, 4, 5, 6, 7); } else { _Pragma("unroll") for (int n = 0; n < 2; ++n) _Pragma("unroll") for (int k = 0; k < 2; ++k) dst[n][k] = *(const LAS bf16x8*)(lds + PG8_SB(b, h) + boff + n * 2048 + k * 1024); } } while (0)
#define PG8_MMA(ai, bj, At, Bt) do { __builtin_amdgcn_s_setprio(1); if constexpr (FP8) { _Pragma("unroll") for (int m = 0; m < 4; ++m) _Pragma("unroll") for (int n = 0; n < 2; ++n) \
            acc[ai][bj][m][n] = __builtin_amdgcn_mfma_scale_f32_16x16x128_f8f6f4(Bt##8[n], At##8[m], acc[ai][bj][m][n], 0, 0, 0, 0, 0, 0); } else { \
        _Pragma("unroll") for (int m = 0; m < 4; ++m) _Pragma("unroll") for (int n = 0; n < 2; ++n) _Pragma("unroll") for (int k = 0; k < 2; ++k) \
        acc[ai][bj][m][n] = __builtin_amdgcn_mfma_f32_16x16x32_bf16(Bt[n][k], At[m][k], acc[ai][bj][m][n], 0, 0, 0); } __builtin_amdgcn_s_setprio(0); } while (0)
#define PG8_WAIT_V(n) asm volatile("s_waitcnt vmcnt(" #n ")" ::: "memory")
#define PG8_WAIT_L(n) asm volatile("s_waitcnt lgkmcnt(" #n ")" ::: "memory")
#define PG8_BAR __builtin_amdgcn_s_barrier()
#define PG8_SCHED __builtin_amdgcn_sched_barrier(0)
    Unit cur, nxt; int ui = 0;
    if (!S.next(0, cur)) return;
    f32x4 acc[2][2][4][2];
#pragma unroll
    for (int a = 0; a < 2; ++a)
#pragma unroll
        for (int b = 0; b < 2; ++b)
#pragma unroll
            for (int m = 0; m < 4; ++m)
#pragma unroll
                for (int n = 0; n < 2; ++n) acc[a][b][m][n] = (f32x4){0.f, 0.f, 0.f, 0.f};
    bf16x8 At[4][2], B0[2][2], B1[2][2]; v8i At8[4], B08[2], B18[2];
    const char* cA = S.a_base(cur); const char* cB = S.b_base(cur);
    PG8_STAGE(PG8_SB(0, 0), cB, voffB); PG8_STAGE(PG8_SB(0, 1), cB + hstepB, voffB); PG8_STAGE(PG8_SA(0, 0), cA, voffA); PG8_STAGE(PG8_SA(0, 1), cA + hstepA, voffA);
    if (wr == 1) PG8_BAR;
    PG8_WAIT_V(2); PG8_BAR;
    PG8_STAGE(PG8_SB(1, 0), cB + kstep, voffB); PG8_STAGE(PG8_SA(1, 0), cA + kstep, voffA); PG8_STAGE(PG8_SB(1, 1), cB + hstepB + kstep, voffB);
    PG8_WAIT_V(6); PG8_BAR;
    for (;;) {
        const bool has_next = S.next(ui + 1, nxt);
        const char* nA = has_next ? S.a_base(nxt) : cA; const char* nB = has_next ? S.b_base(nxt) : cB;
#pragma nounroll
        for (int t = 0; t < nt; t += 2) {
            const bool last = (t == nt - 2);
            asm volatile("" : "+v"(voffA[0]), "+v"(voffB[0]));
            const char* a1 = cA + (size_t)(t + 1) * kstep;
            const char* a2 = last ? nA : cA + (size_t)(t + 2) * kstep; const char* b2 = last ? nB : cB + (size_t)(t + 2) * kstep;
            const char* a3 = a2 + kstep; const char* b3 = b2 + kstep;
            PG8_LDB(B0, 0, 0); PG8_LDB(B1, 0, 1); PG8_SCHED; PG8_LDA(At, 0, 0); PG8_STAGE(PG8_SA(1, 1), a1 + hstepA, voffA);
            PG8_WAIT_V(8); PG8_WAIT_L(0); PG8_BAR; PG8_MMA(0, 0, At, B0); PG8_MMA(0, 1, At, B1); PG8_BAR; PG8_SCHED;
            PG8_LDA(At, 0, 1); PG8_STAGE(PG8_SB(0, 0), b2, voffB); PG8_STAGE(PG8_SB(0, 1), b2 + hstepB, voffB); PG8_STAGE(PG8_SA(0, 0), a2, voffA);
            PG8_WAIT_V(8); PG8_WAIT_L(0); PG8_BAR; PG8_MMA(1, 0, At, B0); PG8_MMA(1, 1, At, B1); PG8_BAR; PG8_SCHED;
            PG8_LDB(B0, 1, 0); PG8_LDB(B1, 1, 1); PG8_SCHED; PG8_LDA(At, 1, 0); PG8_STAGE(PG8_SA(0, 1), a2 + hstepA, voffA);
            PG8_WAIT_V(8); PG8_WAIT_L(0); PG8_BAR; PG8_MMA(0, 0, At, B0); PG8_MMA(0, 1, At, B1); PG8_BAR; PG8_SCHED;
            PG8_LDA(At, 1, 1); PG8_STAGE(PG8_SB(1, 0), b3, voffB); PG8_STAGE(PG8_SB(1, 1), b3 + hstepB, voffB); PG8_STAGE(PG8_SA(1, 0), a3, voffA);
            PG8_WAIT_V(8); PG8_WAIT_L(0); PG8_BAR; PG8_MMA(1, 0, At, B0); PG8_MMA(1, 1, At, B1); PG8_BAR; PG8_SCHED;
        }
        if constexpr (ALIGN_EPI) { if (wr == 0) PG8_BAR; }
        { int ln_; asm volatile("v_mbcnt_lo_u32_b32 %0, -1, 0\n\tv_mbcnt_hi_u32_b32 %0, -1, %0" : "=v"(ln_)); E(acc, cur, wr, wc, ln_ & 15, ln_ >> 4); }
        if (!has_next) break;
#pragma unroll
        for (int a = 0; a < 2; ++a)
#pragma unroll
            for (int b = 0; b < 2; ++b)
#pragma unroll
                for (int m = 0; m < 4; ++m)
#pragma unroll
                    for (int n = 0; n < 2; ++n) acc[a][b][m][n] = (f32x4){0.f, 0.f, 0.f, 0.f};
        cur = nxt; cA = nA; cB = nB; ++ui;
        { int t_; asm volatile("v_mbcnt_lo_u32_b32 %0, -1, 0\n\tv_mbcnt_hi_u32_b32 %0, -1, %0" : "=v"(t_)); t_ |= wid << 6; int R, C; stage_rc(t_ * 16, R, C); const int Rb = Epi::PERM ? ((R & ~31) + perm32(R & 31)) : R;
          voffA[0] = FP8 ? (unsigned)(R * g.lda + 2 * C) : (unsigned)(R * g.lda + C) * 2u; voffB[0] = FP8 ? (unsigned)(Rb * K + 2 * C) : (unsigned)(Rb * K + C) * 2u; }
        if constexpr (ALIGN_EPI) { if (wr == 1) PG8_BAR; }
    }
    PG8_WAIT_V(0);
    if constexpr (!ALIGN_EPI) { if (wr == 0) PG8_BAR; }
    PG8_BAR;
#undef PG8_SA
#undef PG8_SB
#undef PG8_STAGE
#undef PG8_LDA
#undef PG8_LDB
#undef PG8_MMA
#undef PG8_WAIT_V
#undef PG8_WAIT_L
#undef PG8_BAR
#undef PG8_SCHED
}
}
#define XB_TMO      128
#define XB_XCNT(j)  (256  + 64 * (j))
#define XB_XSUB(j)  (1280 + 64 * (j))
#define XB_XGEN(j)  (2304 + 64 * (j))
#define XB_TOP      3328
#define XB_TOPGEN   3392
#define XCD_BAR_WORDS 3456
#define XB_SPIN_CAP (1u << 18)

__device__ __forceinline__ unsigned xb_ld(unsigned* p)              { return __hip_atomic_load(p, __ATOMIC_RELAXED, __HIP_MEMORY_SCOPE_AGENT); }
__device__ __forceinline__ unsigned xb_add(unsigned* p, unsigned v) { return __hip_atomic_fetch_add(p, v, __ATOMIC_RELAXED, __HIP_MEMORY_SCOPE_AGENT); }
__device__ __forceinline__ unsigned xb_xcc_id() { return (unsigned)__builtin_amdgcn_s_getreg((3 << 11) | 20) & 0xFu; }
#define XB_SPIN(cond, bar) do { unsigned _sp = 0; while (cond) { __builtin_amdgcn_s_sleep(1); \
    if ((++_sp & 255u) == 0u) { if (xb_ld(&(bar)[XB_TMO])) break; if (_sp > XB_SPIN_CAP) { atomicAdd(&(bar)[XB_TMO], 1u); break; } } } } while (0)

struct XcdBarrier {
    unsigned* bar; unsigned x;
    volatile LAS unsigned* st;
};

__device__ __forceinline__ XcdBarrier xcd_barrier_post(unsigned* bar, volatile LAS unsigned* st) {
    XcdBarrier b; b.bar = bar; b.x = xb_xcc_id(); b.st = st;
    if (threadIdx.x == 0) (void)xb_add(&bar[XB_XCNT(b.x)], 1u);
    return b;
}
__device__ __forceinline__ void xcd_barrier_complete(unsigned* bar, unsigned x, unsigned& nloc, unsigned& nx) {
    const unsigned G = gridDim.x * gridDim.y * gridDim.z;
    unsigned sum, cnt, mine, sp = 0u;
    for (;;) {
        sum = 0u; cnt = 0u; mine = 0u;
#pragma unroll
        for (unsigned j = 0; j < 16; ++j) { const unsigned c = xb_ld(&bar[XB_XCNT(j)]); sum += c; cnt += (c > 0u) ? 1u : 0u; mine = (j == x) ? c : mine; }
        if (sum == G) break;
        __builtin_amdgcn_s_sleep(1);
        if ((++sp & 255u) == 0u) { if (xb_ld(&bar[XB_TMO])) break; if (sp > XB_SPIN_CAP) { atomicAdd(&bar[XB_TMO], 1u); break; } }
    }
    nloc = mine > 0u ? mine : 1u; nx = cnt > 0u ? cnt : 1u;
}

__device__ __forceinline__ void xcd_barrier(const XcdBarrier& b) {
    asm volatile("s_waitcnt vmcnt(0)" ::: "memory");
    __syncthreads();
    if (threadIdx.x == 0) {
        unsigned* bar = b.bar;
        __builtin_amdgcn_s_waitcnt(0);
        unsigned nloc = b.st[0], nx = b.st[1];
        if (nloc == 0u) { xcd_barrier_complete(bar, b.x, nloc, nx); b.st[0] = nloc; b.st[1] = nx; }
        const unsigned old = xb_add(&bar[XB_XSUB(b.x)], 1u);
        const unsigned gen = old / nloc;
        if (old + 1u == (gen + 1u) * nloc) {
            __builtin_amdgcn_fence(__ATOMIC_RELEASE, "agent");
            asm volatile("s_waitcnt vmcnt(0)" ::: "memory");
            const unsigned og = xb_add(&bar[XB_TOP], 1u);
            const unsigned tg = og / nx;
            if (og + 1u == (tg + 1u) * nx) xb_add(&bar[XB_TOPGEN], 1u);
            else XB_SPIN(xb_ld(&bar[XB_TOPGEN]) == tg, bar);
            __builtin_amdgcn_fence(__ATOMIC_ACQUIRE, "agent");
            xb_add(&bar[XB_XGEN(b.x)], 1u);
            asm volatile("s_waitcnt vmcnt(0)" ::: "memory");
        } else {
            XB_SPIN(xb_ld(&bar[XB_XGEN(b.x)]) == gen, bar);
            __builtin_amdgcn_fence(__ATOMIC_ACQUIRE, "agent");
            asm volatile("s_waitcnt vmcnt(0)" ::: "memory");
        }
    }
    __syncthreads();
}

constexpr int NWAVES = 8, NTHR = 512;
constexpr int D = 1024, BATCH = 2, SEQ = 16384, NMETA = 16;
constexpr int MMAIN = BATCH * SEQ;
constexpr int MROWS = MMAIN + NMETA;
constexpr int MPAD = MMAIN + 256;
constexpr int RGW = 1344, RGBW = 168, NRG = 2816  , KRGO = 1408  , NGT = 4096, KGT = 256, XCW = 2048;
constexpr int FF = 3584, NE = 8, NFF2 = 2 * FF;
constexpr int GH = 4, GDK = 128, GDV = 256, GQK = 512, GVD = 1024, NGLA = 3072, GLAW = 3088, GRANK = 16;
constexpr int MSORT = 265 * 256;
constexpr float LN_EPS = 1e-5f, ALPHA = 1.6817928305074290f;
constexpr int SEG = 128, NSEG_B = SEQ / SEG, NSEG = 1 + BATCH * NSEG_B;
constexpr int CPS = 8, NSC_BH = SEQ / (64 * CPS), NGU = BATCH * GH * NSC_BH + GH;

constexpr size_t MiB = 1u << 20;
constexpr size_t WS_CTL = 0, CTL_ZERO_BYTES = 1 * MiB;
constexpr size_t WL_RGIN = 0, WL_GATES = WL_RGIN + (size_t)NRG * D * 2, WL_RGOUT = WL_GATES + (size_t)NGT * KGT * 2, WL_GLAIN = WL_RGOUT + (size_t)D * KRGO * 2,
                 WL_GLAOUT = WL_GLAIN + (size_t)NGLA * D * 2, WL_FFNIN = WL_GLAOUT + (size_t)D * D * 2, WL_FFNOUT = WL_FFNIN + (size_t)NFF2 * D * 2,
                 WL_MOEIN = WL_FFNOUT + (size_t)D * FF * 2, WL_MOEOUT = WL_MOEIN + (size_t)NE * NFF2 * D * 2, WL_STRIDE = WL_MOEOUT + (size_t)NE * D * FF * 2;
constexpr size_t WS_W = 1 * MiB;
constexpr size_t WS_H = WS_W + 2 * WL_STRIDE;
constexpr size_t WS_HB = WS_H + (size_t)MPAD * D * 4;
constexpr size_t WS_MIX = WS_HB + (size_t)MPAD * D * 2;
constexpr size_t WS_Z = WS_MIX + (size_t)MPAD * D * 4;
constexpr size_t WS_RT = WS_Z + 3 * MiB;
constexpr size_t WS_AGG = WS_RT + 1 * MiB;
constexpr size_t WS_S0 = WS_AGG + 3 * MiB;
constexpr size_t S_PROJ = 0, S_XC = S_PROJ + (size_t)MPAD * NRG * 2, S_LOGA = S_XC + (size_t)MPAD * XCW * 2, S_U = S_LOGA + (size_t)MPAD * RGW * 4, S_Y = S_U + (size_t)MPAD * RGW * 4, S_RG_END = S_Y + (size_t)MPAD * KRGO * 2;
constexpr size_t S_HID = 0;
constexpr size_t S_QKVR = 0, S_KVS = S_QKVR + (size_t)MPAD * NGLA * 2, S_SST = S_KVS + (size_t)NGU * GDK * GDV * 4, S_O = S_SST + (size_t)NGU * GDK * GDV * 4, S_DEC = S_O + (size_t)MPAD * D * 2, S_XB = S_DEC + 1 * MiB, S_EMF = S_XB + (size_t)(BATCH * GH * (SEQ / 64) + GH) * 64 * GDK * 4, S_GLA_END = S_EMF + 3 * MiB;
constexpr size_t S_AS = 0, S_HS = S_AS + (size_t)MSORT * D * 2, S_YS = S_HS + (size_t)MSORT * FF * 2, S_MOE_END = S_YS + (size_t)MSORT * D * 4;
constexpr size_t S_MAX = S_RG_END > S_MOE_END ? (S_RG_END > S_GLA_END ? S_RG_END : S_GLA_END) : (S_MOE_END > S_GLA_END ? S_MOE_END : S_GLA_END);
constexpr size_t WS_END = WS_S0 + S_MAX;
constexpr int CW_TMO = 0, CW_BAR = 4096, CW_MOE = 8192;

constexpr int LDS_BYTES = 163840, MISC_OFF = LDS_BYTES - 64;

struct Frame {
    LAS unsigned char* lds; gu32* ctl; unsigned char* ws;
    int tid, lane, wave, G, bx; unsigned long long dbg_acc;
    __device__ __forceinline__ void fresh() { asm volatile("" : "+s"(wave)); asm volatile("" : "+s"(bx)); asm volatile("" : "+s"(ws));
        asm volatile("v_mbcnt_lo_u32_b32 %0, -1, 0\n\tv_mbcnt_hi_u32_b32 %0, -1, %0" : "=v"(lane));
        tid = (wave << 6) | lane; ctl = (gu32*)(ws + WS_CTL); }
};
struct Args { const float* in[21]; float* out; unsigned char* ws; int ph_lo, ph_hi; unsigned submask; int pad; };

struct EpiBf16Gelu {
    static constexpr bool PERM = true, PAIR = false;
    bf16* O; int ldc, gelu_cols; float sc = 1.0f;
    __device__ __forceinline__ void operator()(const f32x4 (&acc)[2][2][4][2], const pg8::Unit& u, int wr, int wc, int fr, int fq) const {
        const int row0 = u.pm * 256 + wr * 64 + fr, col0 = u.pn * 256 + wc * 32 + 8 * fq;
        float scl = sc; asm volatile("" : "+v"(scl));
#pragma unroll
        for (int ai = 0; ai < 2; ++ai)
#pragma unroll
            for (int m = 0; m < 4; ++m) { bf16* rowp = O + (size_t)(row0 + ai * 128 + m * 16) * ldc + col0;
#pragma unroll
                for (int bj = 0; bj < 2; ++bj) { f32x4 v0 = acc[ai][bj][m][0] * scl, v1 = acc[ai][bj][m][1] * scl;
                    if (col0 + bj * 128 < gelu_cols) {
#pragma unroll
                        for (int j = 0; j < 4; ++j) { v0[j] = gelu_tanh_f(v0[j]); v1[j] = gelu_tanh_f(v1[j]); } }
                    v4u w; w.x = cvt_pk_bf16(v0[0], v0[1]); w.y = cvt_pk_bf16(v0[2], v0[3]); w.z = cvt_pk_bf16(v1[0], v1[1]); w.w = cvt_pk_bf16(v1[2], v1[3]);
                    *(v4u*)(rowp + bj * 128) = w; } }
    }
    __device__ __forceinline__ void meta_task(int task, int& r0, int& aoff) const { r0 = task * 16; aoff = 0; }
    __device__ __forceinline__ void meta(int task, f32x4 a0, f32x4, int fr, int fq) const {
        const int col = task * 16 + 4 * fq;
        if (col < gelu_cols) {
#pragma unroll
            for (int j = 0; j < 4; ++j) a0[j] = gelu_tanh_f(a0[j]); }
        v2u w; w.x = cvt_pk_bf16(a0[0], a0[1]); w.y = cvt_pk_bf16(a0[2], a0[3]);
        *(v2u*)(O + (size_t)(MMAIN + fr) * ldc + col) = w;
    }
};
struct EpiSwiglu {
    static constexpr bool PERM = true, PAIR = true;
    bf16* O; int ldc; float sc;
    __device__ __forceinline__ void operator()(const f32x4 (&acc)[2][2][4][2], const pg8::Unit& u, int wr, int wc, int fr, int fq) const {
        const int row0 = u.pm * 256 + wr * 64 + fr, col0 = u.pn * 128 + wc * 32 + 8 * fq;
        float scl = sc; asm volatile("" : "+v"(scl));
#pragma unroll
        for (int ai = 0; ai < 2; ++ai)
#pragma unroll
            for (int m = 0; m < 4; ++m) { bf16* rowp = O + (size_t)(row0 + ai * 128 + m * 16) * ldc + col0;
                f32x4 g0 = acc[ai][0][m][0] * scl, g1 = acc[ai][0][m][1] * scl; const f32x4 u0 = acc[ai][1][m][0] * scl, u1 = acc[ai][1][m][1] * scl;
#pragma unroll
                for (int j = 0; j < 4; ++j) { g0[j] = silu_f(g0[j]) * u0[j]; g1[j] = silu_f(g1[j]) * u1[j]; }
                v4u w; w.x = cvt_pk_bf16(g0[0], g0[1]); w.y = cvt_pk_bf16(g0[2], g0[3]); w.z = cvt_pk_bf16(g1[0], g1[1]); w.w = cvt_pk_bf16(g1[2], g1[3]);
                *(v4u*)rowp = w; }
    }
    __device__ __forceinline__ void meta_task(int task, int& r0, int& aoff) const { r0 = (task >> 3) * 256 + (task & 7) * 16; aoff = 0; }
    __device__ __forceinline__ void meta(int task, f32x4 a0, f32x4 a1, int fr, int fq) const {
        const int col = (task >> 3) * 128 + (task & 7) * 16 + 4 * fq;
#pragma unroll
        for (int j = 0; j < 4; ++j) a0[j] = silu_f(a0[j] * sc) * (a1[j] * sc);
        v2u w; w.x = cvt_pk_bf16(a0[0], a0[1]); w.y = cvt_pk_bf16(a0[2], a0[3]);
        *(v2u*)(O + (size_t)(MMAIN + fr) * ldc + col) = w;
    }
};
struct EpiSwigluF8 {
    static constexpr bool PERM = true, PAIR = true;
    unsigned char* O; int ldc; float sc, osc;
    __device__ __forceinline__ void operator()(const f32x4 (&acc)[2][2][4][2], const pg8::Unit& u, int wr, int wc, int fr, int fq) const {
        const int row0 = u.pm * 256 + wr * 64 + fr, col0 = u.pn * 128 + wc * 32 + 8 * fq;
        float scl = sc, oscl = osc; asm volatile("" : "+v"(scl), "+v"(oscl));
#pragma unroll
        for (int ai = 0; ai < 2; ++ai)
#pragma unroll
            for (int m = 0; m < 4; ++m) { unsigned char* rowp = O + (size_t)(row0 + ai * 128 + m * 16) * ldc + col0;
                f32x4 g0 = acc[ai][0][m][0] * scl, g1 = acc[ai][0][m][1] * scl; const f32x4 u0 = acc[ai][1][m][0] * scl, u1 = acc[ai][1][m][1] * scl;
#pragma unroll
                for (int j = 0; j < 4; ++j) { g0[j] = silu_f(g0[j]) * u0[j] * oscl; g1[j] = silu_f(g1[j]) * u1[j] * oscl; }
                *(v2u*)rowp = (v2u){pk4_fp8(g0[0], g0[1], g0[2], g0[3]), pk4_fp8(g1[0], g1[1], g1[2], g1[3])}; }
    }
};
struct EpiF32 {
    static constexpr bool PERM = false, PAIR = false;
    float* C; int ldc;
    __device__ __forceinline__ void operator()(const f32x4 (&acc)[2][2][4][2], const pg8::Unit& u, int wr, int wc, int fr, int fq) const {
        const int row0 = u.pm * 256 + wr * 64 + fr, col0 = u.pn * 256 + wc * 32 + 4 * fq;
#pragma unroll
        for (int ai = 0; ai < 2; ++ai)
#pragma unroll
            for (int m = 0; m < 4; ++m) { float* rowp = C + (size_t)(row0 + ai * 128 + m * 16) * ldc + col0;
#pragma unroll
                for (int bj = 0; bj < 2; ++bj)
#pragma unroll
                    for (int n = 0; n < 2; ++n) *(f32x4*)(rowp + bj * 128 + n * 16) = acc[ai][bj][m][n]; }
    }
    __device__ __forceinline__ void meta_task(int task, int& r0, int& aoff) const { r0 = task * 16; aoff = 0; }
    __device__ __forceinline__ void meta(int task, f32x4 a0, f32x4, int fr, int fq) const { *(f32x4*)(C + (size_t)(MMAIN + fr) * ldc + task * 16 + 4 * fq) = a0; }
};

template <class Epi>
__device__ __forceinline__ void meta_gemm(Frame& F, const bf16* A16, int lda, int K, const bf16* Bt, int ntasks, const Epi& E) {
    const int fr = F.lane & 15, fq = F.lane >> 4;
    LAS f32x4* red = (LAS f32x4*)F.lds;
    for (int task = F.bx; task < ntasks; task += F.G) {
        int r0, aoff; E.meta_task(task, r0, aoff);
        f32x4 acc0 = (f32x4){0.f, 0.f, 0.f, 0.f}, acc1 = acc0;
        const bf16* ap = A16 + (size_t)fr * lda + aoff + fq * 8; const bf16* bp0 = Bt + (size_t)(r0 + fr) * K + fq * 8; const bf16* bp1 = bp0 + (size_t)128 * K;
        for (int ks = F.wave; ks < K / 32; ks += NWAVES) {
            const bf16x8 a = *(const bf16x8*)(ap + ks * 32); const bf16x8 b0 = *(const bf16x8*)(bp0 + ks * 32);
            acc0 = __builtin_amdgcn_mfma_f32_16x16x32_bf16(b0, a, acc0, 0, 0, 0);
            if (Epi::PAIR) { const bf16x8 b1 = *(const bf16x8*)(bp1 + ks * 32); acc1 = __builtin_amdgcn_mfma_f32_16x16x32_bf16(b1, a, acc1, 0, 0, 0); }
        }
        red[(F.wave * 2 + 0) * 64 + F.lane] = acc0; if (Epi::PAIR) red[(F.wave * 2 + 1) * 64 + F.lane] = acc1;
        __syncthreads();
        if (F.wave == 0) {
            f32x4 s0 = red[F.lane], s1 = Epi::PAIR ? red[64 + F.lane] : acc1;
#pragma unroll
            for (int w = 1; w < NWAVES; ++w) { s0 += red[(w * 2) * 64 + F.lane]; if (Epi::PAIR) s1 += red[(w * 2 + 1) * 64 + F.lane]; }
            E.meta(task, s0, s1, fr, fq);
        }
        __syncthreads();
    }
}

__device__ __forceinline__ void transpose_item(const float* W, int ldw, int Ksrc, int c0, int nvalid, bf16* WT, int Kdst, int n0, int k0, LAS float* scr, int lane) {
#pragma unroll 8
    for (int i = 0; i < 32; ++i) { const int kk = 2 * i + (lane >> 5), c = lane & 31;
        const bool ok = (k0 + kk < Ksrc) && (c < nvalid); const float v = W[ok ? (size_t)(k0 + kk) * ldw + c0 + c : (size_t)0];
        scr[kk * 33 + c] = ok ? v : 0.f; }
    LDS_WAIT(); asm volatile("" ::: "memory");
    const int c = lane & 7;
#pragma unroll
    for (int j = 0; j < 4; ++j) { const int n = (lane >> 3) + 8 * j; const LAS float* s = scr + (8 * c) * 33 + n;
        v4u o; o.x = pk2(s[0 * 33], s[1 * 33]); o.y = pk2(s[2 * 33], s[3 * 33]); o.z = pk2(s[4 * 33], s[5 * 33]); o.w = pk2(s[6 * 33], s[7 * 33]);
        *(v4u*)(WT + (size_t)(n0 + n) * Kdst + k0 + 8 * c) = o; }
    LDS_WAIT(); asm volatile("" ::: "memory");
}
__device__ __forceinline__ void transpose_item_fp8(const float* W, int ldw, int Ksrc, int c0, int nvalid, unsigned char* WT, int Kdst, int n0, int k0, float scale, LAS float* scr, int lane) {
#pragma unroll 8
    for (int i = 0; i < 32; ++i) { const int kk = 2 * i + (lane >> 5), c = lane & 31;
        const bool ok = (k0 + kk < Ksrc) && (c < nvalid); const float v = W[ok ? (size_t)(k0 + kk) * ldw + c0 + c : (size_t)0];
        scr[kk * 33 + c] = ok ? v * scale : 0.f; }
    LDS_WAIT(); asm volatile("" ::: "memory");
    const int c4 = lane & 3;
#pragma unroll
    for (int j = 0; j < 2; ++j) { const int n = (lane >> 2) + 16 * j; const LAS float* sp = scr + (16 * c4) * 33 + n;
        v4u o; o.x = pk4_fp8(sp[0 * 33], sp[1 * 33], sp[2 * 33], sp[3 * 33]); o.y = pk4_fp8(sp[4 * 33], sp[5 * 33], sp[6 * 33], sp[7 * 33]);
        o.z = pk4_fp8(sp[8 * 33], sp[9 * 33], sp[10 * 33], sp[11 * 33]); o.w = pk4_fp8(sp[12 * 33], sp[13 * 33], sp[14 * 33], sp[15 * 33]);
        *(v4u*)(WT + (size_t)(n0 + n) * Kdst + k0 + 16 * c4) = o; }
    LDS_WAIT(); asm volatile("" ::: "memory");
}
__device__ __forceinline__ void map_id(int n0, int nsrc, int& c0, int& nv) { c0 = n0; nv = nsrc - n0; nv = nv < 0 ? 0 : (nv > 32 ? 32 : nv); if (nv == 0) c0 = 0; }
__device__ __forceinline__ void map_swiglu(int n0, int& c0, int& nv) { const int tile = n0 >> 8, rr = n0 & 255; c0 = rr < 128 ? tile * 128 + rr : FF + tile * 128 + rr - 128; nv = 32; }

__device__ __forceinline__ void p0_prologue(Frame& F, const Args& a) {
    LAS float* scr = (LAS float*)(F.lds + F.wave * 16384);
    const int gw = F.bx * NWAVES + F.wave, NGW = F.G * NWAVES;
    constexpr int I_RGIN = (D / 64) * (NRG / 32), I_GATES = (KGT / 64) * (NGT / 32), I_RGOUT = (KRGO / 64) * (D / 32), I_GLAIN = (D / 64) * (NGLA / 32), I_GLAOUT = (D / 64) * (D / 32),
                  I_FFNIN = (D / 64) * (NFF2 / 32), I_FFNOUT = (FF / 64) * (D / 32), I_MOEIN = NE * I_FFNIN, I_MOEOUT = NE * I_FFNOUT;
    constexpr int I_PER_J = I_RGIN + I_GATES + I_RGOUT + I_GLAIN + I_GLAOUT + I_FFNIN + I_FFNOUT + I_MOEIN + I_MOEOUT;
    for (int it = gw; it < 2 * I_PER_J; it += NGW) {
        const int j = it / I_PER_J; int r = it - j * I_PER_J;
        unsigned char* wl = F.ws + WS_W + (size_t)j * WL_STRIDE;
        int c0, nv;
        if (r < I_RGIN) { const int nb = r % (NRG / 32), kb = r / (NRG / 32); map_id(nb * 32, 2 * RGW, c0, nv);
            transpose_item(a.in[4] + (size_t)j * D * 2 * RGW, 2 * RGW, D, c0, nv, (bf16*)(wl + WL_RGIN), D, nb * 32, kb * 64, scr, F.lane); continue; } r -= I_RGIN;
        if (r < I_GATES) { const int nb = r % (NGT / 32), kb = r / (NGT / 32); const int n0 = nb * 32, pn = n0 >> 8, rr = n0 & 255, g = rr >> 7, cc = rr & 127, d0 = (pn & 1) * 128 + cc, blk = pn >> 1;
            nv = RGBW - d0; nv = nv < 0 ? 0 : (nv > 32 ? 32 : nv); c0 = nv ? d0 : 0;
            transpose_item(a.in[7] + ((size_t)(j * 2 + g) * 8 + blk) * RGBW * RGBW, RGBW, RGBW, c0, nv, (bf16*)(wl + WL_GATES), KGT, n0, kb * 64, scr, F.lane); continue; } r -= I_GATES;
        if (r < I_RGOUT) { const int nb = r % (D / 32), kb = r / (D / 32);
            transpose_item(a.in[10] + (size_t)j * RGW * D, D, RGW, nb * 32, 32, (bf16*)(wl + WL_RGOUT), KRGO, nb * 32, kb * 64, scr, F.lane); continue; } r -= I_RGOUT;
        if (r < I_GLAIN) { const int nb = r % (NGLA / 32), kb = r / (NGLA / 32);
            transpose_item(a.in[11] + (size_t)j * D * GLAW, GLAW, D, nb * 32, 32, (bf16*)(wl + WL_GLAIN), D, nb * 32, kb * 64, scr, F.lane); continue; } r -= I_GLAIN;
        if (r < I_GLAOUT) { const int nb = r % (D / 32), kb = r / (D / 32);
            transpose_item(a.in[15] + (size_t)j * D * D, D, D, nb * 32, 32, (bf16*)(wl + WL_GLAOUT), D, nb * 32, kb * 64, scr, F.lane); continue; } r -= I_GLAOUT;
        if (r < I_FFNIN) { const int nb = r % (NFF2 / 32), kb = r / (NFF2 / 32); map_swiglu(nb * 32, c0, nv);
            transpose_item(a.in[16] + (size_t)j * D * NFF2, NFF2, D, c0, nv, (bf16*)(wl + WL_FFNIN), D, nb * 32, kb * 64, scr, F.lane); continue; } r -= I_FFNIN;
        if (r < I_FFNOUT) { const int nb = r % (D / 32), kb = r / (D / 32);
            transpose_item(a.in[17] + (size_t)j * FF * D, D, FF, nb * 32, 32, (bf16*)(wl + WL_FFNOUT), FF, nb * 32, kb * 64, scr, F.lane); continue; } r -= I_FFNOUT;
        if (r < I_MOEIN) { const int e = r / I_FFNIN, r2 = r % I_FFNIN; const int nb = r2 % (NFF2 / 32), kb = r2 / (NFF2 / 32); map_swiglu(nb * 32, c0, nv);
            transpose_item_fp8(a.in[19] + ((size_t)j * NE + e) * D * NFF2, NFF2, D, c0, nv, (unsigned char*)(wl + WL_MOEIN) + (size_t)e * NFF2 * D, D, nb * 32, kb * 64, 64.0f, scr, F.lane); continue; } r -= I_MOEIN;
        { const int e = r / I_FFNOUT, r2 = r % I_FFNOUT; const int nb = r2 % (D / 32), kb = r2 / (D / 32);
            transpose_item_fp8(a.in[20] + ((size_t)j * NE + e) * FF * D, D, FF, nb * 32, 32, (unsigned char*)(wl + WL_MOEOUT) + (size_t)e * D * FF, FF, nb * 32, kb * 64, 256.0f, scr, F.lane); }
    }
    bf16* HB = (bf16*)(F.ws + WS_HB);
    for (int m = gw; m < MROWS; m += NGW) {
        const float* src = m < MMAIN ? a.in[0] + (size_t)m * D : a.in[1] + (size_t)(m - MMAIN) * D;
#pragma unroll
        for (int q = 0; q < 4; ++q) { const f32x4 v = *(const f32x4*)(src + 4 * F.lane + 256 * q);
            v2u w; w.x = pk2(v[0], v[1]); w.y = pk2(v[2], v[3]); *(v2u*)(HB + (size_t)m * D + 4 * F.lane + 256 * q) = w; }
    }
}

struct LnRow { v4u h[2], a[2], b[2]; float w1, w2; };
__device__ __forceinline__ void unpack8(const v4u& w, float* o) { o[0] = bflo(w.x); o[1] = bfhi(w.x); o[2] = bflo(w.y); o[3] = bfhi(w.y); o[4] = bflo(w.z); o[5] = bfhi(w.z); o[6] = bflo(w.w); o[7] = bfhi(w.w); }
__device__ __forceinline__ void ln_phase(Frame& F, int mixkind, const float* gam, const float* bet, int extra, const float* Wx, int ldx, float* outp, gu32* moe_cnt) {
    bf16* HB = (bf16*)(F.ws + WS_HB); const bf16* MIX = (const bf16*)(F.ws + WS_MIX);
    const bf16* YS = (const bf16*)(F.ws + WS_S0 + S_YS);
    int* E1 = (int*)(F.ws + WS_RT); int* E2 = E1 + MROWS; float* W1 = (float*)(E2 + MROWS); float* W2 = W1 + MROWS; int* POS1 = (int*)(W2 + MROWS); int* POS2 = POS1 + MROWS;
    float* Z = (float*)(F.ws + WS_Z);
    LAS float* WL = (LAS float*)F.lds;
    LAS unsigned* lcnt = (LAS unsigned*)(F.lds + 65536);
    const int NC = extra == 1 ? 16 : (extra == 2 ? 8 : 0);
    if (extra) { for (int i = F.tid; i < NC * D; i += NTHR) { const int c = i / NC, e = i - c * NC; WL[e * D + c] = Wx[(size_t)c * ldx + e]; }
        if (F.tid < 8) lcnt[F.tid] = 0u;
        __syncthreads(); }
    const int gw = F.bx * NWAVES + F.wave, NGW = F.G * NWAVES, lane = F.lane;
    float gv[16], bv[16];
#pragma unroll
    for (int q = 0; q < 2; ++q)
#pragma unroll
        for (int t = 0; t < 2; ++t) { const f32x4 g4 = *(const f32x4*)(gam + 512 * q + 8 * lane + 4 * t), b4 = *(const f32x4*)(bet + 512 * q + 8 * lane + 4 * t);
#pragma unroll
            for (int k = 0; k < 4; ++k) { gv[8 * q + 4 * t + k] = g4[k]; bv[8 * q + 4 * t + k] = b4[k]; } }
    unsigned mycnt = 0u;
    auto ln_load = [&](LnRow (&R)[2], int m0) {
#pragma unroll
        for (int r = 0; r < 2; ++r) { const int m = m0 + r * NGW; if (m < MROWS) {
            const bf16* hp = HB + (size_t)m * D + 8 * lane; R[r].h[0] = *(const v4u*)hp; R[r].h[1] = *(const v4u*)(hp + 512);
            if (mixkind == 1) { const bf16* mp = MIX + (size_t)m * D + 8 * lane; R[r].a[0] = *(const v4u*)mp; R[r].a[1] = *(const v4u*)(mp + 512); }
            if (mixkind == 2) { R[r].w1 = W1[m]; R[r].w2 = W2[m]; const bf16* y1 = YS + (size_t)POS1[m] * D + 8 * lane; const bf16* y2 = YS + (size_t)POS2[m] * D + 8 * lane;
                R[r].a[0] = *(const v4u*)y1; R[r].a[1] = *(const v4u*)(y1 + 512); R[r].b[0] = *(const v4u*)y2; R[r].b[1] = *(const v4u*)(y2 + 512); } } }
    };
    LnRow Rn[2];
    ln_load(Rn, gw);
    for (int m0 = gw; m0 < MROWS; m0 += 2 * NGW) {
        LnRow R[2];
#pragma unroll
        for (int r = 0; r < 2; ++r) R[r] = Rn[r];
        ln_load(Rn, m0 + 2 * NGW);
#pragma unroll
        for (int r = 0; r < 2; ++r) { const int m = m0 + r * NGW; if (m < MROWS) {
            float v[16]; unpack8(R[r].h[0], v); unpack8(R[r].h[1], v + 8);
#pragma unroll
            for (int k = 0; k < 16; ++k) v[k] *= ALPHA;
            if (mixkind == 1) { float t[16]; unpack8(R[r].a[0], t); unpack8(R[r].a[1], t + 8);
#pragma unroll
                for (int k = 0; k < 16; ++k) v[k] += t[k]; }
            if (mixkind == 2) { float t[16], u[16]; unpack8(R[r].a[0], t); unpack8(R[r].a[1], t + 8); unpack8(R[r].b[0], u); unpack8(R[r].b[1], u + 8);
#pragma unroll
                for (int k = 0; k < 16; ++k) v[k] += t[k] * R[r].w1 + u[k] * R[r].w2; }
            float s = 0.f;
#pragma unroll
            for (int k = 0; k < 16; ++k) s += v[k];
            const float mean = wave_sum(s, lane) * (1.f / D); float s2 = 0.f;
#pragma unroll
            for (int k = 0; k < 16; ++k) { v[k] -= mean; s2 += v[k] * v[k]; }
            const float rstd = __builtin_amdgcn_rsqf(wave_sum(s2, lane) * (1.f / D) + LN_EPS);
#pragma unroll
            for (int k = 0; k < 16; ++k) v[k] = v[k] * rstd * gv[k] + bv[k];
            bf16* op = HB + (size_t)m * D + 8 * lane;
            *(v4u*)op = (v4u){pk2(v[0], v[1]), pk2(v[2], v[3]), pk2(v[4], v[5]), pk2(v[6], v[7])}; *(v4u*)(op + 512) = (v4u){pk2(v[8], v[9]), pk2(v[10], v[11]), pk2(v[12], v[13]), pk2(v[14], v[15])};
            if (outp && m < MMAIN) { float* o = outp + (size_t)m * D + 8 * lane;
                *(f32x4*)o = (f32x4){v[0], v[1], v[2], v[3]}; *(f32x4*)(o + 4) = (f32x4){v[4], v[5], v[6], v[7]}; *(f32x4*)(o + 512) = (f32x4){v[8], v[9], v[10], v[11]}; *(f32x4*)(o + 516) = (f32x4){v[12], v[13], v[14], v[15]}; }
            if (extra) {
                float pp[16];
#pragma unroll
                for (int e = 0; e < 16; ++e) { pp[e] = 0.f; if (e < NC) { float p = 0.f;
#pragma unroll
                        for (int q = 0; q < 2; ++q) { const f32x4 w0 = *(const LAS f32x4*)(WL + e * D + 512 * q + 8 * lane), w1 = *(const LAS f32x4*)(WL + e * D + 512 * q + 8 * lane + 4);
                            p += (v[8 * q + 0] * w0[0] + v[8 * q + 1] * w0[1]) + (v[8 * q + 2] * w0[2] + v[8 * q + 3] * w0[3]) + (v[8 * q + 4] * w1[0] + v[8 * q + 5] * w1[1]) + (v[8 * q + 6] * w1[2] + v[8 * q + 7] * w1[3]); }
                        pp[e] = p; } }
                float lg[8]; float zv;
                if (extra == 1) {
#pragma unroll
                    for (int k = 0; k < 8; ++k) { const bool up = lane & 32; const float snd = up ? pp[k] : pp[k + 8], kp = up ? pp[k + 8] : pp[k]; pp[k] = kp + shx(snd, 32, lane); }
#pragma unroll
                    for (int k = 0; k < 4; ++k) { const bool up = lane & 16; const float snd = up ? pp[k] : pp[k + 4], kp = up ? pp[k + 4] : pp[k]; pp[k] = kp + shx(snd, 16, lane); }
#pragma unroll
                    for (int k = 0; k < 2; ++k) { const bool up = lane & 8; const float snd = up ? pp[k] : pp[k + 2], kp = up ? pp[k + 2] : pp[k]; pp[k] = kp + shx(snd, 8, lane); }
                    { const bool up = lane & 4; const float snd = up ? pp[0] : pp[1], kp = up ? pp[1] : pp[0]; zv = kp + shx(snd, 4, lane); }
                    zv += shx(zv, 2, lane); zv += shx(zv, 1, lane);
                } else {
#pragma unroll
                    for (int k = 0; k < 4; ++k) { const bool up = lane & 32; const float snd = up ? pp[k] : pp[k + 4], kp = up ? pp[k + 4] : pp[k]; pp[k] = kp + shx(snd, 32, lane); }
#pragma unroll
                    for (int k = 0; k < 2; ++k) { const bool up = lane & 16; const float snd = up ? pp[k] : pp[k + 2], kp = up ? pp[k + 2] : pp[k]; pp[k] = kp + shx(snd, 16, lane); }
                    float rv; { const bool up = lane & 8; const float snd = up ? pp[0] : pp[1], kp = up ? pp[1] : pp[0]; rv = kp + shx(snd, 8, lane); }
                    rv += shx(rv, 4, lane); rv += shx(rv, 2, lane); rv += shx(rv, 1, lane);
#pragma unroll
                    for (int e = 0; e < 8; ++e) lg[e] = __int_as_float(__builtin_amdgcn_readlane(__float_as_int(rv), ((e >> 2) & 1) * 32 + ((e >> 1) & 1) * 16 + (e & 1) * 8));
                }
                if (extra == 1) { if ((lane & 3) == 0) Z[(size_t)m * 16 + ((lane >> 5) & 1) * 8 + ((lane >> 4) & 1) * 4 + ((lane >> 3) & 1) * 2 + ((lane >> 2) & 1)] = zv; }
                else { int e1 = 0; float l1 = lg[0];
#pragma unroll
                    for (int e = 1; e < 8; ++e) if (lg[e] > l1) { l1 = lg[e]; e1 = e; }
                    int e2 = -1; float l2 = -3.0e38f;
#pragma unroll
                    for (int e = 0; e < 8; ++e) if (e != e1 && lg[e] > l2) { l2 = lg[e]; e2 = e; }
                    const float w2 = 1.f / (1.f + __expf(l1 - l2)), w1 = 1.f - w2;
                    if (lane == 0) { E1[m] = e1; E2[m] = e2; W1[m] = w1; W2[m] = w2; }
                    mycnt += (lane == e1 || lane == e2) ? 1u : 0u; }
            } } }
    }
    if (extra == 2) { if (lane < 8 && mycnt) __hip_atomic_fetch_add(&lcnt[lane], mycnt, __ATOMIC_RELAXED, __HIP_MEMORY_SCOPE_WORKGROUP);
        __syncthreads();
        if (F.tid < 8 && lcnt[F.tid]) __hip_atomic_fetch_add(moe_cnt + F.tid, lcnt[F.tid], RLX_AGENT); }
}

struct EpiGates {
    static constexpr bool PERM = true, PAIR = true;
    bf16* LOGA; bf16* U; const bf16* XC; const float* bg; const float* lam;
    __device__ __forceinline__ void chan4(int ch, f32x4& br, f32x4& bi, f32x4& c8) const {
        br = *(const f32x4*)(bg + ch); bi = *(const f32x4*)(bg + RGW + ch); const f32x4 lm = *(const f32x4*)(lam + ch);
#pragma unroll
        for (int t = 0; t < 4; ++t) { const float x = __expf(-lm[t]); c8[t] = -8.0f * (x * (1.0f - x * (0.5f - x * (0.33333333f - 0.25f * x)))); }
    }
    __device__ __forceinline__ void elem4(int row, int blk, int d, f32x4 ra, f32x4 ia, const f32x4& br, const f32x4& bi, const f32x4& c8) const {
        const int ch = blk * RGBW + d;
        const v2u xw = *(const v2u*)(XC + (size_t)row * XCW + blk * 256 + d);
        const float xc[4] = {bflo(xw.x), bfhi(xw.x), bflo(xw.y), bfhi(xw.y)};
        f32x4 la, uu;
#pragma unroll
        for (int t = 0; t < 4; ++t) {
            const float r = sigmoid_f(ra[t] + br[t]), ig = sigmoid_f(ia[t] + bi[t]);
            const float l = c8[t] * r;
            const float a2 = fast_exp(2.0f * l);
            la[t] = l; uu[t] = __builtin_amdgcn_sqrtf(fmaxf(1.0f - a2, 0.f)) * (ig * xc[t]);
        }
        *(v2u*)(LOGA + (size_t)row * RGW + ch) = (v2u){pk2(la[0], la[1]), pk2(la[2], la[3])}; *(v2u*)(U + (size_t)row * RGW + ch) = (v2u){pk2(uu[0], uu[1]), pk2(uu[2], uu[3])};
    }
    __device__ __forceinline__ void elem8(int row, int blk, int d, f32x4 ra0, f32x4 ia0, f32x4 ra1, f32x4 ia1, const f32x4 (&br)[2], const f32x4 (&bi)[2], const f32x4 (&c8)[2]) const {
        const int ch = blk * RGBW + d;
        const v4u xw = *(const v4u*)(XC + (size_t)row * XCW + blk * 256 + d);
        float xc[8]; unpack8(xw, xc);
        float la[8], uu[8];
#pragma unroll
        for (int t = 0; t < 8; ++t) {
            const float rav = t < 4 ? ra0[t & 3] : ra1[t & 3], iav = t < 4 ? ia0[t & 3] : ia1[t & 3];
            const float r = sigmoid_f(rav + br[t >> 2][t & 3]), ig = sigmoid_f(iav + bi[t >> 2][t & 3]);
            const float l = c8[t >> 2][t & 3] * r;
            const float a2 = fast_exp(2.0f * l);
            la[t] = l; uu[t] = __builtin_amdgcn_sqrtf(fmaxf(1.0f - a2, 0.f)) * (ig * xc[t]);
        }
        *(v4u*)(LOGA + (size_t)row * RGW + ch) = (v4u){pk2(la[0], la[1]), pk2(la[2], la[3]), pk2(la[4], la[5]), pk2(la[6], la[7])};
        *(v4u*)(U + (size_t)row * RGW + ch) = (v4u){pk2(uu[0], uu[1]), pk2(uu[2], uu[3]), pk2(uu[4], uu[5]), pk2(uu[6], uu[7])};
    }
    __device__ __forceinline__ void operator()(const f32x4 (&acc)[2][2][4][2], const pg8::Unit& u, int wr, int wc, int fr, int fq) const {
        const int row0 = u.pm * 256 + wr * 64 + fr, blk = u.pn >> 1, d0 = (u.pn & 1) * 128 + wc * 32 + 8 * fq;
        if (d0 < RGBW) {
            f32x4 br[2], bi[2], c8[2]; chan4(blk * RGBW + d0, br[0], bi[0], c8[0]); chan4(blk * RGBW + d0 + 4, br[1], bi[1], c8[1]);
#pragma unroll
            for (int ai = 0; ai < 2; ++ai)
#pragma unroll
                for (int m = 0; m < 4; ++m) elem8(row0 + ai * 128 + m * 16, blk, d0, acc[ai][0][m][0], acc[ai][1][m][0], acc[ai][0][m][1], acc[ai][1][m][1], br, bi, c8); }
    }
    __device__ __forceinline__ void meta_task(int task, int& r0, int& aoff) const { const int pn = task >> 3; r0 = pn * 256 + (task & 7) * 16; aoff = (pn >> 1) * 256; }
    __device__ __forceinline__ void meta(int task, f32x4 a0, f32x4 a1, int fr, int fq) const {
        const int pn = task >> 3, d = (pn & 1) * 128 + (task & 7) * 16 + 4 * fq;
        if (d < RGBW) { f32x4 br, bi, c8; chan4((pn >> 1) * RGBW + d, br, bi, c8); elem4(MMAIN + fr, pn >> 1, d, a0, a1, br, bi, c8); }
    }
};

__device__ __forceinline__ int conv_src_row(int row, int delta) {
    if (row < MMAIN) { const int t = row & (SEQ - 1); return (t - delta >= 0) ? row - delta : MMAIN + NMETA + (t - delta); }
    const int jm = row - MMAIN; return (jm - delta >= 0) ? row - delta : -1;
}
__device__ __forceinline__ void rg_conv_phase(Frame& F, const float* cw, const float* cb) {
    const bf16* PROJ = (const bf16*)(F.ws + WS_S0 + S_PROJ); bf16* XC = (bf16*)(F.ws + WS_S0 + S_XC);
    const int g = F.tid & 255, blk = g >> 5, kk = (g & 31) * 8, ch = blk * RGBW + kk;
    constexpr int NIT = (MROWS / 4) * 256;
    const int stride = F.G * NTHR;
    if (kk < RGBW) {
        float w[4][8], bb[8];
        { const f32x4 b0 = *(const f32x4*)(cb + ch), b1 = *(const f32x4*)(cb + ch + 4);
#pragma unroll
          for (int k = 0; k < 4; ++k) { bb[k] = b0[k]; bb[4 + k] = b1[k]; } }
#pragma unroll
        for (int tap = 0; tap < 4; ++tap) { const f32x4 w0 = *(const f32x4*)(cw + tap * RGW + ch), w1 = *(const f32x4*)(cw + tap * RGW + ch + 4);
#pragma unroll
            for (int k = 0; k < 4; ++k) { w[tap][k] = w0[k]; w[tap][4 + k] = w1[k]; } }
        for (int idx = F.bx * NTHR + F.tid; idx < NIT; idx += 2 * stride) {
            v4u x[2][7];
#pragma unroll
            for (int it = 0; it < 2; ++it) { const int id2 = idx + it * stride; if (id2 < NIT) { const int r0 = (id2 >> 8) * 4;
#pragma unroll
                for (int t = 0; t < 3; ++t) { const int rr = conv_src_row(r0, 3 - t); x[it][t] = (v4u){0u, 0u, 0u, 0u}; if (rr >= 0) x[it][t] = *(const v4u*)(PROJ + (size_t)rr * NRG + RGW + ch); }
#pragma unroll
                for (int t = 0; t < 4; ++t) x[it][3 + t] = *(const v4u*)(PROJ + (size_t)(r0 + t) * NRG + RGW + ch); } }
#pragma unroll
            for (int it = 0; it < 2; ++it) { const int id2 = idx + it * stride; if (id2 < NIT) { const int r0 = (id2 >> 8) * 4;
                bf16* xo = XC + (size_t)r0 * XCW + blk * 256 + kk;
                float xf[7][8];
#pragma unroll
                for (int t = 0; t < 7; ++t) unpack8(x[it][t], xf[t]);
#pragma unroll
                for (int i = 0; i < 4; ++i) { float a[8];
#pragma unroll
                    for (int k = 0; k < 8; ++k) a[k] = bb[k] + xf[i][k] * w[0][k] + xf[i + 1][k] * w[1][k] + xf[i + 2][k] * w[2][k] + xf[i + 3][k] * w[3][k];
                    *(v4u*)(xo + (size_t)i * XCW) = (v4u){pk2(a[0], a[1]), pk2(a[2], a[3]), pk2(a[4], a[5]), pk2(a[6], a[7])}; } } }
        }
    } else {
        for (int idx = F.bx * NTHR + F.tid; idx < NIT; idx += stride) { bf16* xo = XC + (size_t)((idx >> 8) * 4) * XCW + blk * 256 + kk;
#pragma unroll
            for (int i = 0; i < 4; ++i) *(v4u*)(xo + (size_t)i * XCW) = (v4u){0u, 0u, 0u, 0u}; }
    }
}
template <bool FIX>
__device__ __forceinline__ void rg_scan_phase(Frame& F) {
    const bf16* LOGA = (const bf16*)(F.ws + WS_S0 + S_LOGA); const bf16* U = (const bf16*)(F.ws + WS_S0 + S_U);
    const bf16* PROJ = (const bf16*)(F.ws + WS_S0 + S_PROJ); bf16* Y = (bf16*)(F.ws + WS_S0 + S_Y);
    float* AGGA = (float*)(F.ws + WS_AGG); float* AGGH = AGGA + (size_t)NSEG * RGW;
    const int gw = F.bx * NWAVES + F.wave, NGW = F.G * NWAVES;
    constexpr int NCG = 11, RB = FIX ? 16 : 32;
    for (int task = gw; task < NSEG * NCG; task += NGW) {
        const int seg = task / NCG, cg = task - seg * NCG, ch = cg * 128 + 2 * F.lane;
        const int row0 = seg == 0 ? MMAIN : (seg - 1) * SEG, nrows = seg == 0 ? NMETA : SEG;
        if (ch >= RGW) {
            if (FIX) for (int r = 0; r < nrows; ++r) *(unsigned*)(Y + (size_t)(row0 + r) * KRGO + ch) = 0u;
            continue;
        }
        float h0 = 0.f, h1 = 0.f, c0 = 0.f, c1 = 0.f;
        if (FIX && seg > 0) {
            { const f32x2 hm = *(const f32x2*)(AGGH + ch); h0 = hm[0]; h1 = hm[1]; }
            const int sb = 1 + ((seg - 1) / NSEG_B) * NSEG_B, ns = (seg - 1) % NSEG_B;
            for (int q = 0; q < ns; q += 8) { f32x2 aa[8], hh[8];
#pragma unroll
                for (int t = 0; t < 8; ++t) { const int qq = (q + t < ns) ? q + t : ns - 1; aa[t] = *(const f32x2*)(AGGA + (size_t)(sb + qq) * RGW + ch); hh[t] = *(const f32x2*)(AGGH + (size_t)(sb + qq) * RGW + ch); }
#pragma unroll
                for (int t = 0; t < 8; ++t) if (q + t < ns) { h0 = __expf(aa[t][0]) * h0 + hh[t][0]; h1 = __expf(aa[t][1]) * h1 + hh[t][1]; } }
        }
        for (int r = 0; r < nrows; r += RB) {
            unsigned la[RB], uu[RB], gt[RB];
#pragma unroll
            for (int t = 0; t < RB; ++t) { const int rr = row0 + ((r + t < nrows) ? r + t : nrows - 1); const size_t o = (size_t)rr * RGW + ch; la[t] = *(const unsigned*)(LOGA + o); uu[t] = *(const unsigned*)(U + o); if (FIX) gt[t] = *(const unsigned*)(PROJ + (size_t)rr * NRG + ch); }
#pragma unroll
            for (int t = 0; t < RB; ++t) if (r + t < nrows) { const float l0 = bflo(la[t]), l1 = bfhi(la[t]);
                h0 = __expf(l0) * h0 + bflo(uu[t]); h1 = __expf(l1) * h1 + bfhi(uu[t]); c0 += l0; c1 += l1;
                if (FIX) *(unsigned*)(Y + (size_t)(row0 + r + t) * KRGO + ch) = pk2(h0 * bflo(gt[t]), h1 * bfhi(gt[t])); }
        }
        if (!FIX) { *(f32x2*)(AGGA + (size_t)seg * RGW + ch) = (f32x2){c0, c1}; *(f32x2*)(AGGH + (size_t)seg * RGW + ch) = (f32x2){h0, h1}; }
    }
}

#define RG_PHASES \
        if (IN(pb + 0)) { if (on_rg) { \
            bf16* PROJ = (bf16*)(F.ws + WS_S0 + S_PROJ); EpiBf16Gelu E{PROJ, NRG, RGW}; \
            meta_gemm(F, HB + (size_t)MMAIN * D, D, D, (const bf16*)(wl + WL_RGIN), NRG / 16, E); \
            pg8::Gemm g{D, D}; pg8::DenseOrder S; S.init(HB, D, (const bf16*)(wl + WL_RGIN), D, MMAIN / 256, NRG / 256, F.G, F.bx); \
            pg8::gemm_phase<EpiBf16Gelu, pg8::DenseOrder>(F.lds, F.tid, g, S, E); } \
            SEAM(pb + 0); } \
        if (IN(pb + 1)) { if (on_rg) rg_conv_phase(F, args.in[5] + (size_t)j * 4 * RGW, args.in[6] + (size_t)j * RGW); SEAM(pb + 1); } \
        if (IN(pb + 2)) { if (on_rg) { \
            const bf16* XC = (const bf16*)(F.ws + WS_S0 + S_XC); \
            EpiGates E{(bf16*)(F.ws + WS_S0 + S_LOGA), (bf16*)(F.ws + WS_S0 + S_U), XC, args.in[8] + (size_t)j * 2 * RGW, args.in[9] + (size_t)j * RGW}; \
            meta_gemm(F, XC + (size_t)MMAIN * XCW, XCW, KGT, (const bf16*)(wl + WL_GATES), (NGT / 256) * 8, E); \
            pg8::Gemm g{KGT, XCW}; pg8::GatesOrder S; S.init(XC, XCW, (const bf16*)(wl + WL_GATES), KGT, MMAIN / 256, NGT / 256, F.G, F.bx); \
            pg8::gemm_phase<EpiGates, pg8::GatesOrder>(F.lds, F.tid, g, S, E); } \
            SEAM(pb + 2); } \
        if (IN(pb + 3)) { if (on_rg) rg_scan_phase<false>(F); SEAM(pb + 3); } \
        if (IN(pb + 4)) { if (on_rg) rg_scan_phase<true>(F); SEAM(pb + 4); } \
        if (IN(pb + 5)) { if (on_rg) { \
            const bf16* Y = (const bf16*)(F.ws + WS_S0 + S_Y); EpiBf16Gelu E{MIX, D, 0}; \
            meta_gemm(F, Y + (size_t)MMAIN * KRGO, KRGO, KRGO, (const bf16*)(wl + WL_RGOUT), D / 16, E); \
            pg8::Gemm g{KRGO, KRGO}; pg8::DenseOrder S; S.init(Y, KRGO, (const bf16*)(wl + WL_RGOUT), KRGO, MMAIN / 256, D / 256, F.G, F.bx); \
            pg8::gemm_phase<EpiBf16Gelu, pg8::DenseOrder>(F.lds, F.tid, g, S, E); } \
            SEAM(pb + 5); }

constexpr int GL_QT = 0, GL_KT = 17408  , GL_KTT = 34816, GL_VT = 53248, GL_ST = 90112  , GL_SM = 155648;
constexpr int QTS = 136, KTTS = 72, VTS = 72, PS = 72, BS = 129;
constexpr int GL_NG = GL_SM + 2048  , GL_WG = GL_NG + 1024  ;
static_assert(GL_WG + 4096 <= MISC_OFF, "GLA LDS map (unit constants)");
static_assert(GL_SM + 2560 <= MISC_OFF, "GLA LDS map");

#define GL_BAR() do { asm volatile("s_waitcnt lgkmcnt(0)" ::: "memory"); __builtin_amdgcn_s_barrier(); asm volatile("" ::: "memory"); __builtin_amdgcn_sched_barrier(0); } while (0)
template <int MODE>
__device__ __forceinline__ void gla_phase(Frame& F, const float* wgu, const float* bgate, const float* normg) {
    const bf16* QKVR = (const bf16*)(F.ws + WS_S0 + S_QKVR); const float* Z = (const float*)(F.ws + WS_Z);
    float* KVS = (float*)(F.ws + WS_S0 + S_KVS); const float* SST = (const float*)(F.ws + WS_S0 + S_SST); float* DEC = (float*)(F.ws + WS_S0 + S_DEC);
    bf16* O = (bf16*)(F.ws + WS_S0 + S_O);
    float* XB = (float*)(F.ws + WS_S0 + S_XB); float* EMF = (float*)(F.ws + WS_S0 + S_EMF);
    LAS bf16* QT = (LAS bf16*)(F.lds + GL_QT); LAS bf16* KT = (LAS bf16*)(F.lds + GL_KT); LAS bf16* PP = (LAS bf16*)(F.lds + GL_KT);
    LAS bf16* KTT = (LAS bf16*)(F.lds + GL_KTT); LAS bf16* VT = (LAS bf16*)(F.lds + GL_VT); LAS unsigned char* ST = F.lds + GL_ST;
    LAS float* Bc = (LAS float*)(F.lds + GL_ST); LAS float* ZC = (LAS float*)(F.lds + GL_ST + 36864); LAS float* TOT = (LAS float*)(F.lds + GL_ST + 40960); LAS float* OFFM = (LAS float*)(F.lds + GL_ST + 43520);
    LAS float* em = (LAS float*)(F.lds + GL_SM); LAS float* ef = em + 128; LAS float* stats = ef + 128;
    LAS float* NGL = (LAS float*)(F.lds + GL_NG); LAS bf16* WGL = (LAS bf16*)(F.lds + GL_WG);
    const int tid0 = F.tid;
#ifdef MK_GLA_SEG
    int glt_cur = -1; unsigned long long glt_t = 0ull;
#define GLT(n) do { if (MODE == (MK_GLA_MODE)) { const unsigned long long t_ = __builtin_amdgcn_s_memrealtime(); if (glt_cur == (MK_GLA_SEG)) F.dbg_acc += t_ - glt_t; glt_cur = (n); glt_t = t_; } } while (0)
#else
#define GLT(n)
#endif
    for (int u = F.bx; u < NGU; u += F.G) {
        const bool meta = u >= BATCH * GH * NSC_BH;
        const int h = meta ? u - BATCH * GH * NSC_BH : (u / NSC_BH) % GH, b = meta ? 0 : u / (GH * NSC_BH), sc = meta ? 0 : u % NSC_BH;
        const int nch = meta ? 1 : CPS;
        f32x4 sacc[8][2];
        int lofs = (4 * ((tid0 & 63) >> 4)) * GDV + 32 * (tid0 >> 6) + (tid0 & 15); asm volatile("" : "+v"(lofs));
#pragma unroll
        for (int dt = 0; dt < 8; ++dt)
#pragma unroll
            for (int i = 0; i < 2; ++i) {
                sacc[dt][i] = (f32x4){0.f, 0.f, 0.f, 0.f};
                if (MODE == 1 && !meta) {
#pragma unroll
                    for (int jj = 0; jj < 4; ++jj) sacc[dt][i][jj] = SST[(size_t)u * (GDK * GDV) + (size_t)((16 * dt + jj) * GDV + 16 * i) + lofs]; }
            }
        float dsum = 0.f;
        if (MODE == 1 && tid0 < 256) NGL[tid0] = normg[h * GDV + tid0];
        for (int i = tid0; i < 16 * GDK; i += NTHR) WGL[i] = (bf16)f2bf(wgu[(size_t)(i >> 7) * GQK + h * GDK + (i & 127)]);
        const float bgv = bgate[h * GDK + (tid0 & 127)];
        f32x4 px[4] = {(f32x4){0.f, 0.f, 0.f, 0.f}, (f32x4){0.f, 0.f, 0.f, 0.f}, (f32x4){0.f, 0.f, 0.f, 0.f}, (f32x4){0.f, 0.f, 0.f, 0.f}}; float pem = 0.f, pef = 0.f;
        f32x4 pz = (f32x4){0.f, 0.f, 0.f, 0.f}; v4u pq0 = (v4u){0u, 0u, 0u, 0u}, pq1 = pq0, pk0 = pq0, pk1 = pq0, pv[4] = {pq0, pq0, pq0, pq0};
#define GLA_PREFETCH(cix) do { const int rb_ = meta ? 0 : b * SEQ + (sc * CPS + (cix)) * 64; \
            const size_t chx_ = meta ? (size_t)(BATCH * GH * (SEQ / 64) + h) : (size_t)((b * GH + h) * (SEQ / 64) + sc * CPS + (cix)); \
            if (MODE == 1) { const float* xp_ = XB + chx_ * (64 * GDK) + (size_t)tid0 * 16; \
              _Pragma("unroll") for (int t_ = 0; t_ < 4; ++t_) px[t_] = *(const f32x4*)(xp_ + 4 * t_); \
              if (tid0 < 128) { pem = EMF[chx_ * 256 + tid0]; pef = EMF[chx_ * 256 + 128 + tid0]; } } \
            { const int c_ = tid0 >> 2, part_ = tid0 & 3; const bool ok_ = (tid0 < 256) && (!meta || c_ >= 48); const int row_ = meta ? MMAIN + c_ - 48 : rb_ + c_; \
              pz = (f32x4){0.f, 0.f, 0.f, 0.f}; if (MODE == 0 && ok_) pz = *(const f32x4*)(Z + (size_t)row_ * 16 + 4 * part_); } \
            { const int cC_ = tid0 & 63, g_ = tid0 >> 6; const bool ok_ = !meta || cC_ >= 48; const int row_ = meta ? MMAIN + cC_ - 48 : rb_ + cC_; const bf16* rp_ = QKVR + (size_t)row_ * NGLA; \
              pq0 = (v4u){0u, 0u, 0u, 0u}; pq1 = pq0; pk0 = pq0; pk1 = pq0; pv[0] = pq0; pv[1] = pq0; pv[2] = pq0; pv[3] = pq0; \
              if (ok_) { if (MODE == 1) { pq0 = *(const v4u*)(rp_ + h * GDK + g_ * 16); pq1 = *(const v4u*)(rp_ + h * GDK + g_ * 16 + 8); } \
                  pk0 = *(const v4u*)(rp_ + GQK + h * GDK + g_ * 16); pk1 = *(const v4u*)(rp_ + GQK + h * GDK + g_ * 16 + 8); \
                  _Pragma("unroll") for (int t_ = 0; t_ < 4; ++t_) pv[t_] = *(const v4u*)(rp_ + 2 * GQK + h * GDV + g_ * 32 + 8 * t_); } } } while (0)
        GLA_PREFETCH(0);
        for (int ci = 0; ci < nch; ++ci) {
            int tid = tid0; asm volatile("" : "+v"(tid));
            const int lane = tid & 63, w = __builtin_amdgcn_readfirstlane(tid >> 6), fr = lane & 15, fq = lane >> 4;
            const int rbase = meta ? 0 : b * SEQ + (sc * CPS + ci) * 64;
            GLT(0);
            const int dA = tid & 127, cgp = tid >> 7;
            const int cC = tid & 63, grp = tid >> 6, d0 = grp * 16, e0 = grp * 32;
            const v4u q0 = pq0, q1 = pq1, k0 = pk0, k1 = pk1, vv[4] = {pv[0], pv[1], pv[2], pv[3]};
            const size_t chx = meta ? (size_t)(BATCH * GH * (SEQ / 64) + h) : (size_t)((b * GH + h) * (SEQ / 64) + sc * CPS + ci);
            f32x4 xr4[4] = {px[0], px[1], px[2], px[3]};
            if (MODE == 1) { if (tid < 128) { em[tid] = pem; ef[tid] = pef; } }
            if (MODE == 0) {
            if (tid < 256) *(LAS f32x4*)(ZC + (tid >> 2) * 16 + 4 * (tid & 3)) = pz;
            GL_BAR();
            float wg[16];
#pragma unroll
            for (int i = 0; i < 16; ++i) wg[i] = bf2f(WGL[i * GDK + dA]);
            { float run = 0.f;
#pragma unroll 4
              for (int cc = 0; cc < 16; ++cc) { const int c = cgp * 16 + cc; float lg = bgv;
#pragma unroll
                for (int i4 = 0; i4 < 4; ++i4) { const f32x4 z4 = *(const LAS f32x4*)(ZC + c * 16 + 4 * i4); lg += (z4[0] * wg[4 * i4] + z4[1] * wg[4 * i4 + 1]) + (z4[2] * wg[4 * i4 + 2] + z4[3] * wg[4 * i4 + 3]); }
                float g = (fminf(lg, 0.f) - __logf(1.0f + __expf(-fabsf(lg)))) * (1.0f / 16.0f);
                if (meta && c < 48) g = 0.f;
                run += g; Bc[c * BS + dA] = run; }
              TOT[cgp * 129 + dA] = run; }
            GL_BAR();
            GLT(1);
            if (tid < 128) { const float t0 = TOT[tid], t1 = TOT[129 + tid], t2 = TOT[258 + tid], t3 = TOT[387 + tid];
                const float bm = t0 + Bc[31 * BS + tid], bl = (t0 + t1) + (t2 + t3);
                const float emv_ = __expf(bm), efv_ = __expf(bl - bm); em[tid] = emv_; ef[tid] = efv_; dsum += bl; EMF[chx * 256 + tid] = emv_; EMF[chx * 256 + 128 + tid] = efv_;
                OFFM[tid] = -bm; OFFM[129 + tid] = t0 - bm; OFFM[258 + tid] = t0 + t1 - bm; OFFM[387 + tid] = t0 + t1 + t2 - bm; }
            GL_BAR();
            }
            GLT(2);
            { const int c = cC;
                const unsigned qw[8] = {q0.x, q0.y, q0.z, q0.w, q1.x, q1.y, q1.z, q1.w}, kw[8] = {k0.x, k0.y, k0.z, k0.w, k1.x, k1.y, k1.z, k1.w};
                unsigned qo[8], ko[8];
                const LAS float* bcr = Bc + c * BS + d0; const LAS float* ofr = OFFM + (c >> 4) * 129 + d0;
#pragma unroll
                for (int t = 0; t < 8; ++t) {
                    const int d = d0 + 2 * t;
                    float x0, x1;
                    if (MODE == 0) { x0 = bcr[2 * t] + ofr[2 * t]; x1 = bcr[2 * t + 1] + ofr[2 * t + 1]; xr4[t >> 1][2 * (t & 1)] = x0; xr4[t >> 1][2 * (t & 1) + 1] = x1; }
                    else { x0 = xr4[t >> 1][2 * (t & 1)]; x1 = xr4[t >> 1][2 * (t & 1) + 1]; }
                    const float e0f = __expf(x0), e1f = __expf(x1), r0 = __expf(-x0), r1 = __expf(-x1);
                    const float ka = bflo(kw[t]) * r0, kb = bfhi(kw[t]) * r1;
                    ko[t] = pk2(ka, kb);
                    if (MODE == 1) qo[t] = pk2(bflo(qw[t]) * (0.08838834764831845f * e0f), bfhi(qw[t]) * (0.08838834764831845f * e1f));
                    KTT[(d) * KTTS + c] = (bf16)(ko[t] & 0xffffu); KTT[(d + 1) * KTTS + c] = (bf16)(ko[t] >> 16);
                }
                if (MODE == 0) { float* xp = XB + chx * (64 * GDK) + (size_t)tid * 16;
#pragma unroll
                    for (int t = 0; t < 4; ++t) *(f32x4*)(xp + 4 * t) = xr4[t]; }
                *(LAS v4u*)(KT + c * QTS + d0) = (v4u){ko[0], ko[1], ko[2], ko[3]}; *(LAS v4u*)(KT + c * QTS + d0 + 8) = (v4u){ko[4], ko[5], ko[6], ko[7]};
                if (MODE == 1) { *(LAS v4u*)(QT + c * QTS + d0) = (v4u){qo[0], qo[1], qo[2], qo[3]}; *(LAS v4u*)(QT + c * QTS + d0 + 8) = (v4u){qo[4], qo[5], qo[6], qo[7]}; }
#pragma unroll
                for (int t = 0; t < 4; ++t) { const unsigned vw[4] = {vv[t].x, vv[t].y, vv[t].z, vv[t].w};
#pragma unroll
                    for (int s = 0; s < 4; ++s) { const int e = e0 + 8 * t + 2 * s; VT[e * VTS + c] = (bf16)(vw[s] & 0xffffu); VT[(e + 1) * VTS + c] = (bf16)(vw[s] >> 16); } }
            }
            GL_BAR();
            GLT(3);
            f32x4 pacc[2];
#pragma unroll
            for (int dt = 0; dt < 8; ++dt) { const f32x4 emv = *(const LAS f32x4*)(em + 16 * dt + 4 * fq);
#pragma unroll
                for (int i = 0; i < 2; ++i) { sacc[dt][i] = sacc[dt][i] * emv;
                    if (MODE == 1) { const int e = 32 * w + 16 * i + fr; const int ck = (2 * dt + (fq >> 1)) ^ (e & 15);
                        v2u sw; sw.x = pk2(sacc[dt][i][0], sacc[dt][i][1]); sw.y = pk2(sacc[dt][i][2], sacc[dt][i][3]);
                        *(LAS v2u*)(ST + e * 256 + ck * 16 + (fq & 1) * 8) = sw; } } }
            if (MODE == 1) {
                const int mt = w & 3, ntp = w >> 2;
#pragma unroll
                for (int ii = 0; ii < 2; ++ii) { const int nt = 2 * ntp + ii; pacc[ii] = (f32x4){0.f, 0.f, 0.f, 0.f};
                    if (nt <= mt) {
#pragma unroll
                        for (int ks = 0; ks < 4; ++ks) { const bf16x8 kf = *(const LAS bf16x8*)(KT + (16 * nt + fr) * QTS + 32 * ks + 8 * fq); const bf16x8 qf = *(const LAS bf16x8*)(QT + (16 * mt + fr) * QTS + 32 * ks + 8 * fq);
                            pacc[ii] = __builtin_amdgcn_mfma_f32_16x16x32_bf16(kf, qf, pacc[ii], 0, 0, 0); }
                        if (nt == mt) {
#pragma unroll
                            for (int jj = 0; jj < 4; ++jj) if (4 * fq + jj > fr) pacc[ii][jj] = 0.f; }
                    } }
            }
            GL_BAR();
            if (MODE == 1) { const int mt = w & 3, ntp = w >> 2;
#pragma unroll
                for (int ii = 0; ii < 2; ++ii) { const int nt = 2 * ntp + ii; v2u pw; pw.x = pk2(pacc[ii][0], pacc[ii][1]); pw.y = pk2(pacc[ii][2], pacc[ii][3]);
                    *(LAS v2u*)(PP + (16 * mt + fr) * PS + 16 * nt + 4 * fq) = pw; }
                GL_BAR();
            }
            GLT(4);
            f32x4 oacc[8];
            v2u rr[8];
            if (MODE == 1) { const int cF = 16 * (w & 3) + fr; const bool validF = !meta || cF >= 48; const int rowF = meta ? MMAIN + cF - 48 : rbase + cF;
#pragma unroll
                for (int t = 0; t < 8; ++t) { rr[t] = (v2u){0u, 0u}; if (validF) rr[t] = *(const v2u*)(QKVR + (size_t)rowF * NGLA + 2 * GQK + GVD + h * GDV + 128 * (w >> 2) + 16 * t + 4 * fq); } }
            if (MODE == 1) { const int mt = w & 3, eh = w >> 2;
                bf16x8 pf[2], qf[4];
#pragma unroll
                for (int ks = 0; ks < 2; ++ks) pf[ks] = *(const LAS bf16x8*)(PP + (16 * mt + fr) * PS + 32 * ks + 8 * fq);
#pragma unroll
                for (int ks = 0; ks < 4; ++ks) qf[ks] = *(const LAS bf16x8*)(QT + (16 * mt + fr) * QTS + 32 * ks + 8 * fq);
#pragma unroll
                for (int t = 0; t < 8; ++t) { const int e = 128 * eh + 16 * t + fr; f32x4 a = (f32x4){0.f, 0.f, 0.f, 0.f};
#pragma unroll
                    for (int ks = 0; ks < 2; ++ks) { const bf16x8 vf = *(const LAS bf16x8*)(VT + e * VTS + 32 * ks + 8 * fq); a = __builtin_amdgcn_mfma_f32_16x16x32_bf16(vf, pf[ks], a, 0, 0, 0); }
#pragma unroll
                    for (int ks = 0; ks < 4; ++ks) { const int ck = (4 * ks + fq) ^ (e & 15); const bf16x8 sf = *(const LAS bf16x8*)(ST + e * 256 + ck * 16); a = __builtin_amdgcn_mfma_f32_16x16x32_bf16(sf, qf[ks], a, 0, 0, 0); }
                    oacc[t] = a; }
            }
            { bf16x8 vf[2][2];
#pragma unroll
              for (int i = 0; i < 2; ++i)
#pragma unroll
                  for (int ks = 0; ks < 2; ++ks) vf[i][ks] = *(const LAS bf16x8*)(VT + (32 * w + 16 * i + fr) * VTS + 32 * ks + 8 * fq);
#pragma unroll
              for (int dt = 0; dt < 8; ++dt) { const f32x4 efv = *(const LAS f32x4*)(ef + 16 * dt + 4 * fq);
#pragma unroll
                  for (int ks = 0; ks < 2; ++ks) { const bf16x8 kf = *(const LAS bf16x8*)(KTT + (16 * dt + fr) * KTTS + 32 * ks + 8 * fq);
#pragma unroll
                      for (int i = 0; i < 2; ++i) sacc[dt][i] = __builtin_amdgcn_mfma_f32_16x16x32_bf16(kf, vf[i][ks], sacc[dt][i], 0, 0, 0); }
#pragma unroll
                  for (int i = 0; i < 2; ++i) sacc[dt][i] = sacc[dt][i] * efv; }
            }
            if (ci + 1 < nch) GLA_PREFETCH(ci + 1);
            GLT(5);
            if (MODE == 1) { const int mt = w & 3, eh = w >> 2, c = 16 * mt + fr;
                float s1 = 0.f, s2 = 0.f;
#pragma unroll
                for (int t = 0; t < 8; ++t)
#pragma unroll
                    for (int jj = 0; jj < 4; ++jj) { s1 += oacc[t][jj]; s2 += oacc[t][jj] * oacc[t][jj]; }
                s1 += shx(s1, 16, lane); s1 += shx(s1, 32, lane); s2 += shx(s2, 16, lane); s2 += shx(s2, 32, lane);
                if (fq == 0) { stats[(c * 2 + eh) * 2 + 0] = s1; stats[(c * 2 + eh) * 2 + 1] = s2; }
                GL_BAR();
                const float t1 = stats[(c * 2 + 0) * 2 + 0] + stats[(c * 2 + 1) * 2 + 0], t2 = stats[(c * 2 + 0) * 2 + 1] + stats[(c * 2 + 1) * 2 + 1];
                float inv_dv = 1.0f / GDV; asm volatile("" : "+v"(inv_dv));
                const float mean = t1 * inv_dv, var = fmaxf(t2 * inv_dv - mean * mean, 0.f), rstd = __builtin_amdgcn_rsqf(var + LN_EPS);
                const bool valid = !meta || c >= 48; const int row = meta ? MMAIN + c - 48 : rbase + c;
                if (valid) {
#pragma unroll
                    for (int t = 0; t < 8; ++t) { const int e = 128 * eh + 16 * t + 4 * fq;
                        const v2u rw = rr[t];
                        const f32x4 ng = *(const LAS f32x4*)(NGL + e);
                        const float r4[4] = {bflo(rw.x), bfhi(rw.x), bflo(rw.y), bfhi(rw.y)}; float o4[4];
#pragma unroll
                        for (int jj = 0; jj < 4; ++jj) o4[jj] = (oacc[t][jj] - mean) * rstd * ng[jj] * silu_f(r4[jj]);
                        v2u ow; ow.x = pk2(o4[0], o4[1]); ow.y = pk2(o4[2], o4[3]);
                        *(v2u*)(O + (size_t)row * D + h * GDV + e) = ow; } }
            }
            GL_BAR();
            GLT(6);
        }
        if (MODE == 0) {
            int lofs2 = (4 * ((tid0 & 63) >> 4)) * GDV + 32 * (tid0 >> 6) + (tid0 & 15); asm volatile("" : "+v"(lofs2));
#pragma unroll
            for (int dt = 0; dt < 8; ++dt)
#pragma unroll
                for (int i = 0; i < 2; ++i)
#pragma unroll
                    for (int jj = 0; jj < 4; ++jj) KVS[(size_t)u * (GDK * GDV) + (size_t)((16 * dt + jj) * GDV + 16 * i) + lofs2] = sacc[dt][i][jj];
            if (tid0 < 128) DEC[(size_t)u * GDK + tid0] = dsum;
        }
    }
}
__device__ __forceinline__ void gla_scan_phase(Frame& F) {
    const float* KVS = (const float*)(F.ws + WS_S0 + S_KVS); float* SST = (float*)(F.ws + WS_S0 + S_SST); const float* DEC = (const float*)(F.ws + WS_S0 + S_DEC);
    constexpr int NEL = GDK * GDV;
    for (int idx = F.bx * NTHR + F.tid; idx < BATCH * GH * NEL; idx += F.G * NTHR) {
        const int bh = idx / NEL, el = idx - bh * NEL, d = el / GDV, h = bh % GH;
        float s = KVS[(size_t)(BATCH * GH * NSC_BH + h) * NEL + el];
        const size_t ub = (size_t)bh * NSC_BH;
        SST[ub * NEL + el] = s;
        for (int sc = 0; sc + 1 < NSC_BH; sc += 7) { float dv[7], kv[7];
#pragma unroll
            for (int t = 0; t < 7; ++t) { const int q = (sc + t + 1 < NSC_BH) ? sc + t : NSC_BH - 2; dv[t] = DEC[(ub + q) * GDK + d]; kv[t] = KVS[(ub + q) * NEL + el]; }
#pragma unroll
            for (int t = 0; t < 7; ++t) if (sc + t + 1 < NSC_BH) { s = __expf(dv[t]) * s + kv[t]; SST[(ub + sc + t + 1) * NEL + el] = s; } }
    }
}

#define GLA_PHASES \
        if (IN(pb + 10)) { if (on_gla) { \
            bf16* QKVR = (bf16*)(F.ws + WS_S0 + S_QKVR); EpiBf16Gelu E{QKVR, NGLA, 0}; \
            meta_gemm(F, HB + (size_t)MMAIN * D, D, D, (const bf16*)(wl + WL_GLAIN), NGLA / 16, E); \
            pg8::Gemm g{D, D}; pg8::DenseOrder S; S.init(HB, D, (const bf16*)(wl + WL_GLAIN), D, MMAIN / 256, NGLA / 256, F.G, F.bx); \
            pg8::gemm_phase<EpiBf16Gelu, pg8::DenseOrder>(F.lds, F.tid, g, S, E); } \
            SEAM(pb + 10); } \
        if (IN(pb + 11)) { if (on_gla) gla_phase<0>(F, args.in[12] + (size_t)j * GRANK * GQK, args.in[13] + (size_t)j * GQK, args.in[14] + (size_t)j * GVD); SEAM(pb + 11); } \
        if (IN(pb + 12)) { if (on_gla) gla_scan_phase(F); SEAM(pb + 12); } \
        if (IN(pb + 13)) { if (on_gla) gla_phase<1>(F, args.in[12] + (size_t)j * GRANK * GQK, args.in[13] + (size_t)j * GQK, args.in[14] + (size_t)j * GVD); SEAM(pb + 13); } \
        if (IN(pb + 14)) { if (on_gla) { \
            const bf16* O = (const bf16*)(F.ws + WS_S0 + S_O); EpiBf16Gelu E{MIX, D, 0}; \
            meta_gemm(F, O + (size_t)MMAIN * D, D, D, (const bf16*)(wl + WL_GLAOUT), D / 16, E); \
            pg8::Gemm g{D, D}; pg8::DenseOrder S; S.init(O, D, (const bf16*)(wl + WL_GLAOUT), D, MMAIN / 256, D / 256, F.G, F.bx); \
            pg8::gemm_phase<EpiBf16Gelu, pg8::DenseOrder>(F.lds, F.tid, g, S, E); } \
            SEAM(pb + 14); }

__device__ __forceinline__ void moe_panel_ends(const gu32* cnt, int (&pe)[8]) {
    int acc = 0;
#pragma unroll
    for (int e = 0; e < 8; ++e) { const int c = __builtin_amdgcn_readfirstlane((int)__hip_atomic_load(cnt + e, RLX_AGENT)); acc += (c + 255) >> 8; pe[e] = acc; }
}
__device__ __forceinline__ void moe_gather_phase(Frame& F, gu32* moe) {
    const bf16* HB = (const bf16*)(F.ws + WS_HB); bf16* AS = (bf16*)(F.ws + WS_S0 + S_AS);
    const int* E1 = (const int*)(F.ws + WS_RT); const int* E2 = E1 + MROWS; int* POS1 = (int*)(F.ws + WS_RT) + 4 * MROWS; int* POS2 = POS1 + MROWS;
    LAS unsigned* lcnt = (LAS unsigned*)F.lds; LAS unsigned* lbase = lcnt + 8; LAS int* lpos = (LAS int*)(F.lds + 256);
    const int per = (MROWS + F.G - 1) / F.G, t0 = F.bx * per, nt = (t0 + per <= MROWS) ? per : (MROWS - t0 > 0 ? MROWS - t0 : 0);
    if (F.tid < 8) lcnt[F.tid] = 0u;
    __syncthreads();
    int e1 = 0, e2 = 0; unsigned r1 = 0, r2 = 0;
    if (F.tid < nt) { e1 = E1[t0 + F.tid]; e2 = E2[t0 + F.tid];
        r1 = __hip_atomic_fetch_add(&lcnt[e1], 1u, __ATOMIC_RELAXED, __HIP_MEMORY_SCOPE_WORKGROUP); r2 = __hip_atomic_fetch_add(&lcnt[e2], 1u, __ATOMIC_RELAXED, __HIP_MEMORY_SCOPE_WORKGROUP); }
    __syncthreads();
    if (F.tid < 8) { int ps = 0, accp = 0;
#pragma unroll
        for (int e = 0; e < 8; ++e) { ps = (e == F.tid) ? accp : ps; accp += ((int)__hip_atomic_load(moe + e, RLX_AGENT) + 255) >> 8; }
        const unsigned c = lcnt[F.tid]; const unsigned off = c ? __hip_atomic_fetch_add(moe + 64 + F.tid, c, RLX_AGENT) : 0u;
        lbase[F.tid] = (unsigned)ps * 256u + off; }
    __syncthreads();
    if (F.tid < nt) { const int p1 = (int)(lbase[e1] + r1), p2 = (int)(lbase[e2] + r2); POS1[t0 + F.tid] = p1; POS2[t0 + F.tid] = p2; lpos[2 * F.tid] = p1; lpos[2 * F.tid + 1] = p2; }
    __syncthreads();
    for (int t = F.wave; t < nt; t += NWAVES) {
        const v4u* src = (const v4u*)(HB + (size_t)(t0 + t) * D); const v4u a = src[2 * F.lane], b = src[2 * F.lane + 1];
        float x[16]; unpack8(a, x); unpack8(b, x + 8);
        const v4u o = (v4u){pk4_fp8(x[0], x[1], x[2], x[3]), pk4_fp8(x[4], x[5], x[6], x[7]), pk4_fp8(x[8], x[9], x[10], x[11]), pk4_fp8(x[12], x[13], x[14], x[15])};
        unsigned char* AS8 = (unsigned char*)AS;
        *(v4u*)(AS8 + (size_t)lpos[2 * t] * D + 16 * F.lane) = o; *(v4u*)(AS8 + (size_t)lpos[2 * t + 1] * D + 16 * F.lane) = o;
    }
}

#ifdef MK_IDLE_TICKS
#define IDLE_PROBE { const unsigned long long t0_ = __builtin_amdgcn_s_memrealtime(); while (__builtin_amdgcn_s_memrealtime() - t0_ < (unsigned long long)(MK_IDLE_TICKS)) __builtin_amdgcn_s_sleep(64); }
#else
#define IDLE_PROBE
#endif
#define MOE_PHASES \
        if (IN(pb + 16)) { if (on_moe) moe_gather_phase(F, F.ctl + CW_MOE + 256 * j); IDLE_PROBE SEAM(pb + 16); } \
        if (IN(pb + 17)) { if (on_moe) { \
            const bf16* AS = (const bf16*)(F.ws + WS_S0 + S_AS); unsigned char* HS = (unsigned char*)(F.ws + WS_S0 + S_HS); EpiSwigluF8 E{HS, FF, 0.015625f, 8.0f}; \
            pg8::Gemm g{D, D}; pg8::MoeOrder S; moe_panel_ends(F.ctl + CW_MOE + 256 * j, S.pe); S.e_bytes = (size_t)NFF2 * D; \
            S.init(AS, D, (const bf16*)(wl + WL_MOEIN), D, S.pe[7], NFF2 / 256, F.G, F.bx, 1); \
            pg8::gemm_phase<EpiSwigluF8, pg8::MoeOrder, true, true>(F.lds, F.tid, g, S, E); } \
            SEAM(pb + 17); } \
        if (IN(pb + 18)) { if (on_moe) { \
            const unsigned char* HS = (const unsigned char*)(F.ws + WS_S0 + S_HS); EpiBf16Gelu E{(bf16*)(F.ws + WS_S0 + S_YS), D, 0, 1.0f / 2048.0f}; \
            pg8::Gemm g{FF, FF}; pg8::MoeOrder S; moe_panel_ends(F.ctl + CW_MOE + 256 * j, S.pe); S.e_bytes = (size_t)D * FF; \
            S.init(HS, FF, (const bf16*)(wl + WL_MOEOUT), FF, S.pe[7], D / 256, F.G, F.bx, 1); \
            pg8::gemm_phase<EpiBf16Gelu, pg8::MoeOrder, true, true>(F.lds, F.tid, g, S, E); } \
            SEAM(pb + 18); }

constexpr int NPHASE = 41;
#ifndef MK_PER_PHASE
#define MK_PER_PHASE 0
#endif
#ifndef MK_DBG
#define MK_DBG 0
#endif
#ifndef MK_SUBMASK
#define MK_SUBMASK 0xFFu
#endif

__global__ void __launch_bounds__(NTHR, 2) fwd(Args args) {
    extern __shared__ __attribute__((aligned(16))) unsigned char lds[];
    Frame F;
    F.lds = (LAS unsigned char*)lds; F.ws = args.ws; F.ctl = (gu32*)(args.ws + WS_CTL);
    F.tid = threadIdx.x; F.lane = F.tid & 63; F.wave = __builtin_amdgcn_readfirstlane(F.tid >> 6); F.G = gridDim.x; F.bx = blockIdx.x; F.dbg_acc = 0ull;
    volatile LAS unsigned* MISC = (volatile LAS unsigned*)(F.lds + MISC_OFF);
    if (F.tid < 16) MISC[F.tid] = 0u;
    __syncthreads();
    const int lo = args.ph_lo, hi = args.ph_hi;
    XcdBarrier bar; bar.bar = (unsigned*)(F.ctl + CW_BAR); bar.x = 0; bar.st = nullptr;
    if (hi - lo > 1) bar = xcd_barrier_post((unsigned*)(F.ctl + CW_BAR), MISC);
#ifndef MK_STAMP_BARMASK
#define MK_STAMP_BARMASK 0xFFFFFu
#endif
#ifdef MK_STAMP_MASK
    unsigned long long st_acc = 0ull, st_t0 = 0ull;
#define ST_SEL(k) ((k) == 0 ? (((MK_STAMP_MASK) >> 20) & 1u) : ((((MK_STAMP_MASK) >> (((k) - 1) % 20)) & 1u)))
#define IN(k) (lo <= (k) && (k) < hi && (F.fresh(), st_t0 = __builtin_amdgcn_s_memrealtime(), true))
#define SEAM(k) do { const unsigned long long t1_ = __builtin_amdgcn_s_memrealtime(); if (ST_SEL(k)) st_acc += t1_ - st_t0; if ((k) + 1 < hi) xcd_barrier(bar); if ((((MK_STAMP_MASK) >> 21) & 1u) && ((k) == 0 || (((MK_STAMP_BARMASK) >> (((k) - 1) % 20)) & 1u))) st_acc += __builtin_amdgcn_s_memrealtime() - t1_; } while (0)
#else
#define IN(k) (lo <= (k) && (k) < hi && (F.fresh(), true))
#define SEAM(k) do { if ((k) + 1 < hi) xcd_barrier(bar); } while (0)
#endif
    const unsigned submask = args.submask;
    const float* ln_gain = args.in[2]; const float* ln_bias = args.in[3];
    bf16* HB = (bf16*)(F.ws + WS_HB); bf16* MIX = (bf16*)(F.ws + WS_MIX);

    if (IN(0)) { p0_prologue(F, args); SEAM(0); }

    for (int j = 0; j < 2; ++j) {
        const int pb = 1 + 20 * j;
        unsigned char* wl = F.ws + WS_W + (size_t)j * WL_STRIDE;
        const bool on_rg = (submask >> (4 * j + 0)) & 1u, on_ffn = (submask >> (4 * j + 1)) & 1u, on_gla = (submask >> (4 * j + 2)) & 1u, on_moe = (submask >> (4 * j + 3)) & 1u;
        RG_PHASES
        if (IN(pb + 6)) { ln_phase(F, on_rg ? 1 : 0, ln_gain + (size_t)(2 * j) * 2 * D, ln_bias + (size_t)(2 * j) * 2 * D, 0, nullptr, 0, nullptr, nullptr); SEAM(pb + 6); }
        if (IN(pb + 7)) { if (on_ffn) {
            bf16* HID = (bf16*)(F.ws + WS_S0 + S_HID);
            EpiSwiglu E{HID, FF, 1.0f};
            if (!(MK_DBG & 1)) meta_gemm(F, HB + (size_t)MMAIN * D, D, D, (const bf16*)(wl + WL_FFNIN), (NFF2 / 256) * 8, E);
            pg8::Gemm g{D, D}; pg8::DenseOrder S; S.init(HB, D, (const bf16*)(wl + WL_FFNIN), D, MMAIN / 256, NFF2 / 256, F.G, F.bx);
            if (!(MK_DBG & 2)) pg8::gemm_phase<EpiSwiglu, pg8::DenseOrder>(F.lds, F.tid, g, S, E); }
            SEAM(pb + 7); }
        if (IN(pb + 8)) { if (on_ffn) {
            const bf16* HID = (const bf16*)(F.ws + WS_S0 + S_HID);
            EpiBf16Gelu E{MIX, D, 0};
            if (!(MK_DBG & 4)) meta_gemm(F, HID + (size_t)MMAIN * FF, FF, FF, (const bf16*)(wl + WL_FFNOUT), D / 16, E);
            pg8::Gemm g{FF, FF}; pg8::DenseOrder S; S.init(HID, FF, (const bf16*)(wl + WL_FFNOUT), FF, MMAIN / 256, D / 256, F.G, F.bx);
            if (!(MK_DBG & 8)) pg8::gemm_phase<EpiBf16Gelu, pg8::DenseOrder>(F.lds, F.tid, g, S, E); }
            SEAM(pb + 8); }
        if (IN(pb + 9)) { ln_phase(F, on_ffn ? 1 : 0, ln_gain + (size_t)(2 * j) * 2 * D + D, ln_bias + (size_t)(2 * j) * 2 * D + D, 1, args.in[11] + (size_t)j * D * GLAW + NGLA, GLAW, nullptr, nullptr); SEAM(pb + 9); }
        GLA_PHASES
        if (IN(pb + 15)) { ln_phase(F, on_gla ? 1 : 0, ln_gain + (size_t)(2 * j + 1) * 2 * D, ln_bias + (size_t)(2 * j + 1) * 2 * D, on_moe ? 2 : 0, args.in[18] + (size_t)j * D * NE, NE, nullptr, F.ctl + CW_MOE + 256 * j); SEAM(pb + 15); }
        MOE_PHASES
        if (IN(pb + 19)) { ln_phase(F, on_moe ? 2 : 0, ln_gain + (size_t)(2 * j + 1) * 2 * D + D, ln_bias + (size_t)(2 * j + 1) * 2 * D + D, 0, nullptr, 0, j == 1 ? args.out : nullptr, nullptr); SEAM(pb + 19); }
    }
#ifdef MK_STAMP_MASK
    __syncthreads();
    if (blockIdx.x == 0 && threadIdx.x == 0) args.out[0] = (float)(st_acc + F.dbg_acc) * 0.01f * (MK_STAMP_SCALE);
#endif
#undef IN
#undef SEAM
}

static bool phase_enabled(int k, unsigned mask) {
    if (k == 0) return true;
    const int j = (k - 1) / 20, r = (k - 1) % 20;
    int sub;
    if (r <= 5) sub = 0; else if (r == 6) return true; else if (r <= 8) sub = 1; else if (r == 9) return true;
    else if (r <= 14) sub = 2; else if (r == 15) return true; else if (r <= 18) sub = 3; else return true;
    return (mask >> (4 * j + sub)) & 1u;
}
extern "C" void kernel_launch(void* const* d_in, const int* in_sizes, int n_in, void* d_out, int out_size, void* d_ws, size_t ws_size, hipStream_t stream) {
    static int grid = 0;
    if (grid == 0) {
        if (n_in != 21 || out_size != MMAIN * D || ws_size < WS_END) { fprintf(stderr, "kernel_launch: unexpected shapes: n_in %d out %d ws %zu (need %zu); nothing launched\n", n_in, out_size, ws_size, (size_t)WS_END); grid = -1; return; }
        int dev = 0, cus = 0, per_cu = 0;
        if (hipGetDevice(&dev) != hipSuccess || hipDeviceGetAttribute(&cus, hipDeviceAttributeMultiprocessorCount, dev) != hipSuccess) { grid = -1; return; }
        if (hipFuncSetAttribute((const void*)fwd, hipFuncAttributeMaxDynamicSharedMemorySize, LDS_BYTES) != hipSuccess) { fprintf(stderr, "kernel_launch: hipFuncSetAttribute failed\n"); grid = -1; return; }
        if (hipOccupancyMaxActiveBlocksPerMultiprocessor(&per_cu, (const void*)fwd, NTHR, LDS_BYTES) != hipSuccess || per_cu < 1) fprintf(stderr, "kernel_launch: note: occupancy query reports %d\n", per_cu);
        (void)hipGetLastError();
        grid = cus;
    }
    if (grid < 0) return;
    (void)hipMemsetAsync((char*)d_ws + WS_CTL, 0, CTL_ZERO_BYTES, stream);
    Args a{};
    for (int i = 0; i < 21; ++i) a.in[i] = (const float*)d_in[i];
    a.out = (float*)d_out; a.ws = (unsigned char*)d_ws; a.submask = MK_SUBMASK; a.pad = 0;
#if MK_PER_PHASE
    for (int k = 0; k < NPHASE; ++k) { if (!phase_enabled(k, MK_SUBMASK)) continue; a.ph_lo = k; a.ph_hi = k + 1; hipLaunchKernelGGL(fwd, dim3(grid), dim3(NTHR), LDS_BYTES, stream, a); }
#else
    a.ph_lo = 0; a.ph_hi = NPHASE; hipLaunchKernelGGL(fwd, dim3(grid), dim3(NTHR), LDS_BYTES, stream, a);
#ifdef MK_PROBE_LIST
    { const int pl[] = {MK_PROBE_LIST}; for (int k : pl) { a.ph_lo = k; a.ph_hi = k + 1; hipLaunchKernelGGL(fwd, dim3(grid), dim3(NTHR), LDS_BYTES, stream, a); } }
#endif
#endif
}
```

```cpp
#include <hip/hip_runtime.h>
#include <cstdio>
#include <cstdint>

#define GAS __attribute__((address_space(1)))
#define LAS __attribute__((address_space(3)))
typedef unsigned short bf16;
typedef unsigned v4u __attribute__((ext_vector_type(4)));
typedef unsigned v2u __attribute__((ext_vector_type(2)));
typedef float f32x4 __attribute__((ext_vector_type(4)));
typedef float f32x2 __attribute__((ext_vector_type(2)));
typedef short bf16x8 __attribute__((ext_vector_type(8)));
typedef short bf16x4 __attribute__((ext_vector_type(4)));
typedef GAS unsigned gu32;
#define RLX_AGENT __ATOMIC_RELAXED, __HIP_MEMORY_SCOPE_AGENT
#define LDS_WAIT() asm volatile("s_waitcnt lgkmcnt(0)" ::: "memory")
#define VM_WAIT() asm volatile("s_waitcnt vmcnt(0)" ::: "memory")

__device__ __forceinline__ unsigned f2bf(float f) { unsigned u = __builtin_bit_cast(unsigned, f); return (u + 0x7fffu + ((u >> 16) & 1u)) >> 16; }
__device__ __forceinline__ unsigned pk2(float lo, float hi) { unsigned r; asm("v_cvt_pk_bf16_f32 %0, %1, %2" : "=v"(r) : "v"(lo), "v"(hi)); return r; }
__device__ __forceinline__ float bflo(unsigned w) { return __builtin_bit_cast(float, w << 16); }
__device__ __forceinline__ float bfhi(unsigned w) { return __builtin_bit_cast(float, w & 0xffff0000u); }
__device__ __forceinline__ float bf2f(bf16 b) { return __builtin_bit_cast(float, (unsigned)b << 16); }
__device__ __forceinline__ unsigned cvt_pk_bf16(float lo, float hi) { unsigned r; asm volatile("v_cvt_pk_bf16_f32 %0, %1, %2" : "=v"(r) : "v"(lo), "v"(hi)); return r; }
__device__ __forceinline__ unsigned pk4_fp8(float a, float b, float c, float d) { int w = 0; w = __builtin_amdgcn_cvt_pk_fp8_f32(a, b, w, false); w = __builtin_amdgcn_cvt_pk_fp8_f32(c, d, w, true); return (unsigned)w; }
__device__ __forceinline__ float fast_exp(float x) { return __builtin_amdgcn_exp2f(x * 1.44269504089f); }
__device__ __forceinline__ float sigmoid_f(float x) { return __builtin_amdgcn_rcpf(1.0f + fast_exp(-x)); }
__device__ __forceinline__ float silu_f(float x) { return x * sigmoid_f(x); }
__device__ __forceinline__ float gelu_tanh_f(float x) { const float u = 0.7978845608028654f * (x + 0.044715f * x * x * x); return x * sigmoid_f(2.0f * u); }
__device__ __forceinline__ float shx(float v, int m, int lane) { return __int_as_float(__builtin_amdgcn_ds_bpermute((lane ^ m) << 2, __float_as_int(v))); }
__device__ __forceinline__ float wave_sum(float v, int lane) {
#pragma unroll
    for (int o = 1; o < 64; o <<= 1) v += shx(v, o, lane);
    return v;
}

namespace pg8 {
constexpr int BM = 256, BK = 64, HALF = 128, HTB = HALF * BK * 2  , STAGE_BYTES = 8 * HTB, NXCD = 8, WGM = 8;
__host__ __device__ __forceinline__ int lds_byte(int r, int c) { const int st = (r >> 4) * 2 + (c >> 5), rr = r & 15, cc = c & 31, ob = rr * 64 + cc * 2; return st * 1024 + (ob ^ (((ob >> 9) & 1) << 5)); }
__host__ __device__ __forceinline__ void stage_rc(int b, int& R, int& C) { const int st = b / 1024, sb = b % 1024, swz = sb ^ (((sb >> 9) & 1) << 5); R = (st >> 1) * 16 + swz / 64; C = (st & 1) * 32 + (swz % 64) / 2; }
__host__ __device__ __forceinline__ int perm32(int rho) { const int n = rho >> 4, i = rho & 15; return 8 * (i >> 2) + 4 * n + (i & 3); }

struct Unit { int pm, pn; };
struct Gemm { int K, lda, esz; };

struct OrderBase {
    int nM, nN, nwg, G, c;
    __device__ __forceinline__ void init_order(int nM_, int nN_, int G_, int c_) { nM = nM_; nN = nN_; nwg = nM * nN; G = G_; c = c_; }
    __device__ __forceinline__ bool next(int i, Unit& u) const {
        const long L = (long)i * G + c; if (L >= nwg) return false;
        int wgid = (int)L; { const int q = nwg / NXCD, r = nwg % NXCD, xcd = wgid % NXCD, off = wgid / NXCD; wgid = (xcd < r ? xcd * (q + 1) : r * (q + 1) + (xcd - r) * q) + off; }
        const int nig = WGM * nN, gid = wgid / nig, fm = gid * WGM, gsz = (nM - fm) < WGM ? (nM - fm) : WGM;
        u.pm = __builtin_amdgcn_readfirstlane(fm + ((wgid % nig) % gsz)); u.pn = __builtin_amdgcn_readfirstlane((wgid % nig) / gsz); return true;
    }
};
struct DenseOrder : OrderBase {
    const char* A; const char* Bt; size_t a_tile, b_tile;
    __device__ __forceinline__ void init(const void* A_, int lda, const void* Bt_, int K, int nM_, int nN_, int G_, int c_, int esz = 2) { A = (const char*)A_; Bt = (const char*)Bt_; a_tile = (size_t)BM * lda * esz; b_tile = (size_t)BM * K * esz; init_order(nM_, nN_, G_, c_); }
    __device__ __forceinline__ const char* a_base(const Unit& u) const { return A + (size_t)u.pm * a_tile; }
    __device__ __forceinline__ const char* b_base(const Unit& u) const { return Bt + (size_t)u.pn * b_tile; }
};
struct GatesOrder : DenseOrder {
    __device__ __forceinline__ const char* a_base(const Unit& u) const { return A + (size_t)u.pm * a_tile + (size_t)(u.pn >> 1) * 512; }
};
struct MoeOrder : DenseOrder {
    int pe[8]; size_t e_bytes;
    __device__ __forceinline__ const char* b_base(const Unit& u) const {
        int e = 0;
#pragma unroll
        for (int j = 0; j < 7; ++j) e += (u.pm >= pe[j]) ? 1 : 0;
        return Bt + (size_t)e * e_bytes + (size_t)u.pn * b_tile;
    }
};

typedef int v8i __attribute__((ext_vector_type(8)));
typedef int v4i __attribute__((ext_vector_type(4)));
template <class Epi, class Sched, bool ALIGN_EPI = true, bool FP8 = false, int SCALE_W = 127>
__device__ __forceinline__ void gemm_phase(LAS unsigned char* lds, const int tid, const Gemm g, const Sched& S, const Epi& E) {
    const int wid = __builtin_amdgcn_readfirstlane(tid >> 6), lane = tid & 63, wr = wid >> 2, wc = wid & 3, fr = lane & 15, fq = lane >> 4;
    const int K = g.K, nt = FP8 ? K / 128 : K / BK;
    unsigned voffA[1], voffB[1];
#pragma unroll
    for (int i = 0; i < 1; ++i) { int R, C; stage_rc(tid * 16 + i * 8192, R, C); const int Rb = Epi::PERM ? ((R & ~31) + perm32(R & 31)) : R;
        voffA[i] = FP8 ? (unsigned)(R * g.lda + 2 * C) : (unsigned)(R * g.lda + C) * 2u; voffB[i] = FP8 ? (unsigned)(Rb * K + 2 * C) : (unsigned)(Rb * K + C) * 2u; }
    const size_t kstep = (size_t)(BK * 2);
    const size_t hstepA = (size_t)HALF * g.lda * (FP8 ? 1 : 2), hstepB = (size_t)HALF * K * (FP8 ? 1 : 2);
    const size_t qstepA = hstepA / 2, qstepB = hstepB / 2;
    const unsigned ldsw = (unsigned)wid * 1024u;
    const int aoff = lds_byte(wr * 64 + fr, fq * 8), boff = lds_byte(wc * 32 + fr, fq * 8);
#define PG8_SA(b, h) (((b) * 2 + (h)) * HTB)
#define PG8_SB(b, h) ((4 + (b) * 2 + (h)) * HTB)
#define PG8_STAGE(bufoff, gbase, voff) do { _Pragma("unroll") for (int _i = 0; _i < 2; ++_i) \
        __builtin_amdgcn_global_load_lds((const unsigned*)((const char*)(gbase) + (size_t)_i * ((voff) == voffA ? qstepA : qstepB) + (voff)[0]), (LAS unsigned*)(lds + (bufoff) + ldsw + _i * 8192), 16, 0, 0); } while (0)
#define PG8_LDA(dst, b, h) do { if constexpr (FP8) { _Pragma("unroll") for (int m = 0; m < 4; ++m) dst##8[m] = __builtin_shufflevector(*(const LAS v4i*)(lds + PG8_SA(b, h) + aoff + m * 2048), *(const LAS v4i*)(lds + PG8_SA(b, h) + aoff + m * 2048 + 1024), 0, 1, 2, 3, 4, 5, 6, 7); } else { _Pragma("unroll") for (int m = 0; m < 4; ++m) _Pragma("unroll") for (int k = 0; k < 2; ++k) dst[m][k] = *(const LAS bf16x8*)(lds + PG8_SA(b, h) + aoff + m * 2048 + k * 1024); } } while (0)
#define PG8_LDB(dst, b, h) do { if constexpr (FP8) { _Pragma("unroll") for (int n = 0; n < 2; ++n) dst##8[n] = __builtin_shufflevector(*(const LAS v4i*)(lds + PG8_SB(b, h) + boff + n * 2048), *(const LAS v4i*)(lds + PG8_SB(b, h) + boff + n * 2048 + 1024), 0, 1, 2, 3, 4, 5, 6, 7); } else { _Pragma("unroll") for (int n = 0; n < 2; ++n) _Pragma("unroll") for (int k = 0; k < 2; ++k) dst[n][k] = *(const LAS bf16x8*)(lds + PG8_SB(b, h) + boff + n * 2048 + k * 1024); } } while (0)
#define PG8_MMA(ai, bj, At, Bt) do { __builtin_amdgcn_s_setprio(1); if constexpr (FP8) { _Pragma("unroll") for (int m = 0; m < 4; ++m) _Pragma("unroll") for (int n = 0; n < 2; ++n) \
            acc[ai][bj][m][n] = __builtin_amdgcn_mfma_scale_f32_16x16x128_f8f6f4(Bt##8[n], At##8[m], acc[ai][bj][m][n], 0, 0, 0, 0, 0, 0); } else { \
        _Pragma("unroll") for (int m = 0; m < 4; ++m) _Pragma("unroll") for (int n = 0; n < 2; ++n) _Pragma("unroll") for (int k = 0; k < 2; ++k) \
        acc[ai][bj][m][n] = __builtin_amdgcn_mfma_f32_16x16x32_bf16(Bt[n][k], At[m][k], acc[ai][bj][m][n], 0, 0, 0); } __builtin_amdgcn_s_setprio(0); } while (0)
#define PG8_WAIT_V(n) asm volatile("s_waitcnt vmcnt(" #n ")" ::: "memory")
#define PG8_WAIT_L(n) asm volatile("s_waitcnt lgkmcnt(" #n ")" ::: "memory")
#define PG8_BAR __builtin_amdgcn_s_barrier()
#define PG8_SCHED __builtin_amdgcn_sched_barrier(0)
    Unit cur, nxt; int ui = 0;
    if (!S.next(0, cur)) return;
    f32x4 acc[2][2][4][2];
#pragma unroll
    for (int a = 0; a < 2; ++a)
#pragma unroll
        for (int b = 0; b < 2; ++b)
#pragma unroll
            for (int m = 0; m < 4; ++m)
#pragma unroll
                for (int n = 0; n < 2; ++n) acc[a][b][m][n] = (f32x4){0.f, 0.f, 0.f, 0.f};
    bf16x8 At[4][2], B0[2][2], B1[2][2]; v8i At8[4], B08[2], B18[2];
    const char* cA = S.a_base(cur); const char* cB = S.b_base(cur);
    PG8_STAGE(PG8_SB(0, 0), cB, voffB); PG8_STAGE(PG8_SB(0, 1), cB + hstepB, voffB); PG8_STAGE(PG8_SA(0, 0), cA, voffA); PG8_STAGE(PG8_SA(0, 1), cA + hstepA, voffA);
    if (wr == 1) PG8_BAR;
    PG8_WAIT_V(2); PG8_BAR;
    PG8_STAGE(PG8_SB(1, 0), cB + kstep, voffB); PG8_STAGE(PG8_SA(1, 0), cA + kstep, voffA); PG8_STAGE(PG8_SB(1, 1), cB + hstepB + kstep, voffB);
    PG8_WAIT_V(6); PG8_BAR;
    for (;;) {
        const bool has_next = S.next(ui + 1, nxt);
        const char* nA = has_next ? S.a_base(nxt) : cA; const char* nB = has_next ? S.b_base(nxt) : cB;
#pragma nounroll
        for (int t = 0; t < nt; t += 2) {
            const bool last = (t == nt - 2);
            asm volatile("" : "+v"(voffA[0]), "+v"(voffB[0]));
            const char* a1 = cA + (size_t)(t + 1) * kstep;
            const char* a2 = last ? nA : cA + (size_t)(t + 2) * kstep; const char* b2 = last ? nB : cB + (size_t)(t + 2) * kstep;
            const char* a3 = a2 + kstep; const char* b3 = b2 + kstep;
            PG8_LDB(B0, 0, 0); PG8_LDB(B1, 0, 1); PG8_SCHED; PG8_LDA(At, 0, 0); PG8_STAGE(PG8_SA(1, 1), a1 + hstepA, voffA);
            PG8_WAIT_V(8); PG8_WAIT_L(0); PG8_BAR; PG8_MMA(0, 0, At, B0); PG8_MMA(0, 1, At, B1); PG8_BAR; PG8_SCHED;
            PG8_LDA(At, 0, 1); PG8_STAGE(PG8_SB(0, 0), b2, voffB); PG8_STAGE(PG8_SB(0, 1), b2 + hstepB, voffB); PG8_STAGE(PG8_SA(0, 0), a2, voffA);
            PG8_WAIT_V(8); PG8_WAIT_L(0); PG8_BAR; PG8_MMA(1, 0, At, B0); PG8_MMA(1, 1, At, B1); PG8_BAR; PG8_SCHED;
            PG8_LDB(B0, 1, 0); PG8_LDB(B1, 1, 1); PG8_SCHED; PG8_LDA(At, 1, 0); PG8_STAGE(PG8_SA(0, 1), a2 + hstepA, voffA);
            PG8_WAIT_V(8); PG8_WAIT_L(0); PG8_BAR; PG8_MMA(0, 0, At, B0); PG8_MMA(0, 1, At, B1); PG8_BAR; PG8_SCHED;
            PG8_LDA(At, 1, 1); PG8_STAGE(PG8_SB(1, 0), b3, voffB); PG8_STAGE(PG8_SB(1, 1), b3 + hstepB, voffB); PG8_STAGE(PG8_SA(1, 0), a3, voffA);
            PG8_WAIT_V(8); PG8_WAIT_L(0); PG8_BAR; PG8_MMA(1, 0, At, B0); PG8_MMA(1, 1, At, B1); PG8_BAR; PG8_SCHED;
        }
        if constexpr (ALIGN_EPI) { if (wr == 0) PG8_BAR; }
        { int ln_; asm volatile("v_mbcnt_lo_u32_b32 %0, -1, 0\n\tv_mbcnt_hi_u32_b32 %0, -1, %0" : "=v"(ln_)); E(acc, cur, wr, wc, ln_ & 15, ln_ >> 4); }
        if (!has_next) break;
#pragma unroll
        for (int a = 0; a < 2; ++a)
#pragma unroll
            for (int b = 0; b < 2; ++b)
#pragma unroll
                for (int m = 0; m < 4; ++m)
#pragma unroll
                    for (int n = 0; n < 2; ++n) acc[a][b][m][n] = (f32x4){0.f, 0.f, 0.f, 0.f};
        cur = nxt; cA = nA; cB = nB; ++ui;
        { int t_; asm volatile("v_mbcnt_lo_u32_b32 %0, -1, 0\n\tv_mbcnt_hi_u32_b32 %0, -1, %0" : "=v"(t_)); t_ |= wid << 6; int R, C; stage_rc(t_ * 16, R, C); const int Rb = Epi::PERM ? ((R & ~31) + perm32(R & 31)) : R;
          voffA[0] = FP8 ? (unsigned)(R * g.lda + 2 * C) : (unsigned)(R * g.lda + C) * 2u; voffB[0] = FP8 ? (unsigned)(Rb * K + 2 * C) : (unsigned)(Rb * K + C) * 2u; }
        if constexpr (ALIGN_EPI) { if (wr == 1) PG8_BAR; }
    }
    PG8_WAIT_V(0);
    if constexpr (!ALIGN_EPI) { if (wr == 0) PG8_BAR; }
    PG8_BAR;
#undef PG8_SA
#undef PG8_SB
#undef PG8_STAGE
#undef PG8_LDA
#undef PG8_LDB
#undef PG8_MMA
#undef PG8_WAIT_V
#undef PG8_WAIT_L
#undef PG8_BAR
#undef PG8_SCHED
}
}
#define XB_TMO      128
#define XB_XCNT(j)  (256  + 64 * (j))
#define XB_XSUB(j)  (1280 + 64 * (j))
#define XB_XGEN(j)  (2304 + 64 * (j))
#define XB_TOP      3328
#define XB_TOPGEN   3392
#define XCD_BAR_WORDS 3456
#define XB_SPIN_CAP (1u << 18)

__device__ __forceinline__ unsigned xb_ld(unsigned* p)              { return __hip_atomic_load(p, __ATOMIC_RELAXED, __HIP_MEMORY_SCOPE_AGENT); }
__device__ __forceinline__ unsigned xb_add(unsigned* p, unsigned v) { return __hip_atomic_fetch_add(p, v, __ATOMIC_RELAXED, __HIP_MEMORY_SCOPE_AGENT); }
__device__ __forceinline__ unsigned xb_xcc_id() { return (unsigned)__builtin_amdgcn_s_getreg((3 << 11) | 20) & 0xFu; }
#define XB_SPIN(cond, bar) do { unsigned _sp = 0; while (cond) { __builtin_amdgcn_s_sleep(1); \
    if ((++_sp & 255u) == 0u) { if (xb_ld(&(bar)[XB_TMO])) break; if (_sp > XB_SPIN_CAP) { atomicAdd(&(bar)[XB_TMO], 1u); break; } } } } while (0)

struct XcdBarrier {
    unsigned* bar; unsigned x;
    volatile LAS unsigned* st;
};

__device__ __forceinline__ XcdBarrier xcd_barrier_post(unsigned* bar, volatile LAS unsigned* st) {
    XcdBarrier b; b.bar = bar; b.x = xb_xcc_id(); b.st = st;
    if (threadIdx.x == 0) (void)xb_add(&bar[XB_XCNT(b.x)], 1u);
    return b;
}
__device__ __forceinline__ void xcd_barrier_complete(unsigned* bar, unsigned x, unsigned& nloc, unsigned& nx) {
    const unsigned G = gridDim.x * gridDim.y * gridDim.z;
    unsigned sum, cnt, mine, sp = 0u;
    for (;;) {
        sum = 0u; cnt = 0u; mine = 0u;
#pragma unroll
        for (unsigned j = 0; j < 16; ++j) { const unsigned c = xb_ld(&bar[XB_XCNT(j)]); sum += c; cnt += (c > 0u) ? 1u : 0u; mine = (j == x) ? c : mine; }
        if (sum == G) break;
        __builtin_amdgcn_s_sleep(1);
        if ((++sp & 255u) == 0u) { if (xb_ld(&bar[XB_TMO])) break; if (sp > XB_SPIN_CAP) { atomicAdd(&bar[XB_TMO], 1u); break; } }
    }
    nloc = mine > 0u ? mine : 1u; nx = cnt > 0u ? cnt : 1u;
}

__device__ __forceinline__ void xcd_barrier(const XcdBarrier& b) {
    asm volatile("s_waitcnt vmcnt(0)" ::: "memory");
    __syncthreads();
    if (threadIdx.x == 0) {
        unsigned* bar = b.bar;
        __builtin_amdgcn_s_waitcnt(0);
        unsigned nloc = b.st[0], nx = b.st[1];
        if (nloc == 0u) { xcd_barrier_complete(bar, b.x, nloc, nx); b.st[0] = nloc; b.st[1] = nx; }
        const unsigned old = xb_add(&bar[XB_XSUB(b.x)], 1u);
        const unsigned gen = old / nloc;
        if (old + 1u == (gen + 1u) * nloc) {
            __builtin_amdgcn_fence(__ATOMIC_RELEASE, "agent");
            asm volatile("s_waitcnt vmcnt(0)" ::: "memory");
            const unsigned og = xb_add(&bar[XB_TOP], 1u);
            const unsigned tg = og / nx;
            if (og + 1u == (tg + 1u) * nx) xb_add(&bar[XB_TOPGEN], 1u);
            else XB_SPIN(xb_ld(&bar[XB_TOPGEN]) == tg, bar);
            __builtin_amdgcn_fence(__ATOMIC_ACQUIRE, "agent");
            xb_add(&bar[XB_XGEN(b.x)], 1u);
            asm volatile("s_waitcnt vmcnt(0)" ::: "memory");
        } else {
            XB_SPIN(xb_ld(&bar[XB_XGEN(b.x)]) == gen, bar);
            __builtin_amdgcn_fence(__ATOMIC_ACQUIRE, "agent");
            asm volatile("s_waitcnt vmcnt(0)" ::: "memory");
        }
    }
    __syncthreads();
}

constexpr int NWAVES = 8, NTHR = 512;
constexpr int D = 1024, BATCH = 2, SEQ = 16384, NMETA = 16;
constexpr int MMAIN = BATCH * SEQ;
constexpr int MROWS = MMAIN + NMETA;
constexpr int MPAD = MMAIN + 256;
constexpr int RGW = 1344, RGBW = 168, NRG = 2816  , KRGO = 1408  , NGT = 4096, KGT = 256, XCW = 2048;
constexpr int FF = 3584, NE = 8, NFF2 = 2 * FF;
constexpr int GH = 4, GDK = 128, GDV = 256, GQK = 512, GVD = 1024, NGLA = 3072, GLAW = 3088, GRANK = 16;
constexpr int MSORT = 265 * 256;
constexpr float LN_EPS = 1e-5f, ALPHA = 1.6817928305074290f;
constexpr int SEG = 128, NSEG_B = SEQ / SEG, NSEG = 1 + BATCH * NSEG_B;
constexpr int CPS = 8, NSC_BH = SEQ / (64 * CPS), NGU = BATCH * GH * NSC_BH + GH;

constexpr size_t MiB = 1u << 20;
constexpr size_t WS_CTL = 0, CTL_ZERO_BYTES = 1 * MiB;
constexpr size_t WL_RGIN = 0, WL_GATES = WL_RGIN + (size_t)NRG * D * 2, WL_RGOUT = WL_GATES + (size_t)NGT * KGT * 2, WL_GLAIN = WL_RGOUT + (size_t)D * KRGO * 2,
                 WL_GLAOUT = WL_GLAIN + (size_t)NGLA * D * 2, WL_FFNIN = WL_GLAOUT + (size_t)D * D * 2, WL_FFNOUT = WL_FFNIN + (size_t)NFF2 * D * 2,
                 WL_MOEIN = WL_FFNOUT + (size_t)D * FF * 2, WL_MOEOUT = WL_MOEIN + (size_t)NE * NFF2 * D * 2, WL_STRIDE = WL_MOEOUT + (size_t)NE * D * FF * 2;
constexpr size_t WS_W = 1 * MiB;
constexpr size_t WS_H = WS_W + 2 * WL_STRIDE;
constexpr size_t WS_HB = WS_H + (size_t)MPAD * D * 4;
constexpr size_t WS_MIX = WS_HB + (size_t)MPAD * D * 2;
constexpr size_t WS_Z = WS_MIX + (size_t)MPAD * D * 4;
constexpr size_t WS_RT = WS_Z + 3 * MiB;
constexpr size_t WS_AGG = WS_RT + 1 * MiB;
constexpr size_t WS_S0 = WS_AGG + 3 * MiB;
constexpr size_t S_PROJ = 0, S_XC = S_PROJ + (size_t)MPAD * NRG * 2, S_LOGA = S_XC + (size_t)MPAD * XCW * 2, S_U = S_LOGA + (size_t)MPAD * RGW * 4, S_Y = S_U + (size_t)MPAD * RGW * 4, S_RG_END = S_Y + (size_t)MPAD * KRGO * 2;
constexpr size_t S_HID = 0;
constexpr size_t S_QKVR = 0, S_KVS = S_QKVR + (size_t)MPAD * NGLA * 2, S_SST = S_KVS + (size_t)NGU * GDK * GDV * 4, S_O = S_SST + (size_t)NGU * GDK * GDV * 4, S_DEC = S_O + (size_t)MPAD * D * 2, S_XB = S_DEC + 1 * MiB, S_EMF = S_XB + (size_t)(BATCH * GH * (SEQ / 64) + GH) * 64 * GDK * 4, S_GLA_END = S_EMF + 3 * MiB;
constexpr size_t S_AS = 0, S_HS = S_AS + (size_t)MSORT * D * 2, S_YS = S_HS + (size_t)MSORT * FF * 2, S_MOE_END = S_YS + (size_t)MSORT * D * 4;
constexpr size_t S_MAX = S_RG_END > S_MOE_END ? (S_RG_END > S_GLA_END ? S_RG_END : S_GLA_END) : (S_MOE_END > S_GLA_END ? S_MOE_END : S_GLA_END);
constexpr size_t WS_END = WS_S0 + S_MAX;
constexpr int CW_TMO = 0, CW_BAR = 4096, CW_MOE = 8192;

constexpr int LDS_BYTES = 163840, MISC_OFF = LDS_BYTES - 64;

struct Frame {
    LAS unsigned char* lds; gu32* ctl; unsigned char* ws;
    int tid, lane, wave, G, bx; unsigned long long dbg_acc;
    __device__ __forceinline__ void fresh() { asm volatile("" : "+s"(wave)); asm volatile("" : "+s"(bx)); asm volatile("" : "+s"(ws));
        asm volatile("v_mbcnt_lo_u32_b32 %0, -1, 0\n\tv_mbcnt_hi_u32_b32 %0, -1, %0" : "=v"(lane));
        tid = (wave << 6) | lane; ctl = (gu32*)(ws + WS_CTL); }
};
struct Args { const float* in[21]; float* out; unsigned char* ws; int ph_lo, ph_hi; unsigned submask; int pad; };

struct EpiBf16Gelu {
    static constexpr bool PERM = true, PAIR = false;
    bf16* O; int ldc, gelu_cols; float sc = 1.0f;
    __device__ __forceinline__ void operator()(const f32x4 (&acc)[2][2][4][2], const pg8::Unit& u, int wr, int wc, int fr, int fq) const {
        const int row0 = u.pm * 256 + wr * 64 + fr, col0 = u.pn * 256 + wc * 32 + 8 * fq;
        float scl = sc; asm volatile("" : "+v"(scl));
#pragma unroll
        for (int ai = 0; ai < 2; ++ai)
#pragma unroll
            for (int m = 0; m < 4; ++m) { bf16* rowp = O + (size_t)(row0 + ai * 128 + m * 16) * ldc + col0;
#pragma unroll
                for (int bj = 0; bj < 2; ++bj) { f32x4 v0 = acc[ai][bj][m][0] * scl, v1 = acc[ai][bj][m][1] * scl;
                    if (col0 + bj * 128 < gelu_cols) {
#pragma unroll
                        for (int j = 0; j < 4; ++j) { v0[j] = gelu_tanh_f(v0[j]); v1[j] = gelu_tanh_f(v1[j]); } }
                    v4u w; w.x = cvt_pk_bf16(v0[0], v0[1]); w.y = cvt_pk_bf16(v0[2], v0[3]); w.z = cvt_pk_bf16(v1[0], v1[1]); w.w = cvt_pk_bf16(v1[2], v1[3]);
                    *(v4u*)(rowp + bj * 128) = w; } }
    }
    __device__ __forceinline__ void meta_task(int task, int& r0, int& aoff) const { r0 = task * 16; aoff = 0; }
    __device__ __forceinline__ void meta(int task, f32x4 a0, f32x4, int fr, int fq) const {
        const int col = task * 16 + 4 * fq;
        if (col < gelu_cols) {
#pragma unroll
            for (int j = 0; j < 4; ++j) a0[j] = gelu_tanh_f(a0[j]); }
        v2u w; w.x = cvt_pk_bf16(a0[0], a0[1]); w.y = cvt_pk_bf16(a0[2], a0[3]);
        *(v2u*)(O + (size_t)(MMAIN + fr) * ldc + col) = w;
    }
};
struct EpiSwiglu {
    static constexpr bool PERM = true, PAIR = true;
    bf16* O; int ldc; float sc;
    __device__ __forceinline__ void operator()(const f32x4 (&acc)[2][2][4][2], const pg8::Unit& u, int wr, int wc, int fr, int fq) const {
        const int row0 = u.pm * 256 + wr * 64 + fr, col0 = u.pn * 128 + wc * 32 + 8 * fq;
        float scl = sc; asm volatile("" : "+v"(scl));
#pragma unroll
        for (int ai = 0; ai < 2; ++ai)
#pragma unroll
            for (int m = 0; m < 4; ++m) { bf16* rowp = O + (size_t)(row0 + ai * 128 + m * 16) * ldc + col0;
                f32x4 g0 = acc[ai][0][m][0] * scl, g1 = acc[ai][0][m][1] * scl; const f32x4 u0 = acc[ai][1][m][0] * scl, u1 = acc[ai][1][m][1] * scl;
#pragma unroll
                for (int j = 0; j < 4; ++j) { g0[j] = silu_f(g0[j]) * u0[j]; g1[j] = silu_f(g1[j]) * u1[j]; }
                v4u w; w.x = cvt_pk_bf16(g0[0], g0[1]); w.y = cvt_pk_bf16(g0[2], g0[3]); w.z = cvt_pk_bf16(g1[0], g1[1]); w.w = cvt_pk_bf16(g1[2], g1[3]);
                *(v4u*)rowp = w; }
    }
    __device__ __forceinline__ void meta_task(int task, int& r0, int& aoff) const { r0 = (task >> 3) * 256 + (task & 7) * 16; aoff = 0; }
    __device__ __forceinline__ void meta(int task, f32x4 a0, f32x4 a1, int fr, int fq) const {
        const int col = (task >> 3) * 128 + (task & 7) * 16 + 4 * fq;
#pragma unroll
        for (int j = 0; j < 4; ++j) a0[j] = silu_f(a0[j] * sc) * (a1[j] * sc);
        v2u w; w.x = cvt_pk_bf16(a0[0], a0[1]); w.y = cvt_pk_bf16(a0[2], a0[3]);
        *(v2u*)(O + (size_t)(MMAIN + fr) * ldc + col) = w;
    }
};
struct EpiSwigluF8 {
    static constexpr bool PERM = true, PAIR = true;
    unsigned char* O; int ldc; float sc, osc;
    __device__ __forceinline__ void operator()(const f32x4 (&acc)[2][2][4][2], const pg8::Unit& u, int wr, int wc, int fr, int fq) const {
        const int row0 = u.pm * 256 + wr * 64 + fr, col0 = u.pn * 128 + wc * 32 + 8 * fq;
        float scl = sc, oscl = osc; asm volatile("" : "+v"(scl), "+v"(oscl));
#pragma unroll
        for (int ai = 0; ai < 2; ++ai)
#pragma unroll
            for (int m = 0; m < 4; ++m) { unsigned char* rowp = O + (size_t)(row0 + ai * 128 + m * 16) * ldc + col0;
                f32x4 g0 = acc[ai][0][m][0] * scl, g1 = acc[ai][0][m][1] * scl; const f32x4 u0 = acc[ai][1][m][0] * scl, u1 = acc[ai][1][m][1] * scl;
#pragma unroll
                for (int j = 0; j < 4; ++j) { g0[j] = silu_f(g0[j]) * u0[j] * oscl; g1[j] = silu_f(g1[j]) * u1[j] * oscl; }
                *(v2u*)rowp = (v2u){pk4_fp8(g0[0], g0[1], g0[2], g0[3]), pk4_fp8(g1[0], g1[1], g1[2], g1[3])}; }
    }
};
struct EpiF32 {
    static constexpr bool PERM = false, PAIR = false;
    float* C; int ldc;
    __device__ __forceinline__ void operator()(const f32x4 (&acc)[2][2][4][2], const pg8::Unit& u, int wr, int wc, int fr, int fq) const {
        const int row0 = u.pm * 256 + wr * 64 + fr, col0 = u.pn * 256 + wc * 32 + 4 * fq;
#pragma unroll
        for (int ai = 0; ai < 2; ++ai)
#pragma unroll
            for (int m = 0; m < 4; ++m) { float* rowp = C + (size_t)(row0 + ai * 128 + m * 16) * ldc + col0;
#pragma unroll
                for (int bj = 0; bj < 2; ++bj)
#pragma unroll
                    for (int n = 0; n < 2; ++n) *(f32x4*)(rowp + bj * 128 + n * 16) = acc[ai][bj][m][n]; }
    }
    __device__ __forceinline__ void meta_task(int task, int& r0, int& aoff) const { r0 = task * 16; aoff = 0; }
    __device__ __forceinline__ void meta(int task, f32x4 a0, f32x4, int fr, int fq) const { *(f32x4*)(C + (size_t)(MMAIN + fr) * ldc + task * 16 + 4 * fq) = a0; }
};

template <class Epi>
__device__ __forceinline__ void meta_gemm(Frame& F, const bf16* A16, int lda, int K, const bf16* Bt, int ntasks, const Epi& E) {
    const int fr = F.lane & 15, fq = F.lane >> 4;
    LAS f32x4* red = (LAS f32x4*)F.lds;
    for (int task = F.bx; task < ntasks; task += F.G) {
        int r0, aoff; E.meta_task(task, r0, aoff);
        f32x4 acc0 = (f32x4){0.f, 0.f, 0.f, 0.f}, acc1 = acc0;
        const bf16* ap = A16 + (size_t)fr * lda + aoff + fq * 8; const bf16* bp0 = Bt + (size_t)(r0 + fr) * K + fq * 8; const bf16* bp1 = bp0 + (size_t)128 * K;
        const int nks = K / 32;
        for (int ks0 = F.wave; ks0 < nks; ks0 += 4 * NWAVES) {
            bf16x8 a[4], b0[4], b1[4];
#pragma unroll
            for (int t = 0; t < 4; ++t) { const int ks = ks0 + t * NWAVES; const int kc = ks < nks ? ks : F.wave;
                a[t] = *(const bf16x8*)(ap + kc * 32); b0[t] = *(const bf16x8*)(bp0 + kc * 32); if (Epi::PAIR) b1[t] = *(const bf16x8*)(bp1 + kc * 32); }
#pragma unroll
            for (int t = 0; t < 4; ++t) { if (ks0 + t * NWAVES < nks) {
                acc0 = __builtin_amdgcn_mfma_f32_16x16x32_bf16(b0[t], a[t], acc0, 0, 0, 0);
                if (Epi::PAIR) acc1 = __builtin_amdgcn_mfma_f32_16x16x32_bf16(b1[t], a[t], acc1, 0, 0, 0); } }
        }
        red[(F.wave * 2 + 0) * 64 + F.lane] = acc0; if (Epi::PAIR) red[(F.wave * 2 + 1) * 64 + F.lane] = acc1;
        __syncthreads();
        if (F.wave == 0) {
            f32x4 s0 = red[F.lane], s1 = Epi::PAIR ? red[64 + F.lane] : acc1;
#pragma unroll
            for (int w = 1; w < NWAVES; ++w) { s0 += red[(w * 2) * 64 + F.lane]; if (Epi::PAIR) s1 += red[(w * 2 + 1) * 64 + F.lane]; }
            E.meta(task, s0, s1, fr, fq);
        }
        __syncthreads();
    }
}

__device__ __forceinline__ void transpose_item(const float* W, int ldw, int Ksrc, int c0, int nvalid, bf16* WT, int Kdst, int n0, int k0, LAS float* scr, int lane) {
#pragma unroll 8
    for (int i = 0; i < 32; ++i) { const int kk = 2 * i + (lane >> 5), c = lane & 31;
        const bool ok = (k0 + kk < Ksrc) && (c < nvalid); const float v = W[ok ? (size_t)(k0 + kk) * ldw + c0 + c : (size_t)0];
        scr[kk * 33 + c] = ok ? v : 0.f; }
    LDS_WAIT(); asm volatile("" ::: "memory");
    const int c = lane & 7;
#pragma unroll
    for (int j = 0; j < 4; ++j) { const int n = (lane >> 3) + 8 * j; const LAS float* s = scr + (8 * c) * 33 + n;
        v4u o; o.x = pk2(s[0 * 33], s[1 * 33]); o.y = pk2(s[2 * 33], s[3 * 33]); o.z = pk2(s[4 * 33], s[5 * 33]); o.w = pk2(s[6 * 33], s[7 * 33]);
        *(v4u*)(WT + (size_t)(n0 + n) * Kdst + k0 + 8 * c) = o; }
    LDS_WAIT(); asm volatile("" ::: "memory");
}
__device__ __forceinline__ void transpose_item_fp8(const float* W, int ldw, int Ksrc, int c0, int nvalid, unsigned char* WT, int Kdst, int n0, int k0, float scale, LAS float* scr, int lane) {
#pragma unroll 8
    for (int i = 0; i < 32; ++i) { const int kk = 2 * i + (lane >> 5), c = lane & 31;
        const bool ok = (k0 + kk < Ksrc) && (c < nvalid); const float v = W[ok ? (size_t)(k0 + kk) * ldw + c0 + c : (size_t)0];
        scr[kk * 33 + c] = ok ? v * scale : 0.f; }
    LDS_WAIT(); asm volatile("" ::: "memory");
    const int c4 = lane & 3;
#pragma unroll
    for (int j = 0; j < 2; ++j) { const int n = (lane >> 2) + 16 * j; const LAS float* sp = scr + (16 * c4) * 33 + n;
        v4u o; o.x = pk4_fp8(sp[0 * 33], sp[1 * 33], sp[2 * 33], sp[3 * 33]); o.y = pk4_fp8(sp[4 * 33], sp[5 * 33], sp[6 * 33], sp[7 * 33]);
        o.z = pk4_fp8(sp[8 * 33], sp[9 * 33], sp[10 * 33], sp[11 * 33]); o.w = pk4_fp8(sp[12 * 33], sp[13 * 33], sp[14 * 33], sp[15 * 33]);
        *(v4u*)(WT + (size_t)(n0 + n) * Kdst + k0 + 16 * c4) = o; }
    LDS_WAIT(); asm volatile("" ::: "memory");
}
__device__ __forceinline__ void map_id(int n0, int nsrc, int& c0, int& nv) { c0 = n0; nv = nsrc - n0; nv = nv < 0 ? 0 : (nv > 32 ? 32 : nv); if (nv == 0) c0 = 0; }
__device__ __forceinline__ void map_swiglu(int n0, int& c0, int& nv) { const int tile = n0 >> 8, rr = n0 & 255; c0 = rr < 128 ? tile * 128 + rr : FF + tile * 128 + rr - 128; nv = 32; }

__device__ __forceinline__ void p0_prologue(Frame& F, const Args& a) {
    LAS float* scr = (LAS float*)(F.lds + F.wave * 16384);
    const int gw = F.bx * NWAVES + F.wave, NGW = F.G * NWAVES;
    constexpr int I_RGIN = (D / 64) * (NRG / 32), I_GATES = (KGT / 64) * (NGT / 32), I_RGOUT = (KRGO / 64) * (D / 32), I_GLAIN = (D / 64) * (NGLA / 32), I_GLAOUT = (D / 64) * (D / 32),
                  I_FFNIN = (D / 64) * (NFF2 / 32), I_FFNOUT = (FF / 64) * (D / 32), I_MOEIN = NE * I_FFNIN, I_MOEOUT = NE * I_FFNOUT;
    constexpr int I_PER_J = I_RGIN + I_GATES + I_RGOUT + I_GLAIN + I_GLAOUT + I_FFNIN + I_FFNOUT + I_MOEIN + I_MOEOUT;
    for (int it = gw; it < 2 * I_PER_J; it += NGW) {
        const int j = it / I_PER_J; int r = it - j * I_PER_J;
        unsigned char* wl = F.ws + WS_W + (size_t)j * WL_STRIDE;
        int c0, nv;
        if (r < I_RGIN) { const int nb = r % (NRG / 32), kb = r / (NRG / 32); map_id(nb * 32, 2 * RGW, c0, nv);
            transpose_item(a.in[4] + (size_t)j * D * 2 * RGW, 2 * RGW, D, c0, nv, (bf16*)(wl + WL_RGIN), D, nb * 32, kb * 64, scr, F.lane); continue; } r -= I_RGIN;
        if (r < I_GATES) { const int nb = r % (NGT / 32), kb = r / (NGT / 32); const int n0 = nb * 32, pn = n0 >> 8, rr = n0 & 255, g = rr >> 7, cc = rr & 127, d0 = (pn & 1) * 128 + cc, blk = pn >> 1;
            nv = RGBW - d0; nv = nv < 0 ? 0 : (nv > 32 ? 32 : nv); c0 = nv ? d0 : 0;
            transpose_item(a.in[7] + ((size_t)(j * 2 + g) * 8 + blk) * RGBW * RGBW, RGBW, RGBW, c0, nv, (bf16*)(wl + WL_GATES), KGT, n0, kb * 64, scr, F.lane); continue; } r -= I_GATES;
        if (r < I_RGOUT) { const int nb = r % (D / 32), kb = r / (D / 32);
            transpose_item(a.in[10] + (size_t)j * RGW * D, D, RGW, nb * 32, 32, (bf16*)(wl + WL_RGOUT), KRGO, nb * 32, kb * 64, scr, F.lane); continue; } r -= I_RGOUT;
        if (r < I_GLAIN) { const int nb = r % (NGLA / 32), kb = r / (NGLA / 32);
            transpose_item(a.in[11] + (size_t)j * D * GLAW, GLAW, D, nb * 32, 32, (bf16*)(wl + WL_GLAIN), D, nb * 32, kb * 64, scr, F.lane); continue; } r -= I_GLAIN;
        if (r < I_GLAOUT) { const int nb = r % (D / 32), kb = r / (D / 32);
            transpose_item(a.in[15] + (size_t)j * D * D, D, D, nb * 32, 32, (bf16*)(wl + WL_GLAOUT), D, nb * 32, kb * 64, scr, F.lane); continue; } r -= I_GLAOUT;
        if (r < I_FFNIN) { const int nb = r % (NFF2 / 32), kb = r / (NFF2 / 32); map_swiglu(nb * 32, c0, nv);
            transpose_item(a.in[16] + (size_t)j * D * NFF2, NFF2, D, c0, nv, (bf16*)(wl + WL_FFNIN), D, nb * 32, kb * 64, scr, F.lane); continue; } r -= I_FFNIN;
        if (r < I_FFNOUT) { const int nb = r % (D / 32), kb = r / (D / 32);
            transpose_item(a.in[17] + (size_t)j * FF * D, D, FF, nb * 32, 32, (bf16*)(wl + WL_FFNOUT), FF, nb * 32, kb * 64, scr, F.lane); continue; } r -= I_FFNOUT;
        if (r < I_MOEIN) { const int e = r / I_FFNIN, r2 = r % I_FFNIN; const int nb = r2 % (NFF2 / 32), kb = r2 / (NFF2 / 32); map_swiglu(nb * 32, c0, nv);
            transpose_item_fp8(a.in[19] + ((size_t)j * NE + e) * D * NFF2, NFF2, D, c0, nv, (unsigned char*)(wl + WL_MOEIN) + (size_t)e * NFF2 * D, D, nb * 32, kb * 64, 64.0f, scr, F.lane); continue; } r -= I_MOEIN;
        { const int e = r / I_FFNOUT, r2 = r % I_FFNOUT; const int nb = r2 % (D / 32), kb = r2 / (D / 32);
            transpose_item_fp8(a.in[20] + ((size_t)j * NE + e) * FF * D, D, FF, nb * 32, 32, (unsigned char*)(wl + WL_MOEOUT) + (size_t)e * D * FF, FF, nb * 32, kb * 64, 256.0f, scr, F.lane); }
    }
    bf16* HB = (bf16*)(F.ws + WS_HB);
    for (int m = gw; m < MROWS; m += NGW) {
        const float* src = m < MMAIN ? a.in[0] + (size_t)m * D : a.in[1] + (size_t)(m - MMAIN) * D;
#pragma unroll
        for (int q = 0; q < 4; ++q) { const f32x4 v = *(const f32x4*)(src + 4 * F.lane + 256 * q);
            v2u w; w.x = pk2(v[0], v[1]); w.y = pk2(v[2], v[3]); *(v2u*)(HB + (size_t)m * D + 4 * F.lane + 256 * q) = w; }
    }
}

struct LnRow { v4u h[2], a[2], b[2]; float w1, w2; };
__device__ __forceinline__ void unpack8(const v4u& w, float* o) { o[0] = bflo(w.x); o[1] = bfhi(w.x); o[2] = bflo(w.y); o[3] = bfhi(w.y); o[4] = bflo(w.z); o[5] = bfhi(w.z); o[6] = bflo(w.w); o[7] = bfhi(w.w); }
__device__ __forceinline__ void ln_phase(Frame& F, int mixkind, const float* gam, const float* bet, int extra, const float* Wx, int ldx, float* outp, gu32* moe_cnt) {
    bf16* HB = (bf16*)(F.ws + WS_HB); const bf16* MIX = (const bf16*)(F.ws + WS_MIX);
    const bf16* YS = (const bf16*)(F.ws + WS_S0 + S_YS);
    int* E1 = (int*)(F.ws + WS_RT); int* E2 = E1 + MROWS; float* W1 = (float*)(E2 + MROWS); float* W2 = W1 + MROWS; int* POS1 = (int*)(W2 + MROWS); int* POS2 = POS1 + MROWS;
    float* Z = (float*)(F.ws + WS_Z);
    LAS float* WL = (LAS float*)F.lds;
    LAS unsigned* lcnt = (LAS unsigned*)(F.lds + 65536);
    const int NC = extra == 1 ? 16 : (extra == 2 ? 8 : 0);
    if (extra) { for (int i = F.tid; i < NC * D; i += NTHR) { const int c = i / NC, e = i - c * NC; WL[e * D + c] = Wx[(size_t)c * ldx + e]; }
        if (F.tid < 8) lcnt[F.tid] = 0u;
        __syncthreads(); }
    const int gw = F.bx * NWAVES + F.wave, NGW = F.G * NWAVES, lane = F.lane;
    float gv[16], bv[16];
#pragma unroll
    for (int q = 0; q < 2; ++q)
#pragma unroll
        for (int t = 0; t < 2; ++t) { const f32x4 g4 = *(const f32x4*)(gam + 512 * q + 8 * lane + 4 * t), b4 = *(const f32x4*)(bet + 512 * q + 8 * lane + 4 * t);
#pragma unroll
            for (int k = 0; k < 4; ++k) { gv[8 * q + 4 * t + k] = g4[k]; bv[8 * q + 4 * t + k] = b4[k]; } }
    unsigned mycnt = 0u;
    auto ln_load = [&](LnRow (&R)[2], int m0) {
#pragma unroll
        for (int r = 0; r < 2; ++r) { const int m = m0 + r * NGW; if (m < MROWS) {
            const bf16* hp = HB + (size_t)m * D + 8 * lane; R[r].h[0] = *(const v4u*)hp; R[r].h[1] = *(const v4u*)(hp + 512);
            if (mixkind == 1) { const bf16* mp = MIX + (size_t)m * D + 8 * lane; R[r].a[0] = *(const v4u*)mp; R[r].a[1] = *(const v4u*)(mp + 512); }
            if (mixkind == 2) { R[r].w1 = W1[m]; R[r].w2 = W2[m]; const bf16* y1 = YS + (size_t)POS1[m] * D + 8 * lane; const bf16* y2 = YS + (size_t)POS2[m] * D + 8 * lane;
                R[r].a[0] = *(const v4u*)y1; R[r].a[1] = *(const v4u*)(y1 + 512); R[r].b[0] = *(const v4u*)y2; R[r].b[1] = *(const v4u*)(y2 + 512); } } }
    };
    LnRow Rn[2];
    ln_load(Rn, gw);
    for (int m0 = gw; m0 < MROWS; m0 += 2 * NGW) {
        LnRow R[2];
#pragma unroll
        for (int r = 0; r < 2; ++r) R[r] = Rn[r];
        ln_load(Rn, m0 + 2 * NGW);
#pragma unroll
        for (int r = 0; r < 2; ++r) { const int m = m0 + r * NGW; if (m < MROWS) {
            float v[16]; unpack8(R[r].h[0], v); unpack8(R[r].h[1], v + 8);
#pragma unroll
            for (int k = 0; k < 16; ++k) v[k] *= ALPHA;
            if (mixkind == 1) { float t[16]; unpack8(R[r].a[0], t); unpack8(R[r].a[1], t + 8);
#pragma unroll
                for (int k = 0; k < 16; ++k) v[k] += t[k]; }
            if (mixkind == 2) { float t[16], u[16]; unpack8(R[r].a[0], t); unpack8(R[r].a[1], t + 8); unpack8(R[r].b[0], u); unpack8(R[r].b[1], u + 8);
#pragma unroll
                for (int k = 0; k < 16; ++k) v[k] += t[k] * R[r].w1 + u[k] * R[r].w2; }
            float s = 0.f;
#pragma unroll
            for (int k = 0; k < 16; ++k) s += v[k];
            const float mean = wave_sum(s, lane) * (1.f / D); float s2 = 0.f;
#pragma unroll
            for (int k = 0; k < 16; ++k) { v[k] -= mean; s2 += v[k] * v[k]; }
            const float rstd = __builtin_amdgcn_rsqf(wave_sum(s2, lane) * (1.f / D) + LN_EPS);
#pragma unroll
            for (int k = 0; k < 16; ++k) v[k] = v[k] * rstd * gv[k] + bv[k];
            bf16* op = HB + (size_t)m * D + 8 * lane;
            *(v4u*)op = (v4u){pk2(v[0], v[1]), pk2(v[2], v[3]), pk2(v[4], v[5]), pk2(v[6], v[7])}; *(v4u*)(op + 512) = (v4u){pk2(v[8], v[9]), pk2(v[10], v[11]), pk2(v[12], v[13]), pk2(v[14], v[15])};
            if (outp && m < MMAIN) { float* o = outp + (size_t)m * D + 8 * lane;
                *(f32x4*)o = (f32x4){v[0], v[1], v[2], v[3]}; *(f32x4*)(o + 4) = (f32x4){v[4], v[5], v[6], v[7]}; *(f32x4*)(o + 512) = (f32x4){v[8], v[9], v[10], v[11]}; *(f32x4*)(o + 516) = (f32x4){v[12], v[13], v[14], v[15]}; }
            if (extra) {
                float pp[16];
#pragma unroll
                for (int e = 0; e < 16; ++e) { pp[e] = 0.f; if (e < NC) { float p = 0.f;
#pragma unroll
                        for (int q = 0; q < 2; ++q) { const f32x4 w0 = *(const LAS f32x4*)(WL + e * D + 512 * q + 8 * lane), w1 = *(const LAS f32x4*)(WL + e * D + 512 * q + 8 * lane + 4);
                            p += (v[8 * q + 0] * w0[0] + v[8 * q + 1] * w0[1]) + (v[8 * q + 2] * w0[2] + v[8 * q + 3] * w0[3]) + (v[8 * q + 4] * w1[0] + v[8 * q + 5] * w1[1]) + (v[8 * q + 6] * w1[2] + v[8 * q + 7] * w1[3]); }
                        pp[e] = p; } }
                float lg[8]; float zv;
                if (extra == 1) {
#pragma unroll
                    for (int k = 0; k < 8; ++k) { const bool up = lane & 32; const float snd = up ? pp[k] : pp[k + 8], kp = up ? pp[k + 8] : pp[k]; pp[k] = kp + shx(snd, 32, lane); }
#pragma unroll
                    for (int k = 0; k < 4; ++k) { const bool up = lane & 16; const float snd = up ? pp[k] : pp[k + 4], kp = up ? pp[k + 4] : pp[k]; pp[k] = kp + shx(snd, 16, lane); }
#pragma unroll
                    for (int k = 0; k < 2; ++k) { const bool up = lane & 8; const float snd = up ? pp[k] : pp[k + 2], kp = up ? pp[k + 2] : pp[k]; pp[k] = kp + shx(snd, 8, lane); }
                    { const bool up = lane & 4; const float snd = up ? pp[0] : pp[1], kp = up ? pp[1] : pp[0]; zv = kp + shx(snd, 4, lane); }
                    zv += shx(zv, 2, lane); zv += shx(zv, 1, lane);
                } else {
#pragma unroll
                    for (int k = 0; k < 4; ++k) { const bool up = lane & 32; const float snd = up ? pp[k] : pp[k + 4], kp = up ? pp[k + 4] : pp[k]; pp[k] = kp + shx(snd, 32, lane); }
#pragma unroll
                    for (int k = 0; k < 2; ++k) { const bool up = lane & 16; const float snd = up ? pp[k] : pp[k + 2], kp = up ? pp[k + 2] : pp[k]; pp[k] = kp + shx(snd, 16, lane); }
                    float rv; { const bool up = lane & 8; const float snd = up ? pp[0] : pp[1], kp = up ? pp[1] : pp[0]; rv = kp + shx(snd, 8, lane); }
                    rv += shx(rv, 4, lane); rv += shx(rv, 2, lane); rv += shx(rv, 1, lane);
#pragma unroll
                    for (int e = 0; e < 8; ++e) lg[e] = __int_as_float(__builtin_amdgcn_readlane(__float_as_int(rv), ((e >> 2) & 1) * 32 + ((e >> 1) & 1) * 16 + (e & 1) * 8));
                }
                if (extra == 1) { if ((lane & 3) == 0) Z[(size_t)m * 16 + ((lane >> 5) & 1) * 8 + ((lane >> 4) & 1) * 4 + ((lane >> 3) & 1) * 2 + ((lane >> 2) & 1)] = zv; }
                else { int e1 = 0; float l1 = lg[0];
#pragma unroll
                    for (int e = 1; e < 8; ++e) if (lg[e] > l1) { l1 = lg[e]; e1 = e; }
                    int e2 = -1; float l2 = -3.0e38f;
#pragma unroll
                    for (int e = 0; e < 8; ++e) if (e != e1 && lg[e] > l2) { l2 = lg[e]; e2 = e; }
                    const float w2 = 1.f / (1.f + __expf(l1 - l2)), w1 = 1.f - w2;
                    if (lane == 0) { E1[m] = e1; E2[m] = e2; W1[m] = w1; W2[m] = w2; }
                    mycnt += (lane == e1 || lane == e2) ? 1u : 0u; }
            } } }
    }
    if (extra == 2) { if (lane < 8 && mycnt) __hip_atomic_fetch_add(&lcnt[lane], mycnt, __ATOMIC_RELAXED, __HIP_MEMORY_SCOPE_WORKGROUP);
        __syncthreads();
        if (F.tid < 8 && lcnt[F.tid]) __hip_atomic_fetch_add(moe_cnt + F.tid, lcnt[F.tid], RLX_AGENT); }
}

struct EpiGates {
    static constexpr bool PERM = true, PAIR = true;
    bf16* LOGA; bf16* U; const bf16* XC; const float* bg; const float* lam;
    __device__ __forceinline__ void chan4(int ch, f32x4& br, f32x4& bi, f32x4& c8) const {
        br = *(const f32x4*)(bg + ch); bi = *(const f32x4*)(bg + RGW + ch); const f32x4 lm = *(const f32x4*)(lam + ch);
#pragma unroll
        for (int t = 0; t < 4; ++t) { const float x = __expf(-lm[t]); c8[t] = -8.0f * (x * (1.0f - x * (0.5f - x * (0.33333333f - 0.25f * x)))); }
    }
    __device__ __forceinline__ void elem4(int row, int blk, int d, f32x4 ra, f32x4 ia, const f32x4& br, const f32x4& bi, const f32x4& c8) const {
        const int ch = blk * RGBW + d;
        const v2u xw = *(const v2u*)(XC + (size_t)row * XCW + blk * 256 + d);
        const float xc[4] = {bflo(xw.x), bfhi(xw.x), bflo(xw.y), bfhi(xw.y)};
        f32x4 la, uu;
#pragma unroll
        for (int t = 0; t < 4; ++t) {
            const float r = sigmoid_f(ra[t] + br[t]), ig = sigmoid_f(ia[t] + bi[t]);
            const float l = c8[t] * r;
            const float a2 = fast_exp(2.0f * l);
            la[t] = l; uu[t] = __builtin_amdgcn_sqrtf(fmaxf(1.0f - a2, 0.f)) * (ig * xc[t]);
        }
        *(v2u*)(LOGA + (size_t)row * RGW + ch) = (v2u){pk2(la[0], la[1]), pk2(la[2], la[3])}; *(v2u*)(U + (size_t)row * RGW + ch) = (v2u){pk2(uu[0], uu[1]), pk2(uu[2], uu[3])};
    }
    __device__ __forceinline__ void elem8(int row, int blk, int d, f32x4 ra0, f32x4 ia0, f32x4 ra1, f32x4 ia1, const f32x4 (&br)[2], const f32x4 (&bi)[2], const f32x4 (&c8)[2]) const {
        const int ch = blk * RGBW + d;
        const v4u xw = *(const v4u*)(XC + (size_t)row * XCW + blk * 256 + d);
        float xc[8]; unpack8(xw, xc);
        float la[8], uu[8];
#pragma unroll
        for (int t = 0; t < 8; ++t) {
            const float rav = t < 4 ? ra0[t & 3] : ra1[t & 3], iav = t < 4 ? ia0[t & 3] : ia1[t & 3];
            const float r = sigmoid_f(rav + br[t >> 2][t & 3]), ig = sigmoid_f(iav + bi[t >> 2][t & 3]);
            const float l = c8[t >> 2][t & 3] * r;
            const float a2 = fast_exp(2.0f * l);
            la[t] = l; uu[t] = __builtin_amdgcn_sqrtf(fmaxf(1.0f - a2, 0.f)) * (ig * xc[t]);
        }
        *(v4u*)(LOGA + (size_t)row * RGW + ch) = (v4u){pk2(la[0], la[1]), pk2(la[2], la[3]), pk2(la[4], la[5]), pk2(la[6], la[7])};
        *(v4u*)(U + (size_t)row * RGW + ch) = (v4u){pk2(uu[0], uu[1]), pk2(uu[2], uu[3]), pk2(uu[4], uu[5]), pk2(uu[6], uu[7])};
    }
    __device__ __forceinline__ void operator()(const f32x4 (&acc)[2][2][4][2], const pg8::Unit& u, int wr, int wc, int fr, int fq) const {
        const int row0 = u.pm * 256 + wr * 64 + fr, blk = u.pn >> 1, d0 = (u.pn & 1) * 128 + wc * 32 + 8 * fq;
        if (d0 < RGBW) {
            f32x4 br[2], bi[2], c8[2]; chan4(blk * RGBW + d0, br[0], bi[0], c8[0]); chan4(blk * RGBW + d0 + 4, br[1], bi[1], c8[1]);
#pragma unroll
            for (int ai = 0; ai < 2; ++ai)
#pragma unroll
                for (int m = 0; m < 4; ++m) elem8(row0 + ai * 128 + m * 16, blk, d0, acc[ai][0][m][0], acc[ai][1][m][0], acc[ai][0][m][1], acc[ai][1][m][1], br, bi, c8); }
    }
    __device__ __forceinline__ void meta_task(int task, int& r0, int& aoff) const { const int pn = task >> 3; r0 = pn * 256 + (task & 7) * 16; aoff = (pn >> 1) * 256; }
    __device__ __forceinline__ void meta(int task, f32x4 a0, f32x4 a1, int fr, int fq) const {
        const int pn = task >> 3, d = (pn & 1) * 128 + (task & 7) * 16 + 4 * fq;
        if (d < RGBW) { f32x4 br, bi, c8; chan4((pn >> 1) * RGBW + d, br, bi, c8); elem4(MMAIN + fr, pn >> 1, d, a0, a1, br, bi, c8); }
    }
};

__device__ __forceinline__ int conv_src_row(int row, int delta) {
    if (row < MMAIN) { const int t = row & (SEQ - 1); return (t - delta >= 0) ? row - delta : MMAIN + NMETA + (t - delta); }
    const int jm = row - MMAIN; return (jm - delta >= 0) ? row - delta : -1;
}
__device__ __forceinline__ void rg_conv_phase(Frame& F, const float* cw, const float* cb) {
    const bf16* PROJ = (const bf16*)(F.ws + WS_S0 + S_PROJ); bf16* XC = (bf16*)(F.ws + WS_S0 + S_XC);
    const int g = F.tid & 255, blk = g >> 5, kk = (g & 31) * 8, ch = blk * RGBW + kk;
    constexpr int NIT = (MROWS / 4) * 256;
    const int stride = F.G * NTHR;
    if (kk < RGBW) {
        float w[4][8], bb[8];
        { const f32x4 b0 = *(const f32x4*)(cb + ch), b1 = *(const f32x4*)(cb + ch + 4);
#pragma unroll
          for (int k = 0; k < 4; ++k) { bb[k] = b0[k]; bb[4 + k] = b1[k]; } }
#pragma unroll
        for (int tap = 0; tap < 4; ++tap) { const f32x4 w0 = *(const f32x4*)(cw + tap * RGW + ch), w1 = *(const f32x4*)(cw + tap * RGW + ch + 4);
#pragma unroll
            for (int k = 0; k < 4; ++k) { w[tap][k] = w0[k]; w[tap][4 + k] = w1[k]; } }
        for (int idx = F.bx * NTHR + F.tid; idx < NIT; idx += 2 * stride) {
            v4u x[2][7];
#pragma unroll
            for (int it = 0; it < 2; ++it) { const int id2 = idx + it * stride; if (id2 < NIT) { const int r0 = (id2 >> 8) * 4;
#pragma unroll
                for (int t = 0; t < 3; ++t) { const int rr = conv_src_row(r0, 3 - t); x[it][t] = (v4u){0u, 0u, 0u, 0u}; if (rr >= 0) x[it][t] = *(const v4u*)(PROJ + (size_t)rr * NRG + RGW + ch); }
#pragma unroll
                for (int t = 0; t < 4; ++t) x[it][3 + t] = *(const v4u*)(PROJ + (size_t)(r0 + t) * NRG + RGW + ch); } }
#pragma unroll
            for (int it = 0; it < 2; ++it) { const int id2 = idx + it * stride; if (id2 < NIT) { const int r0 = (id2 >> 8) * 4;
                bf16* xo = XC + (size_t)r0 * XCW + blk * 256 + kk;
                float xf[7][8];
#pragma unroll
                for (int t = 0; t < 7; ++t) unpack8(x[it][t], xf[t]);
#pragma unroll
                for (int i = 0; i < 4; ++i) { float a[8];
#pragma unroll
                    for (int k = 0; k < 8; ++k) a[k] = bb[k] + xf[i][k] * w[0][k] + xf[i + 1][k] * w[1][k] + xf[i + 2][k] * w[2][k] + xf[i + 3][k] * w[3][k];
                    *(v4u*)(xo + (size_t)i * XCW) = (v4u){pk2(a[0], a[1]), pk2(a[2], a[3]), pk2(a[4], a[5]), pk2(a[6], a[7])}; } } }
        }
    } else {
        for (int idx = F.bx * NTHR + F.tid; idx < NIT; idx += stride) { bf16* xo = XC + (size_t)((idx >> 8) * 4) * XCW + blk * 256 + kk;
#pragma unroll
            for (int i = 0; i < 4; ++i) *(v4u*)(xo + (size_t)i * XCW) = (v4u){0u, 0u, 0u, 0u}; }
    }
}
template <bool FIX>
__device__ __forceinline__ void rg_scan_phase(Frame& F) {
    const bf16* LOGA = (const bf16*)(F.ws + WS_S0 + S_LOGA); const bf16* U = (const bf16*)(F.ws + WS_S0 + S_U);
    const bf16* PROJ = (const bf16*)(F.ws + WS_S0 + S_PROJ); bf16* Y = (bf16*)(F.ws + WS_S0 + S_Y);
    float* AGGA = (float*)(F.ws + WS_AGG); float* AGGH = AGGA + (size_t)NSEG * RGW;
    const int gw = F.bx * NWAVES + F.wave, NGW = F.G * NWAVES;
    constexpr int NCG = 11, RB = FIX ? 16 : 32;
    for (int task = gw; task < NSEG * NCG; task += NGW) {
        const int seg = task / NCG, cg = task - seg * NCG, ch = cg * 128 + 2 * F.lane;
        const int row0 = seg == 0 ? MMAIN : (seg - 1) * SEG, nrows = seg == 0 ? NMETA : SEG;
        if (ch >= RGW) {
            if (FIX) for (int r = 0; r < nrows; ++r) *(unsigned*)(Y + (size_t)(row0 + r) * KRGO + ch) = 0u;
            continue;
        }
        float h0 = 0.f, h1 = 0.f, c0 = 0.f, c1 = 0.f;
        if (FIX && seg > 0) {
            { const f32x2 hm = *(const f32x2*)(AGGH + ch); h0 = hm[0]; h1 = hm[1]; }
            const int sb = 1 + ((seg - 1) / NSEG_B) * NSEG_B, ns = (seg - 1) % NSEG_B;
            for (int q = 0; q < ns; q += 8) { f32x2 aa[8], hh[8];
#pragma unroll
                for (int t = 0; t < 8; ++t) { const int qq = (q + t < ns) ? q + t : ns - 1; aa[t] = *(const f32x2*)(AGGA + (size_t)(sb + qq) * RGW + ch); hh[t] = *(const f32x2*)(AGGH + (size_t)(sb + qq) * RGW + ch); }
#pragma unroll
                for (int t = 0; t < 8; ++t) if (q + t < ns) { h0 = __expf(aa[t][0]) * h0 + hh[t][0]; h1 = __expf(aa[t][1]) * h1 + hh[t][1]; } }
        }
        for (int r = 0; r < nrows; r += RB) {
            unsigned la[RB], uu[RB], gt[RB];
#pragma unroll
            for (int t = 0; t < RB; ++t) { const int rr = row0 + ((r + t < nrows) ? r + t : nrows - 1); const size_t o = (size_t)rr * RGW + ch; la[t] = *(const unsigned*)(LOGA + o); uu[t] = *(const unsigned*)(U + o); if (FIX) gt[t] = *(const unsigned*)(PROJ + (size_t)rr * NRG + ch); }
#pragma unroll
            for (int t = 0; t < RB; ++t) if (r + t < nrows) { const float l0 = bflo(la[t]), l1 = bfhi(la[t]);
                h0 = __expf(l0) * h0 + bflo(uu[t]); h1 = __expf(l1) * h1 + bfhi(uu[t]); c0 += l0; c1 += l1;
                if (FIX) *(unsigned*)(Y + (size_t)(row0 + r + t) * KRGO + ch) = pk2(h0 * bflo(gt[t]), h1 * bfhi(gt[t])); }
        }
        if (!FIX) { *(f32x2*)(AGGA + (size_t)seg * RGW + ch) = (f32x2){c0, c1}; *(f32x2*)(AGGH + (size_t)seg * RGW + ch) = (f32x2){h0, h1}; }
    }
}

#define RG_PHASES \
        if (IN(pb + 0)) { if (on_rg) { \
            bf16* PROJ = (bf16*)(F.ws + WS_S0 + S_PROJ); EpiBf16Gelu E{PROJ, NRG, RGW}; \
            meta_gemm(F, HB + (size_t)MMAIN * D, D, D, (const bf16*)(wl + WL_RGIN), NRG / 16, E); \
            pg8::Gemm g{D, D}; pg8::DenseOrder S; S.init(HB, D, (const bf16*)(wl + WL_RGIN), D, MMAIN / 256, NRG / 256, F.G, F.bx); \
            pg8::gemm_phase<EpiBf16Gelu, pg8::DenseOrder>(F.lds, F.tid, g, S, E); } \
            SEAM(pb + 0); } \
        if (IN(pb + 1)) { if (on_rg) rg_conv_phase(F, args.in[5] + (size_t)j * 4 * RGW, args.in[6] + (size_t)j * RGW); SEAM(pb + 1); } \
        if (IN(pb + 2)) { if (on_rg) { \
            const bf16* XC = (const bf16*)(F.ws + WS_S0 + S_XC); \
            EpiGates E{(bf16*)(F.ws + WS_S0 + S_LOGA), (bf16*)(F.ws + WS_S0 + S_U), XC, args.in[8] + (size_t)j * 2 * RGW, args.in[9] + (size_t)j * RGW}; \
            meta_gemm(F, XC + (size_t)MMAIN * XCW, XCW, KGT, (const bf16*)(wl + WL_GATES), (NGT / 256) * 8, E); \
            pg8::Gemm g{KGT, XCW}; pg8::GatesOrder S; S.init(XC, XCW, (const bf16*)(wl + WL_GATES), KGT, MMAIN / 256, NGT / 256, F.G, F.bx); \
            pg8::gemm_phase<EpiGates, pg8::GatesOrder>(F.lds, F.tid, g, S, E); } \
            SEAM(pb + 2); } \
        if (IN(pb + 3)) { if (on_rg) rg_scan_phase<false>(F); SEAM(pb + 3); } \
        if (IN(pb + 4)) { if (on_rg) rg_scan_phase<true>(F); SEAM(pb + 4); } \
        if (IN(pb + 5)) { if (on_rg) { \
            const bf16* Y = (const bf16*)(F.ws + WS_S0 + S_Y); EpiBf16Gelu E{MIX, D, 0}; \
            meta_gemm(F, Y + (size_t)MMAIN * KRGO, KRGO, KRGO, (const bf16*)(wl + WL_RGOUT), D / 16, E); \
            pg8::Gemm g{KRGO, KRGO}; pg8::DenseOrder S; S.init(Y, KRGO, (const bf16*)(wl + WL_RGOUT), KRGO, MMAIN / 256, D / 256, F.G, F.bx); \
            pg8::gemm_phase<EpiBf16Gelu, pg8::DenseOrder>(F.lds, F.tid, g, S, E); } \
            SEAM(pb + 5); }

constexpr int GL_QT = 0, GL_KT = 17408  , GL_KTT = 34816, GL_VT = 53248, GL_ST = 90112  , GL_SM = 155648;
constexpr int QTS = 136, KTTS = 72, VTS = 72, PS = 72, BS = 129;
constexpr int GL_NG = GL_SM + 2048  , GL_WG = GL_NG + 1024  ;
static_assert(GL_WG + 4096 <= MISC_OFF, "GLA LDS map (unit constants)");
static_assert(GL_SM + 2560 <= MISC_OFF, "GLA LDS map");

#define GL_BAR() do { asm volatile("s_waitcnt lgkmcnt(0)" ::: "memory"); __builtin_amdgcn_s_barrier(); asm volatile("" ::: "memory"); __builtin_amdgcn_sched_barrier(0); } while (0)
template <int MODE>
__device__ __forceinline__ void gla_phase(Frame& F, const float* wgu, const float* bgate, const float* normg) {
    const bf16* QKVR = (const bf16*)(F.ws + WS_S0 + S_QKVR); const float* Z = (const float*)(F.ws + WS_Z);
    float* KVS = (float*)(F.ws + WS_S0 + S_KVS); const float* SST = (const float*)(F.ws + WS_S0 + S_SST); float* DEC = (float*)(F.ws + WS_S0 + S_DEC);
    bf16* O = (bf16*)(F.ws + WS_S0 + S_O);
    float* XB = (float*)(F.ws + WS_S0 + S_XB); float* EMF = (float*)(F.ws + WS_S0 + S_EMF);
    LAS bf16* QT = (LAS bf16*)(F.lds + GL_QT); LAS bf16* KT = (LAS bf16*)(F.lds + GL_KT); LAS bf16* PP = (LAS bf16*)(F.lds + GL_KT);
    LAS bf16* KTT = (LAS bf16*)(F.lds + GL_KTT); LAS bf16* VT = (LAS bf16*)(F.lds + GL_VT); LAS unsigned char* ST = F.lds + GL_ST;
    LAS float* Bc = (LAS float*)(F.lds + GL_ST); LAS float* ZC = (LAS float*)(F.lds + GL_ST + 36864); LAS float* TOT = (LAS float*)(F.lds + GL_ST + 40960); LAS float* OFFM = (LAS float*)(F.lds + GL_ST + 43520);
    LAS float* em = (LAS float*)(F.lds + GL_SM); LAS float* ef = em + 128; LAS float* stats = ef + 128;
    LAS float* NGL = (LAS float*)(F.lds + GL_NG); LAS bf16* WGL = (LAS bf16*)(F.lds + GL_WG);
    const int tid0 = F.tid;
#ifdef MK_GLA_SEG
    int glt_cur = -1; unsigned long long glt_t = 0ull;
#define GLT(n) do { if (MODE == (MK_GLA_MODE)) { const unsigned long long t_ = __builtin_amdgcn_s_memrealtime(); if (glt_cur == (MK_GLA_SEG)) F.dbg_acc += t_ - glt_t; glt_cur = (n); glt_t = t_; } } while (0)
#else
#define GLT(n)
#endif
    for (int u = F.bx; u < NGU; u += F.G) {
        const bool meta = u >= BATCH * GH * NSC_BH;
        const int h = meta ? u - BATCH * GH * NSC_BH : (u / NSC_BH) % GH, b = meta ? 0 : u / (GH * NSC_BH), sc = meta ? 0 : u % NSC_BH;
        const int nch = meta ? 1 : CPS;
        f32x4 sacc[8][2];
        int lofs = (4 * ((tid0 & 63) >> 4)) * GDV + 32 * (tid0 >> 6) + (tid0 & 15); asm volatile("" : "+v"(lofs));
#pragma unroll
        for (int dt = 0; dt < 8; ++dt)
#pragma unroll
            for (int i = 0; i < 2; ++i) {
                sacc[dt][i] = (f32x4){0.f, 0.f, 0.f, 0.f};
                if (MODE == 1 && !meta) {
#pragma unroll
                    for (int jj = 0; jj < 4; ++jj) sacc[dt][i][jj] = SST[(size_t)u * (GDK * GDV) + (size_t)((16 * dt + jj) * GDV + 16 * i) + lofs]; }
            }
        float dsum = 0.f;
        if (MODE == 1 && tid0 < 256) NGL[tid0] = normg[h * GDV + tid0];
        for (int i = tid0; i < 16 * GDK; i += NTHR) WGL[i] = (bf16)f2bf(wgu[(size_t)(i >> 7) * GQK + h * GDK + (i & 127)]);
        const float bgv = bgate[h * GDK + (tid0 & 127)];
        f32x4 px[4] = {(f32x4){0.f, 0.f, 0.f, 0.f}, (f32x4){0.f, 0.f, 0.f, 0.f}, (f32x4){0.f, 0.f, 0.f, 0.f}, (f32x4){0.f, 0.f, 0.f, 0.f}}; float pem = 0.f, pef = 0.f;
        f32x4 pz = (f32x4){0.f, 0.f, 0.f, 0.f}; v4u pq0 = (v4u){0u, 0u, 0u, 0u}, pq1 = pq0, pk0 = pq0, pk1 = pq0, pv[4] = {pq0, pq0, pq0, pq0};
#define GLA_PREFETCH(cix) do { const int rb_ = meta ? 0 : b * SEQ + (sc * CPS + (cix)) * 64; \
            const size_t chx_ = meta ? (size_t)(BATCH * GH * (SEQ / 64) + h) : (size_t)((b * GH + h) * (SEQ / 64) + sc * CPS + (cix)); \
            if (MODE == 1) { const float* xp_ = XB + chx_ * (64 * GDK) + (size_t)tid0 * 16; \
              _Pragma("unroll") for (int t_ = 0; t_ < 4; ++t_) px[t_] = *(const f32x4*)(xp_ + 4 * t_); \
              if (tid0 < 128) { pem = EMF[chx_ * 256 + tid0]; pef = EMF[chx_ * 256 + 128 + tid0]; } } \
            { const int c_ = tid0 >> 2, part_ = tid0 & 3; const bool ok_ = (tid0 < 256) && (!meta || c_ >= 48); const int row_ = meta ? MMAIN + c_ - 48 : rb_ + c_; \
              pz = (f32x4){0.f, 0.f, 0.f, 0.f}; if (MODE == 0 && ok_) pz = *(const f32x4*)(Z + (size_t)row_ * 16 + 4 * part_); } \
            { const int cC_ = tid0 & 63, g_ = tid0 >> 6; const bool ok_ = !meta || cC_ >= 48; const int row_ = meta ? MMAIN + cC_ - 48 : rb_ + cC_; const bf16* rp_ = QKVR + (size_t)row_ * NGLA; \
              pq0 = (v4u){0u, 0u, 0u, 0u}; pq1 = pq0; pk0 = pq0; pk1 = pq0; pv[0] = pq0; pv[1] = pq0; pv[2] = pq0; pv[3] = pq0; \
              if (ok_) { if (MODE == 1) { pq0 = *(const v4u*)(rp_ + h * GDK + g_ * 16); pq1 = *(const v4u*)(rp_ + h * GDK + g_ * 16 + 8); } \
                  pk0 = *(const v4u*)(rp_ + GQK + h * GDK + g_ * 16); pk1 = *(const v4u*)(rp_ + GQK + h * GDK + g_ * 16 + 8); \
                  _Pragma("unroll") for (int t_ = 0; t_ < 4; ++t_) pv[t_] = *(const v4u*)(rp_ + 2 * GQK + h * GDV + g_ * 32 + 8 * t_); } } } while (0)
        GLA_PREFETCH(0);
        for (int ci = 0; ci < nch; ++ci) {
            int tid = tid0; asm volatile("" : "+v"(tid));
            const int lane = tid & 63, w = __builtin_amdgcn_readfirstlane(tid >> 6), fr = lane & 15, fq = lane >> 4;
            const int rbase = meta ? 0 : b * SEQ + (sc * CPS + ci) * 64;
            GLT(0);
            const int dA = tid & 127, cgp = tid >> 7;
            const int cC = tid & 63, grp = tid >> 6, d0 = grp * 16, e0 = grp * 32;
            const v4u q0 = pq0, q1 = pq1, k0 = pk0, k1 = pk1, vv[4] = {pv[0], pv[1], pv[2], pv[3]};
            const size_t chx = meta ? (size_t)(BATCH * GH * (SEQ / 64) + h) : (size_t)((b * GH + h) * (SEQ / 64) + sc * CPS + ci);
            f32x4 xr4[4] = {px[0], px[1], px[2], px[3]};
            if (MODE == 1) { if (tid < 128) { em[tid] = pem; ef[tid] = pef; } }
            if (MODE == 0) {
            if (tid < 256) *(LAS f32x4*)(ZC + (tid >> 2) * 16 + 4 * (tid & 3)) = pz;
            GL_BAR();
            float wg[16];
#pragma unroll
            for (int i = 0; i < 16; ++i) wg[i] = bf2f(WGL[i * GDK + dA]);
            { float run = 0.f;
#pragma unroll 4
              for (int cc = 0; cc < 16; ++cc) { const int c = cgp * 16 + cc; float lg = bgv;
#pragma unroll
                for (int i4 = 0; i4 < 4; ++i4) { const f32x4 z4 = *(const LAS f32x4*)(ZC + c * 16 + 4 * i4); lg += (z4[0] * wg[4 * i4] + z4[1] * wg[4 * i4 + 1]) + (z4[2] * wg[4 * i4 + 2] + z4[3] * wg[4 * i4 + 3]); }
                float g = (fminf(lg, 0.f) - __logf(1.0f + __expf(-fabsf(lg)))) * (1.0f / 16.0f);
                if (meta && c < 48) g = 0.f;
                run += g; Bc[c * BS + dA] = run; }
              TOT[cgp * 129 + dA] = run; }
            GL_BAR();
            GLT(1);
            if (tid < 128) { const float t0 = TOT[tid], t1 = TOT[129 + tid], t2 = TOT[258 + tid], t3 = TOT[387 + tid];
                const float bm = t0 + Bc[31 * BS + tid], bl = (t0 + t1) + (t2 + t3);
                const float emv_ = __expf(bm), efv_ = __expf(bl - bm); em[tid] = emv_; ef[tid] = efv_; dsum += bl; EMF[chx * 256 + tid] = emv_; EMF[chx * 256 + 128 + tid] = efv_;
                OFFM[tid] = -bm; OFFM[129 + tid] = t0 - bm; OFFM[258 + tid] = t0 + t1 - bm; OFFM[387 + tid] = t0 + t1 + t2 - bm; }
            GL_BAR();
            }
            GLT(2);
            { const int c = cC;
                const unsigned qw[8] = {q0.x, q0.y, q0.z, q0.w, q1.x, q1.y, q1.z, q1.w}, kw[8] = {k0.x, k0.y, k0.z, k0.w, k1.x, k1.y, k1.z, k1.w};
                unsigned qo[8], ko[8];
                const LAS float* bcr = Bc + c * BS + d0; const LAS float* ofr = OFFM + (c >> 4) * 129 + d0;
#pragma unroll
                for (int t = 0; t < 8; ++t) {
                    const int d = d0 + 2 * t;
                    float x0, x1;
                    if (MODE == 0) { x0 = bcr[2 * t] + ofr[2 * t]; x1 = bcr[2 * t + 1] + ofr[2 * t + 1]; xr4[t >> 1][2 * (t & 1)] = x0; xr4[t >> 1][2 * (t & 1) + 1] = x1; }
                    else { x0 = xr4[t >> 1][2 * (t & 1)]; x1 = xr4[t >> 1][2 * (t & 1) + 1]; }
                    const float e0f = __expf(x0), e1f = __expf(x1), r0 = __expf(-x0), r1 = __expf(-x1);
                    const float ka = bflo(kw[t]) * r0, kb = bfhi(kw[t]) * r1;
                    ko[t] = pk2(ka, kb);
                    if (MODE == 1) qo[t] = pk2(bflo(qw[t]) * (0.08838834764831845f * e0f), bfhi(qw[t]) * (0.08838834764831845f * e1f));
                    KTT[(d) * KTTS + c] = (bf16)(ko[t] & 0xffffu); KTT[(d + 1) * KTTS + c] = (bf16)(ko[t] >> 16);
                }
                if (MODE == 0) { float* xp = XB + chx * (64 * GDK) + (size_t)tid * 16;
#pragma unroll
                    for (int t = 0; t < 4; ++t) *(f32x4*)(xp + 4 * t) = xr4[t]; }
                *(LAS v4u*)(KT + c * QTS + d0) = (v4u){ko[0], ko[1], ko[2], ko[3]}; *(LAS v4u*)(KT + c * QTS + d0 + 8) = (v4u){ko[4], ko[5], ko[6], ko[7]};
                if (MODE == 1) { *(LAS v4u*)(QT + c * QTS + d0) = (v4u){qo[0], qo[1], qo[2], qo[3]}; *(LAS v4u*)(QT + c * QTS + d0 + 8) = (v4u){qo[4], qo[5], qo[6], qo[7]}; }
#pragma unroll
                for (int t = 0; t < 4; ++t) { const unsigned vw[4] = {vv[t].x, vv[t].y, vv[t].z, vv[t].w};
#pragma unroll
                    for (int s = 0; s < 4; ++s) { const int e = e0 + 8 * t + 2 * s; VT[e * VTS + c] = (bf16)(vw[s] & 0xffffu); VT[(e + 1) * VTS + c] = (bf16)(vw[s] >> 16); } }
            }
            GL_BAR();
            GLT(3);
            f32x4 pacc[2];
#pragma unroll
            for (int dt = 0; dt < 8; ++dt) { const f32x4 emv = *(const LAS f32x4*)(em + 16 * dt + 4 * fq);
#pragma unroll
                for (int i = 0; i < 2; ++i) { sacc[dt][i] = sacc[dt][i] * emv;
                    if (MODE == 1) { const int e = 32 * w + 16 * i + fr; const int ck = (2 * dt + (fq >> 1)) ^ (e & 15);
                        v2u sw; sw.x = pk2(sacc[dt][i][0], sacc[dt][i][1]); sw.y = pk2(sacc[dt][i][2], sacc[dt][i][3]);
                        *(LAS v2u*)(ST + e * 256 + ck * 16 + (fq & 1) * 8) = sw; } } }
            if (MODE == 1) {
                const int mt = w & 3, ntp = w >> 2;
#pragma unroll
                for (int ii = 0; ii < 2; ++ii) { const int nt = 2 * ntp + ii; pacc[ii] = (f32x4){0.f, 0.f, 0.f, 0.f};
                    if (nt <= mt) {
#pragma unroll
                        for (int ks = 0; ks < 4; ++ks) { const bf16x8 kf = *(const LAS bf16x8*)(KT + (16 * nt + fr) * QTS + 32 * ks + 8 * fq); const bf16x8 qf = *(const LAS bf16x8*)(QT + (16 * mt + fr) * QTS + 32 * ks + 8 * fq);
                            pacc[ii] = __builtin_amdgcn_mfma_f32_16x16x32_bf16(kf, qf, pacc[ii], 0, 0, 0); }
                        if (nt == mt) {
#pragma unroll
                            for (int jj = 0; jj < 4; ++jj) if (4 * fq + jj > fr) pacc[ii][jj] = 0.f; }
                    } }
            }
            GL_BAR();
            if (MODE == 1) { const int mt = w & 3, ntp = w >> 2;
#pragma unroll
                for (int ii = 0; ii < 2; ++ii) { const int nt = 2 * ntp + ii; v2u pw; pw.x = pk2(pacc[ii][0], pacc[ii][1]); pw.y = pk2(pacc[ii][2], pacc[ii][3]);
                    *(LAS v2u*)(PP + (16 * mt + fr) * PS + 16 * nt + 4 * fq) = pw; }
                GL_BAR();
            }
            GLT(4);
            f32x4 oacc[8];
            v2u rr[8];
            if (MODE == 1) { const int cF = 16 * (w & 3) + fr; const bool validF = !meta || cF >= 48; const int rowF = meta ? MMAIN + cF - 48 : rbase + cF;
#pragma unroll
                for (int t = 0; t < 8; ++t) { rr[t] = (v2u){0u, 0u}; if (validF) rr[t] = *(const v2u*)(QKVR + (size_t)rowF * NGLA + 2 * GQK + GVD + h * GDV + 128 * (w >> 2) + 16 * t + 4 * fq); } }
            if (MODE == 1) { const int mt = w & 3, eh = w >> 2;
                bf16x8 pf[2], qf[4];
#pragma unroll
                for (int ks = 0; ks < 2; ++ks) pf[ks] = *(const LAS bf16x8*)(PP + (16 * mt + fr) * PS + 32 * ks + 8 * fq);
#pragma unroll
                for (int ks = 0; ks < 4; ++ks) qf[ks] = *(const LAS bf16x8*)(QT + (16 * mt + fr) * QTS + 32 * ks + 8 * fq);
#pragma unroll
                for (int t = 0; t < 8; ++t) { const int e = 128 * eh + 16 * t + fr; f32x4 a = (f32x4){0.f, 0.f, 0.f, 0.f};
#pragma unroll
                    for (int ks = 0; ks < 2; ++ks) { const bf16x8 vf = *(const LAS bf16x8*)(VT + e * VTS + 32 * ks + 8 * fq); a = __builtin_amdgcn_mfma_f32_16x16x32_bf16(vf, pf[ks], a, 0, 0, 0); }
#pragma unroll
                    for (int ks = 0; ks < 4; ++ks) { const int ck = (4 * ks + fq) ^ (e & 15); const bf16x8 sf = *(const LAS bf16x8*)(ST + e * 256 + ck * 16); a = __builtin_amdgcn_mfma_f32_16x16x32_bf16(sf, qf[ks], a, 0, 0, 0); }
                    oacc[t] = a; }
            }
            { bf16x8 vf[2][2];
#pragma unroll
              for (int i = 0; i < 2; ++i)
#pragma unroll
                  for (int ks = 0; ks < 2; ++ks) vf[i][ks] = *(const LAS bf16x8*)(VT + (32 * w + 16 * i + fr) * VTS + 32 * ks + 8 * fq);
#pragma unroll
              for (int dt = 0; dt < 8; ++dt) { const f32x4 efv = *(const LAS f32x4*)(ef + 16 * dt + 4 * fq);
#pragma unroll
                  for (int ks = 0; ks < 2; ++ks) { const bf16x8 kf = *(const LAS bf16x8*)(KTT + (16 * dt + fr) * KTTS + 32 * ks + 8 * fq);
#pragma unroll
                      for (int i = 0; i < 2; ++i) sacc[dt][i] = __builtin_amdgcn_mfma_f32_16x16x32_bf16(kf, vf[i][ks], sacc[dt][i], 0, 0, 0); }
#pragma unroll
                  for (int i = 0; i < 2; ++i) sacc[dt][i] = sacc[dt][i] * efv; }
            }
            if (ci + 1 < nch) GLA_PREFETCH(ci + 1);
            GLT(5);
            if (MODE == 1) { const int mt = w & 3, eh = w >> 2, c = 16 * mt + fr;
                float s1 = 0.f, s2 = 0.f;
#pragma unroll
                for (int t = 0; t < 8; ++t)
#pragma unroll
                    for (int jj = 0; jj < 4; ++jj) { s1 += oacc[t][jj]; s2 += oacc[t][jj] * oacc[t][jj]; }
                s1 += shx(s1, 16, lane); s1 += shx(s1, 32, lane); s2 += shx(s2, 16, lane); s2 += shx(s2, 32, lane);
                if (fq == 0) { stats[(c * 2 + eh) * 2 + 0] = s1; stats[(c * 2 + eh) * 2 + 1] = s2; }
                GL_BAR();
                const float t1 = stats[(c * 2 + 0) * 2 + 0] + stats[(c * 2 + 1) * 2 + 0], t2 = stats[(c * 2 + 0) * 2 + 1] + stats[(c * 2 + 1) * 2 + 1];
                float inv_dv = 1.0f / GDV; asm volatile("" : "+v"(inv_dv));
                const float mean = t1 * inv_dv, var = fmaxf(t2 * inv_dv - mean * mean, 0.f), rstd = __builtin_amdgcn_rsqf(var + LN_EPS);
                const bool valid = !meta || c >= 48; const int row = meta ? MMAIN + c - 48 : rbase + c;
                if (valid) {
#pragma unroll
                    for (int t = 0; t < 8; ++t) { const int e = 128 * eh + 16 * t + 4 * fq;
                        const v2u rw = rr[t];
                        const f32x4 ng = *(const LAS f32x4*)(NGL + e);
                        const float r4[4] = {bflo(rw.x), bfhi(rw.x), bflo(rw.y), bfhi(rw.y)}; float o4[4];
#pragma unroll
                        for (int jj = 0; jj < 4; ++jj) o4[jj] = (oacc[t][jj] - mean) * rstd * ng[jj] * silu_f(r4[jj]);
                        v2u ow; ow.x = pk2(o4[0], o4[1]); ow.y = pk2(o4[2], o4[3]);
                        *(v2u*)(O + (size_t)row * D + h * GDV + e) = ow; } }
            }
            GL_BAR();
            GLT(6);
        }
        if (MODE == 0) {
            int lofs2 = (4 * ((tid0 & 63) >> 4)) * GDV + 32 * (tid0 >> 6) + (tid0 & 15); asm volatile("" : "+v"(lofs2));
#pragma unroll
            for (int dt = 0; dt < 8; ++dt)
#pragma unroll
                for (int i = 0; i < 2; ++i)
#pragma unroll
                    for (int jj = 0; jj < 4; ++jj) KVS[(size_t)u * (GDK * GDV) + (size_t)((16 * dt + jj) * GDV + 16 * i) + lofs2] = sacc[dt][i][jj];
            if (tid0 < 128) DEC[(size_t)u * GDK + tid0] = dsum;
        }
    }
}
__device__ __forceinline__ void gla_scan_phase(Frame& F) {
    const float* KVS = (const float*)(F.ws + WS_S0 + S_KVS); float* SST = (float*)(F.ws + WS_S0 + S_SST); const float* DEC = (const float*)(F.ws + WS_S0 + S_DEC);
    constexpr int NEL = GDK * GDV;
    for (int idx = F.bx * NTHR + F.tid; idx < BATCH * GH * NEL; idx += F.G * NTHR) {
        const int bh = idx / NEL, el = idx - bh * NEL, d = el / GDV, h = bh % GH;
        float s = KVS[(size_t)(BATCH * GH * NSC_BH + h) * NEL + el];
        const size_t ub = (size_t)bh * NSC_BH;
        SST[ub * NEL + el] = s;
        for (int sc = 0; sc + 1 < NSC_BH; sc += 7) { float dv[7], kv[7];
#pragma unroll
            for (int t = 0; t < 7; ++t) { const int q = (sc + t + 1 < NSC_BH) ? sc + t : NSC_BH - 2; dv[t] = DEC[(ub + q) * GDK + d]; kv[t] = KVS[(ub + q) * NEL + el]; }
#pragma unroll
            for (int t = 0; t < 7; ++t) if (sc + t + 1 < NSC_BH) { s = __expf(dv[t]) * s + kv[t]; SST[(ub + sc + t + 1) * NEL + el] = s; } }
    }
}

#define GLA_PHASES \
        if (IN(pb + 10)) { if (on_gla) { \
            bf16* QKVR = (bf16*)(F.ws + WS_S0 + S_QKVR); EpiBf16Gelu E{QKVR, NGLA, 0}; \
            meta_gemm(F, HB + (size_t)MMAIN * D, D, D, (const bf16*)(wl + WL_GLAIN), NGLA / 16, E); \
            pg8::Gemm g{D, D}; pg8::DenseOrder S; S.init(HB, D, (const bf16*)(wl + WL_GLAIN), D, MMAIN / 256, NGLA / 256, F.G, F.bx); \
            pg8::gemm_phase<EpiBf16Gelu, pg8::DenseOrder>(F.lds, F.tid, g, S, E); } \
            SEAM(pb + 10); } \
        if (IN(pb + 11)) { if (on_gla) gla_phase<0>(F, args.in[12] + (size_t)j * GRANK * GQK, args.in[13] + (size_t)j * GQK, args.in[14] + (size_t)j * GVD); SEAM(pb + 11); } \
        if (IN(pb + 12)) { if (on_gla) gla_scan_phase(F); SEAM(pb + 12); } \
        if (IN(pb + 13)) { if (on_gla) gla_phase<1>(F, args.in[12] + (size_t)j * GRANK * GQK, args.in[13] + (size_t)j * GQK, args.in[14] + (size_t)j * GVD); SEAM(pb + 13); } \
        if (IN(pb + 14)) { if (on_gla) { \
            const bf16* O = (const bf16*)(F.ws + WS_S0 + S_O); EpiBf16Gelu E{MIX, D, 0}; \
            meta_gemm(F, O + (size_t)MMAIN * D, D, D, (const bf16*)(wl + WL_GLAOUT), D / 16, E); \
            pg8::Gemm g{D, D}; pg8::DenseOrder S; S.init(O, D, (const bf16*)(wl + WL_GLAOUT), D, MMAIN / 256, D / 256, F.G, F.bx); \
            pg8::gemm_phase<EpiBf16Gelu, pg8::DenseOrder>(F.lds, F.tid, g, S, E); } \
            SEAM(pb + 14); }

__device__ __forceinline__ void moe_panel_ends(const gu32* cnt, int (&pe)[8]) {
    int acc = 0;
#pragma unroll
    for (int e = 0; e < 8; ++e) { const int c = __builtin_amdgcn_readfirstlane((int)__hip_atomic_load(cnt + e, RLX_AGENT)); acc += (c + 255) >> 8; pe[e] = acc; }
}
__device__ __forceinline__ void moe_gather_phase(Frame& F, gu32* moe) {
    const bf16* HB = (const bf16*)(F.ws + WS_HB); bf16* AS = (bf16*)(F.ws + WS_S0 + S_AS);
    const int* E1 = (const int*)(F.ws + WS_RT); const int* E2 = E1 + MROWS; int* POS1 = (int*)(F.ws + WS_RT) + 4 * MROWS; int* POS2 = POS1 + MROWS;
    LAS unsigned* lcnt = (LAS unsigned*)F.lds; LAS unsigned* lbase = lcnt + 8; LAS int* lpos = (LAS int*)(F.lds + 256);
    const int per = (MROWS + F.G - 1) / F.G, t0 = F.bx * per, nt = (t0 + per <= MROWS) ? per : (MROWS - t0 > 0 ? MROWS - t0 : 0);
    if (F.tid < 8) lcnt[F.tid] = 0u;
    __syncthreads();
    int e1 = 0, e2 = 0; unsigned r1 = 0, r2 = 0;
    if (F.tid < nt) { e1 = E1[t0 + F.tid]; e2 = E2[t0 + F.tid];
        r1 = __hip_atomic_fetch_add(&lcnt[e1], 1u, __ATOMIC_RELAXED, __HIP_MEMORY_SCOPE_WORKGROUP); r2 = __hip_atomic_fetch_add(&lcnt[e2], 1u, __ATOMIC_RELAXED, __HIP_MEMORY_SCOPE_WORKGROUP); }
    __syncthreads();
    if (F.tid < 8) { int ps = 0, accp = 0;
#pragma unroll
        for (int e = 0; e < 8; ++e) { ps = (e == F.tid) ? accp : ps; accp += ((int)__hip_atomic_load(moe + e, RLX_AGENT) + 255) >> 8; }
        const unsigned c = lcnt[F.tid]; const unsigned off = c ? __hip_atomic_fetch_add(moe + 64 + F.tid, c, RLX_AGENT) : 0u;
        lbase[F.tid] = (unsigned)ps * 256u + off; }
    __syncthreads();
    if (F.tid < nt) { const int p1 = (int)(lbase[e1] + r1), p2 = (int)(lbase[e2] + r2); POS1[t0 + F.tid] = p1; POS2[t0 + F.tid] = p2; lpos[2 * F.tid] = p1; lpos[2 * F.tid + 1] = p2; }
    __syncthreads();
    for (int t = F.wave; t < nt; t += NWAVES) {
        const v4u* src = (const v4u*)(HB + (size_t)(t0 + t) * D); const v4u a = src[2 * F.lane], b = src[2 * F.lane + 1];
        float x[16]; unpack8(a, x); unpack8(b, x + 8);
        const v4u o = (v4u){pk4_fp8(x[0], x[1], x[2], x[3]), pk4_fp8(x[4], x[5], x[6], x[7]), pk4_fp8(x[8], x[9], x[10], x[11]), pk4_fp8(x[12], x[13], x[14], x[15])};
        unsigned char* AS8 = (unsigned char*)AS;
        *(v4u*)(AS8 + (size_t)lpos[2 * t] * D + 16 * F.lane) = o; *(v4u*)(AS8 + (size_t)lpos[2 * t + 1] * D + 16 * F.lane) = o;
    }
}

#ifdef MK_IDLE_TICKS
#define IDLE_PROBE { const unsigned long long t0_ = __builtin_amdgcn_s_memrealtime(); while (__builtin_amdgcn_s_memrealtime() - t0_ < (unsigned long long)(MK_IDLE_TICKS)) __builtin_amdgcn_s_sleep(64); }
#else
#define IDLE_PROBE
#endif
#define MOE_PHASES \
        if (IN(pb + 16)) { if (on_moe) moe_gather_phase(F, F.ctl + CW_MOE + 256 * j); IDLE_PROBE SEAM(pb + 16); } \
        if (IN(pb + 17)) { if (on_moe) { \
            const bf16* AS = (const bf16*)(F.ws + WS_S0 + S_AS); unsigned char* HS = (unsigned char*)(F.ws + WS_S0 + S_HS); EpiSwigluF8 E{HS, FF, 0.015625f, 8.0f}; \
            pg8::Gemm g{D, D}; pg8::MoeOrder S; moe_panel_ends(F.ctl + CW_MOE + 256 * j, S.pe); S.e_bytes = (size_t)NFF2 * D; \
            S.init(AS, D, (const bf16*)(wl + WL_MOEIN), D, S.pe[7], NFF2 / 256, F.G, F.bx, 1); \
            pg8::gemm_phase<EpiSwigluF8, pg8::MoeOrder, true, true>(F.lds, F.tid, g, S, E); } \
            SEAM(pb + 17); } \
        if (IN(pb + 18)) { if (on_moe) { \
            const unsigned char* HS = (const unsigned char*)(F.ws + WS_S0 + S_HS); EpiBf16Gelu E{(bf16*)(F.ws + WS_S0 + S_YS), D, 0, 1.0f / 2048.0f}; \
            pg8::Gemm g{FF, FF}; pg8::MoeOrder S; moe_panel_ends(F.ctl + CW_MOE + 256 * j, S.pe); S.e_bytes = (size_t)D * FF; \
            S.init(HS, FF, (const bf16*)(wl + WL_MOEOUT), FF, S.pe[7], D / 256, F.G, F.bx, 1); \
            pg8::gemm_phase<EpiBf16Gelu, pg8::MoeOrder, true, true>(F.lds, F.tid, g, S, E); } \
            SEAM(pb + 18); }

constexpr int NPHASE = 41;
#ifndef MK_PER_PHASE
#define MK_PER_PHASE 0
#endif
#ifndef MK_DBG
#define MK_DBG 0
#endif
#ifndef MK_SUBMASK
#define MK_SUBMASK 0xFFu
#endif

__global__ void __launch_bounds__(NTHR, 2) fwd(Args args) {
    extern __shared__ __attribute__((aligned(16))) unsigned char lds[];
    Frame F;
    F.lds = (LAS unsigned char*)lds; F.ws = args.ws; F.ctl = (gu32*)(args.ws + WS_CTL);
    F.tid = threadIdx.x; F.lane = F.tid & 63; F.wave = __builtin_amdgcn_readfirstlane(F.tid >> 6); F.G = gridDim.x; F.bx = blockIdx.x; F.dbg_acc = 0ull;
    volatile LAS unsigned* MISC = (volatile LAS unsigned*)(F.lds + MISC_OFF);
    if (F.tid < 16) MISC[F.tid] = 0u;
    __syncthreads();
    const int lo = args.ph_lo, hi = args.ph_hi;
    XcdBarrier bar; bar.bar = (unsigned*)(F.ctl + CW_BAR); bar.x = 0; bar.st = nullptr;
    if (hi - lo > 1) bar = xcd_barrier_post((unsigned*)(F.ctl + CW_BAR), MISC);
#ifndef MK_STAMP_BARMASK
#define MK_STAMP_BARMASK 0xFFFFFu
#endif
#ifdef MK_STAMP_MASK
    unsigned long long st_acc = 0ull, st_t0 = 0ull;
#define ST_SEL(k) ((k) == 0 ? (((MK_STAMP_MASK) >> 20) & 1u) : ((((MK_STAMP_MASK) >> (((k) - 1) % 20)) & 1u)))
#define IN(k) (lo <= (k) && (k) < hi && (F.fresh(), st_t0 = __builtin_amdgcn_s_memrealtime(), true))
#define SEAM(k) do { const unsigned long long t1_ = __builtin_amdgcn_s_memrealtime(); if (ST_SEL(k)) st_acc += t1_ - st_t0; if ((k) + 1 < hi) xcd_barrier(bar); if ((((MK_STAMP_MASK) >> 21) & 1u) && ((k) == 0 || (((MK_STAMP_BARMASK) >> (((k) - 1) % 20)) & 1u))) st_acc += __builtin_amdgcn_s_memrealtime() - t1_; } while (0)
#else
#define IN(k) (lo <= (k) && (k) < hi && (F.fresh(), true))
#define SEAM(k) do { if ((k) + 1 < hi) xcd_barrier(bar); } while (0)
#endif
    const unsigned submask = args.submask;
    const float* ln_gain = args.in[2]; const float* ln_bias = args.in[3];
    bf16* HB = (bf16*)(F.ws + WS_HB); bf16* MIX = (bf16*)(F.ws + WS_MIX);

    if (IN(0)) { p0_prologue(F, args); SEAM(0); }

    for (int j = 0; j < 2; ++j) {
        const int pb = 1 + 20 * j;
        unsigned char* wl = F.ws + WS_W + (size_t)j * WL_STRIDE;
        const bool on_rg = (submask >> (4 * j + 0)) & 1u, on_ffn = (submask >> (4 * j + 1)) & 1u, on_gla = (submask >> (4 * j + 2)) & 1u, on_moe = (submask >> (4 * j + 3)) & 1u;
        RG_PHASES
        if (IN(pb + 6)) { ln_phase(F, on_rg ? 1 : 0, ln_gain + (size_t)(2 * j) * 2 * D, ln_bias + (size_t)(2 * j) * 2 * D, 0, nullptr, 0, nullptr, nullptr); SEAM(pb + 6); }
        if (IN(pb + 7)) { if (on_ffn) {
            bf16* HID = (bf16*)(F.ws + WS_S0 + S_HID);
            EpiSwiglu E{HID, FF, 1.0f};
            if (!(MK_DBG & 1)) meta_gemm(F, HB + (size_t)MMAIN * D, D, D, (const bf16*)(wl + WL_FFNIN), (NFF2 / 256) * 8, E);
            pg8::Gemm g{D, D}; pg8::DenseOrder S; S.init(HB, D, (const bf16*)(wl + WL_FFNIN), D, MMAIN / 256, NFF2 / 256, F.G, F.bx);
            if (!(MK_DBG & 2)) pg8::gemm_phase<EpiSwiglu, pg8::DenseOrder>(F.lds, F.tid, g, S, E); }
            SEAM(pb + 7); }
        if (IN(pb + 8)) { if (on_ffn) {
            const bf16* HID = (const bf16*)(F.ws + WS_S0 + S_HID);
            EpiBf16Gelu E{MIX, D, 0};
            if (!(MK_DBG & 4)) meta_gemm(F, HID + (size_t)MMAIN * FF, FF, FF, (const bf16*)(wl + WL_FFNOUT), D / 16, E);
            pg8::Gemm g{FF, FF}; pg8::DenseOrder S; S.init(HID, FF, (const bf16*)(wl + WL_FFNOUT), FF, MMAIN / 256, D / 256, F.G, F.bx);
            if (!(MK_DBG & 8)) pg8::gemm_phase<EpiBf16Gelu, pg8::DenseOrder>(F.lds, F.tid, g, S, E); }
            SEAM(pb + 8); }
        if (IN(pb + 9)) { ln_phase(F, on_ffn ? 1 : 0, ln_gain + (size_t)(2 * j) * 2 * D + D, ln_bias + (size_t)(2 * j) * 2 * D + D, 1, args.in[11] + (size_t)j * D * GLAW + NGLA, GLAW, nullptr, nullptr); SEAM(pb + 9); }
        GLA_PHASES
        if (IN(pb + 15)) { ln_phase(F, on_gla ? 1 : 0, ln_gain + (size_t)(2 * j + 1) * 2 * D, ln_bias + (size_t)(2 * j + 1) * 2 * D, on_moe ? 2 : 0, args.in[18] + (size_t)j * D * NE, NE, nullptr, F.ctl + CW_MOE + 256 * j); SEAM(pb + 15); }
        MOE_PHASES
        if (IN(pb + 19)) { ln_phase(F, on_moe ? 2 : 0, ln_gain + (size_t)(2 * j + 1) * 2 * D + D, ln_bias + (size_t)(2 * j + 1) * 2 * D + D, 0, nullptr, 0, j == 1 ? args.out : nullptr, nullptr); SEAM(pb + 19); }
    }
#ifdef MK_STAMP_MASK
    __syncthreads();
    if (blockIdx.x == 0 && threadIdx.x == 0) args.out[0] = (float)(st_acc + F.dbg_acc) * 0.01f * (MK_STAMP_SCALE);
#endif
#undef IN
#undef SEAM
}

static bool phase_enabled(int k, unsigned mask) {
    if (k == 0) return true;
    const int j = (k - 1) / 20, r = (k - 1) % 20;
    int sub;
    if (r <= 5) sub = 0; else if (r == 6) return true; else if (r <= 8) sub = 1; else if (r == 9) return true;
    else if (r <= 14) sub = 2; else if (r == 15) return true; else if (r <= 18) sub = 3; else return true;
    return (mask >> (4 * j + sub)) & 1u;
}
extern "C" void kernel_launch(void* const* d_in, const int* in_sizes, int n_in, void* d_out, int out_size, void* d_ws, size_t ws_size, hipStream_t stream) {
    static int grid = 0;
    if (grid == 0) {
        if (n_in != 21 || out_size != MMAIN * D || ws_size < WS_END) { fprintf(stderr, "kernel_launch: unexpected shapes: n_in %d out %d ws %zu (need %zu); nothing launched\n", n_in, out_size, ws_size, (size_t)WS_END); grid = -1; return; }
        int dev = 0, cus = 0, per_cu = 0;
        if (hipGetDevice(&dev) != hipSuccess || hipDeviceGetAttribute(&cus, hipDeviceAttributeMultiprocessorCount, dev) != hipSuccess) { grid = -1; return; }
        if (hipFuncSetAttribute((const void*)fwd, hipFuncAttributeMaxDynamicSharedMemorySize, LDS_BYTES) != hipSuccess) { fprintf(stderr, "kernel_launch: hipFuncSetAttribute failed\n"); grid = -1; return; }
        if (hipOccupancyMaxActiveBlocksPerMultiprocessor(&per_cu, (const void*)fwd, NTHR, LDS_BYTES) != hipSuccess || per_cu < 1) fprintf(stderr, "kernel_launch: note: occupancy query reports %d\n", per_cu);
        (void)hipGetLastError();
        grid = cus;
    }
    if (grid < 0) return;
    (void)hipMemsetAsync((char*)d_ws + WS_CTL, 0, CTL_ZERO_BYTES, stream);
    Args a{};
    for (int i = 0; i < 21; ++i) a.in[i] = (const float*)d_in[i];
    a.out = (float*)d_out; a.ws = (unsigned char*)d_ws; a.submask = MK_SUBMASK; a.pad = 0;
#if MK_PER_PHASE
    for (int k = 0; k < NPHASE; ++k) { if (!phase_enabled(k, MK_SUBMASK)) continue; a.ph_lo = k; a.ph_hi = k + 1; hipLaunchKernelGGL(fwd, dim3(grid), dim3(NTHR), LDS_BYTES, stream, a); }
#else
    a.ph_lo = 0; a.ph_hi = NPHASE; hipLaunchKernelGGL(fwd, dim3(grid), dim3(NTHR), LDS_BYTES, stream, a);
#ifdef MK_PROBE_LIST
    { const int pl[] = {MK_PROBE_LIST}; for (int k : pl) { a.ph_lo = k; a.ph_hi = k + 1; hipLaunchKernelGGL(fwd, dim3(grid), dim3(NTHR), LDS_BYTES, stream, a); } }
#endif
#endif
}
```

```cpp
#include <hip/hip_runtime.h>
#include <cstdio>
#include <cstdint>

#define GAS __attribute__((address_space(1)))
#define LAS __attribute__((address_space(3)))
typedef unsigned short bf16;
typedef unsigned v4u __attribute__((ext_vector_type(4)));
typedef unsigned v2u __attribute__((ext_vector_type(2)));
typedef float f32x4 __attribute__((ext_vector_type(4)));
typedef float f32x2 __attribute__((ext_vector_type(2)));
typedef short bf16x8 __attribute__((ext_vector_type(8)));
typedef short bf16x4 __attribute__((ext_vector_type(4)));
typedef GAS unsigned gu32;
#define RLX_AGENT __ATOMIC_RELAXED, __HIP_MEMORY_SCOPE_AGENT
#define LDS_WAIT() asm volatile("s_waitcnt lgkmcnt(0)" ::: "memory")
#define VM_WAIT() asm volatile("s_waitcnt vmcnt(0)" ::: "memory")

__device__ __forceinline__ unsigned f2bf(float f) { unsigned u = __builtin_bit_cast(unsigned, f); return (u + 0x7fffu + ((u >> 16) & 1u)) >> 16; }
__device__ __forceinline__ unsigned pk2(float lo, float hi) { unsigned r; asm("v_cvt_pk_bf16_f32 %0, %1, %2" : "=v"(r) : "v"(lo), "v"(hi)); return r; }
__device__ __forceinline__ float bflo(unsigned w) { return __builtin_bit_cast(float, w << 16); }
__device__ __forceinline__ float bfhi(unsigned w) { return __builtin_bit_cast(float, w & 0xffff0000u); }
__device__ __forceinline__ float bf2f(bf16 b) { return __builtin_bit_cast(float, (unsigned)b << 16); }
__device__ __forceinline__ unsigned cvt_pk_bf16(float lo, float hi) { unsigned r; asm volatile("v_cvt_pk_bf16_f32 %0, %1, %2" : "=v"(r) : "v"(lo), "v"(hi)); return r; }
__device__ __forceinline__ unsigned pk4_fp8(float a, float b, float c, float d) { int w = 0; w = __builtin_amdgcn_cvt_pk_fp8_f32(a, b, w, false); w = __builtin_amdgcn_cvt_pk_fp8_f32(c, d, w, true); return (unsigned)w; }
__device__ __forceinline__ float fast_exp(float x) { return __builtin_amdgcn_exp2f(x * 1.44269504089f); }
__device__ __forceinline__ float sigmoid_f(float x) { return __builtin_amdgcn_rcpf(1.0f + fast_exp(-x)); }
__device__ __forceinline__ float silu_f(float x) { return x * sigmoid_f(x); }
__device__ __forceinline__ float gelu_tanh_f(float x) { const float u = 0.7978845608028654f * (x + 0.044715f * x * x * x); return x * sigmoid_f(2.0f * u); }
__device__ __forceinline__ float shx(float v, int m, int lane) { return __int_as_float(__builtin_amdgcn_ds_bpermute((lane ^ m) << 2, __float_as_int(v))); }
__device__ __forceinline__ float wave_sum(float v, int lane) {
    (void)lane;
    v += __int_as_float(__builtin_amdgcn_update_dpp(0, __float_as_int(v), 0xB1, 0xF, 0xF, true));
    v += __int_as_float(__builtin_amdgcn_update_dpp(0, __float_as_int(v), 0x4E, 0xF, 0xF, true));
    v += __int_as_float(__builtin_amdgcn_update_dpp(0, __float_as_int(v), 0x141, 0xF, 0xF, true));
    v += __int_as_float(__builtin_amdgcn_update_dpp(0, __float_as_int(v), 0x140, 0xF, 0xF, true));
    const float r0 = __int_as_float(__builtin_amdgcn_readlane(__float_as_int(v), 0)), r1 = __int_as_float(__builtin_amdgcn_readlane(__float_as_int(v), 16));
    const float r2 = __int_as_float(__builtin_amdgcn_readlane(__float_as_int(v), 32)), r3 = __int_as_float(__builtin_amdgcn_readlane(__float_as_int(v), 48));
    return (r0 + r1) + (r2 + r3);
}

namespace pg8 {
constexpr int BM = 256, BK = 64, HALF = 128, HTB = HALF * BK * 2  , STAGE_BYTES = 8 * HTB, NXCD = 8, WGM = 8;
__host__ __device__ __forceinline__ int lds_byte(int r, int c) { const int st = (r >> 4) * 2 + (c >> 5), rr = r & 15, cc = c & 31, ob = rr * 64 + cc * 2; return st * 1024 + (ob ^ (((ob >> 9) & 1) << 5)); }
__host__ __device__ __forceinline__ void stage_rc(int b, int& R, int& C) { const int st = b / 1024, sb = b % 1024, swz = sb ^ (((sb >> 9) & 1) << 5); R = (st >> 1) * 16 + swz / 64; C = (st & 1) * 32 + (swz % 64) / 2; }
__host__ __device__ __forceinline__ int perm32(int rho) { const int n = rho >> 4, i = rho & 15; return 8 * (i >> 2) + 4 * n + (i & 3); }

struct Unit { int pm, pn; };
struct Gemm { int K, lda, esz; };

struct OrderBase {
    int nM, nN, nwg, G, c;
    __device__ __forceinline__ void init_order(int nM_, int nN_, int G_, int c_) { nM = nM_; nN = nN_; nwg = nM * nN; G = G_; c = c_; }
    __device__ __forceinline__ bool next(int i, Unit& u) const {
        const long L = (long)i * G + c; if (L >= nwg) return false;
        int wgid = (int)L; { const int q = nwg / NXCD, r = nwg % NXCD, xcd = wgid % NXCD, off = wgid / NXCD; wgid = (xcd < r ? xcd * (q + 1) : r * (q + 1) + (xcd - r) * q) + off; }
        const int nig = WGM * nN, gid = wgid / nig, fm = gid * WGM, gsz = (nM - fm) < WGM ? (nM - fm) : WGM;
        u.pm = __builtin_amdgcn_readfirstlane(fm + ((wgid % nig) % gsz)); u.pn = __builtin_amdgcn_readfirstlane((wgid % nig) / gsz); return true;
    }
};
struct DenseOrder : OrderBase {
    const char* A; const char* Bt; size_t a_tile, b_tile;
    __device__ __forceinline__ void init(const void* A_, int lda, const void* Bt_, int K, int nM_, int nN_, int G_, int c_, int esz = 2) { A = (const char*)A_; Bt = (const char*)Bt_; a_tile = (size_t)BM * lda * esz; b_tile = (size_t)BM * K * esz; init_order(nM_, nN_, G_, c_); }
    __device__ __forceinline__ const char* a_base(const Unit& u) const { return A + (size_t)u.pm * a_tile; }
    __device__ __forceinline__ const char* b_base(const Unit& u) const { return Bt + (size_t)u.pn * b_tile; }
};
struct GatesOrder : DenseOrder {
    __device__ __forceinline__ const char* a_base(const Unit& u) const { return A + (size_t)u.pm * a_tile + (size_t)(u.pn >> 1) * 512; }
};
struct MoeOrder : DenseOrder {
    int pe[8]; size_t e_bytes;
    __device__ __forceinline__ const char* b_base(const Unit& u) const {
        int e = 0;
#pragma unroll
        for (int j = 0; j < 7; ++j) e += (u.pm >= pe[j]) ? 1 : 0;
        return Bt + (size_t)e * e_bytes + (size_t)u.pn * b_tile;
    }
};

typedef int v8i __attribute__((ext_vector_type(8)));
typedef int v4i __attribute__((ext_vector_type(4)));
template <class Epi, class Sched, bool ALIGN_EPI = true, bool FP8 = false, int SCALE_W = 127>
__device__ __forceinline__ void gemm_phase(LAS unsigned char* lds, const int tid, const Gemm g, const Sched& S, const Epi& E) {
    const int wid = __builtin_amdgcn_readfirstlane(tid >> 6), lane = tid & 63, wr = wid >> 2, wc = wid & 3, fr = lane & 15, fq = lane >> 4;
    const int K = g.K, nt = FP8 ? K / 128 : K / BK;
    unsigned voffA[1], voffB[1];
#pragma unroll
    for (int i = 0; i < 1; ++i) { int R, C; stage_rc(tid * 16 + i * 8192, R, C); const int Rb = Epi::PERM ? ((R & ~31) + perm32(R & 31)) : R;
        voffA[i] = FP8 ? (unsigned)(R * g.lda + 2 * C) : (unsigned)(R * g.lda + C) * 2u; voffB[i] = FP8 ? (unsigned)(Rb * K + 2 * C) : (unsigned)(Rb * K + C) * 2u; }
    const size_t kstep = (size_t)(BK * 2);
    const size_t hstepA = (size_t)HALF * g.lda * (FP8 ? 1 : 2), hstepB = (size_t)HALF * K * (FP8 ? 1 : 2);
    const size_t qstepA = hstepA / 2, qstepB = hstepB / 2;
    const unsigned ldsw = (unsigned)wid * 1024u;
    const int aoff = lds_byte(wr * 64 + fr, fq * 8), boff = lds_byte(wc * 32 + fr, fq * 8);
#define PG8_SA(b, h) (((b) * 2 + (h)) * HTB)
#define PG8_SB(b, h) ((4 + (b) * 2 + (h)) * HTB)
#define PG8_STAGE(bufoff, gbase, voff) do { _Pragma("unroll") for (int _i = 0; _i < 2; ++_i) \
        __builtin_amdgcn_global_load_lds((const unsigned*)((const char*)(gbase) + (size_t)_i * ((voff) == voffA ? qstepA : qstepB) + (voff)[0]), (LAS unsigned*)(lds + (bufoff) + ldsw + _i * 8192), 16, 0, 0); } while (0)
#define PG8_LDA(dst, b, h) do { if constexpr (FP8) { _Pragma("unroll") for (int m = 0; m < 4; ++m) dst##8[m] = __builtin_shufflevector(*(const LAS v4i*)(lds + PG8_SA(b, h) + aoff + m * 2048), *(const LAS v4i*)(lds + PG8_SA(b, h) + aoff + m * 2048 + 1024), 0, 1, 2, 3, 4, 5, 6, 7); } else { _Pragma("unroll") for (int m = 0; m < 4; ++m) _Pragma("unroll") for (int k = 0; k < 2; ++k) dst[m][k] = *(const LAS bf16x8*)(lds + PG8_SA(b, h) + aoff + m * 2048 + k * 1024); } } while (0)
#define PG8_LDB(dst, b, h) do { if constexpr (FP8) { _Pragma("unroll") for (int n = 0; n < 2; ++n) dst##8[n] = __builtin_shufflevector(*(const LAS v4i*)(lds + PG8_SB(b, h) + boff + n * 2048), *(const LAS v4i*)(lds + PG8_SB(b, h) + boff + n * 2048 + 1024), 0, 1, 2, 3, 4, 5, 6, 7); } else { _Pragma("unroll") for (int n = 0; n < 2; ++n) _Pragma("unroll") for (int k = 0; k < 2; ++k) dst[n][k] = *(const LAS bf16x8*)(lds + PG8_SB(b, h) + boff + n * 2048 + k * 1024); } } while (0)
#define PG8_MMA(ai, bj, At, Bt) do { __builtin_amdgcn_s_setprio(1); if constexpr (FP8) { _Pragma("unroll") for (int m = 0; m < 4; ++m) _Pragma("unroll") for (int n = 0; n < 2; ++n) \
            acc[ai][bj][m][n] = __builtin_amdgcn_mfma_scale_f32_16x16x128_f8f6f4(Bt##8[n], At##8[m], acc[ai][bj][m][n], 0, 0, 0, 0, 0, 0); } else { \
        _Pragma("unroll") for (int m = 0; m < 4; ++m) _Pragma("unroll") for (int n = 0; n < 2; ++n) _Pragma("unroll") for (int k = 0; k < 2; ++k) \
        acc[ai][bj][m][n] = __builtin_amdgcn_mfma_f32_16x16x32_bf16(Bt[n][k], At[m][k], acc[ai][bj][m][n], 0, 0, 0); } __builtin_amdgcn_s_setprio(0); } while (0)
#define PG8_WAIT_V(n) asm volatile("s_waitcnt vmcnt(" #n ")" ::: "memory")
#define PG8_WAIT_L(n) asm volatile("s_waitcnt lgkmcnt(" #n ")" ::: "memory")
#define PG8_BAR __builtin_amdgcn_s_barrier()
#define PG8_SCHED __builtin_amdgcn_sched_barrier(0)
    Unit cur, nxt; int ui = 0;
    if (!S.next(0, cur)) return;
    f32x4 acc[2][2][4][2];
#pragma unroll
    for (int a = 0; a < 2; ++a)
#pragma unroll
        for (int b = 0; b < 2; ++b)
#pragma unroll
            for (int m = 0; m < 4; ++m)
#pragma unroll
                for (int n = 0; n < 2; ++n) acc[a][b][m][n] = (f32x4){0.f, 0.f, 0.f, 0.f};
    bf16x8 At[4][2], B0[2][2], B1[2][2]; v8i At8[4], B08[2], B18[2];
    const char* cA = S.a_base(cur); const char* cB = S.b_base(cur);
    PG8_STAGE(PG8_SB(0, 0), cB, voffB); PG8_STAGE(PG8_SB(0, 1), cB + hstepB, voffB); PG8_STAGE(PG8_SA(0, 0), cA, voffA); PG8_STAGE(PG8_SA(0, 1), cA + hstepA, voffA);
    if (wr == 1) PG8_BAR;
    PG8_WAIT_V(2); PG8_BAR;
    PG8_STAGE(PG8_SB(1, 0), cB + kstep, voffB); PG8_STAGE(PG8_SA(1, 0), cA + kstep, voffA); PG8_STAGE(PG8_SB(1, 1), cB + hstepB + kstep, voffB);
    PG8_WAIT_V(6); PG8_BAR;
    for (;;) {
        const bool has_next = S.next(ui + 1, nxt);
        const char* nA = has_next ? S.a_base(nxt) : cA; const char* nB = has_next ? S.b_base(nxt) : cB;
#pragma nounroll
        for (int t = 0; t < nt; t += 2) {
            const bool last = (t == nt - 2);
            asm volatile("" : "+v"(voffA[0]), "+v"(voffB[0]));
            const char* a1 = cA + (size_t)(t + 1) * kstep;
            const char* a2 = last ? nA : cA + (size_t)(t + 2) * kstep; const char* b2 = last ? nB : cB + (size_t)(t + 2) * kstep;
            const char* a3 = a2 + kstep; const char* b3 = b2 + kstep;
            PG8_LDB(B0, 0, 0); PG8_LDB(B1, 0, 1); PG8_SCHED; PG8_LDA(At, 0, 0); PG8_STAGE(PG8_SA(1, 1), a1 + hstepA, voffA);
            PG8_WAIT_V(8); PG8_WAIT_L(0); PG8_BAR; PG8_MMA(0, 0, At, B0); PG8_MMA(0, 1, At, B1); PG8_BAR; PG8_SCHED;
            PG8_LDA(At, 0, 1); PG8_STAGE(PG8_SB(0, 0), b2, voffB); PG8_STAGE(PG8_SB(0, 1), b2 + hstepB, voffB); PG8_STAGE(PG8_SA(0, 0), a2, voffA);
            PG8_WAIT_V(8); PG8_WAIT_L(0); PG8_BAR; PG8_MMA(1, 0, At, B0); PG8_MMA(1, 1, At, B1); PG8_BAR; PG8_SCHED;
            PG8_LDB(B0, 1, 0); PG8_LDB(B1, 1, 1); PG8_SCHED; PG8_LDA(At, 1, 0); PG8_STAGE(PG8_SA(0, 1), a2 + hstepA, voffA);
            PG8_WAIT_V(8); PG8_WAIT_L(0); PG8_BAR; PG8_MMA(0, 0, At, B0); PG8_MMA(0, 1, At, B1); PG8_BAR; PG8_SCHED;
            PG8_LDA(At, 1, 1); PG8_STAGE(PG8_SB(1, 0), b3, voffB); PG8_STAGE(PG8_SB(1, 1), b3 + hstepB, voffB); PG8_STAGE(PG8_SA(1, 0), a3, voffA);
            PG8_WAIT_V(8); PG8_WAIT_L(0); PG8_BAR; PG8_MMA(1, 0, At, B0); PG8_MMA(1, 1, At, B1); PG8_BAR; PG8_SCHED;
        }
        if constexpr (ALIGN_EPI) { if (wr == 0) PG8_BAR; }
        { int ln_; asm volatile("v_mbcnt_lo_u32_b32 %0, -1, 0\n\tv_mbcnt_hi_u32_b32 %0, -1, %0" : "=v"(ln_)); E(acc, cur, wr, wc, ln_ & 15, ln_ >> 4); }
        if (!has_next) break;
#pragma unroll
        for (int a = 0; a < 2; ++a)
#pragma unroll
            for (int b = 0; b < 2; ++b)
#pragma unroll
                for (int m = 0; m < 4; ++m)
#pragma unroll
                    for (int n = 0; n < 2; ++n) acc[a][b][m][n] = (f32x4){0.f, 0.f, 0.f, 0.f};
        cur = nxt; cA = nA; cB = nB; ++ui;
        { int t_; asm volatile("v_mbcnt_lo_u32_b32 %0, -1, 0\n\tv_mbcnt_hi_u32_b32 %0, -1, %0" : "=v"(t_)); t_ |= wid << 6; int R, C; stage_rc(t_ * 16, R, C); const int Rb = Epi::PERM ? ((R & ~31) + perm32(R & 31)) : R;
          voffA[0] = FP8 ? (unsigned)(R * g.lda + 2 * C) : (unsigned)(R * g.lda + C) * 2u; voffB[0] = FP8 ? (unsigned)(Rb * K + 2 * C) : (unsigned)(Rb * K + C) * 2u; }
        if constexpr (ALIGN_EPI) { if (wr == 1) PG8_BAR; }
    }
    PG8_WAIT_V(0);
    if constexpr (!ALIGN_EPI) { if (wr == 0) PG8_BAR; }
    PG8_BAR;
#undef PG8_SA
#undef PG8_SB
#undef PG8_STAGE
#undef PG8_LDA
#undef PG8_LDB
#undef PG8_MMA
#undef PG8_WAIT_V
#undef PG8_WAIT_L
#undef PG8_BAR
#undef PG8_SCHED
}
}
#define XB_TMO      128
#define XB_XCNT(j)  (256  + 64 * (j))
#define XB_XSUB(j)  (1280 + 64 * (j))
#define XB_XGEN(j)  (2304 + 64 * (j))
#define XB_TOP      3328
#define XB_TOPGEN   3392
#define XCD_BAR_WORDS 3456
#define XB_SPIN_CAP (1u << 18)

__device__ __forceinline__ unsigned xb_ld(unsigned* p)              { return __hip_atomic_load(p, __ATOMIC_RELAXED, __HIP_MEMORY_SCOPE_AGENT); }
__device__ __forceinline__ unsigned xb_add(unsigned* p, unsigned v) { return __hip_atomic_fetch_add(p, v, __ATOMIC_RELAXED, __HIP_MEMORY_SCOPE_AGENT); }
__device__ __forceinline__ unsigned xb_xcc_id() { return (unsigned)__builtin_amdgcn_s_getreg((3 << 11) | 20) & 0xFu; }
#define XB_SPIN(cond, bar) do { unsigned _sp = 0; while (cond) { __builtin_amdgcn_s_sleep(1); \
    if ((++_sp & 255u) == 0u) { if (xb_ld(&(bar)[XB_TMO])) break; if (_sp > XB_SPIN_CAP) { atomicAdd(&(bar)[XB_TMO], 1u); break; } } } } while (0)

struct XcdBarrier {
    unsigned* bar; unsigned x;
    volatile LAS unsigned* st;
};

__device__ __forceinline__ XcdBarrier xcd_barrier_post(unsigned* bar, volatile LAS unsigned* st) {
    XcdBarrier b; b.bar = bar; b.x = xb_xcc_id(); b.st = st;
    if (threadIdx.x == 0) (void)xb_add(&bar[XB_XCNT(b.x)], 1u);
    return b;
}
__device__ __forceinline__ void xcd_barrier_complete(unsigned* bar, unsigned x, unsigned& nloc, unsigned& nx) {
    const unsigned G = gridDim.x * gridDim.y * gridDim.z;
    unsigned sum, cnt, mine, sp = 0u;
    for (;;) {
        sum = 0u; cnt = 0u; mine = 0u;
#pragma unroll
        for (unsigned j = 0; j < 16; ++j) { const unsigned c = xb_ld(&bar[XB_XCNT(j)]); sum += c; cnt += (c > 0u) ? 1u : 0u; mine = (j == x) ? c : mine; }
        if (sum == G) break;
        __builtin_amdgcn_s_sleep(1);
        if ((++sp & 255u) == 0u) { if (xb_ld(&bar[XB_TMO])) break; if (sp > XB_SPIN_CAP) { atomicAdd(&bar[XB_TMO], 1u); break; } }
    }
    nloc = mine > 0u ? mine : 1u; nx = cnt > 0u ? cnt : 1u;
}

__device__ __forceinline__ void xcd_barrier(const XcdBarrier& b) {
    asm volatile("s_waitcnt vmcnt(0)" ::: "memory");
    __syncthreads();
    if (threadIdx.x == 0) {
        unsigned* bar = b.bar;
        __builtin_amdgcn_s_waitcnt(0);
        unsigned nloc = b.st[0], nx = b.st[1];
        if (nloc == 0u) { xcd_barrier_complete(bar, b.x, nloc, nx); b.st[0] = nloc; b.st[1] = nx; }
        const unsigned old = xb_add(&bar[XB_XSUB(b.x)], 1u);
        const unsigned gen = old / nloc;
        if (old + 1u == (gen + 1u) * nloc) {
            __builtin_amdgcn_fence(__ATOMIC_RELEASE, "agent");
            asm volatile("s_waitcnt vmcnt(0)" ::: "memory");
            const unsigned og = xb_add(&bar[XB_TOP], 1u);
            const unsigned tg = og / nx;
            if (og + 1u == (tg + 1u) * nx) xb_add(&bar[XB_TOPGEN], 1u);
            else XB_SPIN(xb_ld(&bar[XB_TOPGEN]) == tg, bar);
            __builtin_amdgcn_fence(__ATOMIC_ACQUIRE, "agent");
            xb_add(&bar[XB_XGEN(b.x)], 1u);
            asm volatile("s_waitcnt vmcnt(0)" ::: "memory");
        } else {
            XB_SPIN(xb_ld(&bar[XB_XGEN(b.x)]) == gen, bar);
            __builtin_amdgcn_fence(__ATOMIC_ACQUIRE, "agent");
            asm volatile("s_waitcnt vmcnt(0)" ::: "memory");
        }
    }
    __syncthreads();
}

constexpr int NWAVES = 8, NTHR = 512;
constexpr int D = 1024, BATCH = 2, SEQ = 16384, NMETA = 16;
constexpr int MMAIN = BATCH * SEQ;
constexpr int MROWS = MMAIN + NMETA;
constexpr int MPAD = MMAIN + 256;
constexpr int RGW = 1344, RGBW = 168, NRG = 2816  , KRGO = 1408  , NGT = 4096, KGT = 256, XCW = 2048;
constexpr int FF = 3584, NE = 8, NFF2 = 2 * FF;
constexpr int GH = 4, GDK = 128, GDV = 256, GQK = 512, GVD = 1024, NGLA = 3072, GLAW = 3088, GRANK = 16;
constexpr int MSORT = 265 * 256;
constexpr float LN_EPS = 1e-5f, ALPHA = 1.6817928305074290f;
constexpr int SEG = 128, NSEG_B = SEQ / SEG, NSEG = 1 + BATCH * NSEG_B;
constexpr int CPS = 8, NSC_BH = SEQ / (64 * CPS), NGU = BATCH * GH * NSC_BH + GH;

constexpr size_t MiB = 1u << 20;
constexpr size_t WS_CTL = 0, CTL_ZERO_BYTES = 1 * MiB;
constexpr size_t WL_RGIN = 0, WL_GATES = WL_RGIN + (size_t)NRG * D * 2, WL_RGOUT = WL_GATES + (size_t)NGT * KGT * 2, WL_GLAIN = WL_RGOUT + (size_t)D * KRGO * 2,
                 WL_GLAOUT = WL_GLAIN + (size_t)NGLA * D * 2, WL_FFNIN = WL_GLAOUT + (size_t)D * D * 2, WL_FFNOUT = WL_FFNIN + (size_t)NFF2 * D * 2,
                 WL_MOEIN = WL_FFNOUT + (size_t)D * FF * 2, WL_MOEOUT = WL_MOEIN + (size_t)NE * NFF2 * D * 2, WL_STRIDE = WL_MOEOUT + (size_t)NE * D * FF * 2;
constexpr size_t WS_W = 1 * MiB;
constexpr size_t WS_H = WS_W + 2 * WL_STRIDE;
constexpr size_t WS_HB = WS_H + (size_t)MPAD * D * 4;
constexpr size_t WS_MIX = WS_HB + (size_t)MPAD * D * 2;
constexpr size_t WS_Z = WS_MIX + (size_t)MPAD * D * 4;
constexpr size_t WS_RT = WS_Z + 3 * MiB;
constexpr size_t WS_AGG = WS_RT + 1 * MiB;
constexpr size_t WS_S0 = WS_AGG + 3 * MiB;
constexpr size_t S_PROJ = 0, S_XC = S_PROJ + (size_t)MPAD * NRG * 2, S_LOGA = S_XC + (size_t)MPAD * XCW * 2, S_U = S_LOGA + (size_t)MPAD * RGW * 4, S_Y = S_U + (size_t)MPAD * RGW * 4, S_RG_END = S_Y + (size_t)MPAD * KRGO * 2;
constexpr size_t S_HID = 0;
constexpr size_t S_QKVR = 0, S_KVS = S_QKVR + (size_t)MPAD * NGLA * 2, S_SST = S_KVS + (size_t)NGU * GDK * GDV * 4, S_O = S_SST + (size_t)NGU * GDK * GDV * 4, S_DEC = S_O + (size_t)MPAD * D * 2, S_XB = S_DEC + 1 * MiB, S_EMF = S_XB + (size_t)(BATCH * GH * (SEQ / 64) + GH) * 64 * GDK * 4, S_GLA_END = S_EMF + 3 * MiB;
constexpr size_t S_AS = 0, S_HS = S_AS + (size_t)MSORT * D * 2, S_YS = S_HS + (size_t)MSORT * FF * 2, S_MOE_END = S_YS + (size_t)MSORT * D * 4;
constexpr size_t S_MAX = S_RG_END > S_MOE_END ? (S_RG_END > S_GLA_END ? S_RG_END : S_GLA_END) : (S_MOE_END > S_GLA_END ? S_MOE_END : S_GLA_END);
constexpr size_t WS_END = WS_S0 + S_MAX;
constexpr int CW_TMO = 0, CW_BAR = 4096, CW_MOE = 8192;

constexpr int LDS_BYTES = 163840, MISC_OFF = LDS_BYTES - 64;

struct Frame {
    LAS unsigned char* lds; gu32* ctl; unsigned char* ws;
    int tid, lane, wave, G, bx; unsigned long long dbg_acc;
    __device__ __forceinline__ void fresh() { asm volatile("" : "+s"(wave)); asm volatile("" : "+s"(bx)); asm volatile("" : "+s"(ws));
        asm volatile("v_mbcnt_lo_u32_b32 %0, -1, 0\n\tv_mbcnt_hi_u32_b32 %0, -1, %0" : "=v"(lane));
        tid = (wave << 6) | lane; ctl = (gu32*)(ws + WS_CTL); }
};
struct Args { const float* in[21]; float* out; unsigned char* ws; int ph_lo, ph_hi; unsigned submask; int pad; };

struct EpiBf16Gelu {
    static constexpr bool PERM = true, PAIR = false;
    bf16* O; int ldc, gelu_cols; float sc = 1.0f;
    __device__ __forceinline__ void operator()(const f32x4 (&acc)[2][2][4][2], const pg8::Unit& u, int wr, int wc, int fr, int fq) const {
        const int row0 = u.pm * 256 + wr * 64 + fr, col0 = u.pn * 256 + wc * 32 + 8 * fq;
        float scl = sc; asm volatile("" : "+v"(scl));
#pragma unroll
        for (int ai = 0; ai < 2; ++ai)
#pragma unroll
            for (int m = 0; m < 4; ++m) { bf16* rowp = O + (size_t)(row0 + ai * 128 + m * 16) * ldc + col0;
#pragma unroll
                for (int bj = 0; bj < 2; ++bj) { f32x4 v0 = acc[ai][bj][m][0] * scl, v1 = acc[ai][bj][m][1] * scl;
                    if (col0 + bj * 128 < gelu_cols) {
#pragma unroll
                        for (int j = 0; j < 4; ++j) { v0[j] = gelu_tanh_f(v0[j]); v1[j] = gelu_tanh_f(v1[j]); } }
                    v4u w; w.x = cvt_pk_bf16(v0[0], v0[1]); w.y = cvt_pk_bf16(v0[2], v0[3]); w.z = cvt_pk_bf16(v1[0], v1[1]); w.w = cvt_pk_bf16(v1[2], v1[3]);
                    *(v4u*)(rowp + bj * 128) = w; } }
    }
    __device__ __forceinline__ void meta_task(int task, int& r0, int& aoff) const { r0 = task * 16; aoff = 0; }
    __device__ __forceinline__ void meta(int task, f32x4 a0, f32x4, int fr, int fq) const {
        const int col = task * 16 + 4 * fq;
        if (col < gelu_cols) {
#pragma unroll
            for (int j = 0; j < 4; ++j) a0[j] = gelu_tanh_f(a0[j]); }
        v2u w; w.x = cvt_pk_bf16(a0[0], a0[1]); w.y = cvt_pk_bf16(a0[2], a0[3]);
        *(v2u*)(O + (size_t)(MMAIN + fr) * ldc + col) = w;
    }
};
struct EpiSwiglu {
    static constexpr bool PERM = true, PAIR = true;
    bf16* O; int ldc; float sc;
    __device__ __forceinline__ void operator()(const f32x4 (&acc)[2][2][4][2], const pg8::Unit& u, int wr, int wc, int fr, int fq) const {
        const int row0 = u.pm * 256 + wr * 64 + fr, col0 = u.pn * 128 + wc * 32 + 8 * fq;
        float scl = sc; asm volatile("" : "+v"(scl));
#pragma unroll
        for (int ai = 0; ai < 2; ++ai)
#pragma unroll
            for (int m = 0; m < 4; ++m) { bf16* rowp = O + (size_t)(row0 + ai * 128 + m * 16) * ldc + col0;
                f32x4 g0 = acc[ai][0][m][0] * scl, g1 = acc[ai][0][m][1] * scl; const f32x4 u0 = acc[ai][1][m][0] * scl, u1 = acc[ai][1][m][1] * scl;
#pragma unroll
                for (int j = 0; j < 4; ++j) { g0[j] = silu_f(g0[j]) * u0[j]; g1[j] = silu_f(g1[j]) * u1[j]; }
                v4u w; w.x = cvt_pk_bf16(g0[0], g0[1]); w.y = cvt_pk_bf16(g0[2], g0[3]); w.z = cvt_pk_bf16(g1[0], g1[1]); w.w = cvt_pk_bf16(g1[2], g1[3]);
                *(v4u*)rowp = w; }
    }
    __device__ __forceinline__ void meta_task(int task, int& r0, int& aoff) const { r0 = (task >> 3) * 256 + (task & 7) * 16; aoff = 0; }
    __device__ __forceinline__ void meta(int task, f32x4 a0, f32x4 a1, int fr, int fq) const {
        const int col = (task >> 3) * 128 + (task & 7) * 16 + 4 * fq;
#pragma unroll
        for (int j = 0; j < 4; ++j) a0[j] = silu_f(a0[j] * sc) * (a1[j] * sc);
        v2u w; w.x = cvt_pk_bf16(a0[0], a0[1]); w.y = cvt_pk_bf16(a0[2], a0[3]);
        *(v2u*)(O + (size_t)(MMAIN + fr) * ldc + col) = w;
    }
};
struct EpiSwigluF8 {
    static constexpr bool PERM = true, PAIR = true;
    unsigned char* O; int ldc; float sc, osc;
    __device__ __forceinline__ void operator()(const f32x4 (&acc)[2][2][4][2], const pg8::Unit& u, int wr, int wc, int fr, int fq) const {
        const int row0 = u.pm * 256 + wr * 64 + fr, col0 = u.pn * 128 + wc * 32 + 8 * fq;
        float scl = sc, oscl = osc; asm volatile("" : "+v"(scl), "+v"(oscl));
#pragma unroll
        for (int ai = 0; ai < 2; ++ai)
#pragma unroll
            for (int m = 0; m < 4; ++m) { unsigned char* rowp = O + (size_t)(row0 + ai * 128 + m * 16) * ldc + col0;
                f32x4 g0 = acc[ai][0][m][0] * scl, g1 = acc[ai][0][m][1] * scl; const f32x4 u0 = acc[ai][1][m][0] * scl, u1 = acc[ai][1][m][1] * scl;
#pragma unroll
                for (int j = 0; j < 4; ++j) { g0[j] = silu_f(g0[j]) * u0[j] * oscl; g1[j] = silu_f(g1[j]) * u1[j] * oscl; }
                *(v2u*)rowp = (v2u){pk4_fp8(g0[0], g0[1], g0[2], g0[3]), pk4_fp8(g1[0], g1[1], g1[2], g1[3])}; }
    }
};
struct EpiF32 {
    static constexpr bool PERM = false, PAIR = false;
    float* C; int ldc;
    __device__ __forceinline__ void operator()(const f32x4 (&acc)[2][2][4][2], const pg8::Unit& u, int wr, int wc, int fr, int fq) const {
        const int row0 = u.pm * 256 + wr * 64 + fr, col0 = u.pn * 256 + wc * 32 + 4 * fq;
#pragma unroll
        for (int ai = 0; ai < 2; ++ai)
#pragma unroll
            for (int m = 0; m < 4; ++m) { float* rowp = C + (size_t)(row0 + ai * 128 + m * 16) * ldc + col0;
#pragma unroll
                for (int bj = 0; bj < 2; ++bj)
#pragma unroll
                    for (int n = 0; n < 2; ++n) *(f32x4*)(rowp + bj * 128 + n * 16) = acc[ai][bj][m][n]; }
    }
    __device__ __forceinline__ void meta_task(int task, int& r0, int& aoff) const { r0 = task * 16; aoff = 0; }
    __device__ __forceinline__ void meta(int task, f32x4 a0, f32x4, int fr, int fq) const { *(f32x4*)(C + (size_t)(MMAIN + fr) * ldc + task * 16 + 4 * fq) = a0; }
};

template <class Epi>
__device__ __forceinline__ void meta_gemm(Frame& F, const bf16* A16, int lda, int K, const bf16* Bt, int ntasks, const Epi& E) {
    const int fr = F.lane & 15, fq = F.lane >> 4;
    LAS f32x4* red = (LAS f32x4*)F.lds;
    for (int task = F.bx; task < ntasks; task += F.G) {
        int r0, aoff; E.meta_task(task, r0, aoff);
        f32x4 acc0 = (f32x4){0.f, 0.f, 0.f, 0.f}, acc1 = acc0;
        const bf16* ap = A16 + (size_t)fr * lda + aoff + fq * 8; const bf16* bp0 = Bt + (size_t)(r0 + fr) * K + fq * 8; const bf16* bp1 = bp0 + (size_t)128 * K;
        const int nks = K / 32;
        for (int ks0 = F.wave; ks0 < nks; ks0 += 4 * NWAVES) {
            bf16x8 a[4], b0[4], b1[4];
#pragma unroll
            for (int t = 0; t < 4; ++t) { const int ks = ks0 + t * NWAVES; const int kc = ks < nks ? ks : F.wave;
                a[t] = *(const bf16x8*)(ap + kc * 32); b0[t] = *(const bf16x8*)(bp0 + kc * 32); if (Epi::PAIR) b1[t] = *(const bf16x8*)(bp1 + kc * 32); }
#pragma unroll
            for (int t = 0; t < 4; ++t) { if (ks0 + t * NWAVES < nks) {
                acc0 = __builtin_amdgcn_mfma_f32_16x16x32_bf16(b0[t], a[t], acc0, 0, 0, 0);
                if (Epi::PAIR) acc1 = __builtin_amdgcn_mfma_f32_16x16x32_bf16(b1[t], a[t], acc1, 0, 0, 0); } }
        }
        red[(F.wave * 2 + 0) * 64 + F.lane] = acc0; if (Epi::PAIR) red[(F.wave * 2 + 1) * 64 + F.lane] = acc1;
        __syncthreads();
        if (F.wave == 0) {
            f32x4 s0 = red[F.lane], s1 = Epi::PAIR ? red[64 + F.lane] : acc1;
#pragma unroll
            for (int w = 1; w < NWAVES; ++w) { s0 += red[(w * 2) * 64 + F.lane]; if (Epi::PAIR) s1 += red[(w * 2 + 1) * 64 + F.lane]; }
            E.meta(task, s0, s1, fr, fq);
        }
        __syncthreads();
    }
}

__device__ __forceinline__ void transpose_item(const float* W, int ldw, int Ksrc, int c0, int nvalid, bf16* WT, int Kdst, int n0, int k0, LAS float* scr, int lane) {
#pragma unroll 8
    for (int i = 0; i < 32; ++i) { const int kk = 2 * i + (lane >> 5), c = lane & 31;
        const bool ok = (k0 + kk < Ksrc) && (c < nvalid); const float v = W[ok ? (size_t)(k0 + kk) * ldw + c0 + c : (size_t)0];
        scr[kk * 33 + c] = ok ? v : 0.f; }
    LDS_WAIT(); asm volatile("" ::: "memory");
    const int c = lane & 7;
#pragma unroll
    for (int j = 0; j < 4; ++j) { const int n = (lane >> 3) + 8 * j; const LAS float* s = scr + (8 * c) * 33 + n;
        v4u o; o.x = pk2(s[0 * 33], s[1 * 33]); o.y = pk2(s[2 * 33], s[3 * 33]); o.z = pk2(s[4 * 33], s[5 * 33]); o.w = pk2(s[6 * 33], s[7 * 33]);
        *(v4u*)(WT + (size_t)(n0 + n) * Kdst + k0 + 8 * c) = o; }
    LDS_WAIT(); asm volatile("" ::: "memory");
}
__device__ __forceinline__ void transpose_item_fp8(const float* W, int ldw, int Ksrc, int c0, int nvalid, unsigned char* WT, int Kdst, int n0, int k0, float scale, LAS float* scr, int lane) {
#pragma unroll 8
    for (int i = 0; i < 32; ++i) { const int kk = 2 * i + (lane >> 5), c = lane & 31;
        const bool ok = (k0 + kk < Ksrc) && (c < nvalid); const float v = W[ok ? (size_t)(k0 + kk) * ldw + c0 + c : (size_t)0];
        scr[kk * 33 + c] = ok ? v * scale : 0.f; }
    LDS_WAIT(); asm volatile("" ::: "memory");
    const int c4 = lane & 3;
#pragma unroll
    for (int j = 0; j < 2; ++j) { const int n = (lane >> 2) + 16 * j; const LAS float* sp = scr + (16 * c4) * 33 + n;
        v4u o; o.x = pk4_fp8(sp[0 * 33], sp[1 * 33], sp[2 * 33], sp[3 * 33]); o.y = pk4_fp8(sp[4 * 33], sp[5 * 33], sp[6 * 33], sp[7 * 33]);
        o.z = pk4_fp8(sp[8 * 33], sp[9 * 33], sp[10 * 33], sp[11 * 33]); o.w = pk4_fp8(sp[12 * 33], sp[13 * 33], sp[14 * 33], sp[15 * 33]);
        *(v4u*)(WT + (size_t)(n0 + n) * Kdst + k0 + 16 * c4) = o; }
    LDS_WAIT(); asm volatile("" ::: "memory");
}
__device__ __forceinline__ void map_id(int n0, int nsrc, int& c0, int& nv) { c0 = n0; nv = nsrc - n0; nv = nv < 0 ? 0 : (nv > 32 ? 32 : nv); if (nv == 0) c0 = 0; }
__device__ __forceinline__ void map_swiglu(int n0, int& c0, int& nv) { const int tile = n0 >> 8, rr = n0 & 255; c0 = rr < 128 ? tile * 128 + rr : FF + tile * 128 + rr - 128; nv = 32; }

__device__ __forceinline__ void p0_prologue(Frame& F, const Args& a) {
    LAS float* scr = (LAS float*)(F.lds + F.wave * 16384);
    const int gw = F.bx * NWAVES + F.wave, NGW = F.G * NWAVES;
    constexpr int I_RGIN = (D / 64) * (NRG / 32), I_GATES = (KGT / 64) * (NGT / 32), I_RGOUT = (KRGO / 64) * (D / 32), I_GLAIN = (D / 64) * (NGLA / 32), I_GLAOUT = (D / 64) * (D / 32),
                  I_FFNIN = (D / 64) * (NFF2 / 32), I_FFNOUT = (FF / 64) * (D / 32), I_MOEIN = NE * I_FFNIN, I_MOEOUT = NE * I_FFNOUT;
    constexpr int I_PER_J = I_RGIN + I_GATES + I_RGOUT + I_GLAIN + I_GLAOUT + I_FFNIN + I_FFNOUT + I_MOEIN + I_MOEOUT;
    for (int it = gw; it < 2 * I_PER_J; it += NGW) {
        const int j = it / I_PER_J; int r = it - j * I_PER_J;
        unsigned char* wl = F.ws + WS_W + (size_t)j * WL_STRIDE;
        int c0, nv;
        if (r < I_RGIN) { const int nb = r % (NRG / 32), kb = r / (NRG / 32); map_id(nb * 32, 2 * RGW, c0, nv);
            transpose_item(a.in[4] + (size_t)j * D * 2 * RGW, 2 * RGW, D, c0, nv, (bf16*)(wl + WL_RGIN), D, nb * 32, kb * 64, scr, F.lane); continue; } r -= I_RGIN;
        if (r < I_GATES) { const int nb = r % (NGT / 32), kb = r / (NGT / 32); const int n0 = nb * 32, pn = n0 >> 8, rr = n0 & 255, g = rr >> 7, cc = rr & 127, d0 = (pn & 1) * 128 + cc, blk = pn >> 1;
            nv = RGBW - d0; nv = nv < 0 ? 0 : (nv > 32 ? 32 : nv); c0 = nv ? d0 : 0;
            transpose_item(a.in[7] + ((size_t)(j * 2 + g) * 8 + blk) * RGBW * RGBW, RGBW, RGBW, c0, nv, (bf16*)(wl + WL_GATES), KGT, n0, kb * 64, scr, F.lane); continue; } r -= I_GATES;
        if (r < I_RGOUT) { const int nb = r % (D / 32), kb = r / (D / 32);
            transpose_item(a.in[10] + (size_t)j * RGW * D, D, RGW, nb * 32, 32, (bf16*)(wl + WL_RGOUT), KRGO, nb * 32, kb * 64, scr, F.lane); continue; } r -= I_RGOUT;
        if (r < I_GLAIN) { const int nb = r % (NGLA / 32), kb = r / (NGLA / 32);
            transpose_item(a.in[11] + (size_t)j * D * GLAW, GLAW, D, nb * 32, 32, (bf16*)(wl + WL_GLAIN), D, nb * 32, kb * 64, scr, F.lane); continue; } r -= I_GLAIN;
        if (r < I_GLAOUT) { const int nb = r % (D / 32), kb = r / (D / 32);
            transpose_item(a.in[15] + (size_t)j * D * D, D, D, nb * 32, 32, (bf16*)(wl + WL_GLAOUT), D, nb * 32, kb * 64, scr, F.lane); continue; } r -= I_GLAOUT;
        if (r < I_FFNIN) { const int nb = r % (NFF2 / 32), kb = r / (NFF2 / 32); map_swiglu(nb * 32, c0, nv);
            transpose_item(a.in[16] + (size_t)j * D * NFF2, NFF2, D, c0, nv, (bf16*)(wl + WL_FFNIN), D, nb * 32, kb * 64, scr, F.lane); continue; } r -= I_FFNIN;
        if (r < I_FFNOUT) { const int nb = r % (D / 32), kb = r / (D / 32);
            transpose_item(a.in[17] + (size_t)j * FF * D, D, FF, nb * 32, 32, (bf16*)(wl + WL_FFNOUT), FF, nb * 32, kb * 64, scr, F.lane); continue; } r -= I_FFNOUT;
        if (r < I_MOEIN) { const int e = r / I_FFNIN, r2 = r % I_FFNIN; const int nb = r2 % (NFF2 / 32), kb = r2 / (NFF2 / 32); map_swiglu(nb * 32, c0, nv);
            transpose_item_fp8(a.in[19] + ((size_t)j * NE + e) * D * NFF2, NFF2, D, c0, nv, (unsigned char*)(wl + WL_MOEIN) + (size_t)e * NFF2 * D, D, nb * 32, kb * 64, 64.0f, scr, F.lane); continue; } r -= I_MOEIN;
        { const int e = r / I_FFNOUT, r2 = r % I_FFNOUT; const int nb = r2 % (D / 32), kb = r2 / (D / 32);
            transpose_item_fp8(a.in[20] + ((size_t)j * NE + e) * FF * D, D, FF, nb * 32, 32, (unsigned char*)(wl + WL_MOEOUT) + (size_t)e * D * FF, FF, nb * 32, kb * 64, 256.0f, scr, F.lane); }
    }
    bf16* HB = (bf16*)(F.ws + WS_HB);
    for (int m = gw; m < MROWS; m += NGW) {
        const float* src = m < MMAIN ? a.in[0] + (size_t)m * D : a.in[1] + (size_t)(m - MMAIN) * D;
#pragma unroll
        for (int q = 0; q < 4; ++q) { const f32x4 v = *(const f32x4*)(src + 4 * F.lane + 256 * q);
            v2u w; w.x = pk2(v[0], v[1]); w.y = pk2(v[2], v[3]); *(v2u*)(HB + (size_t)m * D + 4 * F.lane + 256 * q) = w; }
    }
}

struct LnRow { v4u h[2], a[2], b[2]; float w1, w2; };
__device__ __forceinline__ void unpack8(const v4u& w, float* o) { o[0] = bflo(w.x); o[1] = bfhi(w.x); o[2] = bflo(w.y); o[3] = bfhi(w.y); o[4] = bflo(w.z); o[5] = bfhi(w.z); o[6] = bflo(w.w); o[7] = bfhi(w.w); }
__device__ __forceinline__ void ln_phase(Frame& F, int mixkind, const float* gam, const float* bet, int extra, const float* Wx, int ldx, float* outp, gu32* moe_cnt) {
    bf16* HB = (bf16*)(F.ws + WS_HB); const bf16* MIX = (const bf16*)(F.ws + WS_MIX);
    const bf16* YS = (const bf16*)(F.ws + WS_S0 + S_YS);
    int* E1 = (int*)(F.ws + WS_RT); int* E2 = E1 + MROWS; float* W1 = (float*)(E2 + MROWS); float* W2 = W1 + MROWS; int* POS1 = (int*)(W2 + MROWS); int* POS2 = POS1 + MROWS;
    float* Z = (float*)(F.ws + WS_Z);
    LAS float* WL = (LAS float*)F.lds;
    LAS unsigned* lcnt = (LAS unsigned*)(F.lds + 65536);
    const int NC = extra == 1 ? 16 : (extra == 2 ? 8 : 0);
    if (extra) { for (int i = F.tid; i < NC * D; i += NTHR) { const int c = i / NC, e = i - c * NC; WL[((e * 2 + (c >> 9)) * 2 + ((c >> 2) & 1)) * 256 + 4 * ((c & 511) >> 3) + (c & 3)] = Wx[(size_t)c * ldx + e]; }
        if (F.tid < 8) lcnt[F.tid] = 0u;
        __syncthreads(); }
    const int gw = F.bx * NWAVES + F.wave, NGW = F.G * NWAVES, lane = F.lane;
    float gv[16], bv[16];
#pragma unroll
    for (int q = 0; q < 2; ++q)
#pragma unroll
        for (int t = 0; t < 2; ++t) { const f32x4 g4 = *(const f32x4*)(gam + 512 * q + 8 * lane + 4 * t), b4 = *(const f32x4*)(bet + 512 * q + 8 * lane + 4 * t);
#pragma unroll
            for (int k = 0; k < 4; ++k) { gv[8 * q + 4 * t + k] = g4[k]; bv[8 * q + 4 * t + k] = b4[k]; } }
    unsigned mycnt = 0u;
    auto ln_load = [&](LnRow (&R)[2], int m0) {
#pragma unroll
        for (int r = 0; r < 2; ++r) { const int m = m0 + r * NGW; if (m < MROWS) {
            const bf16* hp = HB + (size_t)m * D + 8 * lane; R[r].h[0] = *(const v4u*)hp; R[r].h[1] = *(const v4u*)(hp + 512);
            if (mixkind == 1) { const bf16* mp = MIX + (size_t)m * D + 8 * lane; R[r].a[0] = *(const v4u*)mp; R[r].a[1] = *(const v4u*)(mp + 512); }
            if (mixkind == 2) { R[r].w1 = W1[m]; R[r].w2 = W2[m]; const bf16* y1 = YS + (size_t)POS1[m] * D + 8 * lane; const bf16* y2 = YS + (size_t)POS2[m] * D + 8 * lane;
                R[r].a[0] = *(const v4u*)y1; R[r].a[1] = *(const v4u*)(y1 + 512); R[r].b[0] = *(const v4u*)y2; R[r].b[1] = *(const v4u*)(y2 + 512); } } }
    };
    LnRow Rn[2];
    ln_load(Rn, gw);
    for (int m0 = gw; m0 < MROWS; m0 += 2 * NGW) {
        LnRow R[2];
#pragma unroll
        for (int r = 0; r < 2; ++r) R[r] = Rn[r];
        ln_load(Rn, m0 + 2 * NGW);
#pragma unroll
        for (int r = 0; r < 2; ++r) { const int m = m0 + r * NGW; if (m < MROWS) {
            float v[16]; unpack8(R[r].h[0], v); unpack8(R[r].h[1], v + 8);
#pragma unroll
            for (int k = 0; k < 16; ++k) v[k] *= ALPHA;
            if (mixkind == 1) { float t[16]; unpack8(R[r].a[0], t); unpack8(R[r].a[1], t + 8);
#pragma unroll
                for (int k = 0; k < 16; ++k) v[k] += t[k]; }
            if (mixkind == 2) { float t[16], u[16]; unpack8(R[r].a[0], t); unpack8(R[r].a[1], t + 8); unpack8(R[r].b[0], u); unpack8(R[r].b[1], u + 8);
#pragma unroll
                for (int k = 0; k < 16; ++k) v[k] += t[k] * R[r].w1 + u[k] * R[r].w2; }
            float s = 0.f;
#pragma unroll
            for (int k = 0; k < 16; ++k) s += v[k];
            const float mean = wave_sum(s, lane) * (1.f / D); float s2 = 0.f;
#pragma unroll
            for (int k = 0; k < 16; ++k) { v[k] -= mean; s2 += v[k] * v[k]; }
            const float rstd = __builtin_amdgcn_rsqf(wave_sum(s2, lane) * (1.f / D) + LN_EPS);
#pragma unroll
            for (int k = 0; k < 16; ++k) v[k] = v[k] * rstd * gv[k] + bv[k];
            bf16* op = HB + (size_t)m * D + 8 * lane;
            *(v4u*)op = (v4u){pk2(v[0], v[1]), pk2(v[2], v[3]), pk2(v[4], v[5]), pk2(v[6], v[7])}; *(v4u*)(op + 512) = (v4u){pk2(v[8], v[9]), pk2(v[10], v[11]), pk2(v[12], v[13]), pk2(v[14], v[15])};
            if (outp && m < MMAIN) { float* o = outp + (size_t)m * D + 8 * lane;
                *(f32x4*)o = (f32x4){v[0], v[1], v[2], v[3]}; *(f32x4*)(o + 4) = (f32x4){v[4], v[5], v[6], v[7]}; *(f32x4*)(o + 512) = (f32x4){v[8], v[9], v[10], v[11]}; *(f32x4*)(o + 516) = (f32x4){v[12], v[13], v[14], v[15]}; }
            if (extra) {
                float pp[16];
#pragma unroll
                for (int e = 0; e < 16; ++e) { pp[e] = 0.f; if (e < NC) { float p = 0.f;
#pragma unroll
                        for (int q = 0; q < 2; ++q) { const f32x4 w0 = *(const LAS f32x4*)(WL + ((e * 2 + q) * 2 + 0) * 256 + 4 * lane), w1 = *(const LAS f32x4*)(WL + ((e * 2 + q) * 2 + 1) * 256 + 4 * lane);
                            p += (v[8 * q + 0] * w0[0] + v[8 * q + 1] * w0[1]) + (v[8 * q + 2] * w0[2] + v[8 * q + 3] * w0[3]) + (v[8 * q + 4] * w1[0] + v[8 * q + 5] * w1[1]) + (v[8 * q + 6] * w1[2] + v[8 * q + 7] * w1[3]); }
                        pp[e] = p; } }
                float lg[8]; float zv;
                if (extra == 1) {
#pragma unroll
                    for (int k = 0; k < 8; ++k) { const bool up = lane & 32; const float snd = up ? pp[k] : pp[k + 8], kp = up ? pp[k + 8] : pp[k]; pp[k] = kp + shx(snd, 32, lane); }
#pragma unroll
                    for (int k = 0; k < 4; ++k) { const bool up = lane & 16; const float snd = up ? pp[k] : pp[k + 4], kp = up ? pp[k + 4] : pp[k]; pp[k] = kp + shx(snd, 16, lane); }
#pragma unroll
                    for (int k = 0; k < 2; ++k) { const bool up = lane & 8; const float snd = up ? pp[k] : pp[k + 2], kp = up ? pp[k + 2] : pp[k]; pp[k] = kp + shx(snd, 8, lane); }
                    { const bool up = lane & 4; const float snd = up ? pp[0] : pp[1], kp = up ? pp[1] : pp[0]; zv = kp + shx(snd, 4, lane); }
                    zv += shx(zv, 2, lane); zv += shx(zv, 1, lane);
                } else {
#pragma unroll
                    for (int k = 0; k < 4; ++k) { const bool up = lane & 32; const float snd = up ? pp[k] : pp[k + 4], kp = up ? pp[k + 4] : pp[k]; pp[k] = kp + shx(snd, 32, lane); }
#pragma unroll
                    for (int k = 0; k < 2; ++k) { const bool up = lane & 16; const float snd = up ? pp[k] : pp[k + 2], kp = up ? pp[k + 2] : pp[k]; pp[k] = kp + shx(snd, 16, lane); }
                    float rv; { const bool up = lane & 8; const float snd = up ? pp[0] : pp[1], kp = up ? pp[1] : pp[0]; rv = kp + shx(snd, 8, lane); }
                    rv += shx(rv, 4, lane); rv += shx(rv, 2, lane); rv += shx(rv, 1, lane);
#pragma unroll
                    for (int e = 0; e < 8; ++e) lg[e] = __int_as_float(__builtin_amdgcn_readlane(__float_as_int(rv), ((e >> 2) & 1) * 32 + ((e >> 1) & 1) * 16 + (e & 1) * 8));
                }
                if (extra == 1) { if ((lane & 3) == 0) Z[(size_t)m * 16 + ((lane >> 5) & 1) * 8 + ((lane >> 4) & 1) * 4 + ((lane >> 3) & 1) * 2 + ((lane >> 2) & 1)] = zv; }
                else { int e1 = 0; float l1 = lg[0];
#pragma unroll
                    for (int e = 1; e < 8; ++e) if (lg[e] > l1) { l1 = lg[e]; e1 = e; }
                    int e2 = -1; float l2 = -3.0e38f;
#pragma unroll
                    for (int e = 0; e < 8; ++e) if (e != e1 && lg[e] > l2) { l2 = lg[e]; e2 = e; }
                    const float w2 = 1.f / (1.f + __expf(l1 - l2)), w1 = 1.f - w2;
                    if (lane == 0) { E1[m] = e1; E2[m] = e2; W1[m] = w1; W2[m] = w2; }
                    mycnt += (lane == e1 || lane == e2) ? 1u : 0u; }
            } } }
    }
    if (extra == 2) { if (lane < 8 && mycnt) __hip_atomic_fetch_add(&lcnt[lane], mycnt, __ATOMIC_RELAXED, __HIP_MEMORY_SCOPE_WORKGROUP);
        __syncthreads();
        if (F.tid < 8 && lcnt[F.tid]) __hip_atomic_fetch_add(moe_cnt + F.tid, lcnt[F.tid], RLX_AGENT); }
}

struct EpiGates {
    static constexpr bool PERM = true, PAIR = true;
    bf16* LOGA; bf16* U; const bf16* XC; const float* bg; const float* lam;
    __device__ __forceinline__ void chan4(int ch, f32x4& br, f32x4& bi, f32x4& c8) const {
        br = *(const f32x4*)(bg + ch); bi = *(const f32x4*)(bg + RGW + ch); const f32x4 lm = *(const f32x4*)(lam + ch);
#pragma unroll
        for (int t = 0; t < 4; ++t) { const float x = __expf(-lm[t]); c8[t] = -8.0f * (x * (1.0f - x * (0.5f - x * (0.33333333f - 0.25f * x)))); }
    }
    __device__ __forceinline__ void elem4(int row, int blk, int d, f32x4 ra, f32x4 ia, const f32x4& br, const f32x4& bi, const f32x4& c8) const {
        const int ch = blk * RGBW + d;
        const v2u xw = *(const v2u*)(XC + (size_t)row * XCW + blk * 256 + d);
        const float xc[4] = {bflo(xw.x), bfhi(xw.x), bflo(xw.y), bfhi(xw.y)};
        f32x4 la, uu;
#pragma unroll
        for (int t = 0; t < 4; ++t) {
            const float r = sigmoid_f(ra[t] + br[t]), ig = sigmoid_f(ia[t] + bi[t]);
            const float l = c8[t] * r;
            const float a2 = fast_exp(2.0f * l);
            la[t] = l; uu[t] = __builtin_amdgcn_sqrtf(fmaxf(1.0f - a2, 0.f)) * (ig * xc[t]);
        }
        *(v2u*)(LOGA + (size_t)row * RGW + ch) = (v2u){pk2(la[0], la[1]), pk2(la[2], la[3])}; *(v2u*)(U + (size_t)row * RGW + ch) = (v2u){pk2(uu[0], uu[1]), pk2(uu[2], uu[3])};
    }
    __device__ __forceinline__ void elem8(int row, int blk, int d, f32x4 ra0, f32x4 ia0, f32x4 ra1, f32x4 ia1, const f32x4 (&br)[2], const f32x4 (&bi)[2], const f32x4 (&c8)[2]) const {
        const int ch = blk * RGBW + d;
        const v4u xw = *(const v4u*)(XC + (size_t)row * XCW + blk * 256 + d);
        float xc[8]; unpack8(xw, xc);
        float la[8], uu[8];
#pragma unroll
        for (int t = 0; t < 8; ++t) {
            const float rav = t < 4 ? ra0[t & 3] : ra1[t & 3], iav = t < 4 ? ia0[t & 3] : ia1[t & 3];
            const float r = sigmoid_f(rav + br[t >> 2][t & 3]), ig = sigmoid_f(iav + bi[t >> 2][t & 3]);
            const float l = c8[t >> 2][t & 3] * r;
            const float a2 = fast_exp(2.0f * l);
            la[t] = l; uu[t] = __builtin_amdgcn_sqrtf(fmaxf(1.0f - a2, 0.f)) * (ig * xc[t]);
        }
        *(v4u*)(LOGA + (size_t)row * RGW + ch) = (v4u){pk2(la[0], la[1]), pk2(la[2], la[3]), pk2(la[4], la[5]), pk2(la[6], la[7])};
        *(v4u*)(U + (size_t)row * RGW + ch) = (v4u){pk2(uu[0], uu[1]), pk2(uu[2], uu[3]), pk2(uu[4], uu[5]), pk2(uu[6], uu[7])};
    }
    __device__ __forceinline__ void operator()(const f32x4 (&acc)[2][2][4][2], const pg8::Unit& u, int wr, int wc, int fr, int fq) const {
        const int row0 = u.pm * 256 + wr * 64 + fr, blk = u.pn >> 1, d0 = (u.pn & 1) * 128 + wc * 32 + 8 * fq;
        if (d0 < RGBW) {
            f32x4 br[2], bi[2], c8[2]; chan4(blk * RGBW + d0, br[0], bi[0], c8[0]); chan4(blk * RGBW + d0 + 4, br[1], bi[1], c8[1]);
#pragma unroll
            for (int ai = 0; ai < 2; ++ai)
#pragma unroll
                for (int m = 0; m < 4; ++m) elem8(row0 + ai * 128 + m * 16, blk, d0, acc[ai][0][m][0], acc[ai][1][m][0], acc[ai][0][m][1], acc[ai][1][m][1], br, bi, c8); }
    }
    __device__ __forceinline__ void meta_task(int task, int& r0, int& aoff) const { const int pn = task >> 3; r0 = pn * 256 + (task & 7) * 16; aoff = (pn >> 1) * 256; }
    __device__ __forceinline__ void meta(int task, f32x4 a0, f32x4 a1, int fr, int fq) const {
        const int pn = task >> 3, d = (pn & 1) * 128 + (task & 7) * 16 + 4 * fq;
        if (d < RGBW) { f32x4 br, bi, c8; chan4((pn >> 1) * RGBW + d, br, bi, c8); elem4(MMAIN + fr, pn >> 1, d, a0, a1, br, bi, c8); }
    }
};

__device__ __forceinline__ int conv_src_row(int row, int delta) {
    if (row < MMAIN) { const int t = row & (SEQ - 1); return (t - delta >= 0) ? row - delta : MMAIN + NMETA + (t - delta); }
    const int jm = row - MMAIN; return (jm - delta >= 0) ? row - delta : -1;
}
__device__ __forceinline__ void rg_conv_phase(Frame& F, const float* cw, const float* cb) {
    const bf16* PROJ = (const bf16*)(F.ws + WS_S0 + S_PROJ); bf16* XC = (bf16*)(F.ws + WS_S0 + S_XC);
    const int g = F.tid & 255, blk = g >> 5, kk = (g & 31) * 8, ch = blk * RGBW + kk;
    constexpr int NIT = (MROWS / 4) * 256;
    const int stride = F.G * NTHR;
    if (kk < RGBW) {
        float w[4][8], bb[8];
        { const f32x4 b0 = *(const f32x4*)(cb + ch), b1 = *(const f32x4*)(cb + ch + 4);
#pragma unroll
          for (int k = 0; k < 4; ++k) { bb[k] = b0[k]; bb[4 + k] = b1[k]; } }
#pragma unroll
        for (int tap = 0; tap < 4; ++tap) { const f32x4 w0 = *(const f32x4*)(cw + tap * RGW + ch), w1 = *(const f32x4*)(cw + tap * RGW + ch + 4);
#pragma unroll
            for (int k = 0; k < 4; ++k) { w[tap][k] = w0[k]; w[tap][4 + k] = w1[k]; } }
        for (int idx = F.bx * NTHR + F.tid; idx < NIT; idx += 2 * stride) {
            v4u x[2][7];
#pragma unroll
            for (int it = 0; it < 2; ++it) { const int id2 = idx + it * stride; if (id2 < NIT) { const int r0 = (id2 >> 8) * 4;
#pragma unroll
                for (int t = 0; t < 3; ++t) { const int rr = conv_src_row(r0, 3 - t); x[it][t] = (v4u){0u, 0u, 0u, 0u}; if (rr >= 0) x[it][t] = *(const v4u*)(PROJ + (size_t)rr * NRG + RGW + ch); }
#pragma unroll
                for (int t = 0; t < 4; ++t) x[it][3 + t] = *(const v4u*)(PROJ + (size_t)(r0 + t) * NRG + RGW + ch); } }
#pragma unroll
            for (int it = 0; it < 2; ++it) { const int id2 = idx + it * stride; if (id2 < NIT) { const int r0 = (id2 >> 8) * 4;
                bf16* xo = XC + (size_t)r0 * XCW + blk * 256 + kk;
                float xf[7][8];
#pragma unroll
                for (int t = 0; t < 7; ++t) unpack8(x[it][t], xf[t]);
#pragma unroll
                for (int i = 0; i < 4; ++i) { float a[8];
#pragma unroll
                    for (int k = 0; k < 8; ++k) a[k] = bb[k] + xf[i][k] * w[0][k] + xf[i + 1][k] * w[1][k] + xf[i + 2][k] * w[2][k] + xf[i + 3][k] * w[3][k];
                    *(v4u*)(xo + (size_t)i * XCW) = (v4u){pk2(a[0], a[1]), pk2(a[2], a[3]), pk2(a[4], a[5]), pk2(a[6], a[7])}; } } }
        }
    } else {
        for (int idx = F.bx * NTHR + F.tid; idx < NIT; idx += stride) { bf16* xo = XC + (size_t)((idx >> 8) * 4) * XCW + blk * 256 + kk;
#pragma unroll
            for (int i = 0; i < 4; ++i) *(v4u*)(xo + (size_t)i * XCW) = (v4u){0u, 0u, 0u, 0u}; }
    }
}
template <bool FIX>
__device__ __forceinline__ void rg_scan_phase(Frame& F) {
    const bf16* LOGA = (const bf16*)(F.ws + WS_S0 + S_LOGA); const bf16* U = (const bf16*)(F.ws + WS_S0 + S_U);
    const bf16* PROJ = (const bf16*)(F.ws + WS_S0 + S_PROJ); bf16* Y = (bf16*)(F.ws + WS_S0 + S_Y);
    float* AGGA = (float*)(F.ws + WS_AGG); float* AGGH = AGGA + (size_t)NSEG * RGW;
    const int gw = F.bx * NWAVES + F.wave, NGW = F.G * NWAVES;
    constexpr int NCG = 11, RB = FIX ? 16 : 32;
    for (int task = gw; task < NSEG * NCG; task += NGW) {
        const int seg = task / NCG, cg = task - seg * NCG, ch = cg * 128 + 2 * F.lane;
        const int row0 = seg == 0 ? MMAIN : (seg - 1) * SEG, nrows = seg == 0 ? NMETA : SEG;
        if (ch >= RGW) {
            if (FIX) for (int r = 0; r < nrows; ++r) *(unsigned*)(Y + (size_t)(row0 + r) * KRGO + ch) = 0u;
            continue;
        }
        float h0 = 0.f, h1 = 0.f, c0 = 0.f, c1 = 0.f;
        if (FIX && seg > 0) {
            { const f32x2 hm = *(const f32x2*)(AGGH + ch); h0 = hm[0]; h1 = hm[1]; }
            const int sb = 1 + ((seg - 1) / NSEG_B) * NSEG_B, ns = (seg - 1) % NSEG_B;
            for (int q = 0; q < ns; q += 8) { f32x2 aa[8], hh[8];
#pragma unroll
                for (int t = 0; t < 8; ++t) { const int qq = (q + t < ns) ? q + t : ns - 1; aa[t] = *(const f32x2*)(AGGA + (size_t)(sb + qq) * RGW + ch); hh[t] = *(const f32x2*)(AGGH + (size_t)(sb + qq) * RGW + ch); }
#pragma unroll
                for (int t = 0; t < 8; ++t) if (q + t < ns) { h0 = __expf(aa[t][0]) * h0 + hh[t][0]; h1 = __expf(aa[t][1]) * h1 + hh[t][1]; } }
        }
        for (int r = 0; r < nrows; r += RB) {
            unsigned la[RB], uu[RB], gt[RB];
#pragma unroll
            for (int t = 0; t < RB; ++t) { const int rr = row0 + ((r + t < nrows) ? r + t : nrows - 1); const size_t o = (size_t)rr * RGW + ch; la[t] = *(const unsigned*)(LOGA + o); uu[t] = *(const unsigned*)(U + o); if (FIX) gt[t] = *(const unsigned*)(PROJ + (size_t)rr * NRG + ch); }
#pragma unroll
            for (int t = 0; t < RB; ++t) if (r + t < nrows) { const float l0 = bflo(la[t]), l1 = bfhi(la[t]);
                h0 = __expf(l0) * h0 + bflo(uu[t]); h1 = __expf(l1) * h1 + bfhi(uu[t]); c0 += l0; c1 += l1;
                if (FIX) *(unsigned*)(Y + (size_t)(row0 + r + t) * KRGO + ch) = pk2(h0 * bflo(gt[t]), h1 * bfhi(gt[t])); }
        }
        if (!FIX) { *(f32x2*)(AGGA + (size_t)seg * RGW + ch) = (f32x2){c0, c1}; *(f32x2*)(AGGH + (size_t)seg * RGW + ch) = (f32x2){h0, h1}; }
    }
}

#define RG_PHASES \
        if (IN(pb + 0)) { if (on_rg) { \
            bf16* PROJ = (bf16*)(F.ws + WS_S0 + S_PROJ); EpiBf16Gelu E{PROJ, NRG, RGW}; \
            meta_gemm(F, HB + (size_t)MMAIN * D, D, D, (const bf16*)(wl + WL_RGIN), NRG / 16, E); \
            pg8::Gemm g{D, D}; pg8::DenseOrder S; S.init(HB, D, (const bf16*)(wl + WL_RGIN), D, MMAIN / 256, NRG / 256, F.G, F.bx); \
            pg8::gemm_phase<EpiBf16Gelu, pg8::DenseOrder>(F.lds, F.tid, g, S, E); } \
            SEAM(pb + 0); } \
        if (IN(pb + 1)) { if (on_rg) rg_conv_phase(F, args.in[5] + (size_t)j * 4 * RGW, args.in[6] + (size_t)j * RGW); SEAM(pb + 1); } \
        if (IN(pb + 2)) { if (on_rg) { \
            const bf16* XC = (const bf16*)(F.ws + WS_S0 + S_XC); \
            EpiGates E{(bf16*)(F.ws + WS_S0 + S_LOGA), (bf16*)(F.ws + WS_S0 + S_U), XC, args.in[8] + (size_t)j * 2 * RGW, args.in[9] + (size_t)j * RGW}; \
            meta_gemm(F, XC + (size_t)MMAIN * XCW, XCW, KGT, (const bf16*)(wl + WL_GATES), (NGT / 256) * 8, E); \
            pg8::Gemm g{KGT, XCW}; pg8::GatesOrder S; S.init(XC, XCW, (const bf16*)(wl + WL_GATES), KGT, MMAIN / 256, NGT / 256, F.G, F.bx); \
            pg8::gemm_phase<EpiGates, pg8::GatesOrder>(F.lds, F.tid, g, S, E); } \
            SEAM(pb + 2); } \
        if (IN(pb + 3)) { if (on_rg) rg_scan_phase<false>(F); SEAM(pb + 3); } \
        if (IN(pb + 4)) { if (on_rg) rg_scan_phase<true>(F); SEAM(pb + 4); } \
        if (IN(pb + 5)) { if (on_rg) { \
            const bf16* Y = (const bf16*)(F.ws + WS_S0 + S_Y); EpiBf16Gelu E{MIX, D, 0}; \
            meta_gemm(F, Y + (size_t)MMAIN * KRGO, KRGO, KRGO, (const bf16*)(wl + WL_RGOUT), D / 16, E); \
            pg8::Gemm g{KRGO, KRGO}; pg8::DenseOrder S; S.init(Y, KRGO, (const bf16*)(wl + WL_RGOUT), KRGO, MMAIN / 256, D / 256, F.G, F.bx); \
            pg8::gemm_phase<EpiBf16Gelu, pg8::DenseOrder>(F.lds, F.tid, g, S, E); } \
            SEAM(pb + 5); }

constexpr int GL_QT = 0, GL_KT = 17408  , GL_KTT = 34816, GL_VT = 53248, GL_ST = 90112  , GL_SM = 155648;
constexpr int QTS = 136, KTTS = 72, VTS = 72, PS = 72, BS = 129;
constexpr int GL_NG = GL_SM + 2048  , GL_WG = GL_NG + 1024  ;
static_assert(GL_WG + 4096 <= MISC_OFF, "GLA LDS map (unit constants)");
static_assert(GL_SM + 2560 <= MISC_OFF, "GLA LDS map");

#define GL_BAR() do { asm volatile("s_waitcnt lgkmcnt(0)" ::: "memory"); __builtin_amdgcn_s_barrier(); asm volatile("" ::: "memory"); __builtin_amdgcn_sched_barrier(0); } while (0)
template <int MODE>
__device__ __forceinline__ void gla_phase(Frame& F, const float* wgu, const float* bgate, const float* normg) {
    const bf16* QKVR = (const bf16*)(F.ws + WS_S0 + S_QKVR); const float* Z = (const float*)(F.ws + WS_Z);
    float* KVS = (float*)(F.ws + WS_S0 + S_KVS); const float* SST = (const float*)(F.ws + WS_S0 + S_SST); float* DEC = (float*)(F.ws + WS_S0 + S_DEC);
    bf16* O = (bf16*)(F.ws + WS_S0 + S_O);
    float* XB = (float*)(F.ws + WS_S0 + S_XB); float* EMF = (float*)(F.ws + WS_S0 + S_EMF);
    LAS bf16* QT = (LAS bf16*)(F.lds + GL_QT); LAS bf16* KT = (LAS bf16*)(F.lds + GL_KT); LAS bf16* PP = (LAS bf16*)(F.lds + GL_KT);
    LAS bf16* KTT = (LAS bf16*)(F.lds + GL_KTT); LAS bf16* VT = (LAS bf16*)(F.lds + GL_VT); LAS unsigned char* ST = F.lds + GL_ST;
    LAS float* Bc = (LAS float*)(F.lds + GL_ST); LAS float* ZC = (LAS float*)(F.lds + GL_ST + 36864); LAS float* TOT = (LAS float*)(F.lds + GL_ST + 40960); LAS float* OFFM = (LAS float*)(F.lds + GL_ST + 43520);
    LAS float* em = (LAS float*)(F.lds + GL_SM); LAS float* ef = em + 128; LAS float* stats = ef + 128;
    LAS float* NGL = (LAS float*)(F.lds + GL_NG); LAS bf16* WGL = (LAS bf16*)(F.lds + GL_WG);
    const int tid0 = F.tid;
#ifdef MK_GLA_SEG
    int glt_cur = -1; unsigned long long glt_t = 0ull;
#define GLT(n) do { if (MODE == (MK_GLA_MODE)) { const unsigned long long t_ = __builtin_amdgcn_s_memrealtime(); if (glt_cur == (MK_GLA_SEG)) F.dbg_acc += t_ - glt_t; glt_cur = (n); glt_t = t_; } } while (0)
#else
#define GLT(n)
#endif
    for (int u = F.bx; u < NGU; u += F.G) {
        const bool meta = u >= BATCH * GH * NSC_BH;
        const int h = meta ? u - BATCH * GH * NSC_BH : (u / NSC_BH) % GH, b = meta ? 0 : u / (GH * NSC_BH), sc = meta ? 0 : u % NSC_BH;
        const int nch = meta ? 1 : CPS;
        f32x4 sacc[8][2];
        int lofs = (4 * ((tid0 & 63) >> 4)) * GDV + 32 * (tid0 >> 6) + (tid0 & 15); asm volatile("" : "+v"(lofs));
#pragma unroll
        for (int dt = 0; dt < 8; ++dt)
#pragma unroll
            for (int i = 0; i < 2; ++i) {
                sacc[dt][i] = (f32x4){0.f, 0.f, 0.f, 0.f};
                if (MODE == 1 && !meta) {
#pragma unroll
                    for (int jj = 0; jj < 4; ++jj) sacc[dt][i][jj] = SST[(size_t)u * (GDK * GDV) + (size_t)((16 * dt + jj) * GDV + 16 * i) + lofs]; }
            }
        float dsum = 0.f;
        if (MODE == 1 && tid0 < 256) NGL[tid0] = normg[h * GDV + tid0];
        for (int i = tid0; i < 16 * GDK; i += NTHR) WGL[i] = (bf16)f2bf(wgu[(size_t)(i >> 7) * GQK + h * GDK + (i & 127)]);
        const float bgv = bgate[h * GDK + (tid0 & 127)];
        f32x4 px[4] = {(f32x4){0.f, 0.f, 0.f, 0.f}, (f32x4){0.f, 0.f, 0.f, 0.f}, (f32x4){0.f, 0.f, 0.f, 0.f}, (f32x4){0.f, 0.f, 0.f, 0.f}}; float pem = 0.f, pef = 0.f;
        f32x4 pz = (f32x4){0.f, 0.f, 0.f, 0.f}; v4u pq0 = (v4u){0u, 0u, 0u, 0u}, pq1 = pq0, pk0 = pq0, pk1 = pq0, pv[4] = {pq0, pq0, pq0, pq0};
#define GLA_PREFETCH(cix) do { const int rb_ = meta ? 0 : b * SEQ + (sc * CPS + (cix)) * 64; \
            const size_t chx_ = meta ? (size_t)(BATCH * GH * (SEQ / 64) + h) : (size_t)((b * GH + h) * (SEQ / 64) + sc * CPS + (cix)); \
            if (MODE == 1) { const float* xp_ = XB + chx_ * (64 * GDK) + (size_t)tid0 * 16; \
              _Pragma("unroll") for (int t_ = 0; t_ < 4; ++t_) px[t_] = *(const f32x4*)(xp_ + 4 * t_); \
              if (tid0 < 128) { pem = EMF[chx_ * 256 + tid0]; pef = EMF[chx_ * 256 + 128 + tid0]; } } \
            { const int c_ = tid0 >> 2, part_ = tid0 & 3; const bool ok_ = (tid0 < 256) && (!meta || c_ >= 48); const int row_ = meta ? MMAIN + c_ - 48 : rb_ + c_; \
              pz = (f32x4){0.f, 0.f, 0.f, 0.f}; if (MODE == 0 && ok_) pz = *(const f32x4*)(Z + (size_t)row_ * 16 + 4 * part_); } \
            { const int cC_ = tid0 & 63, g_ = tid0 >> 6; const bool ok_ = !meta || cC_ >= 48; const int row_ = meta ? MMAIN + cC_ - 48 : rb_ + cC_; const bf16* rp_ = QKVR + (size_t)row_ * NGLA; \
              pq0 = (v4u){0u, 0u, 0u, 0u}; pq1 = pq0; pk0 = pq0; pk1 = pq0; pv[0] = pq0; pv[1] = pq0; pv[2] = pq0; pv[3] = pq0; \
              if (ok_) { if (MODE == 1) { pq0 = *(const v4u*)(rp_ + h * GDK + g_ * 16); pq1 = *(const v4u*)(rp_ + h * GDK + g_ * 16 + 8); } \
                  pk0 = *(const v4u*)(rp_ + GQK + h * GDK + g_ * 16); pk1 = *(const v4u*)(rp_ + GQK + h * GDK + g_ * 16 + 8); \
                  _Pragma("unroll") for (int t_ = 0; t_ < 4; ++t_) pv[t_] = *(const v4u*)(rp_ + 2 * GQK + h * GDV + g_ * 32 + 8 * t_); } } } while (0)
        GLA_PREFETCH(0);
        for (int ci = 0; ci < nch; ++ci) {
            int tid = tid0; asm volatile("" : "+v"(tid));
            const int lane = tid & 63, w = __builtin_amdgcn_readfirstlane(tid >> 6), fr = lane & 15, fq = lane >> 4;
            const int rbase = meta ? 0 : b * SEQ + (sc * CPS + ci) * 64;
            GLT(0);
            const int dA = tid & 127, cgp = tid >> 7;
            const int cC = tid & 63, grp = tid >> 6, d0 = grp * 16, e0 = grp * 32;
            const v4u q0 = pq0, q1 = pq1, k0 = pk0, k1 = pk1, vv[4] = {pv[0], pv[1], pv[2], pv[3]};
            const size_t chx = meta ? (size_t)(BATCH * GH * (SEQ / 64) + h) : (size_t)((b * GH + h) * (SEQ / 64) + sc * CPS + ci);
            f32x4 xr4[4] = {px[0], px[1], px[2], px[3]};
            if (MODE == 1) { if (tid < 128) { em[tid] = pem; ef[tid] = pef; } }
            if (MODE == 0) {
            if (tid < 256) *(LAS f32x4*)(ZC + (tid >> 2) * 16 + 4 * (tid & 3)) = pz;
            GL_BAR();
            float wg[16];
#pragma unroll
            for (int i = 0; i < 16; ++i) wg[i] = bf2f(WGL[i * GDK + dA]);
            { float run = 0.f;
#pragma unroll 4
              for (int cc = 0; cc < 16; ++cc) { const int c = cgp * 16 + cc; float lg = bgv;
#pragma unroll
                for (int i4 = 0; i4 < 4; ++i4) { const f32x4 z4 = *(const LAS f32x4*)(ZC + c * 16 + 4 * i4); lg += (z4[0] * wg[4 * i4] + z4[1] * wg[4 * i4 + 1]) + (z4[2] * wg[4 * i4 + 2] + z4[3] * wg[4 * i4 + 3]); }
                float g = (fminf(lg, 0.f) - __logf(1.0f + __expf(-fabsf(lg)))) * (1.0f / 16.0f);
                if (meta && c < 48) g = 0.f;
                run += g; Bc[c * BS + dA] = run; }
              TOT[cgp * 129 + dA] = run; }
            GL_BAR();
            GLT(1);
            if (tid < 128) { const float t0 = TOT[tid], t1 = TOT[129 + tid], t2 = TOT[258 + tid], t3 = TOT[387 + tid];
                const float bm = t0 + Bc[31 * BS + tid], bl = (t0 + t1) + (t2 + t3);
                const float emv_ = __expf(bm), efv_ = __expf(bl - bm); em[tid] = emv_; ef[tid] = efv_; dsum += bl; EMF[chx * 256 + tid] = emv_; EMF[chx * 256 + 128 + tid] = efv_;
                OFFM[tid] = -bm; OFFM[129 + tid] = t0 - bm; OFFM[258 + tid] = t0 + t1 - bm; OFFM[387 + tid] = t0 + t1 + t2 - bm; }
            GL_BAR();
            }
            GLT(2);
            { const int c = cC;
                const unsigned qw[8] = {q0.x, q0.y, q0.z, q0.w, q1.x, q1.y, q1.z, q1.w}, kw[8] = {k0.x, k0.y, k0.z, k0.w, k1.x, k1.y, k1.z, k1.w};
                unsigned qo[8], ko[8];
                const LAS float* bcr = Bc + c * BS + d0; const LAS float* ofr = OFFM + (c >> 4) * 129 + d0;
#pragma unroll
                for (int t = 0; t < 8; ++t) {
                    const int d = d0 + 2 * t;
                    float x0, x1;
                    if (MODE == 0) { x0 = bcr[2 * t] + ofr[2 * t]; x1 = bcr[2 * t + 1] + ofr[2 * t + 1]; xr4[t >> 1][2 * (t & 1)] = x0; xr4[t >> 1][2 * (t & 1) + 1] = x1; }
                    else { x0 = xr4[t >> 1][2 * (t & 1)]; x1 = xr4[t >> 1][2 * (t & 1) + 1]; }
                    const float e0f = __expf(x0), e1f = __expf(x1), r0 = __expf(-x0), r1 = __expf(-x1);
                    const float ka = bflo(kw[t]) * r0, kb = bfhi(kw[t]) * r1;
                    ko[t] = pk2(ka, kb);
                    if (MODE == 1) qo[t] = pk2(bflo(qw[t]) * (0.08838834764831845f * e0f), bfhi(qw[t]) * (0.08838834764831845f * e1f));
                    KTT[(d) * KTTS + c] = (bf16)(ko[t] & 0xffffu); KTT[(d + 1) * KTTS + c] = (bf16)(ko[t] >> 16);
                }
                if (MODE == 0) { float* xp = XB + chx * (64 * GDK) + (size_t)tid * 16;
#pragma unroll
                    for (int t = 0; t < 4; ++t) *(f32x4*)(xp + 4 * t) = xr4[t]; }
                *(LAS v4u*)(KT + c * QTS + d0) = (v4u){ko[0], ko[1], ko[2], ko[3]}; *(LAS v4u*)(KT + c * QTS + d0 + 8) = (v4u){ko[4], ko[5], ko[6], ko[7]};
                if (MODE == 1) { *(LAS v4u*)(QT + c * QTS + d0) = (v4u){qo[0], qo[1], qo[2], qo[3]}; *(LAS v4u*)(QT + c * QTS + d0 + 8) = (v4u){qo[4], qo[5], qo[6], qo[7]}; }
#pragma unroll
                for (int t = 0; t < 4; ++t) { const unsigned vw[4] = {vv[t].x, vv[t].y, vv[t].z, vv[t].w};
#pragma unroll
                    for (int s = 0; s < 4; ++s) { const int e = e0 + 8 * t + 2 * s; VT[e * VTS + c] = (bf16)(vw[s] & 0xffffu); VT[(e + 1) * VTS + c] = (bf16)(vw[s] >> 16); } }
            }
            GL_BAR();
            GLT(3);
            f32x4 pacc[2];
#pragma unroll
            for (int dt = 0; dt < 8; ++dt) { const f32x4 emv = *(const LAS f32x4*)(em + 16 * dt + 4 * fq);
#pragma unroll
                for (int i = 0; i < 2; ++i) { sacc[dt][i] = sacc[dt][i] * emv;
                    if (MODE == 1) { const int e = 32 * w + 16 * i + fr; const int ck = (2 * dt + (fq >> 1)) ^ (e & 15);
                        v2u sw; sw.x = pk2(sacc[dt][i][0], sacc[dt][i][1]); sw.y = pk2(sacc[dt][i][2], sacc[dt][i][3]);
                        *(LAS v2u*)(ST + e * 256 + ck * 16 + (fq & 1) * 8) = sw; } } }
            if (MODE == 1) {
                const int mt = w & 3, ntp = w >> 2;
#pragma unroll
                for (int ii = 0; ii < 2; ++ii) { const int nt = 2 * ntp + ii; pacc[ii] = (f32x4){0.f, 0.f, 0.f, 0.f};
                    if (nt <= mt) {
#pragma unroll
                        for (int ks = 0; ks < 4; ++ks) { const bf16x8 kf = *(const LAS bf16x8*)(KT + (16 * nt + fr) * QTS + 32 * ks + 8 * fq); const bf16x8 qf = *(const LAS bf16x8*)(QT + (16 * mt + fr) * QTS + 32 * ks + 8 * fq);
                            pacc[ii] = __builtin_amdgcn_mfma_f32_16x16x32_bf16(kf, qf, pacc[ii], 0, 0, 0); }
                        if (nt == mt) {
#pragma unroll
                            for (int jj = 0; jj < 4; ++jj) if (4 * fq + jj > fr) pacc[ii][jj] = 0.f; }
                    } }
            }
            GL_BAR();
            if (MODE == 1) { const int mt = w & 3, ntp = w >> 2;
#pragma unroll
                for (int ii = 0; ii < 2; ++ii) { const int nt = 2 * ntp + ii; v2u pw; pw.x = pk2(pacc[ii][0], pacc[ii][1]); pw.y = pk2(pacc[ii][2], pacc[ii][3]);
                    *(LAS v2u*)(PP + (16 * mt + fr) * PS + 16 * nt + 4 * fq) = pw; }
                GL_BAR();
            }
            GLT(4);
            f32x4 oacc[8];
            v2u rr[8];
            if (MODE == 1) { const int cF = 16 * (w & 3) + fr; const bool validF = !meta || cF >= 48; const int rowF = meta ? MMAIN + cF - 48 : rbase + cF;
#pragma unroll
                for (int t = 0; t < 8; ++t) { rr[t] = (v2u){0u, 0u}; if (validF) rr[t] = *(const v2u*)(QKVR + (size_t)rowF * NGLA + 2 * GQK + GVD + h * GDV + 128 * (w >> 2) + 16 * t + 4 * fq); } }
            if (MODE == 1) { const int mt = w & 3, eh = w >> 2;
                bf16x8 pf[2], qf[4];
#pragma unroll
                for (int ks = 0; ks < 2; ++ks) pf[ks] = *(const LAS bf16x8*)(PP + (16 * mt + fr) * PS + 32 * ks + 8 * fq);
#pragma unroll
                for (int ks = 0; ks < 4; ++ks) qf[ks] = *(const LAS bf16x8*)(QT + (16 * mt + fr) * QTS + 32 * ks + 8 * fq);
#pragma unroll
                for (int t = 0; t < 8; ++t) { const int e = 128 * eh + 16 * t + fr; f32x4 a = (f32x4){0.f, 0.f, 0.f, 0.f};
#pragma unroll
                    for (int ks = 0; ks < 2; ++ks) { const bf16x8 vf = *(const LAS bf16x8*)(VT + e * VTS + 32 * ks + 8 * fq); a = __builtin_amdgcn_mfma_f32_16x16x32_bf16(vf, pf[ks], a, 0, 0, 0); }
#pragma unroll
                    for (int ks = 0; ks < 4; ++ks) { const int ck = (4 * ks + fq) ^ (e & 15); const bf16x8 sf = *(const LAS bf16x8*)(ST + e * 256 + ck * 16); a = __builtin_amdgcn_mfma_f32_16x16x32_bf16(sf, qf[ks], a, 0, 0, 0); }
                    oacc[t] = a; }
            }
            { bf16x8 vf[2][2];
#pragma unroll
              for (int i = 0; i < 2; ++i)
#pragma unroll
                  for (int ks = 0; ks < 2; ++ks) vf[i][ks] = *(const LAS bf16x8*)(VT + (32 * w + 16 * i + fr) * VTS + 32 * ks + 8 * fq);
#pragma unroll
              for (int dt = 0; dt < 8; ++dt) { const f32x4 efv = *(const LAS f32x4*)(ef + 16 * dt + 4 * fq);
#pragma unroll
                  for (int ks = 0; ks < 2; ++ks) { const bf16x8 kf = *(const LAS bf16x8*)(KTT + (16 * dt + fr) * KTTS + 32 * ks + 8 * fq);
#pragma unroll
                      for (int i = 0; i < 2; ++i) sacc[dt][i] = __builtin_amdgcn_mfma_f32_16x16x32_bf16(kf, vf[i][ks], sacc[dt][i], 0, 0, 0); }
#pragma unroll
                  for (int i = 0; i < 2; ++i) sacc[dt][i] = sacc[dt][i] * efv; }
            }
            if (ci + 1 < nch) GLA_PREFETCH(ci + 1);
            GLT(5);
            if (MODE == 1) { const int mt = w & 3, eh = w >> 2, c = 16 * mt + fr;
                float s1 = 0.f, s2 = 0.f;
#pragma unroll
                for (int t = 0; t < 8; ++t)
#pragma unroll
                    for (int jj = 0; jj < 4; ++jj) { s1 += oacc[t][jj]; s2 += oacc[t][jj] * oacc[t][jj]; }
                s1 += shx(s1, 16, lane); s1 += shx(s1, 32, lane); s2 += shx(s2, 16, lane); s2 += shx(s2, 32, lane);
                if (fq == 0) { stats[(c * 2 + eh) * 2 + 0] = s1; stats[(c * 2 + eh) * 2 + 1] = s2; }
                GL_BAR();
                const float t1 = stats[(c * 2 + 0) * 2 + 0] + stats[(c * 2 + 1) * 2 + 0], t2 = stats[(c * 2 + 0) * 2 + 1] + stats[(c * 2 + 1) * 2 + 1];
                float inv_dv = 1.0f / GDV; asm volatile("" : "+v"(inv_dv));
                const float mean = t1 * inv_dv, var = fmaxf(t2 * inv_dv - mean * mean, 0.f), rstd = __builtin_amdgcn_rsqf(var + LN_EPS);
                const bool valid = !meta || c >= 48; const int row = meta ? MMAIN + c - 48 : rbase + c;
                if (valid) {
#pragma unroll
                    for (int t = 0; t < 8; ++t) { const int e = 128 * eh + 16 * t + 4 * fq;
                        const v2u rw = rr[t];
                        const f32x4 ng = *(const LAS f32x4*)(NGL + e);
                        const float r4[4] = {bflo(rw.x), bfhi(rw.x), bflo(rw.y), bfhi(rw.y)}; float o4[4];
#pragma unroll
                        for (int jj = 0; jj < 4; ++jj) o4[jj] = (oacc[t][jj] - mean) * rstd * ng[jj] * silu_f(r4[jj]);
                        v2u ow; ow.x = pk2(o4[0], o4[1]); ow.y = pk2(o4[2], o4[3]);
                        *(v2u*)(O + (size_t)row * D + h * GDV + e) = ow; } }
            }
            GL_BAR();
            GLT(6);
        }
        if (MODE == 0) {
            int lofs2 = (4 * ((tid0 & 63) >> 4)) * GDV + 32 * (tid0 >> 6) + (tid0 & 15); asm volatile("" : "+v"(lofs2));
#pragma unroll
            for (int dt = 0; dt < 8; ++dt)
#pragma unroll
                for (int i = 0; i < 2; ++i)
#pragma unroll
                    for (int jj = 0; jj < 4; ++jj) KVS[(size_t)u * (GDK * GDV) + (size_t)((16 * dt + jj) * GDV + 16 * i) + lofs2] = sacc[dt][i][jj];
            if (tid0 < 128) DEC[(size_t)u * GDK + tid0] = dsum;
        }
    }
}
__device__ __forceinline__ void gla_scan_phase(Frame& F) {
    const float* KVS = (const float*)(F.ws + WS_S0 + S_KVS); float* SST = (float*)(F.ws + WS_S0 + S_SST); const float* DEC = (const float*)(F.ws + WS_S0 + S_DEC);
    constexpr int NEL = GDK * GDV;
    for (int idx = F.bx * NTHR + F.tid; idx < BATCH * GH * NEL; idx += F.G * NTHR) {
        const int bh = idx / NEL, el = idx - bh * NEL, d = el / GDV, h = bh % GH;
        float s = KVS[(size_t)(BATCH * GH * NSC_BH + h) * NEL + el];
        const size_t ub = (size_t)bh * NSC_BH;
        SST[ub * NEL + el] = s;
        for (int sc = 0; sc + 1 < NSC_BH; sc += 7) { float dv[7], kv[7];
#pragma unroll
            for (int t = 0; t < 7; ++t) { const int q = (sc + t + 1 < NSC_BH) ? sc + t : NSC_BH - 2; dv[t] = DEC[(ub + q) * GDK + d]; kv[t] = KVS[(ub + q) * NEL + el]; }
#pragma unroll
            for (int t = 0; t < 7; ++t) if (sc + t + 1 < NSC_BH) { s = __expf(dv[t]) * s + kv[t]; SST[(ub + sc + t + 1) * NEL + el] = s; } }
    }
}

#define GLA_PHASES \
        if (IN(pb + 10)) { if (on_gla) { \
            bf16* QKVR = (bf16*)(F.ws + WS_S0 + S_QKVR); EpiBf16Gelu E{QKVR, NGLA, 0}; \
            meta_gemm(F, HB + (size_t)MMAIN * D, D, D, (const bf16*)(wl + WL_GLAIN), NGLA / 16, E); \
            pg8::Gemm g{D, D}; pg8::DenseOrder S; S.init(HB, D, (const bf16*)(wl + WL_GLAIN), D, MMAIN / 256, NGLA / 256, F.G, F.bx); \
            pg8::gemm_phase<EpiBf16Gelu, pg8::DenseOrder>(F.lds, F.tid, g, S, E); } \
            SEAM(pb + 10); } \
        if (IN(pb + 11)) { if (on_gla) gla_phase<0>(F, args.in[12] + (size_t)j * GRANK * GQK, args.in[13] + (size_t)j * GQK, args.in[14] + (size_t)j * GVD); SEAM(pb + 11); } \
        if (IN(pb + 12)) { if (on_gla) gla_scan_phase(F); SEAM(pb + 12); } \
        if (IN(pb + 13)) { if (on_gla) gla_phase<1>(F, args.in[12] + (size_t)j * GRANK * GQK, args.in[13] + (size_t)j * GQK, args.in[14] + (size_t)j * GVD); SEAM(pb + 13); } \
        if (IN(pb + 14)) { if (on_gla) { \
            const bf16* O = (const bf16*)(F.ws + WS_S0 + S_O); EpiBf16Gelu E{MIX, D, 0}; \
            meta_gemm(F, O + (size_t)MMAIN * D, D, D, (const bf16*)(wl + WL_GLAOUT), D / 16, E); \
            pg8::Gemm g{D, D}; pg8::DenseOrder S; S.init(O, D, (const bf16*)(wl + WL_GLAOUT), D, MMAIN / 256, D / 256, F.G, F.bx); \
            pg8::gemm_phase<EpiBf16Gelu, pg8::DenseOrder>(F.lds, F.tid, g, S, E); } \
            SEAM(pb + 14); }

__device__ __forceinline__ void moe_panel_ends(const gu32* cnt, int (&pe)[8]) {
    int acc = 0;
#pragma unroll
    for (int e = 0; e < 8; ++e) { const int c = __builtin_amdgcn_readfirstlane((int)__hip_atomic_load(cnt + e, RLX_AGENT)); acc += (c + 255) >> 8; pe[e] = acc; }
}
__device__ __forceinline__ void moe_gather_phase(Frame& F, gu32* moe) {
    const bf16* HB = (const bf16*)(F.ws + WS_HB); bf16* AS = (bf16*)(F.ws + WS_S0 + S_AS);
    const int* E1 = (const int*)(F.ws + WS_RT); const int* E2 = E1 + MROWS; int* POS1 = (int*)(F.ws + WS_RT) + 4 * MROWS; int* POS2 = POS1 + MROWS;
    LAS unsigned* lcnt = (LAS unsigned*)F.lds; LAS unsigned* lbase = lcnt + 8; LAS int* lpos = (LAS int*)(F.lds + 256);
    const int per = (MROWS + F.G - 1) / F.G, t0 = F.bx * per, nt = (t0 + per <= MROWS) ? per : (MROWS - t0 > 0 ? MROWS - t0 : 0);
    if (F.tid < 8) lcnt[F.tid] = 0u;
    __syncthreads();
    int e1 = 0, e2 = 0; unsigned r1 = 0, r2 = 0;
    if (F.tid < nt) { e1 = E1[t0 + F.tid]; e2 = E2[t0 + F.tid];
        r1 = __hip_atomic_fetch_add(&lcnt[e1], 1u, __ATOMIC_RELAXED, __HIP_MEMORY_SCOPE_WORKGROUP); r2 = __hip_atomic_fetch_add(&lcnt[e2], 1u, __ATOMIC_RELAXED, __HIP_MEMORY_SCOPE_WORKGROUP); }
    __syncthreads();
    if (F.tid < 8) { int ps = 0, accp = 0;
#pragma unroll
        for (int e = 0; e < 8; ++e) { ps = (e == F.tid) ? accp : ps; accp += ((int)__hip_atomic_load(moe + e, RLX_AGENT) + 255) >> 8; }
        const unsigned c = lcnt[F.tid]; const unsigned off = c ? __hip_atomic_fetch_add(moe + 64 + F.tid, c, RLX_AGENT) : 0u;
        lbase[F.tid] = (unsigned)ps * 256u + off; }
    __syncthreads();
    if (F.tid < nt) { const int p1 = (int)(lbase[e1] + r1), p2 = (int)(lbase[e2] + r2); POS1[t0 + F.tid] = p1; POS2[t0 + F.tid] = p2; lpos[2 * F.tid] = p1; lpos[2 * F.tid + 1] = p2; }
    __syncthreads();
    for (int t = F.wave; t < nt; t += NWAVES) {
        const v4u* src = (const v4u*)(HB + (size_t)(t0 + t) * D); const v4u a = src[2 * F.lane], b = src[2 * F.lane + 1];
        float x[16]; unpack8(a, x); unpack8(b, x + 8);
        const v4u o = (v4u){pk4_fp8(x[0], x[1], x[2], x[3]), pk4_fp8(x[4], x[5], x[6], x[7]), pk4_fp8(x[8], x[9], x[10], x[11]), pk4_fp8(x[12], x[13], x[14], x[15])};
        unsigned char* AS8 = (unsigned char*)AS;
        *(v4u*)(AS8 + (size_t)lpos[2 * t] * D + 16 * F.lane) = o; *(v4u*)(AS8 + (size_t)lpos[2 * t + 1] * D + 16 * F.lane) = o;
    }
}

#ifdef MK_IDLE_TICKS
#define IDLE_PROBE { const unsigned long long t0_ = __builtin_amdgcn_s_memrealtime(); while (__builtin_amdgcn_s_memrealtime() - t0_ < (unsigned long long)(MK_IDLE_TICKS)) __builtin_amdgcn_s_sleep(64); }
#else
#define IDLE_PROBE
#endif
#define MOE_PHASES \
        if (IN(pb + 16)) { if (on_moe) moe_gather_phase(F, F.ctl + CW_MOE + 256 * j); IDLE_PROBE SEAM(pb + 16); } \
        if (IN(pb + 17)) { if (on_moe) { \
            const bf16* AS = (const bf16*)(F.ws + WS_S0 + S_AS); unsigned char* HS = (unsigned char*)(F.ws + WS_S0 + S_HS); EpiSwigluF8 E{HS, FF, 0.015625f, 8.0f}; \
            pg8::Gemm g{D, D}; pg8::MoeOrder S; moe_panel_ends(F.ctl + CW_MOE + 256 * j, S.pe); S.e_bytes = (size_t)NFF2 * D; \
            S.init(AS, D, (const bf16*)(wl + WL_MOEIN), D, S.pe[7], NFF2 / 256, F.G, F.bx, 1); \
            pg8::gemm_phase<EpiSwigluF8, pg8::MoeOrder, true, true>(F.lds, F.tid, g, S, E); } \
            SEAM(pb + 17); } \
        if (IN(pb + 18)) { if (on_moe) { \
            const unsigned char* HS = (const unsigned char*)(F.ws + WS_S0 + S_HS); EpiBf16Gelu E{(bf16*)(F.ws + WS_S0 + S_YS), D, 0, 1.0f / 2048.0f}; \
            pg8::Gemm g{FF, FF}; pg8::MoeOrder S; moe_panel_ends(F.ctl + CW_MOE + 256 * j, S.pe); S.e_bytes = (size_t)D * FF; \
            S.init(HS, FF, (const bf16*)(wl + WL_MOEOUT), FF, S.pe[7], D / 256, F.G, F.bx, 1); \
            pg8::gemm_phase<EpiBf16Gelu, pg8::MoeOrder, true, true>(F.lds, F.tid, g, S, E); } \
            SEAM(pb + 18); }

constexpr int NPHASE = 41;
#ifndef MK_PER_PHASE
#define MK_PER_PHASE 0
#endif
#ifndef MK_DBG
#define MK_DBG 0
#endif
#ifndef MK_SUBMASK
#define MK_SUBMASK 0xFFu
#endif

__global__ void __launch_bounds__(NTHR, 2) fwd(Args args) {
    extern __shared__ __attribute__((aligned(16))) unsigned char lds[];
    Frame F;
    F.lds = (LAS unsigned char*)lds; F.ws = args.ws; F.ctl = (gu32*)(args.ws + WS_CTL);
    F.tid = threadIdx.x; F.lane = F.tid & 63; F.wave = __builtin_amdgcn_readfirstlane(F.tid >> 6); F.G = gridDim.x; F.bx = blockIdx.x; F.dbg_acc = 0ull;
    volatile LAS unsigned* MISC = (volatile LAS unsigned*)(F.lds + MISC_OFF);
    if (F.tid < 16) MISC[F.tid] = 0u;
    __syncthreads();
    const int lo = args.ph_lo, hi = args.ph_hi;
    XcdBarrier bar; bar.bar = (unsigned*)(F.ctl + CW_BAR); bar.x = 0; bar.st = nullptr;
    if (hi - lo > 1) bar = xcd_barrier_post((unsigned*)(F.ctl + CW_BAR), MISC);
#ifndef MK_STAMP_BARMASK
#define MK_STAMP_BARMASK 0xFFFFFu
#endif
#ifdef MK_STAMP_MASK
    unsigned long long st_acc = 0ull, st_t0 = 0ull;
#define ST_SEL(k) ((k) == 0 ? (((MK_STAMP_MASK) >> 20) & 1u) : ((((MK_STAMP_MASK) >> (((k) - 1) % 20)) & 1u)))
#define IN(k) (lo <= (k) && (k) < hi && (F.fresh(), st_t0 = __builtin_amdgcn_s_memrealtime(), true))
#define SEAM(k) do { const unsigned long long t1_ = __builtin_amdgcn_s_memrealtime(); if (ST_SEL(k)) st_acc += t1_ - st_t0; if ((k) + 1 < hi) xcd_barrier(bar); if ((((MK_STAMP_MASK) >> 21) & 1u) && ((k) == 0 || (((MK_STAMP_BARMASK) >> (((k) - 1) % 20)) & 1u))) st_acc += __builtin_amdgcn_s_memrealtime() - t1_; } while (0)
#else
#define IN(k) (lo <= (k) && (k) < hi && (F.fresh(), true))
#define SEAM(k) do { if ((k) + 1 < hi) xcd_barrier(bar); } while (0)
#endif
    const unsigned submask = args.submask;
    const float* ln_gain = args.in[2]; const float* ln_bias = args.in[3];
    bf16* HB = (bf16*)(F.ws + WS_HB); bf16* MIX = (bf16*)(F.ws + WS_MIX);

    if (IN(0)) { p0_prologue(F, args); SEAM(0); }

    for (int j = 0; j < 2; ++j) {
        const int pb = 1 + 20 * j;
        unsigned char* wl = F.ws + WS_W + (size_t)j * WL_STRIDE;
        const bool on_rg = (submask >> (4 * j + 0)) & 1u, on_ffn = (submask >> (4 * j + 1)) & 1u, on_gla = (submask >> (4 * j + 2)) & 1u, on_moe = (submask >> (4 * j + 3)) & 1u;
        RG_PHASES
        if (IN(pb + 6)) { ln_phase(F, on_rg ? 1 : 0, ln_gain + (size_t)(2 * j) * 2 * D, ln_bias + (size_t)(2 * j) * 2 * D, 0, nullptr, 0, nullptr, nullptr); SEAM(pb + 6); }
        if (IN(pb + 7)) { if (on_ffn) {
            bf16* HID = (bf16*)(F.ws + WS_S0 + S_HID);
            EpiSwiglu E{HID, FF, 1.0f};
            if (!(MK_DBG & 1)) meta_gemm(F, HB + (size_t)MMAIN * D, D, D, (const bf16*)(wl + WL_FFNIN), (NFF2 / 256) * 8, E);
            pg8::Gemm g{D, D}; pg8::DenseOrder S; S.init(HB, D, (const bf16*)(wl + WL_FFNIN), D, MMAIN / 256, NFF2 / 256, F.G, F.bx);
            if (!(MK_DBG & 2)) pg8::gemm_phase<EpiSwiglu, pg8::DenseOrder>(F.lds, F.tid, g, S, E); }
            SEAM(pb + 7); }
        if (IN(pb + 8)) { if (on_ffn) {
            const bf16* HID = (const bf16*)(F.ws + WS_S0 + S_HID);
            EpiBf16Gelu E{MIX, D, 0};
            if (!(MK_DBG & 4)) meta_gemm(F, HID + (size_t)MMAIN * FF, FF, FF, (const bf16*)(wl + WL_FFNOUT), D / 16, E);
            pg8::Gemm g{FF, FF}; pg8::DenseOrder S; S.init(HID, FF, (const bf16*)(wl + WL_FFNOUT), FF, MMAIN / 256, D / 256, F.G, F.bx);
            if (!(MK_DBG & 8)) pg8::gemm_phase<EpiBf16Gelu, pg8::DenseOrder>(F.lds, F.tid, g, S, E); }
            SEAM(pb + 8); }
        if (IN(pb + 9)) { ln_phase(F, on_ffn ? 1 : 0, ln_gain + (size_t)(2 * j) * 2 * D + D, ln_bias + (size_t)(2 * j) * 2 * D + D, 1, args.in[11] + (size_t)j * D * GLAW + NGLA, GLAW, nullptr, nullptr); SEAM(pb + 9); }
        GLA_PHASES
        if (IN(pb + 15)) { ln_phase(F, on_gla ? 1 : 0, ln_gain + (size_t)(2 * j + 1) * 2 * D, ln_bias + (size_t)(2 * j + 1) * 2 * D, on_moe ? 2 : 0, args.in[18] + (size_t)j * D * NE, NE, nullptr, F.ctl + CW_MOE + 256 * j); SEAM(pb + 15); }
        MOE_PHASES
        if (IN(pb + 19)) { ln_phase(F, on_moe ? 2 : 0, ln_gain + (size_t)(2 * j + 1) * 2 * D + D, ln_bias + (size_t)(2 * j + 1) * 2 * D + D, 0, nullptr, 0, j == 1 ? args.out : nullptr, nullptr); SEAM(pb + 19); }
    }
#ifdef MK_STAMP_MASK
    __syncthreads();
    if (blockIdx.x == 0 && threadIdx.x == 0) args.out[0] = (float)(st_acc + F.dbg_acc) * 0.01f * (MK_STAMP_SCALE);
#endif
#undef IN
#undef SEAM
}

static bool phase_enabled(int k, unsigned mask) {
    if (k == 0) return true;
    const int j = (k - 1) / 20, r = (k - 1) % 20;
    int sub;
    if (r <= 5) sub = 0; else if (r == 6) return true; else if (r <= 8) sub = 1; else if (r == 9) return true;
    else if (r <= 14) sub = 2; else if (r == 15) return true; else if (r <= 18) sub = 3; else return true;
    return (mask >> (4 * j + sub)) & 1u;
}
extern "C" void kernel_launch(void* const* d_in, const int* in_sizes, int n_in, void* d_out, int out_size, void* d_ws, size_t ws_size, hipStream_t stream) {
    static int grid = 0;
    if (grid == 0) {
        if (n_in != 21 || out_size != MMAIN * D || ws_size < WS_END) { fprintf(stderr, "kernel_launch: unexpected shapes: n_in %d out %d ws %zu (need %zu); nothing launched\n", n_in, out_size, ws_size, (size_t)WS_END); grid = -1; return; }
        int dev = 0, cus = 0, per_cu = 0;
        if (hipGetDevice(&dev) != hipSuccess || hipDeviceGetAttribute(&cus, hipDeviceAttributeMultiprocessorCount, dev) != hipSuccess) { grid = -1; return; }
        if (hipFuncSetAttribute((const void*)fwd, hipFuncAttributeMaxDynamicSharedMemorySize, LDS_BYTES) != hipSuccess) { fprintf(stderr, "kernel_launch: hipFuncSetAttribute failed\n"); grid = -1; return; }
        if (hipOccupancyMaxActiveBlocksPerMultiprocessor(&per_cu, (const void*)fwd, NTHR, LDS_BYTES) != hipSuccess || per_cu < 1) fprintf(stderr, "kernel_launch: note: occupancy query reports %d\n", per_cu);
        (void)hipGetLastError();
        grid = cus;
    }
    if (grid < 0) return;
    (void)hipMemsetAsync((char*)d_ws + WS_CTL, 0, CTL_ZERO_BYTES, stream);
    Args a{};
    for (int i = 0; i < 21; ++i) a.in[i] = (const float*)d_in[i];
    a.out = (float*)d_out; a.ws = (unsigned char*)d_ws; a.submask = MK_SUBMASK; a.pad = 0;
#if MK_PER_PHASE
    for (int k = 0; k < NPHASE; ++k) { if (!phase_enabled(k, MK_SUBMASK)) continue; a.ph_lo = k; a.ph_hi = k + 1; hipLaunchKernelGGL(fwd, dim3(grid), dim3(NTHR), LDS_BYTES, stream, a); }
#else
    a.ph_lo = 0; a.ph_hi = NPHASE; hipLaunchKernelGGL(fwd, dim3(grid), dim3(NTHR), LDS_BYTES, stream, a);
#ifdef MK_PROBE_LIST
    { const int pl[] = {MK_PROBE_LIST}; for (int k : pl) { a.ph_lo = k; a.ph_hi = k + 1; hipLaunchKernelGGL(fwd, dim3(grid), dim3(NTHR), LDS_BYTES, stream, a); } }
#endif
#endif
}
```
